# Optimizing an MI355X kernel written in HIP

```python
import math
import jax
import jax.numpy as jnp
from jax import lax
import numpy as np

D_MODEL = 1024
BATCH = 32
SEQ = 256
DEPTH = 4
DEC_BATCH = 2
DEC_SEQ = 4096
PAST_LEN = 256

GRID_W = 64
D_MIX = D_MODEL
A_HEADS = 4
A_QK = 64
A_V = 2 * A_QK
A_WIDTH = A_HEADS * A_V
B_HEADS = 4
B_DK = 64
B_DV = 64
B_WIDTH = B_HEADS * B_DV
B_QKV = B_HEADS * (2 * B_DK + B_DV)
C_HEADS = 4
C_DK = 64
C_DV = 64
C_KEYS = C_HEADS * C_DK
C_WIDTH = C_HEADS * C_DV
SHORT_CONV = 3
DELTA_CHUNK = 64
HGRN_CHUNK = 16
Q_BLOCK = 128
ROPE_BASE = 10000.0
D_FF = ((8 * D_MODEL // 3 + 255) // 256) * 256
ALPHA = (2 * DEPTH) ** 0.25
BETA_INIT = (8 * DEPTH) ** -0.25
LN_EPS = 1e-5
RMS_EPS = 1e-6
IN_SPLITS = (A_HEADS * 2 * A_QK, A_HEADS * 2 * A_QK, A_WIDTH,
             B_QKV, B_WIDTH, 2 * B_HEADS, 2 * B_HEADS,
             C_KEYS, 2 * C_KEYS, C_WIDTH, C_WIDTH)
D_IN = sum(IN_SPLITS)

kernel_name = 'hybrid_diff_delta_hgrn2_dit_step'


def _split_points():
    return [int(s) for s in np.cumsum(IN_SPLITS)[:-1]]


def layer_norm(x, g, b):
    xf = x.astype(jnp.float32)
    mu = jnp.mean(xf, -1, keepdims=True)
    var = jnp.mean(jnp.square(xf - mu), -1, keepdims=True)
    return ((xf - mu) * lax.rsqrt(var + LN_EPS) * g.astype(jnp.float32) + b.astype(jnp.float32)).astype(x.dtype)


def rms_norm(x, g):
    xf = x.astype(jnp.float32)
    return (xf * lax.rsqrt(jnp.mean(xf * xf, -1, keepdims=True) + RMS_EPS) * g.astype(jnp.float32)).astype(x.dtype)


def l2norm(x):
    return x * lax.rsqrt(jnp.sum(x * x, -1, keepdims=True) + 1e-6)


def short_conv(x, w):
    return lax.conv_general_dilated(x, w[:, None, :].astype(x.dtype), window_strides=(1,),
                                    padding=[(SHORT_CONV // 2, SHORT_CONV // 2)],
                                    dimension_numbers=('NWC', 'WIO', 'NWC'),
                                    feature_group_count=x.shape[-1])


def axial_rope(x):
    L = x.shape[1]
    n_rows = L // GRID_W
    row = jnp.repeat(jnp.arange(n_rows), GRID_W)
    col = jnp.tile(jnp.arange(GRID_W), n_rows)
    half = A_QK // 2
    nf = half // 2
    inv_freq = ROPE_BASE ** (-jnp.arange(nf, dtype=jnp.float32) / nf)
    bshape = (1, L) + (1,) * (x.ndim - 3) + (nf,)
    xf = x.astype(jnp.float32)

    def rotate(xa, pos):
        ang = pos.astype(jnp.float32)[:, None] * inv_freq
        cos = jnp.cos(ang).reshape(bshape)
        sin = jnp.sin(ang).reshape(bshape)
        x1, x2 = xa[..., :nf], xa[..., nf:]
        return jnp.concatenate([x1 * cos - x2 * sin, x2 * cos + x1 * sin], -1)

    return jnp.concatenate([rotate(xf[..., :half], row), rotate(xf[..., half:], col)], -1).astype(x.dtype)


def diff_attention(q1, q2, k1, k2, v, lam):
    B, Lq, H, d = q1.shape
    nb = Lq // Q_BLOCK
    scale = d ** -0.5
    qs = jnp.moveaxis(jnp.stack([q1, q2]).reshape(2, B, nb, Q_BLOCK, H, d), 2, 0)

    def block(qq):
        s1 = jnp.einsum('bqhd,bkhd->bhqk', qq[0], k1, preferred_element_type=jnp.float32) * scale
        s2 = jnp.einsum('bqhd,bkhd->bhqk', qq[1], k2, preferred_element_type=jnp.float32) * scale
        p = jax.nn.softmax(s1, -1) - lam * jax.nn.softmax(s2, -1)
        return jnp.einsum('bhqk,bkhv->bqhv', p.astype(v.dtype), v)

    out = lax.map(block, qs)
    return jnp.moveaxis(out, 0, 1).reshape(B, Lq, H, v.shape[-1])


def gated_delta_chunked(q, k, v, beta, g, s0):
    B, H, L, dk = q.shape
    dv = v.shape[-1]
    C = DELTA_CHUNK
    N = L // C
    q = q.reshape(B, H, N, C, dk)
    k = k.reshape(B, H, N, C, dk)
    v = v.reshape(B, H, N, C, dv)
    beta = beta.reshape(B, H, N, C)
    b = jnp.cumsum(g.reshape(B, H, N, C), -1)
    causal = jnp.tril(jnp.ones((C, C), bool))
    strict = jnp.tril(jnp.ones((C, C), bool), -1)
    decay = jnp.where(causal, jnp.exp(jnp.where(causal, b[..., :, None] - b[..., None, :], 0.0)), 0.0)
    kb = k * beta[..., None]
    m = jnp.where(strict, jnp.einsum('bhntd,bhnsd->bhnts', kb, k) * decay, 0.0)
    a = m + jnp.eye(C, dtype=q.dtype)
    rhs = jnp.concatenate([v * beta[..., None], kb * jnp.exp(b)[..., None]], -1)
    sol = lax.linalg.triangular_solve(a, rhs, left_side=True, lower=True, unit_diagonal=True)
    u, w = sol[..., :dv], sol[..., dv:]
    qk = jnp.where(causal, jnp.einsum('bhntd,bhnsd->bhnts', q, k) * decay, 0.0)
    b_last = b[..., -1:]
    q_dec = q * jnp.exp(b)[..., None]
    k_dec = k * jnp.exp(b_last - b)[..., None]
    g_last = jnp.exp(b_last[..., 0])
    xs = tuple(jnp.moveaxis(t, 2, 0) for t in (u, w, qk, q_dec, k_dec, g_last))

    def step(S, inp):
        u_n, w_n, qk_n, qd_n, kd_n, gl_n = inp
        v_new = u_n - jnp.einsum('bhcd,bhde->bhce', w_n, S)
        o = jnp.einsum('bhcd,bhde->bhce', qd_n, S) + jnp.einsum('bhts,bhse->bhte', qk_n, v_new)
        S = S * gl_n[..., None, None] + jnp.einsum('bhcd,bhce->bhde', kd_n, v_new)
        return S, o

    S, o = lax.scan(step, s0, xs)
    return jnp.moveaxis(o, 0, 2).reshape(B, H, L, dv), S


def gla_chunked(q, k, v, g, s0):
    B, H, L, dk = q.shape
    dv = v.shape[-1]
    C = HGRN_CHUNK
    N = L // C
    q = q.reshape(B, H, N, C, dk)
    k = k.reshape(B, H, N, C, dk)
    g = g.reshape(B, H, N, C, dk)
    v = v.reshape(B, H, N, C, dv)
    b = jnp.cumsum(g, axis=3)
    causal = jnp.tril(jnp.ones((C, C), bool))[:, :, None]
    diff = b[:, :, :, :, None, :] - b[:, :, :, None, :, :]
    dec = jnp.where(causal, jnp.exp(jnp.where(causal, diff, 0.0)), 0.0)
    attn = jnp.einsum('bhntsd,bhnsd->bhnts', q[:, :, :, :, None, :] * dec, k)
    intra = jnp.einsum('bhnts,bhnse->bhnte', attn, v)
    b_last = b[:, :, :, -1:, :]
    q_dec = q * jnp.exp(b)
    k_dec = k * jnp.exp(b_last - b)
    g_last = jnp.exp(b_last[:, :, :, 0, :])
    xs = tuple(jnp.moveaxis(t, 2, 0) for t in (intra, q_dec, k_dec, v, g_last))

    def step(S, inp):
        intra_n, qd_n, kd_n, v_n, gl_n = inp
        o = intra_n + jnp.einsum('bhcd,bhde->bhce', qd_n, S)
        S = S * gl_n[..., None] + jnp.einsum('bhcd,bhce->bhde', kd_n, v_n)
        return S, o

    S, o = lax.scan(step, s0, xs)
    return jnp.moveaxis(o, 0, 2).reshape(B, H, L, dv), S


def _flip(t):
    return jnp.flip(t, axis=2)


def delta_mixer(qkv, gate, beta_raw, a_raw, conv_w, a_log, dt_bias, norm_g, s0):
    B, L, _ = qkv.shape
    f32 = jnp.float32
    qkv_c = jax.nn.silu(short_conv(qkv, conv_w)).astype(f32)
    q, k, v = jnp.split(qkv_c, [B_HEADS * B_DK, 2 * B_HEADS * B_DK], axis=-1)
    q = l2norm(q.reshape(B, L, B_HEADS, B_DK).transpose(0, 2, 1, 3)) * B_DK ** -0.5
    k = l2norm(k.reshape(B, L, B_HEADS, B_DK).transpose(0, 2, 1, 3))
    v = v.reshape(B, L, B_HEADS, B_DV).transpose(0, 2, 1, 3)
    beta = jax.nn.sigmoid(beta_raw.astype(f32)).reshape(B, L, 2, B_HEADS).transpose(2, 0, 3, 1)
    a = a_raw.astype(f32).reshape(B, L, 2, B_HEADS).transpose(2, 0, 3, 1)
    g = -jnp.exp(a_log.astype(f32))[:, None, :, None] * jax.nn.softplus(a + dt_bias.astype(f32)[:, None, :, None])
    s0 = s0.astype(f32)
    o_f, s_f = gated_delta_chunked(q, k, v, beta[0], g[0], s0[:, 0])
    o_b, s_b = gated_delta_chunked(_flip(q), _flip(k), _flip(v), _flip(beta[1]), _flip(g[1]), s0[:, 1])
    o = (o_f + _flip(o_b)).transpose(0, 2, 1, 3)
    o = rms_norm(o, norm_g) * jax.nn.silu(gate.astype(f32).reshape(B, L, B_HEADS, B_DV))
    return o.reshape(B, L, B_WIDTH).astype(qkv.dtype), jnp.stack([s_f, s_b], 1)


def hgrn_mixer(q_raw, f_raw, i_raw, gate, lb, norm_g, s0):
    B, L, _ = q_raw.shape
    f32 = jnp.float32
    q = jax.nn.silu(q_raw.astype(f32)).reshape(B, L, C_HEADS, C_DK).transpose(0, 2, 1, 3)
    v = i_raw.astype(f32).reshape(B, L, C_HEADS, C_DV).transpose(0, 2, 1, 3)
    lbb = lb.astype(f32)[:, None, None, :]
    forget = lbb + (1.0 - lbb) * jax.nn.sigmoid(f_raw.astype(f32).reshape(B, L, 2, C_KEYS).transpose(2, 0, 1, 3))
    key = (1.0 - forget).reshape(2, B, L, C_HEADS, C_DK).transpose(0, 1, 3, 2, 4)
    g = jnp.log(forget).reshape(2, B, L, C_HEADS, C_DK).transpose(0, 1, 3, 2, 4)
    s0 = s0.astype(f32)
    o_f, s_f = gla_chunked(q, key[0], v, g[0], s0[:, 0])
    o_b, s_b = gla_chunked(_flip(q), _flip(key[1]), _flip(v), _flip(g[1]), s0[:, 1])
    o = (o_f + _flip(o_b)).transpose(0, 2, 1, 3)
    o = rms_norm(o, norm_g) * jax.nn.silu(gate.astype(f32).reshape(B, L, C_HEADS, C_DV))
    return o.reshape(B, L, C_WIDTH).astype(q_raw.dtype), jnp.stack([s_f, s_b], 1)


def token_mixers(z, conv_w, delta_a_log, delta_dt_bias, delta_norm, lb, hgrn_norm, lam, lam_scale, diff_norm, ctx):
    B, L, _ = z.shape
    aq, ak, av, bqkv, bg, bbeta, ba, cq, cf, ci, cg = jnp.split(z, _split_points(), axis=-1)
    aq = aq.reshape(B, L, A_HEADS, 2, A_QK)
    ak = ak.reshape(B, L, A_HEADS, 2, A_QK)
    v = av.reshape(B, L, A_HEADS, A_V)
    if ctx is None:
        k_all, v_all = ak, v
        s0_d = jnp.zeros((B, 2, B_HEADS, B_DK, B_DV), jnp.float32)
        s0_h = jnp.zeros((B, 2, C_HEADS, C_DK, C_DV), jnp.float32)
    else:
        ctx_k, ctx_v, s0_d, s0_h = ctx
        aq = axial_rope(aq)
        k_lat = axial_rope(ak)
        k_all = jnp.concatenate([k_lat, ctx_k.reshape(B, -1, A_HEADS, 2, A_QK).astype(ak.dtype)], 1)
        v_all = jnp.concatenate([v, ctx_v.astype(v.dtype)], 1)
    o_a = diff_attention(aq[..., 0, :], aq[..., 1, :], k_all[..., 0, :], k_all[..., 1, :], v_all, lam)
    o_a = (rms_norm(o_a, diff_norm) * lam_scale).reshape(B, L, A_WIDTH)
    o_b, s_d = delta_mixer(bqkv, bg, bbeta, ba, conv_w, delta_a_log, delta_dt_bias, delta_norm, s0_d)
    o_c, s_h = hgrn_mixer(cq, cf, ci, cg, lb, hgrn_norm, s0_h)
    o = jnp.concatenate([o_a.astype(z.dtype), o_b, o_c], -1)
    return o, ak.reshape(B, L, A_HEADS, 2 * A_QK), v, s_d, s_h


def trunk_layer(x, mod, w_in, w_out, conv_w, delta_a_log, delta_dt_bias, delta_norm, lb, hgrn_norm,
                lam, lam_scale, diff_norm, ln_g, ln_b, w_ffn_in, w_ffn_out, ctx):
    shift_m, scale_m, gate_m, shift_f, scale_f, gate_f = jnp.split(mod.astype(x.dtype), 6, axis=-1)
    z = (x * (1 + scale_m) + shift_m) @ w_in
    o, k_c, v_c, s_d, s_h = token_mixers(z, conv_w, delta_a_log, delta_dt_bias, delta_norm, lb, hgrn_norm,
                                         lam, lam_scale, diff_norm, ctx)
    x = layer_norm(ALPHA * x + gate_m * (o @ w_out), ln_g[0], ln_b[0])
    gt, up = jnp.split((x * (1 + scale_f) + shift_f) @ w_ffn_in, 2, axis=-1)
    x = layer_norm(ALPHA * x + gate_f * ((jax.nn.silu(gt) * up) @ w_ffn_out), ln_g[1], ln_b[1])
    return x, k_c, v_c, s_d, s_h


def setup_inputs(seed: int = 0) -> dict:
    key = jax.random.key(seed)
    ks = jax.random.split(key, 24)
    f32 = jnp.float32

    def nrm(k, shape, s):
        return jax.random.normal(k, shape, f32) * s

    dt = jnp.exp(jax.random.uniform(ks[13], (DEPTH, 2, B_HEADS), f32, math.log(1e-3), math.log(1e-1)))
    return {
        'x_prompt': nrm(ks[0], (BATCH, SEQ, D_MODEL), 1.0),
        'x_sample': nrm(ks[1], (DEC_BATCH, DEC_SEQ, D_MODEL), 1.0),
        'cache_attn_k': nrm(ks[2], (DEC_BATCH, DEPTH, PAST_LEN, A_HEADS, 2 * A_QK), 1.0),
        'cache_attn_v': nrm(ks[3], (DEC_BATCH, DEPTH, PAST_LEN, A_HEADS, A_V), 1.0),
        'state_delta': nrm(ks[4], (DEC_BATCH, DEPTH, 2, B_HEADS, B_DK, B_DV), 0.1),
        'state_hgrn': nrm(ks[5], (DEC_BATCH, DEPTH, 2, C_HEADS, C_DK, C_DV), 0.5),
        'c': nrm(ks[6], (DEC_BATCH, D_MODEL), 1.0),
        'c_ctx': nrm(ks[7], (D_MODEL,), 1.0),
        'w_mod': nrm(ks[8], (DEPTH, D_MODEL, 6 * D_MODEL), D_MODEL ** -0.5),
        'b_mod': nrm(ks[9], (DEPTH, 6 * D_MODEL), 0.02),
        'w_in': nrm(ks[10], (DEPTH, D_MODEL, D_IN), D_MODEL ** -0.5),
        'conv_w': nrm(ks[11], (DEPTH, SHORT_CONV, B_QKV), SHORT_CONV ** -0.5),
        'delta_a_log': jnp.log(jax.random.uniform(ks[12], (DEPTH, 2, B_HEADS), f32, 1.0, 16.0)),
        'delta_dt_bias': dt + jnp.log(-jnp.expm1(-dt)),
        'delta_norm': 1.0 + nrm(ks[14], (DEPTH, B_DV), 0.02),
        'hgrn_lb': 1.0 + nrm(ks[15], (2, DEPTH, C_KEYS), 0.1),
        'hgrn_norm': 1.0 + nrm(ks[16], (DEPTH, C_DV), 0.02),
        'diff_lambda': nrm(ks[17], (DEPTH, 4, A_QK), 0.1),
        'diff_norm': 1.0 + nrm(ks[18], (DEPTH, A_V), 0.02),
        'w_out': nrm(ks[19], (DEPTH, D_MIX, D_MODEL), BETA_INIT * D_MIX ** -0.5),
        'ln_g': 1.0 + nrm(ks[20], (DEPTH, 2, D_MODEL), 0.02),
        'ln_b': nrm(ks[21], (DEPTH, 2, D_MODEL), 0.02),
        'w_ffn_in': nrm(ks[22], (DEPTH, D_MODEL, 2 * D_FF), D_MODEL ** -0.5),
        'w_ffn_out': nrm(ks[23], (DEPTH, D_FF, D_MODEL), BETA_INIT * D_FF ** -0.5),
    }


def reference(x_prompt, x_sample, cache_attn_k, cache_attn_v, state_delta, state_hgrn, c, c_ctx,
              w_mod, b_mod, w_in, conv_w, delta_a_log, delta_dt_bias, delta_norm, hgrn_lb, hgrn_norm,
              diff_lambda, diff_norm, w_out, ln_g, ln_b, w_ffn_in, w_ffn_out):
    f32 = jnp.float32
    lb_soft = jax.nn.softmax(hgrn_lb.astype(f32), axis=1)
    lb_all = jnp.cumsum(lb_soft, axis=1) - lb_soft[:, :1]
    c_silu = jax.nn.silu(c)
    cctx_silu = jax.nn.silu(c_ctx)
    xp, xs = x_prompt, x_sample
    new_k, new_v, new_sd, new_sh = [], [], [], []
    for l in range(DEPTH):
        lam_init = 0.8 - 0.6 * math.exp(-0.3 * l)
        dl = diff_lambda[l].astype(f32)
        lam = jnp.exp(jnp.sum(dl[0] * dl[1])) - jnp.exp(jnp.sum(dl[2] * dl[3])) + lam_init
        mod_p = (cctx_silu @ w_mod[l] + b_mod[l])[None, None, :]
        mod_s = (c_silu @ w_mod[l] + b_mod[l])[:, None, :]
        shared = (w_in[l], w_out[l], conv_w[l], delta_a_log[l], delta_dt_bias[l], delta_norm[l], lb_all[:, l],
                  hgrn_norm[l], lam, 1.0 - lam_init, diff_norm[l], ln_g[l], ln_b[l], w_ffn_in[l], w_ffn_out[l])
        xp, k_c, v_c, s_d, s_h = trunk_layer(xp, mod_p, *shared, None)
        xs, _, _, _, _ = trunk_layer(xs, mod_s, *shared,
                                     (cache_attn_k[:, l], cache_attn_v[:, l], state_delta[:, l], state_hgrn[:, l]))
        new_k.append(k_c)
        new_v.append(v_c)
        new_sd.append(s_d)
        new_sh.append(s_h)
    return (xp, xs, jnp.stack(new_k, 1), jnp.stack(new_v, 1), jnp.stack(new_sd, 1), jnp.stack(new_sh, 1))
```

```cpp
#include <hip/hip_runtime.h>
#include <hip/hip_cooperative_groups.h>
#include <cstdio>
#include <cstdint>
namespace cg = cooperative_groups;

#define PHON(k) ((PHM_ >> (k)) & 1)
#ifndef MK_ONE_LAUNCH
#define MK_ONE_LAUNCH 1
#endif

#define DI __device__ __forceinline__
#define LAS __attribute__((address_space(3)))
typedef unsigned short bf16_t;
typedef short bf16x8 __attribute__((ext_vector_type(8)));
typedef short s16x4 __attribute__((ext_vector_type(4)));
typedef float f32x4 __attribute__((ext_vector_type(4)));
typedef float f32x16 __attribute__((ext_vector_type(16)));
typedef float f32x2 __attribute__((ext_vector_type(2)));
typedef unsigned u32x4 __attribute__((ext_vector_type(4)));
typedef unsigned u32x2 __attribute__((ext_vector_type(2)));

constexpr int MROWS = 16384, DM = 1024, DEPTH = 4, DFF = 2816, DIN = 3856, ZLD = 2320;
constexpr float ALPHA = 1.681792830507429f, LN_EPS = 1e-5f, RMS_EPS = 1e-6f;
constexpr float QSCALE = 0.125f * 1.4426950408889634f;
constexpr int ZB_BQ = 0, ZB_BK = 256, ZB_BV = 512, ZB_BG = 768, ZB_BBETA = 1024, ZB_BA = 1032, ZB_CQ = 1040, ZB_CF = 1296, ZB_CI = 1808, ZB_CG = 2064;
constexpr size_t OUT_K = 16777216, OUT_V = 33554432, OUT_SD = 50331648, OUT_SH = 54525952;
constexpr size_t MiB = 1u << 20;
constexpr size_t WS_CTL = 0, WS_MOD = 64 * 1024, WS_TAB = 512 * 1024, WS_CK = 1 * MiB, WS_CV = 3 * MiB, WS_W = 8 * MiB, WBUF = 27 * MiB;
constexpr size_t W_IN = 0, W_OUT = 8 * MiB, W_FFI = 10 * MiB, W_FFO = 21 * MiB;
constexpr size_t WS_XM = 62 * MiB, WS_O = 94 * MiB, WS_ZB = 126 * MiB, WS_Q = 199 * MiB, WS_K = 215 * MiB, WS_V = 231 * MiB;
constexpr size_t WS_ACT = 126 * MiB;
constexpr size_t WS_DPW = 247 * MiB, WS_DPQD = 263 * MiB, WS_DPQK = 279 * MiB, WS_DPKD = 295 * MiB;
constexpr size_t WS_DPU = WS_XM;
constexpr size_t WS_OD = 311 * MiB, WS_HS = 343 * MiB, WS_HD = 375 * MiB, WS_GL = 375 * MiB + 512 * 1024, WS_END = 376 * MiB;
constexpr int LDS_BYTES = 147456;
constexpr int NPHASE = 2 + 9 * DEPTH;

struct Params { const float* in[24]; float* out; unsigned char* ws; int ph_lo, ph_hi; };

DI unsigned cvt_pk_bf16(float lo, float hi) { unsigned r; asm volatile("v_cvt_pk_bf16_f32 %0, %1, %2" : "=v"(r) : "v"(lo), "v"(hi)); return r; }
DI bf16_t f2bf(float f) { return (bf16_t)(cvt_pk_bf16(f, 0.f) & 0xffffu); }
DI float bf2f(bf16_t b) { return __uint_as_float(((unsigned)b) << 16); }
DI float sigmoidf_(float x) { return 1.0f / (1.0f + __expf(-x)); }
DI float siluf_(float x) { return x / (1.0f + __expf(-x)); }
DI float wave_sum(float v) {
#pragma unroll
    for (int o = 1; o < 64; o <<= 1) v += __shfl_xor(v, o);
    return v;
}
DI u32x2 pack4(f32x4 v) { u32x2 w; w.x = cvt_pk_bf16(v[0], v[1]); w.y = cvt_pk_bf16(v[2], v[3]); return w; }
DI bf16x8 pack8(f32x4 a, f32x4 b) { u32x4 w; w.x = cvt_pk_bf16(a[0], a[1]); w.y = cvt_pk_bf16(a[2], a[3]); w.z = cvt_pk_bf16(b[0], b[1]); w.w = cvt_pk_bf16(b[2], b[3]); return __builtin_bit_cast(bf16x8, w); }
DI int pinv(int k) { return (k >> 5) * 32 + ((k >> 2) & 3) * 8 + ((k >> 4) & 1) * 4 + (k & 3); }
DI int row_mod(int r) { return r < 8192 ? 0 : 1 + ((r - 8192) >> 12); }

namespace pg8 {
constexpr int BM = 256, BK = 64, HALF = 128, HTB = HALF * BK * 2, STAGE_BYTES = 8 * HTB, NXCD = 8, WGM = 8;
DI int lds_byte(int r, int c) { const int st = (r >> 4) * 2 + (c >> 5), rr = r & 15, cc = c & 31, ob = rr * 64 + cc * 2; return st * 1024 + (ob ^ (((ob >> 9) & 1) << 5)); }
DI void stage_rc(int b, int& R, int& C) { const int st = b / 1024, sb = b % 1024, swz = sb ^ (((sb >> 9) & 1) << 5); R = (st >> 1) * 16 + swz / 64; C = (st & 1) * 32 + (swz % 64) / 2; }
struct Unit { int pm, pn; };
struct Gemm { const bf16_t* A; const bf16_t* Bt; int M, N, K; };
struct StaticOrder {
    int nM, nN, nwg, G, c;
    DI void init(int M, int N, int G_, int c_) { nM = M / BM; nN = N / BM; nwg = nM * nN; G = G_; c = c_; }
    DI bool next(int i, Unit& u) const {
        const long L = (long)i * G + c; if (L >= nwg) return false;
        int wgid = (int)L; { const int q = nwg / NXCD, r = nwg % NXCD, xcd = wgid % NXCD, off = wgid / NXCD; wgid = (xcd < r ? xcd * (q + 1) : r * (q + 1) + (xcd - r) * q) + off; }
        const int nig = WGM * nN, gid = wgid / nig, fm = gid * WGM, gsz = (nM - fm) < WGM ? (nM - fm) : WGM;
        u.pm = fm + ((wgid % nig) % gsz); u.pn = (wgid % nig) / gsz; return true;
    }
};

template <class Epi>
DI void gemm_phase(LAS unsigned char* lds, const Gemm g, const StaticOrder& S, const Epi& E, int tid_in) {
    const int tid = tid_in, wid = __builtin_amdgcn_readfirstlane(tid >> 6), lane = tid & 63, wr = wid >> 2, wc = wid & 3, fr = lane & 15, fq = lane >> 4;
    const int K = g.K, nt = K / BK;
    unsigned voffA[2];
#pragma unroll
    for (int i = 0; i < 2; ++i) { int R, C; stage_rc(tid * 16 + i * 8192, R, C); voffA[i] = (unsigned)(R * K + C) * 2u; }
    const size_t kstep = (size_t)(BK * 2);
    const size_t hstep = (size_t)HALF * K * 2;
    const size_t tstep = 2 * hstep;
    const unsigned ldsw = (unsigned)wid * 1024u;
    const int aoff = lds_byte(wr * 64 + fr, fq * 8), boff = lds_byte(wc * 32 + fr, fq * 8);
#define PG8_SA(b, h) (((b) * 2 + (h)) * HTB)
#define PG8_SB(b, h) ((4 + (b) * 2 + (h)) * HTB)
#define PG8_STAGE(bufoff, gbase) do { _Pragma("unroll") for (int _i = 0; _i < 2; ++_i) \
        __builtin_amdgcn_global_load_lds((const unsigned*)((const char*)(gbase) + voffA[_i]), (LAS unsigned*)(lds + (bufoff) + ldsw + _i * 8192), 16, 0, 0); } while (0)
#define PG8_LDA(dst, b, h) do { _Pragma("unroll") for (int m = 0; m < 4; ++m) _Pragma("unroll") for (int k = 0; k < 2; ++k) dst[m][k] = *(const LAS bf16x8*)(lds + PG8_SA(b, h) + aoff + m * 2048 + k * 1024); } while (0)
#define PG8_LDB(dst, b, h) do { _Pragma("unroll") for (int n = 0; n < 2; ++n) _Pragma("unroll") for (int k = 0; k < 2; ++k) dst[n][k] = *(const LAS bf16x8*)(lds + PG8_SB(b, h) + boff + n * 2048 + k * 1024); } while (0)
#define PG8_MMA(ai, bj, At, Bt) do { __builtin_amdgcn_s_setprio(1); _Pragma("unroll") for (int m = 0; m < 4; ++m) _Pragma("unroll") for (int n = 0; n < 2; ++n) _Pragma("unroll") for (int k = 0; k < 2; ++k) \
        acc[ai][bj][m][n] = __builtin_amdgcn_mfma_f32_16x16x32_bf16(Bt[n][k], At[m][k], acc[ai][bj][m][n], 0, 0, 0); __builtin_amdgcn_s_setprio(0); } while (0)
#define PG8_WAIT_V(n) asm volatile("s_waitcnt vmcnt(" #n ")" ::: "memory")
#define PG8_WAIT_L(n) asm volatile("s_waitcnt lgkmcnt(" #n ")" ::: "memory")
#define PG8_BAR __builtin_amdgcn_s_barrier()
#define PG8_SCHED __builtin_amdgcn_sched_barrier(0)
    Unit cur, nxt; int ui = 0;
    if (!S.next(0, cur)) return;
    f32x4 acc[2][2][4][2];
#pragma unroll
    for (int a = 0; a < 2; ++a)
#pragma unroll
        for (int b = 0; b < 2; ++b)
#pragma unroll
            for (int m = 0; m < 4; ++m)
#pragma unroll
                for (int n = 0; n < 2; ++n) acc[a][b][m][n] = (f32x4){0.f, 0.f, 0.f, 0.f};
    bf16x8 At[4][2], B0[2][2], B1[2][2];
    const char* cA = (const char*)g.A + (size_t)cur.pm * tstep; const char* cB = (const char*)g.Bt + (size_t)cur.pn * tstep;
    PG8_STAGE(PG8_SB(0, 0), cB); PG8_STAGE(PG8_SB(0, 1), cB + hstep); PG8_STAGE(PG8_SA(0, 0), cA); PG8_STAGE(PG8_SA(0, 1), cA + hstep);
    if (wr == 1) PG8_BAR;
    PG8_WAIT_V(2); PG8_BAR;
    PG8_STAGE(PG8_SB(1, 0), cB + kstep); PG8_STAGE(PG8_SA(1, 0), cA + kstep); PG8_STAGE(PG8_SB(1, 1), cB + hstep + kstep);
    PG8_WAIT_V(6); PG8_BAR;
    for (;;) {
        const bool has_next = S.next(ui + 1, nxt);
        const char* nA = has_next ? (const char*)g.A + (size_t)nxt.pm * tstep : cA; const char* nB = has_next ? (const char*)g.Bt + (size_t)nxt.pn * tstep : cB;
        for (int t = 0; t < nt; t += 2) {
            const bool last = (t == nt - 2);
            const char* a1 = cA + (size_t)(t + 1) * kstep;
            const char* a2 = last ? nA : cA + (size_t)(t + 2) * kstep; const char* b2 = last ? nB : cB + (size_t)(t + 2) * kstep;
            const char* a3 = a2 + kstep; const char* b3 = b2 + kstep;
            PG8_LDB(B0, 0, 0); PG8_LDB(B1, 0, 1); PG8_SCHED; PG8_LDA(At, 0, 0); PG8_STAGE(PG8_SA(1, 1), a1 + hstep);
            PG8_WAIT_V(8); PG8_WAIT_L(0); PG8_BAR; PG8_MMA(0, 0, At, B0); PG8_MMA(0, 1, At, B1); PG8_BAR; PG8_SCHED;
            PG8_LDA(At, 0, 1); PG8_STAGE(PG8_SB(0, 0), b2); PG8_STAGE(PG8_SB(0, 1), b2 + hstep); PG8_STAGE(PG8_SA(0, 0), a2);
            PG8_WAIT_V(8); PG8_WAIT_L(0); PG8_BAR; PG8_MMA(1, 0, At, B0); PG8_MMA(1, 1, At, B1); PG8_BAR; PG8_SCHED;
            PG8_LDB(B0, 1, 0); PG8_LDB(B1, 1, 1); PG8_SCHED; PG8_LDA(At, 1, 0); PG8_STAGE(PG8_SA(0, 1), a2 + hstep);
            PG8_WAIT_V(8); PG8_WAIT_L(0); PG8_BAR; PG8_MMA(0, 0, At, B0); PG8_MMA(0, 1, At, B1); PG8_BAR; PG8_SCHED;
            PG8_LDA(At, 1, 1); PG8_STAGE(PG8_SB(1, 0), b3); PG8_STAGE(PG8_SB(1, 1), b3 + hstep); PG8_STAGE(PG8_SA(1, 0), a3);
            PG8_WAIT_V(8); PG8_WAIT_L(0); PG8_BAR; PG8_MMA(1, 0, At, B0); PG8_MMA(1, 1, At, B1); PG8_BAR; PG8_SCHED;
        }
        if (wr == 0) PG8_BAR;
        E(acc, cur, wr, wc, fr, fq);
        if (!has_next) break;
#pragma unroll
        for (int a = 0; a < 2; ++a)
#pragma unroll
            for (int b = 0; b < 2; ++b)
#pragma unroll
                for (int m = 0; m < 4; ++m)
#pragma unroll
                    for (int n = 0; n < 2; ++n) acc[a][b][m][n] = (f32x4){0.f, 0.f, 0.f, 0.f};
        cur = nxt; cA = nA; cB = nB; ++ui;
        if (wr == 1) PG8_BAR;
    }
    PG8_WAIT_V(0);
    PG8_BAR;
#undef PG8_SA
#undef PG8_SB
#undef PG8_STAGE
#undef PG8_LDA
#undef PG8_LDB
#undef PG8_MMA
#undef PG8_WAIT_V
#undef PG8_WAIT_L
#undef PG8_BAR
#undef PG8_SCHED
}
}

struct EpiIn {
    bf16_t *Qb, *Kb, *Vb, *zb; float *outK, *outV; const f32x2* rope; int layer;
    DI void operator()(const f32x4 (&acc)[2][2][4][2], const pg8::Unit& u, int wr, int wc, int fr, int fq) const {
        const int tile = u.pn; const bool sample = u.pm >= 32;
        if (tile < 6) {
            const int kind = tile >> 1; const int cb = (tile & 1) * 256 + wc * 32 + 4 * fq;
            bf16_t* dst = Qb + (size_t)kind * (16u * 1024u * 1024u / 2u);
            float* of = outK + (size_t)(kind >= 1 ? kind - 1 : 0) * 16777216u;
#pragma unroll
            for (int ai = 0; ai < 2; ++ai)
#pragma unroll
                for (int m = 0; m < 4; ++m) {
                    const int r = u.pm * 256 + ai * 128 + wr * 64 + m * 16 + fr;
#pragma unroll
                    for (int bj = 0; bj < 2; ++bj) {
                        f32x4 a = acc[ai][bj][m][0], b = acc[ai][bj][m][1]; const int cc = cb + bj * 128;
                        if (!sample && kind >= 1) { float* o = of + ((size_t)((r >> 8) * 4 + layer) * 256 + (r & 255)) * 512 + cc; *(f32x4*)o = a; *(f32x4*)(o + 16) = b; }
                        if (sample && kind < 2) {
                            const int t = (r - 8192) & 4095; const int pos = (wc & 1) ? (t & 63) : (t >> 6); const f32x2* rp = rope + pos * 16 + 4 * fq;
#pragma unroll
                            for (int j = 0; j < 4; ++j) { const f32x2 cs = rp[j]; const float x1 = a[j], x2 = b[j]; a[j] = x1 * cs.x - x2 * cs.y; b[j] = x2 * cs.x + x1 * cs.y; }
                        }
                        if (kind == 0) { a = a * QSCALE; b = b * QSCALE; }
                        *(u32x2*)(dst + (size_t)r * 512 + cc) = pack4(a); *(u32x2*)(dst + (size_t)r * 512 + cc + 16) = pack4(b);
                    }
                    asm volatile("" ::: "memory");
                }
        } else {
#pragma unroll
            for (int ai = 0; ai < 2; ++ai)
#pragma unroll
                for (int m = 0; m < 4; ++m) {
                    const int r = u.pm * 256 + ai * 128 + wr * 64 + m * 16 + fr;
#pragma unroll
                    for (int bj = 0; bj < 2; ++bj)
#pragma unroll
                        for (int n = 0; n < 2; ++n) { const int c = (tile - 6) * 256 + bj * 128 + wc * 32 + 16 * n + 4 * fq; if (c < ZLD) *(u32x2*)(zb + (size_t)r * ZLD + c) = pack4(acc[ai][bj][m][n]); }
                    asm volatile("" ::: "memory");
                }
        }
    }
};
struct EpiRes {
    float* x; const float* gate;
    DI void operator()(const f32x4 (&acc)[2][2][4][2], const pg8::Unit& u, int wr, int wc, int fr, int fq) const {
        const float* gv = gate + row_mod(u.pm * 256) * 6144;
#pragma unroll
        for (int ai = 0; ai < 2; ++ai)
#pragma unroll
            for (int m = 0; m < 4; ++m) {
                const int r = u.pm * 256 + ai * 128 + wr * 64 + m * 16 + fr;
#pragma unroll
                for (int bj = 0; bj < 2; ++bj)
#pragma unroll
                    for (int n = 0; n < 2; ++n) { const int c = u.pn * 256 + bj * 128 + wc * 32 + 16 * n + 4 * fq; const f32x4 g4 = *(const f32x4*)(gv + c); float* xp = x + (size_t)r * DM + c; const f32x4 xv = *(const f32x4*)xp; *(f32x4*)xp = xv * ALPHA + g4 * acc[ai][bj][m][n]; }
            }
    }
};
struct EpiFfn {
    bf16_t* act;
    DI void operator()(const f32x4 (&acc)[2][2][4][2], const pg8::Unit& u, int wr, int wc, int fr, int fq) const {
#pragma unroll
        for (int ai = 0; ai < 2; ++ai)
#pragma unroll
            for (int m = 0; m < 4; ++m) {
                const int r = u.pm * 256 + ai * 128 + wr * 64 + m * 16 + fr;
#pragma unroll
                for (int n = 0; n < 2; ++n) { const f32x4 gt = acc[ai][0][m][n], up = acc[ai][1][m][n]; f32x4 o;
#pragma unroll
                    for (int j = 0; j < 4; ++j) o[j] = siluf_(gt[j]) * up[j];
                    *(u32x2*)(act + (size_t)r * DFF + u.pn * 128 + wc * 32 + 16 * n + 4 * fq) = pack4(o); }
            }
    }
};

struct Ctx {
    const Params* p; LAS unsigned char* lds; float* L; int tid, lane, wave, G, gw, NGW;
    unsigned char* ws; float* out;
};

DI void tr_item(const float* W, int K, int N, bf16_t* WT, int mode, float* scr, int item, int lane) {
    const int nblk = (N + 31) / 32, kb = item / nblk, nb = item % nblk, k0 = 64 * kb, n0 = 32 * nb;
    const int nn = n0 + (lane & 31);
#pragma unroll 8
    for (int i = 0; i < 32; ++i) { const int kk = 2 * i + (lane >> 5); scr[kk * 33 + (lane & 31)] = (nn < N) ? W[(size_t)(k0 + kk) * N + nn] : 0.f; }
    __builtin_amdgcn_wave_barrier();
    const int c = lane & 7;
#pragma unroll
    for (int j = 0; j < 4; ++j) {
        const int nl = (lane >> 3) + 8 * j, n = n0 + nl; const float* s = scr + (8 * c) * 33 + nl;
        if (n < N) {
            int dst = n; if (mode == 1) { if (n < DFF) dst = (n >> 7) * 256 + (n & 127); else { const int jj = n - DFF; dst = (jj >> 7) * 256 + 128 + (jj & 127); } }
            u32x4 o; o.x = cvt_pk_bf16(s[0 * 33], s[1 * 33]); o.y = cvt_pk_bf16(s[2 * 33], s[3 * 33]); o.z = cvt_pk_bf16(s[4 * 33], s[5 * 33]); o.w = cvt_pk_bf16(s[6 * 33], s[7 * 33]);
            *(u32x4*)(WT + (size_t)dst * K + k0 + 8 * c) = o;
        }
    }
    __builtin_amdgcn_wave_barrier();
}
DI void convert_layer_weights(const Ctx& C, int layer) {
    const Params& p = *C.p;
    unsigned char* wb = C.ws + WS_W + (size_t)(layer & 1) * WBUF;
    bf16_t* Win = (bf16_t*)(wb + W_IN); bf16_t* Wout = (bf16_t*)(wb + W_OUT); bf16_t* Wffi = (bf16_t*)(wb + W_FFI); bf16_t* Wffo = (bf16_t*)(wb + W_FFO);
    float* scr = C.L + C.wave * (64 * 33);
    constexpr int I_IN = 16 * 121, I_OUT = 16 * 32, I_FFI = 16 * 176, I_FFO = 44 * 32, NIT = I_IN + I_OUT + I_FFI + I_FFO;
    for (int it = C.gw; it < NIT; it += C.NGW) {
        int r = it;
        if (r < I_IN) { tr_item(p.in[10] + (size_t)layer * DM * DIN, DM, DIN, Win, 0, scr, r, C.lane); continue; } r -= I_IN;
        if (r < I_OUT) { tr_item(p.in[19] + (size_t)layer * DM * DM, DM, DM, Wout, 0, scr, r, C.lane); continue; } r -= I_OUT;
        if (r < I_FFI) { tr_item(p.in[22] + (size_t)layer * DM * 2 * DFF, DM, 2 * DFF, Wffi, 1, scr, r, C.lane); continue; } r -= I_FFI;
        tr_item(p.in[23] + (size_t)layer * DFF * DM, DFF, DM, Wffo, 0, scr, r, C.lane);
    }
    u32x4* z = (u32x4*)(Win + (size_t)DIN * DM); const int nz = 240 * DM * 2 / 16;
    for (int i = blockIdx.x * 512 + C.tid; i < nz; i += C.G * 512) z[i] = (u32x4){0u, 0u, 0u, 0u};
}

DI void mod_unit(const Ctx& C, int u) {
    const Params& p = *C.p; const int tid = C.tid;
    float* cs = C.L; float* red = C.L + 3072;
    const int layer = u >> 6, col0 = (u & 63) * 96;
    __syncthreads();
    for (int i = tid; i < 3072; i += 512) { const int v = i >> 10, k = i & 1023; const float c = (v == 0) ? p.in[7][k] : p.in[6][(v - 1) * 1024 + k]; cs[i] = siluf_(c); }
    __syncthreads();
    if (tid < 504) {
        const int cgp = tid % 24, rs = tid / 24;
        f32x4 a0 = {0, 0, 0, 0}, a1 = a0, a2 = a0;
        const float* Wp = p.in[8] + (size_t)layer * DM * 6144 + col0 + cgp * 4;
        for (int k = rs; k < 1024; k += 21) { const f32x4 w = *(const f32x4*)(Wp + (size_t)k * 6144); a0 += w * cs[k]; a1 += w * cs[1024 + k]; a2 += w * cs[2048 + k]; }
        float* rr = red + rs * 288 + cgp * 4;
#pragma unroll
        for (int j = 0; j < 4; ++j) { rr[j] = a0[j]; rr[96 + j] = a1[j]; rr[192 + j] = a2[j]; }
    }
    __syncthreads();
    if (tid < 288) {
        const int v = tid / 96, cc = tid % 96; float s = 0.f;
        for (int rs = 0; rs < 21; ++rs) s += red[rs * 288 + tid];
        ((float*)(C.ws + WS_MOD))[(size_t)(layer * 3 + v) * 6144 + col0 + cc] = s + p.in[9][layer * 6144 + col0 + cc];
    }
}

DI void phase0a(const Ctx& C) {
    const Params& p = *C.p;
    for (int u = blockIdx.x; u < 256; u += C.G) mod_unit(C, u);
    __syncthreads();
    convert_layer_weights(C, 0);
    const int gt = blockIdx.x * 512 + C.tid, NT = C.G * 512;
    float* tab = (float*)(C.ws + WS_TAB);
    if (gt < 1024) { const int pos = gt >> 4, i = gt & 15; const float inv = __builtin_amdgcn_exp2f(-(float)i * (13.287712379549449f / 16.0f)); float rev = (float)pos * inv * 0.15915494309189535f; rev -= floorf(rev);
        tab[2 * gt] = __builtin_amdgcn_cosf(rev); tab[2 * gt + 1] = __builtin_amdgcn_sinf(rev); }
    if (gt >= 1024 && gt < 1028) { const int l = gt - 1024; const float* dl = p.in[17] + l * 256; float s01 = 0.f, s23 = 0.f; for (int i = 0; i < 64; ++i) { s01 += dl[i] * dl[64 + i]; s23 += dl[128 + i] * dl[192 + i]; }
        tab[2048 + l] = __expf(s01) - __expf(s23) + (0.8f - 0.6f * __expf(-0.3f * (float)l)); }
    if (gt >= 2048 && gt < 2560) { const int dir = (gt - 2048) >> 8, c = gt & 255; const float* lb = p.in[15] + dir * 1024 + c; float v[4], mx = -1e30f; for (int l = 0; l < 4; ++l) { v[l] = lb[l * 256]; mx = fmaxf(mx, v[l]); }
        float s = 0.f; for (int l = 0; l < 4; ++l) { v[l] = __expf(v[l] - mx); s += v[l]; } float cum = 0.f; for (int l = 0; l < 4; ++l) { if (l > 0) cum += v[l] / s; tab[4096 + (dir * 4 + l) * 256 + c] = cum; } }
    bf16_t* ck = (bf16_t*)(C.ws + WS_CK); bf16_t* cv = (bf16_t*)(C.ws + WS_CV);
    for (int i = gt; i < 2 * 4 * 256 * 512 / 4; i += NT) { const int e = i * 4; const int c = e & 511, j = (e >> 9) & 255, l = (e >> 17) & 3, b = e >> 19;
        const size_t dst = ((size_t)((l * 2 + b) * 256 + j)) * 512 + c;
        *(u32x2*)(ck + dst) = pack4(*(const f32x4*)(p.in[2] + e)); *(u32x2*)(cv + dst) = pack4(*(const f32x4*)(p.in[3] + e)); }
}

DI void row_pass(const Ctx& C, int mode, const float* lng, const float* lnb, const float* modl, int sc_off, int sh_off, bool write_xm) {
    const Params& p = *C.p; float* x = C.out; bf16_t* xm = (bf16_t*)(C.ws + WS_XM);
    for (int r = C.gw; r < MROWS; r += C.NGW) {
        const float* src = mode == 0 ? (r < 8192 ? p.in[0] + (size_t)r * DM : p.in[1] + (size_t)(r - 8192) * DM) : x + (size_t)r * DM;
        f32x4 v[4];
#pragma unroll
        for (int j = 0; j < 4; ++j) v[j] = *(const f32x4*)(src + 4 * C.lane + 256 * j);
        if (mode == 1) {
            float s = 0.f;
#pragma unroll
            for (int j = 0; j < 4; ++j) s += (v[j][0] + v[j][1]) + (v[j][2] + v[j][3]);
            const float mean = wave_sum(s) * (1.f / DM); float s2 = 0.f;
#pragma unroll
            for (int j = 0; j < 4; ++j) { v[j] = v[j] - mean; s2 += (v[j][0] * v[j][0] + v[j][1] * v[j][1]) + (v[j][2] * v[j][2] + v[j][3] * v[j][3]); }
            const float rstd = 1.0f / sqrtf(wave_sum(s2) * (1.f / DM) + LN_EPS);
#pragma unroll
            for (int j = 0; j < 4; ++j) { const f32x4 g4 = *(const f32x4*)(lng + 4 * C.lane + 256 * j), b4 = *(const f32x4*)(lnb + 4 * C.lane + 256 * j); v[j] = v[j] * rstd * g4 + b4; }
        }
#pragma unroll
        for (int j = 0; j < 4; ++j) *(f32x4*)(x + (size_t)r * DM + 4 * C.lane + 256 * j) = v[j];
        if (write_xm) {
            const float* mv = modl + row_mod(r) * 6144;
#pragma unroll
            for (int j = 0; j < 4; ++j) { const int c = 4 * C.lane + 256 * j; const f32x4 sc = *(const f32x4*)(mv + sc_off + c), sh = *(const f32x4*)(mv + sh_off + c);
                *(u32x2*)(xm + (size_t)r * DM + c) = pack4(v[j] * (sc + 1.0f) + sh); }
        }
    }
}

#define MFMA32(a, b, c) __builtin_amdgcn_mfma_f32_32x32x16_bf16((a), (b), (c), 0, 0, 0)
#define MFMA16(a, b, c) __builtin_amdgcn_mfma_f32_16x16x32_bf16((a), (b), (c), 0, 0, 0)
constexpr int AK_LD = 72, AV_LD = 136;
template <int PASS>
DI void attn_pass(int tid, int q, int hi, int half, int h, int nst, int nlat, const bf16_t* Klat, const bf16_t* Vlat, const bf16_t* Kctx, const bf16_t* Vctx,
                  LAS bf16_t* K1s, LAS bf16_t* K2s, LAS bf16_t* VTs, const bf16x8 (&q1)[4], const bf16x8 (&q2)[4],
                  float& m1, float& l1, float& m2, float& l2, float iL1, float iL2, f32x16 (&o)[4]) {
        u32x4 kreg[4], vreg[4];
        {
            const bf16_t* kb0 = (0 < nlat) ? Klat : Kctx; const bf16_t* vb0 = (0 < nlat) ? Vlat : Vctx;
#pragma unroll
            for (int i = 0; i < 2; ++i) { const int id = tid + 512 * i, key = id >> 3, ch = id & 7; kreg[i] = *(const u32x4*)(kb0 + (size_t)key * 512 + h * 128 + ch * 8); kreg[2 + i] = *(const u32x4*)(kb0 + (size_t)key * 512 + h * 128 + 64 + ch * 8); }
            if (PASS == 1) {
#pragma unroll
                for (int i = 0; i < 4; ++i) { const int id = tid + 512 * i, key = id >> 4, ch = id & 15; vreg[i] = *(const u32x4*)(vb0 + (size_t)key * 512 + h * 128 + ch * 8); }
            }
        }
        for (int st = 0; st < nst; ++st) {
            __syncthreads();
#pragma unroll
            for (int i = 0; i < 2; ++i) { const int id = tid + 512 * i, key = id >> 3, ch = id & 7; *(LAS u32x4*)(K1s + key * AK_LD + ch * 8) = kreg[i]; *(LAS u32x4*)(K2s + key * AK_LD + ch * 8) = kreg[2 + i]; }
            if (PASS == 1) {
#pragma unroll
                for (int i = 0; i < 4; ++i) { const int id = tid + 512 * i, key = id >> 4, ch = id & 15; const u32x4 vv = vreg[i];
#pragma unroll
                    for (int e = 0; e < 4; ++e) { VTs[(ch * 8 + 2 * e) * AV_LD + key] = (bf16_t)(vv[e] & 0xffffu); VTs[(ch * 8 + 2 * e + 1) * AV_LD + key] = (bf16_t)(vv[e] >> 16); } }
            }
            __syncthreads();
            if (st + 1 < nst) {
                const int sn = st + 1; const bf16_t* kbn = (sn < nlat) ? Klat + (size_t)sn * 128 * 512 : Kctx + (size_t)(sn - nlat) * 128 * 512; const bf16_t* vbn = (sn < nlat) ? Vlat + (size_t)sn * 128 * 512 : Vctx + (size_t)(sn - nlat) * 128 * 512;
#pragma unroll
                for (int i = 0; i < 2; ++i) { const int id = tid + 512 * i, key = id >> 3, ch = id & 7; kreg[i] = *(const u32x4*)(kbn + (size_t)key * 512 + h * 128 + ch * 8); kreg[2 + i] = *(const u32x4*)(kbn + (size_t)key * 512 + h * 128 + 64 + ch * 8); }
                if (PASS == 1) {
#pragma unroll
                    for (int i = 0; i < 4; ++i) { const int id = tid + 512 * i, key = id >> 4, ch = id & 15; vreg[i] = *(const u32x4*)(vbn + (size_t)key * 512 + h * 128 + ch * 8); }
                }
            }
#pragma unroll
            for (int kbk = 0; kbk < 2; ++kbk) {
                const int keyrow = half * 64 + kbk * 32 + q;
                f32x16 s1, pr;
#pragma unroll
                for (int r = 0; r < 16; ++r) s1[r] = 0.f;
#pragma unroll
                for (int ks = 0; ks < 4; ++ks) { const bf16x8 a1 = *(const LAS bf16x8*)(K1s + keyrow * AK_LD + 16 * ks + 8 * hi); s1 = MFMA32(a1, q1[ks], s1); }
                if (PASS == 0) {
                    float mx1 = s1[0];
#pragma unroll
                    for (int r = 1; r < 16; ++r) mx1 = fmaxf(mx1, s1[r]);
                    const float n1 = fmaxf(m1, mx1); float a1s = 0.f;
#pragma unroll
                    for (int r = 0; r < 16; ++r) a1s += __builtin_amdgcn_exp2f(s1[r] - n1);
                    l1 = l1 * __builtin_amdgcn_exp2f(m1 - n1) + a1s; m1 = n1;
                } else {
#pragma unroll
                    for (int r = 0; r < 16; ++r) pr[r] = __builtin_amdgcn_exp2f(s1[r] - m1) * iL1;
                }
#pragma unroll
                for (int r = 0; r < 16; ++r) s1[r] = 0.f;
#pragma unroll
                for (int ks = 0; ks < 4; ++ks) { const bf16x8 a2 = *(const LAS bf16x8*)(K2s + keyrow * AK_LD + 16 * ks + 8 * hi); s1 = MFMA32(a2, q2[ks], s1); }
                if (PASS == 0) {
                    float mx2 = s1[0];
#pragma unroll
                    for (int r = 1; r < 16; ++r) mx2 = fmaxf(mx2, s1[r]);
                    const float n2 = fmaxf(m2, mx2); float a2s = 0.f;
#pragma unroll
                    for (int r = 0; r < 16; ++r) a2s += __builtin_amdgcn_exp2f(s1[r] - n2);
                    l2 = l2 * __builtin_amdgcn_exp2f(m2 - n2) + a2s; m2 = n2;
                } else {
#pragma unroll
                    for (int r = 0; r < 16; ++r) pr[r] -= __builtin_amdgcn_exp2f(s1[r] - m2) * iL2;
                    bf16x8 pb[2];
                    { u32x4 t0, t1; t0.x = cvt_pk_bf16(pr[0], pr[1]); t0.y = cvt_pk_bf16(pr[2], pr[3]); t0.z = cvt_pk_bf16(pr[4], pr[5]); t0.w = cvt_pk_bf16(pr[6], pr[7]);
                      t1.x = cvt_pk_bf16(pr[8], pr[9]); t1.y = cvt_pk_bf16(pr[10], pr[11]); t1.z = cvt_pk_bf16(pr[12], pr[13]); t1.w = cvt_pk_bf16(pr[14], pr[15]);
                      pb[0] = __builtin_bit_cast(bf16x8, t0); pb[1] = __builtin_bit_cast(bf16x8, t1); }
#pragma unroll
                    for (int blk = 0; blk < 4; ++blk)
#pragma unroll
                        for (int s = 0; s < 2; ++s) {
                            const LAS bf16_t* vp = VTs + (blk * 32 + q) * AV_LD + half * 64 + kbk * 32 + 16 * s + 4 * hi;
                            const s16x4 lo = *(const LAS s16x4*)vp, hh = *(const LAS s16x4*)(vp + 8);
                            const bf16x8 av = __builtin_shufflevector(lo, hh, 0, 1, 2, 3, 4, 5, 6, 7);
                            o[blk] = MFMA32(av, pb[s], o[blk]);
                        }
                }
            }
        }
}
DI void attn_unit(const Ctx& C, int layer, int uidx) {
    int tid = C.tid; asm volatile("" : "+v"(tid)); const int lane = tid & 63, w = __builtin_amdgcn_readfirstlane(tid >> 6), wq = w & 3, half = w >> 2, q = lane & 31, hi = lane >> 5;
    const bf16_t* Qb = (const bf16_t*)(C.ws + WS_Q); const bf16_t* Kb = (const bf16_t*)(C.ws + WS_K); const bf16_t* Vb = (const bf16_t*)(C.ws + WS_V);
    const bf16_t* cK = (const bf16_t*)(C.ws + WS_CK); const bf16_t* cV = (const bf16_t*)(C.ws + WS_CV);
    int b, h, rowq0, nst, nlat; const bf16_t *Klat, *Vlat, *Kctx = nullptr, *Vctx = nullptr;
    if (uidx < 256) { b = uidx >> 7; h = (uidx >> 5) & 3; const int qb = uidx & 31; rowq0 = 8192 + b * 4096 + qb * 128; nst = 34; nlat = 32;
        Klat = Kb + (size_t)(8192 + b * 4096) * 512; Vlat = Vb + (size_t)(8192 + b * 4096) * 512; Kctx = cK + (size_t)((layer * 2 + b) * 256) * 512; Vctx = cV + (size_t)((layer * 2 + b) * 256) * 512; }
    else { const int v = uidx - 256; b = v >> 3; h = (v >> 1) & 3; const int qb = v & 1; rowq0 = b * 256 + qb * 128; nst = 2; nlat = 2; Klat = Kb + (size_t)(b * 256) * 512; Vlat = Vb + (size_t)(b * 256) * 512; }
    LAS bf16_t* K1s = (LAS bf16_t*)C.lds; LAS bf16_t* K2s = K1s + 128 * AK_LD; LAS bf16_t* VTs = K2s + 128 * AK_LD;
    LAS float* ex = (LAS float*)(C.lds + 73728);
    const float lam = ((const float*)(C.ws + WS_TAB))[2048 + layer];
    bf16x8 q1[4], q2[4];
    { const bf16_t* qp = Qb + (size_t)(rowq0 + 32 * wq + q) * 512 + h * 128 + 8 * hi;
#pragma unroll
      for (int ks = 0; ks < 4; ++ks) { q1[ks] = *(const bf16x8*)(qp + 16 * ks); q2[ks] = *(const bf16x8*)(qp + 64 + 16 * ks); } }
    float m1 = -1e30f, l1 = 0.f, m2 = -1e30f, l2 = 0.f, iL1 = 0.f, iL2 = 0.f;
    f32x16 o[4];
#pragma unroll
    for (int i = 0; i < 4; ++i)
#pragma unroll
        for (int r = 0; r < 16; ++r) o[i][r] = 0.f;
    attn_pass<0>(tid, q, hi, half, h, nst, nlat, Klat, Vlat, Kctx, Vctx, K1s, K2s, VTs, q1, q2, m1, l1, m2, l2, iL1, iL2, o);
    {
        {
            { const float om = __shfl_xor(m1, 32), ol = __shfl_xor(l1, 32); const float nm = fmaxf(m1, om); l1 = l1 * __builtin_amdgcn_exp2f(m1 - nm) + ol * __builtin_amdgcn_exp2f(om - nm); m1 = nm; }
            { const float om = __shfl_xor(m2, 32), ol = __shfl_xor(l2, 32); const float nm = fmaxf(m2, om); l2 = l2 * __builtin_amdgcn_exp2f(m2 - nm) + ol * __builtin_amdgcn_exp2f(om - nm); m2 = nm; }
            if (hi == 0) { ex[(w * 4 + 0) * 32 + q] = m1; ex[(w * 4 + 1) * 32 + q] = l1; ex[(w * 4 + 2) * 32 + q] = m2; ex[(w * 4 + 3) * 32 + q] = l2; }
            __syncthreads();
            { const int ow = w ^ 4; const float om1 = ex[(ow * 4 + 0) * 32 + q], ol1 = ex[(ow * 4 + 1) * 32 + q], om2 = ex[(ow * 4 + 2) * 32 + q], ol2 = ex[(ow * 4 + 3) * 32 + q];
              float nm = fmaxf(m1, om1); l1 = l1 * __builtin_amdgcn_exp2f(m1 - nm) + ol1 * __builtin_amdgcn_exp2f(om1 - nm); m1 = nm;
              nm = fmaxf(m2, om2); l2 = l2 * __builtin_amdgcn_exp2f(m2 - nm) + ol2 * __builtin_amdgcn_exp2f(om2 - nm); m2 = nm; }
            iL1 = 1.0f / l1; iL2 = lam / l2;
        }
    }
    attn_pass<1>(tid, q, hi, half, h, nst, nlat, Klat, Vlat, Kctx, Vctx, K1s, K2s, VTs, q1, q2, m1, l1, m2, l2, iL1, iL2, o);
    __syncthreads();
    LAS float* comb = (LAS float*)C.lds;
    if (half == 1) {
#pragma unroll
        for (int blk = 0; blk < 4; ++blk)
#pragma unroll
            for (int r = 0; r < 16; ++r) comb[(wq * 64 + blk * 16 + r) * 64 + lane] = o[blk][r];
    }
    __syncthreads();
    if (half == 0) {
        float ss = 0.f;
#pragma unroll
        for (int blk = 0; blk < 4; ++blk)
#pragma unroll
            for (int r = 0; r < 16; ++r) { const float v = o[blk][r] + comb[(wq * 64 + blk * 16 + r) * 64 + lane]; o[blk][r] = v; ss += v * v; }
        ss += __shfl_xor(ss, 32);
        const float lam_init = 0.8f - 0.6f * __expf(-0.3f * (float)layer);
        const float sc = (1.0f / sqrtf(ss * (1.0f / 128.0f) + RMS_EPS)) * (1.0f - lam_init);
        const float* dn = C.p->in[18] + layer * 128;
        bf16_t* ob = (bf16_t*)(C.ws + WS_O) + (size_t)(rowq0 + 32 * wq + q) * DM + h * 128;
#pragma unroll
        for (int blk = 0; blk < 4; ++blk)
#pragma unroll
            for (int r = 0; r < 16; ++r) { const int dv = blk * 32 + (r & 3) + 8 * (r >> 2) + 4 * hi; ob[dv] = f2bf(o[blk][r] * sc * dn[dv]); }
    }
    __syncthreads();
}

DI void delta_prep_unit(const Ctx& C, int layer, int unit) {
    const Params& p = *C.p; int tid = C.tid; asm volatile("" : "+v"(tid)); const int lane = tid & 63, w = __builtin_amdgcn_readfirstlane(tid >> 6);
    const int tc = unit >> 2, h = unit & 3, row0 = tc * 64;
    int ci, nch; if (tc < 128) { ci = tc & 3; nch = 4; } else { ci = (tc - 128) & 63; nch = 64; }
    const bool has_prev = ci > 0, has_next = ci < nch - 1;
    float* qs = C.L; float* kk = C.L + 4160; float* vv = C.L + 8320; float* KK0 = C.L + 12480; float* QK0 = KK0 + 4096; float* Ms = QK0 + 4096; float* bc = Ms + 8192; float* be = bc + 128;
    const bf16_t* zb = (const bf16_t*)(C.ws + WS_ZB);
    const float* cw = p.in[11] + layer * 3 * 768;
    __syncthreads();
#pragma unroll 1
    for (int i = 0; i < 24; ++i) {
        const int idx = tid + 512 * i, t = idx / 192, c = idx % 192, which = c >> 6, d = c & 63, col = which * 256 + h * 64 + d;
        float acc = 0.f;
#pragma unroll
        for (int j = 0; j < 3; ++j) { const int tt = t + j - 1; const bool ok = (tt >= 0 || has_prev) && (tt < 64 || has_next); if (ok) acc += cw[j * 768 + col] * bf2f(zb[(size_t)(row0 + tt) * ZLD + col]); }
        (which == 0 ? qs : (which == 1 ? kk : vv))[t * 65 + d] = siluf_(acc);
    }
    __syncthreads();
    { const int r = tid >> 2, part = tid & 3; float* base = (r < 64 ? qs + r * 65 : kk + (r - 64) * 65) + part * 16; float ss = 0.f;
#pragma unroll
      for (int i = 0; i < 16; ++i) ss += base[i] * base[i];
      ss += __shfl_xor(ss, 1); ss += __shfl_xor(ss, 2);
      const float sc = (1.0f / sqrtf(ss + 1e-6f)) * (r < 64 ? 0.125f : 1.0f);
#pragma unroll
      for (int i = 0; i < 16; ++i) base[i] *= sc; }
    if (w < 2) {
        const int dir = w, i = lane, tt = dir ? 63 - i : i; const size_t row = (size_t)(row0 + tt);
        const float braw = bf2f(zb[row * ZLD + ZB_BBETA + dir * 4 + h]), araw = bf2f(zb[row * ZLD + ZB_BA + dir * 4 + h]);
        const float A = __expf(p.in[12][layer * 8 + dir * 4 + h]); const float x = araw + p.in[13][layer * 8 + dir * 4 + h];
        const float sp = x > 20.f ? x : log1pf(__expf(x)); float g = -A * sp;
#pragma unroll
        for (int off = 1; off < 64; off <<= 1) { const float t = __shfl_up(g, off); if (lane >= off) g += t; }
        bc[dir * 64 + i] = g; const float bt = sigmoidf_(braw); be[dir * 64 + i] = bt; be[128 + dir * 64 + i] = bt * __expf(g);
    }
    __syncthreads();
    { const int a = tid >> 3, b0 = (tid & 7) * 8; float ka[8], qa[8];
#pragma unroll
      for (int j = 0; j < 8; ++j) { ka[j] = 0.f; qa[j] = 0.f; }
#pragma unroll 2
      for (int d = 0; d < 64; ++d) { const float kav = kk[a * 65 + d], qav = qs[a * 65 + d];
#pragma unroll
          for (int j = 0; j < 8; ++j) { const float kb = kk[(b0 + j) * 65 + d]; ka[j] += kav * kb; qa[j] += qav * kb; } }
#pragma unroll
      for (int j = 0; j < 8; ++j) { KK0[a * 64 + b0 + j] = ka[j]; QK0[a * 64 + b0 + j] = qa[j]; } }
    __syncthreads();
    bf16_t* dpW = (bf16_t*)(C.ws + WS_DPW); bf16_t* dpQD = (bf16_t*)(C.ws + WS_DPQD); bf16_t* dpQK = (bf16_t*)(C.ws + WS_DPQK); bf16_t* dpKD = (bf16_t*)(C.ws + WS_DPKD); bf16_t* dpU = (bf16_t*)(C.ws + WS_DPU);
    float* dpGL = (float*)(C.ws + WS_GL);
    { const int i = tid >> 3, j0 = (tid & 7) * 8;
#pragma unroll
      for (int dir = 0; dir < 2; ++dir) {
          const size_t ud = ((size_t)tc * 4 + h) * 2 + dir;
          const float bi = bc[dir * 64 + i], betai = be[dir * 64 + i]; const int ai = dir ? 63 - i : i;
#pragma unroll
          for (int jj = 0; jj < 8; ++jj) { const int j = j0 + jj, aj = dir ? 63 - j : j;
              const float dec = (j <= i) ? __expf(bi - bc[dir * 64 + j]) : 0.f;
              Ms[dir * 4096 + j * 64 + i] = (j < i) ? betai * KK0[ai * 64 + aj] * dec : 0.f;
              dpQK[ud * 4096 + i * 64 + pinv(j)] = f2bf(QK0[ai * 64 + aj] * dec); }
      } }
    __syncthreads();
    if (w < 4) {
        const int dir = w >> 1, c = (w & 1) * 64 + lane; const size_t ud = ((size_t)tc * 4 + h) * 2 + dir;
        const float* Msd = Ms + dir * 4096; const bool isU = (w & 1) == 0; const float* scp = be + (isU ? 0 : 128) + dir * 64; const float* srcp = (isU ? vv : kk) + lane;
        float x[64];
#pragma unroll
        for (int rb = 0; rb < 4; ++rb) {
            float r[16];
#pragma unroll
            for (int ii = 0; ii < 16; ++ii) { const int i = 16 * rb + ii, tt = dir ? 63 - i : i; r[ii] = scp[i] * srcp[tt * 65]; }
            asm volatile("" ::: "memory");
#pragma unroll
            for (int j = 0; j < 16 * rb; ++j) {
                const float* mp = Msd + j * 64 + 16 * rb;
                const f32x4 ma = *(const f32x4*)mp, mb = *(const f32x4*)(mp + 4), mc = *(const f32x4*)(mp + 8), md = *(const f32x4*)(mp + 12);
                const float xj = x[j];
#pragma unroll
                for (int c4 = 0; c4 < 4; ++c4) { r[c4] -= ma[c4] * xj; r[4 + c4] -= mb[c4] * xj; r[8 + c4] -= mc[c4] * xj; r[12 + c4] -= md[c4] * xj; }
                if ((j & 3) == 3) asm volatile("" ::: "memory");
            }
#pragma unroll
            for (int jj = 0; jj < 16; ++jj) {
                const float xj = r[jj]; x[16 * rb + jj] = xj;
                const float* mp = Msd + (16 * rb + jj) * 64 + 16 * rb;
#pragma unroll
                for (int ii = jj + 1; ii < 16; ++ii) r[ii] -= mp[ii] * xj;
                if ((jj & 3) == 3) asm volatile("" ::: "memory");
            }
        }
        if (c < 64) {
            bf16_t* up = dpU + ud * 4096 + c * 64;
#pragma unroll
            for (int i = 0; i < 64; i += 8) { u32x4 o; o.x = cvt_pk_bf16(x[i], x[i + 1]); o.y = cvt_pk_bf16(x[i + 2], x[i + 3]); o.z = cvt_pk_bf16(x[i + 4], x[i + 5]); o.w = cvt_pk_bf16(x[i + 6], x[i + 7]); *(u32x4*)(up + i) = o; }
        } else {
            bf16_t* wp = dpW + ud * 4096 + pinv(c - 64);
#pragma unroll
            for (int i = 0; i < 64; ++i) wp[i * 64] = f2bf(x[i]);
        }
    } else {
#pragma unroll 1
        for (int it = 0; it < 64; ++it) {
            const int e = (tid - 256) + 256 * it, dir = e >> 13, which = (e >> 12) & 1, rem = e & 4095; const size_t ud = ((size_t)tc * 4 + h) * 2 + dir;
            if (which == 0) { const int i = rem >> 6, d = rem & 63, tt = dir ? 63 - i : i; dpQD[ud * 4096 + i * 64 + pinv(d)] = f2bf(qs[tt * 65 + d] * __expf(bc[dir * 64 + i])); }
            else { const int dk = rem >> 6, i = rem & 63, tt = dir ? 63 - i : i; dpKD[ud * 4096 + dk * 64 + pinv(i)] = f2bf(kk[tt * 65 + dk] * __expf(bc[dir * 64 + 63] - bc[dir * 64 + i])); }
        }
        if (tid == 256 || tid == 257) { const int dir = tid - 256; dpGL[((size_t)tc * 4 + h) * 2 + dir] = __expf(bc[dir * 64 + 63]); }
    }
}

DI void delta_scan_unit(const Ctx& C, int layer, bool sample, int b, int h) {
    const Params& p = *C.p; int lane = C.lane; asm volatile("" : "+v"(lane)); const int w = C.wave, dir = w >> 2, sl = w & 3, col = lane & 15, g = lane >> 4;
    const int tc0 = sample ? 128 + b * 64 : b * 4, nch = sample ? 64 : 4;
    const bf16_t* dpW = (const bf16_t*)(C.ws + WS_DPW); const bf16_t* dpQD = (const bf16_t*)(C.ws + WS_DPQD); const bf16_t* dpQK = (const bf16_t*)(C.ws + WS_DPQK); const bf16_t* dpKD = (const bf16_t*)(C.ws + WS_DPKD); const bf16_t* dpU = (const bf16_t*)(C.ws + WS_DPU);
    const float* dpGL = (const float*)(C.ws + WS_GL); float* od = (float*)(C.ws + WS_OD) + (size_t)dir * MROWS * 256;
    f32x4 S[4];
    if (sample) { const float* s0 = p.in[4] + ((((size_t)b * 4 + layer) * 2 + dir) * 4 + h) * 4096;
#pragma unroll
        for (int rb = 0; rb < 4; ++rb)
#pragma unroll
            for (int ii = 0; ii < 4; ++ii) S[rb][ii] = s0[(16 * rb + 4 * g + ii) * 64 + 16 * sl + col]; }
    else {
#pragma unroll
        for (int rb = 0; rb < 4; ++rb) S[rb] = (f32x4){0.f, 0.f, 0.f, 0.f}; }
    for (int n = 0; n < nch; ++n) {
        const int tc = dir ? tc0 + nch - 1 - n : tc0 + n; const size_t ud = ((size_t)tc * 4 + h) * 2 + dir;
        const size_t fo = ud * 4096 + (size_t)col * 64 + g * 8;
        bf16x8 Wf[4][2], QDf[4][2], QKf[4][2], KDf[4][2]; f32x4 u[4];
#pragma unroll
        for (int rb = 0; rb < 4; ++rb)
#pragma unroll
            for (int ks = 0; ks < 2; ++ks) { const size_t o = fo + rb * 1024 + ks * 32; Wf[rb][ks] = *(const bf16x8*)(dpW + o); QDf[rb][ks] = *(const bf16x8*)(dpQD + o); QKf[rb][ks] = *(const bf16x8*)(dpQK + o); KDf[rb][ks] = *(const bf16x8*)(dpKD + o); }
#pragma unroll
        for (int rb = 0; rb < 4; ++rb) { const s16x4 uu = *(const s16x4*)(dpU + ud * 4096 + (16 * sl + col) * 64 + 16 * rb + 4 * g);
#pragma unroll
            for (int ii = 0; ii < 4; ++ii) u[rb][ii] = bf2f((bf16_t)uu[ii]); }
        const float gl = dpGL[ud];
        bf16x8 Sb[2]; Sb[0] = pack8(S[0], S[1]); Sb[1] = pack8(S[2], S[3]);
        f32x4 vn[4];
#pragma unroll
        for (int rb = 0; rb < 4; ++rb) { f32x4 t = (f32x4){0.f, 0.f, 0.f, 0.f}; t = MFMA16(Wf[rb][0], Sb[0], t); t = MFMA16(Wf[rb][1], Sb[1], t); vn[rb] = u[rb] - t; }
        bf16x8 vb[2]; vb[0] = pack8(vn[0], vn[1]); vb[1] = pack8(vn[2], vn[3]);
        const int rowb = tc * 64;
#pragma unroll
        for (int rb = 0; rb < 4; ++rb) { f32x4 o = (f32x4){0.f, 0.f, 0.f, 0.f}; o = MFMA16(QDf[rb][0], Sb[0], o); o = MFMA16(QDf[rb][1], Sb[1], o); o = MFMA16(QKf[rb][0], vb[0], o); o = MFMA16(QKf[rb][1], vb[1], o);
#pragma unroll
            for (int ii = 0; ii < 4; ++ii) { const int i = 16 * rb + 4 * g + ii; const int tt = dir ? 63 - i : i; od[(size_t)(rowb + tt) * 256 + h * 64 + 16 * sl + col] = o[ii]; } }
#pragma unroll
        for (int rb = 0; rb < 4; ++rb) { f32x4 sn = S[rb] * gl; sn = MFMA16(KDf[rb][0], vb[0], sn); sn = MFMA16(KDf[rb][1], vb[1], sn); S[rb] = sn; }
    }
    if (!sample) { float* so = C.out + OUT_SD + ((((size_t)b * 4 + layer) * 2 + dir) * 4 + h) * 4096;
#pragma unroll
        for (int rb = 0; rb < 4; ++rb)
#pragma unroll
            for (int ii = 0; ii < 4; ++ii) so[(16 * rb + 4 * g + ii) * 64 + 16 * sl + col] = S[rb][ii]; }
}

DI float hgrn_forget(const bf16_t* zb, size_t row, int dir, int h, int d, float lb) { const float x = bf2f(zb[row * ZLD + ZB_CF + dir * 256 + h * 64 + d]); return lb + (1.0f - lb) * sigmoidf_(x); }
DI void hgrn_local_unit(const Ctx& C, int layer, int unit) {
    int lane = C.lane; asm volatile("" : "+v"(lane)); const int dir = unit & 1, h = (unit >> 1) & 3, tc = unit >> 3, row0 = tc * 64;
    const bf16_t* zb = (const bf16_t*)(C.ws + WS_ZB);
    float* fs = C.L + C.wave * 1024;
    const float lb = ((const float*)(C.ws + WS_TAB))[4096 + (dir * 4 + layer) * 256 + h * 64 + lane];
    float S[64];
#pragma unroll
    for (int d = 0; d < 64; ++d) S[d] = 0.f;
    float Dl = 1.0f;
    for (int sb = 0; sb < 4; ++sb) {
        float vr[16];
#pragma unroll
        for (int i = 0; i < 16; ++i) { const int ti = sb * 16 + i, tt = dir ? 63 - ti : ti; const size_t row = (size_t)(row0 + tt);
            const float f = hgrn_forget(zb, row, dir, h, lane, lb); fs[i * 64 + lane] = f; Dl *= f; vr[i] = bf2f(zb[row * ZLD + ZB_CI + h * 64 + lane]); }
        __builtin_amdgcn_wave_barrier();
#pragma unroll
        for (int i = 0; i < 16; ++i) { const float v = vr[i];
#pragma unroll
            for (int d = 0; d < 64; d += 4) { const f32x4 f4 = *(const f32x4*)(fs + i * 64 + d);
#pragma unroll
                for (int c = 0; c < 4; ++c) S[d + c] = fmaf(f4[c], S[d + c] - v, v);
                if ((d & 15) == 12) asm volatile("" ::: "memory"); } }
        __builtin_amdgcn_wave_barrier();
    }
    float* hs = (float*)(C.ws + WS_HS) + (size_t)unit * 4096;
#pragma unroll
    for (int d = 0; d < 64; ++d) hs[d * 64 + lane] = S[d];
    ((float*)(C.ws + WS_HD))[(size_t)unit * 64 + lane] = Dl;
}
DI void hgrn_scan_unit(const Ctx& C, int layer, bool sample, int b, int h, int dir) {
    const Params& p = *C.p; const int tid = C.tid; const int tc0 = sample ? 128 + b * 64 : b * 4, nch = sample ? 64 : 4;
    float* HS = (float*)(C.ws + WS_HS); const float* HD = (const float*)(C.ws + WS_HD);
    f32x4 S0, S1;
    if (sample) { const float* s0 = p.in[5] + ((((size_t)b * 4 + layer) * 2 + dir) * 4 + h) * 4096 + tid * 8; S0 = *(const f32x4*)s0; S1 = *(const f32x4*)(s0 + 4); }
    else { S0 = (f32x4){0.f, 0.f, 0.f, 0.f}; S1 = S0; }
    for (int n = 0; n < nch; ++n) {
        const int tc = dir ? tc0 + nch - 1 - n : tc0 + n; const size_t uh = ((size_t)tc * 4 + h) * 2 + dir;
        float* hp = HS + uh * 4096 + tid * 8; const f32x4 l0 = *(const f32x4*)hp, l1 = *(const f32x4*)(hp + 4); const float Dd = HD[uh * 64 + (tid >> 3)];
        *(f32x4*)hp = S0; *(f32x4*)(hp + 4) = S1;
        S0 = S0 * Dd + l0; S1 = S1 * Dd + l1;
    }
    if (!sample) { float* so = C.out + OUT_SH + ((((size_t)b * 4 + layer) * 2 + dir) * 4 + h) * 4096 + tid * 8; *(f32x4*)so = S0; *(f32x4*)(so + 4) = S1; }
}
DI void hgrn_final_unit(const Ctx& C, int layer, int tc) {
    const Params& p = *C.p; int lane = C.lane; asm volatile("" : "+v"(lane)); const int w = C.wave, h = w >> 1, eh = w & 1, e = eh * 32 + (lane & 31), dh = lane >> 5, row0 = tc * 64;
    const bf16_t* zb = (const bf16_t*)(C.ws + WS_ZB); const float* HS = (const float*)(C.ws + WS_HS);
    float* otile = C.L;
    float* fs = C.L + 16384 + w * 2048; float* qst = fs + 1024;
    __syncthreads();
    for (int dir = 0; dir < 2; ++dir) {
        const size_t uh = ((size_t)tc * 4 + h) * 2 + dir;
        const float lb = ((const float*)(C.ws + WS_TAB))[4096 + (dir * 4 + layer) * 256 + h * 64 + lane];
        float S[32];
#pragma unroll
        for (int k = 0; k < 32; ++k) S[k] = HS[uh * 4096 + (32 * dh + k) * 64 + e];
        for (int sb = 0; sb < 4; ++sb) {
            float vr[16];
#pragma unroll
            for (int i = 0; i < 16; ++i) { const int ti = sb * 16 + i, tt = dir ? 63 - ti : ti; const size_t row = (size_t)(row0 + tt);
                fs[i * 64 + lane] = hgrn_forget(zb, row, dir, h, lane, lb); qst[i * 64 + lane] = siluf_(bf2f(zb[row * ZLD + ZB_CQ + h * 64 + lane])); vr[i] = bf2f(zb[row * ZLD + ZB_CI + h * 64 + e]); }
            __builtin_amdgcn_wave_barrier();
#pragma unroll
            for (int i = 0; i < 16; ++i) { const float v = vr[i]; float os = 0.f;
#pragma unroll
                for (int k = 0; k < 32; k += 4) { const f32x4 f4 = *(const f32x4*)(fs + i * 64 + 32 * dh + k), q4 = *(const f32x4*)(qst + i * 64 + 32 * dh + k);
#pragma unroll
                    for (int c = 0; c < 4; ++c) { S[k + c] = fmaf(f4[c], S[k + c] - v, v); os = fmaf(q4[c], S[k + c], os); }
                    if ((k & 15) == 12) asm volatile("" ::: "memory"); }
                os += __shfl_xor(os, 32);
                const int ti = sb * 16 + i, tt = dir ? 63 - ti : ti;
                if (dh == 0) { float* op = otile + (h * 64 + tt) * 64 + e; if (dir == 0) *op = os; else *op += os; }
                asm volatile("" ::: "memory"); }
            __builtin_amdgcn_wave_barrier();
        }
    }
    __syncthreads();
    bf16_t* ob = (bf16_t*)(C.ws + WS_O);
    const float ng = p.in[16][layer * 64 + lane];
    for (int rr = 0; rr < 32; ++rr) { const int idx = w * 32 + rr, hh = idx >> 6, tt = idx & 63; const size_t row = (size_t)(row0 + tt);
        const float v = otile[(hh * 64 + tt) * 64 + lane]; const float ss = wave_sum(v * v);
        const float gt = siluf_(bf2f(zb[row * ZLD + ZB_CG + hh * 64 + lane]));
        ob[row * DM + 768 + hh * 64 + lane] = f2bf(v * (1.0f / sqrtf(ss * (1.0f / 64.0f) + RMS_EPS)) * ng * gt); }
}
DI void delta_combine(const Ctx& C, int layer) {
    const Params& p = *C.p; const bf16_t* zb = (const bf16_t*)(C.ws + WS_ZB); const float* od = (const float*)(C.ws + WS_OD); bf16_t* ob = (bf16_t*)(C.ws + WS_O);
    const float ng = p.in[14][layer * 64 + C.lane];
    for (int it = C.gw; it < MROWS * 4; it += C.NGW) { const int h = it & 3; const size_t row = (size_t)(it >> 2);
        const float v = od[row * 256 + h * 64 + C.lane] + od[(size_t)MROWS * 256 + row * 256 + h * 64 + C.lane]; const float ss = wave_sum(v * v);
        const float gt = siluf_(bf2f(zb[row * ZLD + ZB_BG + h * 64 + C.lane]));
        ob[row * DM + 512 + h * 64 + C.lane] = f2bf(v * (1.0f / sqrtf(ss * (1.0f / 64.0f) + RMS_EPS)) * ng * gt); }
}

template <unsigned PHM_>
__global__ void __launch_bounds__(512) fwd_megakernel(Params p) {
    extern __shared__ __attribute__((aligned(16))) unsigned char lds_raw[];
    for (int ph = p.ph_lo; ph < p.ph_hi; ++ph) {
        int tid_ = threadIdx.x; asm volatile("" : "+v"(tid_));
        unsigned char* ws_ = p.ws; asm volatile("" : "+s"(ws_));
        float* out_ = p.out; asm volatile("" : "+s"(out_));
        Ctx C; C.p = &p; C.lds = (LAS unsigned char*)lds_raw; C.L = (float*)lds_raw; C.tid = tid_; C.lane = C.tid & 63; C.wave = __builtin_amdgcn_readfirstlane(C.tid >> 6);
        C.G = gridDim.x; C.gw = blockIdx.x * 8 + C.wave; C.NGW = C.G * 8; C.ws = ws_; C.out = out_;
        unsigned* ctl = (unsigned*)(ws_ + WS_CTL);
        const float* modbuf = (const float*)(ws_ + WS_MOD);
        bf16_t* xm = (bf16_t*)(ws_ + WS_XM); bf16_t* ob = (bf16_t*)(ws_ + WS_O); bf16_t* act = (bf16_t*)(ws_ + WS_ACT);
        if (ph == 0) { if (PHON(0)) phase0a(C); }
        else if (ph == 1) { if (PHON(1)) row_pass(C, 0, nullptr, nullptr, modbuf, 1024, 0, true); }
        else {
            const int layer = (ph - 2) / 9, sub = (ph - 2) % 9;
            unsigned char* wb = ws_ + WS_W + (size_t)(layer & 1) * WBUF;
            const float* modl = modbuf + (size_t)layer * 3 * 6144;
            if (sub == 0) { if (PHON(2)) {
                pg8::Gemm g{xm, (const bf16_t*)(wb + W_IN), MROWS, 4096, DM}; pg8::StaticOrder S; S.init(MROWS, 4096, C.G, (int)blockIdx.x);
                EpiIn E{(bf16_t*)(ws_ + WS_Q), (bf16_t*)(ws_ + WS_K), (bf16_t*)(ws_ + WS_V), (bf16_t*)(ws_ + WS_ZB), out_ + OUT_K, out_ + OUT_V, (const f32x2*)(ws_ + WS_TAB), layer};
                pg8::gemm_phase(C.lds, g, S, E, C.tid); }
            } else if (sub == 1) {
                if (PHON(3) && layer + 1 < DEPTH) convert_layer_weights(C, layer + 1);
                __syncthreads();
                if (PHON(4)) for (int u = blockIdx.x; u < 1024; u += C.G) delta_prep_unit(C, layer, u);
                __syncthreads();
                if (PHON(5)) for (int u = C.gw; u < 2048; u += C.NGW) hgrn_local_unit(C, layer, u);
            } else if (sub == 2) {
                LAS int* slot = (LAS int*)(C.lds + 147392);
                for (;;) {
                    __syncthreads();
                    if (C.tid == 0) *slot = (int)atomicAdd(ctl + 64 * (layer + 1), 1u);
                    __syncthreads();
                    const int u = *slot;
                    if (u >= 920) break;
                    if (u < 8) { if (PHON(6)) delta_scan_unit(C, layer, true, u >> 2, u & 3); }
                    else if (u < 24) { const int v = u - 8; if (PHON(7)) hgrn_scan_unit(C, layer, true, v >> 3, (v >> 1) & 3, v & 1); }
                    else if (u < 280) { if (PHON(8)) attn_unit(C, layer, u - 24); }
                    else if (u < 408) { const int v = u - 280; if (PHON(6)) delta_scan_unit(C, layer, false, v >> 2, v & 3); }
                    else if (u < 664) { if (PHON(8)) attn_unit(C, layer, 256 + (u - 408)); }
                    else { const int v = u - 664; if (PHON(7)) hgrn_scan_unit(C, layer, false, v >> 3, (v >> 1) & 3, v & 1); }
                }
            } else if (sub == 3) {
                if (PHON(9)) for (int u = blockIdx.x; u < 256; u += C.G) hgrn_final_unit(C, layer, u);
                if (PHON(10)) delta_combine(C, layer);
            } else if (sub == 4) {
                pg8::Gemm g{ob, (const bf16_t*)(wb + W_OUT), MROWS, DM, DM}; pg8::StaticOrder S; S.init(MROWS, DM, C.G, (int)blockIdx.x);
                EpiRes E{out_, modl + 2048};
                if (PHON(11)) pg8::gemm_phase(C.lds, g, S, E, C.tid);
            } else if (sub == 5) {
                if (PHON(12)) row_pass(C, 1, p.in[20] + (size_t)(layer * 2) * DM, p.in[21] + (size_t)(layer * 2) * DM, modl, 4096, 3072, true);
            } else if (sub == 6) {
                pg8::Gemm g{xm, (const bf16_t*)(wb + W_FFI), MROWS, 2 * DFF, DM}; pg8::StaticOrder S; S.init(MROWS, 2 * DFF, C.G, (int)blockIdx.x);
                EpiFfn E{act};
                if (PHON(13)) pg8::gemm_phase(C.lds, g, S, E, C.tid);
            } else if (sub == 7) {
                pg8::Gemm g{act, (const bf16_t*)(wb + W_FFO), MROWS, DM, DFF}; pg8::StaticOrder S; S.init(MROWS, DM, C.G, (int)blockIdx.x);
                EpiRes E{out_, modl + 5120};
                if (PHON(14)) pg8::gemm_phase(C.lds, g, S, E, C.tid);
            } else {
                const bool last = layer + 1 == DEPTH;
                if (PHON(12)) row_pass(C, 1, p.in[20] + (size_t)(layer * 2 + 1) * DM, p.in[21] + (size_t)(layer * 2 + 1) * DM, modbuf + (size_t)(last ? layer : layer + 1) * 3 * 6144, 1024, 0, !last);
            }
        }
        if (ph + 1 < p.ph_hi) { __threadfence(); cg::this_grid().sync(); }
    }
}

static unsigned phase_mask(int ph) {
    if (ph == 0) return 1u << 0; if (ph == 1) return 1u << 1;
    const int sub = (ph - 2) % 9;
    switch (sub) { case 0: return 1u << 2; case 1: return (1u << 3) | (1u << 4) | (1u << 5); case 2: return (1u << 6) | (1u << 7) | (1u << 8); case 3: return (1u << 9) | (1u << 10);
        case 4: return 1u << 11; case 5: return 1u << 12; case 6: return 1u << 13; case 7: return 1u << 14; default: return 1u << 12; }
}
typedef void (*kern_t)(Params);
static kern_t kernel_for_mask(unsigned m) {
    switch (m) {
        case 1u << 0: return fwd_megakernel<1u << 0>; case 1u << 1: return fwd_megakernel<1u << 1>; case 1u << 2: return fwd_megakernel<1u << 2>;
        case (1u << 3) | (1u << 4) | (1u << 5): return fwd_megakernel<(1u << 3) | (1u << 4) | (1u << 5)>;
        case (1u << 6) | (1u << 7) | (1u << 8): return fwd_megakernel<(1u << 6) | (1u << 7) | (1u << 8)>;
        case (1u << 9) | (1u << 10): return fwd_megakernel<(1u << 9) | (1u << 10)>;
        case 1u << 11: return fwd_megakernel<1u << 11>; case 1u << 12: return fwd_megakernel<1u << 12>; case 1u << 13: return fwd_megakernel<1u << 13>; default: return fwd_megakernel<1u << 14>;
    }
}
extern "C" void kernel_launch(void* const* d_in, const int* in_sizes, int n_in, void* d_out, int out_size, void* d_ws, size_t ws_size, hipStream_t stream) {
    static int grid = 0;
    if (grid == 0) {
        if (n_in != 24 || out_size != 58720256 || ws_size < WS_END) { fprintf(stderr, "kernel_launch: unexpected shapes (n_in %d out %d ws %zu)\n", n_in, out_size, ws_size); grid = -1; return; }
        int dev = 0, cus = 0;
        (void)hipGetDevice(&dev); (void)hipDeviceGetAttribute(&cus, hipDeviceAttributeMultiprocessorCount, dev);
#if MK_ONE_LAUNCH
        if (hipFuncSetAttribute((const void*)fwd_megakernel<0x7FFFu>, hipFuncAttributeMaxDynamicSharedMemorySize, LDS_BYTES) != hipSuccess) { fprintf(stderr, "kernel_launch: hipFuncSetAttribute failed\n"); grid = -1; return; }
#else
        for (int ph = 0; ph < 11; ++ph) (void)hipFuncSetAttribute((const void*)kernel_for_mask(phase_mask(ph)), hipFuncAttributeMaxDynamicSharedMemorySize, LDS_BYTES);
#endif
        (void)hipGetLastError();
        grid = cus > 0 ? cus : 256;
    }
    if (grid < 0) return;
    (void)hipMemsetAsync((char*)d_ws + WS_CTL, 0, 4096, stream);
    Params p{};
    for (int i = 0; i < 24; ++i) p.in[i] = (const float*)d_in[i];
    p.out = (float*)d_out; p.ws = (unsigned char*)d_ws;
#if MK_ONE_LAUNCH
    p.ph_lo = 0; p.ph_hi = NPHASE;
    void* args[] = {&p};
    hipError_t e = hipLaunchCooperativeKernel((const void*)fwd_megakernel<0x7FFFu>, dim3(grid), dim3(512), args, LDS_BYTES, stream);
    if (e != hipSuccess) fprintf(stderr, "cooperative launch failed: %s (grid %d)\n", hipGetErrorString(e), grid);
#else
    for (int ph = 0; ph < NPHASE; ++ph) { p.ph_lo = ph; p.ph_hi = ph + 1; hipLaunchKernelGGL(kernel_for_mask(phase_mask(ph)), dim3(grid), dim3(512), LDS_BYTES, stream, p); }
#endif
}
```

```cpp
#include <hip/hip_runtime.h>
#include <hip/hip_cooperative_groups.h>
#include <cstdio>
#include <cstdint>
namespace cg = cooperative_groups;

#define PHON(k) ((PHM_ >> (k)) & 1)
#ifndef MK_ONE_LAUNCH
#define MK_ONE_LAUNCH 1
#endif

#define DI __device__ __forceinline__
#define LAS __attribute__((address_space(3)))
typedef unsigned short bf16_t;
typedef short bf16x8 __attribute__((ext_vector_type(8)));
typedef short s16x4 __attribute__((ext_vector_type(4)));
typedef float f32x4 __attribute__((ext_vector_type(4)));
typedef float f32x16 __attribute__((ext_vector_type(16)));
typedef float f32x2 __attribute__((ext_vector_type(2)));
typedef unsigned u32x4 __attribute__((ext_vector_type(4)));
typedef unsigned u32x2 __attribute__((ext_vector_type(2)));

constexpr int MROWS = 16384, DM = 1024, DEPTH = 4, DFF = 2816, DIN = 3856, ZLD = 2320;
constexpr float ALPHA = 1.681792830507429f, LN_EPS = 1e-5f, RMS_EPS = 1e-6f;
constexpr float QSCALE = 0.125f * 1.4426950408889634f;
constexpr int ZB_BQ = 0, ZB_BK = 256, ZB_BV = 512, ZB_BG = 768, ZB_BBETA = 1024, ZB_BA = 1032, ZB_CQ = 1040, ZB_CF = 1296, ZB_CI = 1808, ZB_CG = 2064;
constexpr size_t OUT_K = 16777216, OUT_V = 33554432, OUT_SD = 50331648, OUT_SH = 54525952;
constexpr size_t MiB = 1u << 20;
constexpr size_t WS_CTL = 0, WS_MOD = 64 * 1024, WS_TAB = 512 * 1024, WS_CK = 1 * MiB, WS_CV = 3 * MiB, WS_W = 8 * MiB, WBUF = 27 * MiB;
constexpr size_t W_IN = 0, W_OUT = 8 * MiB, W_FFI = 10 * MiB, W_FFO = 21 * MiB;
constexpr size_t WS_XM = 62 * MiB, WS_O = 94 * MiB, WS_ZB = 126 * MiB, WS_Q = 199 * MiB, WS_K = 215 * MiB, WS_V = 231 * MiB;
constexpr size_t WS_ACT = 126 * MiB;
constexpr size_t WS_DPW = 247 * MiB, WS_DPQD = 263 * MiB, WS_DPQK = 279 * MiB, WS_DPKD = 295 * MiB;
constexpr size_t WS_DPU = WS_XM;
constexpr size_t WS_OD = 311 * MiB, WS_HS = 343 * MiB, WS_HD = 375 * MiB, WS_GL = 375 * MiB + 512 * 1024, WS_END = 376 * MiB;
constexpr int LDS_BYTES = 147456;
constexpr int NPHASE = 2 + 9 * DEPTH;

struct Params { const float* in[24]; float* out; unsigned char* ws; int ph_lo, ph_hi; };

DI unsigned cvt_pk_bf16(float lo, float hi) { unsigned r; asm volatile("v_cvt_pk_bf16_f32 %0, %1, %2" : "=v"(r) : "v"(lo), "v"(hi)); return r; }
DI bf16_t f2bf(float f) { return (bf16_t)(cvt_pk_bf16(f, 0.f) & 0xffffu); }
DI float bf2f(bf16_t b) { return __uint_as_float(((unsigned)b) << 16); }
DI float sigmoidf_(float x) { return 1.0f / (1.0f + __expf(-x)); }
DI float siluf_(float x) { return x / (1.0f + __expf(-x)); }
DI float wave_sum(float v) {
#pragma unroll
    for (int o = 1; o < 64; o <<= 1) v += __shfl_xor(v, o);
    return v;
}
DI u32x2 pack4(f32x4 v) { u32x2 w; w.x = cvt_pk_bf16(v[0], v[1]); w.y = cvt_pk_bf16(v[2], v[3]); return w; }
DI bf16x8 pack8(f32x4 a, f32x4 b) { u32x4 w; w.x = cvt_pk_bf16(a[0], a[1]); w.y = cvt_pk_bf16(a[2], a[3]); w.z = cvt_pk_bf16(b[0], b[1]); w.w = cvt_pk_bf16(b[2], b[3]); return __builtin_bit_cast(bf16x8, w); }
DI int pinv(int k) { return (k >> 5) * 32 + ((k >> 2) & 3) * 8 + ((k >> 4) & 1) * 4 + (k & 3); }
DI int row_mod(int r) { return r < 8192 ? 0 : 1 + ((r - 8192) >> 12); }

namespace pg8 {
constexpr int BM = 256, BK = 64, HALF = 128, HTB = HALF * BK * 2, STAGE_BYTES = 8 * HTB, NXCD = 8, WGM = 8;
DI int lds_byte(int r, int c) { const int st = (r >> 4) * 2 + (c >> 5), rr = r & 15, cc = c & 31, ob = rr * 64 + cc * 2; return st * 1024 + (ob ^ (((ob >> 9) & 1) << 5)); }
DI void stage_rc(int b, int& R, int& C) { const int st = b / 1024, sb = b % 1024, swz = sb ^ (((sb >> 9) & 1) << 5); R = (st >> 1) * 16 + swz / 64; C = (st & 1) * 32 + (swz % 64) / 2; }
struct Unit { int pm, pn; };
struct Gemm { const bf16_t* A; const bf16_t* Bt; int M, N, K; };
struct StaticOrder {
    int nM, nN, nwg, G, c;
    DI void init(int M, int N, int G_, int c_) { nM = M / BM; nN = N / BM; nwg = nM * nN; G = G_; c = c_; }
    DI bool next(int i, Unit& u) const {
        const long L = (long)i * G + c; if (L >= nwg) return false;
        int wgid = (int)L; { const int q = nwg / NXCD, r = nwg % NXCD, xcd = wgid % NXCD, off = wgid / NXCD; wgid = (xcd < r ? xcd * (q + 1) : r * (q + 1) + (xcd - r) * q) + off; }
        const int nig = WGM * nN, gid = wgid / nig, fm = gid * WGM, gsz = (nM - fm) < WGM ? (nM - fm) : WGM;
        u.pm = fm + ((wgid % nig) % gsz); u.pn = (wgid % nig) / gsz; return true;
    }
};

template <class Epi>
DI void gemm_phase(LAS unsigned char* lds, const Gemm g, const StaticOrder& S, const Epi& E, int tid_in) {
    const int tid = tid_in, wid = __builtin_amdgcn_readfirstlane(tid >> 6), lane = tid & 63, wr = wid >> 2, wc = wid & 3, fr = lane & 15, fq = lane >> 4;
    const int K = g.K, nt = K / BK;
    unsigned voffA[2];
#pragma unroll
    for (int i = 0; i < 2; ++i) { int R, C; stage_rc(tid * 16 + i * 8192, R, C); voffA[i] = (unsigned)(R * K + C) * 2u; }
    const size_t kstep = (size_t)(BK * 2);
    const size_t hstep = (size_t)HALF * K * 2;
    const size_t tstep = 2 * hstep;
    const unsigned ldsw = (unsigned)wid * 1024u;
    const int aoff = lds_byte(wr * 64 + fr, fq * 8), boff = lds_byte(wc * 32 + fr, fq * 8);
#define PG8_SA(b, h) (((b) * 2 + (h)) * HTB)
#define PG8_SB(b, h) ((4 + (b) * 2 + (h)) * HTB)
#define PG8_STAGE(bufoff, gbase) do { _Pragma("unroll") for (int _i = 0; _i < 2; ++_i) \
        __builtin_amdgcn_global_load_lds((const unsigned*)((const char*)(gbase) + voffA[_i]), (LAS unsigned*)(lds + (bufoff) + ldsw + _i * 8192), 16, 0, 0); } while (0)
#define PG8_LDA(dst, b, h) do { _Pragma("unroll") for (int m = 0; m < 4; ++m) _Pragma("unroll") for (int k = 0; k < 2; ++k) dst[m][k] = *(const LAS bf16x8*)(lds + PG8_SA(b, h) + aoff + m * 2048 + k * 1024); } while (0)
#define PG8_LDB(dst, b, h) do { _Pragma("unroll") for (int n = 0; n < 2; ++n) _Pragma("unroll") for (int k = 0; k < 2; ++k) dst[n][k] = *(const LAS bf16x8*)(lds + PG8_SB(b, h) + boff + n * 2048 + k * 1024); } while (0)
#define PG8_MMA(ai, bj, At, Bt) do { __builtin_amdgcn_s_setprio(1); _Pragma("unroll") for (int m = 0; m < 4; ++m) _Pragma("unroll") for (int n = 0; n < 2; ++n) _Pragma("unroll") for (int k = 0; k < 2; ++k) \
        acc[ai][bj][m][n] = __builtin_amdgcn_mfma_f32_16x16x32_bf16(Bt[n][k], At[m][k], acc[ai][bj][m][n], 0, 0, 0); __builtin_amdgcn_s_setprio(0); } while (0)
#define PG8_WAIT_V(n) asm volatile("s_waitcnt vmcnt(" #n ")" ::: "memory")
#define PG8_WAIT_L(n) asm volatile("s_waitcnt lgkmcnt(" #n ")" ::: "memory")
#define PG8_BAR __builtin_amdgcn_s_barrier()
#define PG8_SCHED __builtin_amdgcn_sched_barrier(0)
    Unit cur, nxt; int ui = 0;
    if (!S.next(0, cur)) return;
    f32x4 acc[2][2][4][2];
#pragma unroll
    for (int a = 0; a < 2; ++a)
#pragma unroll
        for (int b = 0; b < 2; ++b)
#pragma unroll
            for (int m = 0; m < 4; ++m)
#pragma unroll
                for (int n = 0; n < 2; ++n) acc[a][b][m][n] = (f32x4){0.f, 0.f, 0.f, 0.f};
    bf16x8 At[4][2], B0[2][2], B1[2][2];
    const char* cA = (const char*)g.A + (size_t)cur.pm * tstep; const char* cB = (const char*)g.Bt + (size_t)cur.pn * tstep;
    PG8_STAGE(PG8_SB(0, 0), cB); PG8_STAGE(PG8_SB(0, 1), cB + hstep); PG8_STAGE(PG8_SA(0, 0), cA); PG8_STAGE(PG8_SA(0, 1), cA + hstep);
    if (wr == 1) PG8_BAR;
    PG8_WAIT_V(2); PG8_BAR;
    PG8_STAGE(PG8_SB(1, 0), cB + kstep); PG8_STAGE(PG8_SA(1, 0), cA + kstep); PG8_STAGE(PG8_SB(1, 1), cB + hstep + kstep);
    PG8_WAIT_V(6); PG8_BAR;
    for (;;) {
        const bool has_next = S.next(ui + 1, nxt);
        const char* nA = has_next ? (const char*)g.A + (size_t)nxt.pm * tstep : cA; const char* nB = has_next ? (const char*)g.Bt + (size_t)nxt.pn * tstep : cB;
        for (int t = 0; t < nt; t += 2) {
            const bool last = (t == nt - 2);
            const char* a1 = cA + (size_t)(t + 1) * kstep;
            const char* a2 = last ? nA : cA + (size_t)(t + 2) * kstep; const char* b2 = last ? nB : cB + (size_t)(t + 2) * kstep;
            const char* a3 = a2 + kstep; const char* b3 = b2 + kstep;
            PG8_LDB(B0, 0, 0); PG8_LDB(B1, 0, 1); PG8_SCHED; PG8_LDA(At, 0, 0); PG8_STAGE(PG8_SA(1, 1), a1 + hstep);
            PG8_WAIT_V(8); PG8_WAIT_L(0); PG8_BAR; PG8_MMA(0, 0, At, B0); PG8_MMA(0, 1, At, B1); PG8_BAR; PG8_SCHED;
            PG8_LDA(At, 0, 1); PG8_STAGE(PG8_SB(0, 0), b2); PG8_STAGE(PG8_SB(0, 1), b2 + hstep); PG8_STAGE(PG8_SA(0, 0), a2);
            PG8_WAIT_V(8); PG8_WAIT_L(0); PG8_BAR; PG8_MMA(1, 0, At, B0); PG8_MMA(1, 1, At, B1); PG8_BAR; PG8_SCHED;
            PG8_LDB(B0, 1, 0); PG8_LDB(B1, 1, 1); PG8_SCHED; PG8_LDA(At, 1, 0); PG8_STAGE(PG8_SA(0, 1), a2 + hstep);
            PG8_WAIT_V(8); PG8_WAIT_L(0); PG8_BAR; PG8_MMA(0, 0, At, B0); PG8_MMA(0, 1, At, B1); PG8_BAR; PG8_SCHED;
            PG8_LDA(At, 1, 1); PG8_STAGE(PG8_SB(1, 0), b3); PG8_STAGE(PG8_SB(1, 1), b3 + hstep); PG8_STAGE(PG8_SA(1, 0), a3);
            PG8_WAIT_V(8); PG8_WAIT_L(0); PG8_BAR; PG8_MMA(1, 0, At, B0); PG8_MMA(1, 1, At, B1); PG8_BAR; PG8_SCHED;
        }
        if (wr == 0) PG8_BAR;
        E(acc, cur, wr, wc, fr, fq);
        if (!has_next) break;
#pragma unroll
        for (int a = 0; a < 2; ++a)
#pragma unroll
            for (int b = 0; b < 2; ++b)
#pragma unroll
                for (int m = 0; m < 4; ++m)
#pragma unroll
                    for (int n = 0; n < 2; ++n) acc[a][b][m][n] = (f32x4){0.f, 0.f, 0.f, 0.f};
        cur = nxt; cA = nA; cB = nB; ++ui;
        if (wr == 1) PG8_BAR;
    }
    PG8_WAIT_V(0);
    PG8_BAR;
#undef PG8_SA
#undef PG8_SB
#undef PG8_STAGE
#undef PG8_LDA
#undef PG8_LDB
#undef PG8_MMA
#undef PG8_WAIT_V
#undef PG8_WAIT_L
#undef PG8_BAR
#undef PG8_SCHED
}
}

struct EpiIn {
    bf16_t *Qb, *Kb, *Vb, *zb; float *outK, *outV; const f32x2* rope; int layer;
    DI void operator()(const f32x4 (&acc)[2][2][4][2], const pg8::Unit& u, int wr, int wc, int fr, int fq) const {
        const int tile = u.pn; const bool sample = u.pm >= 32;
        if (tile < 6) {
            const int kind = tile >> 1; const int cb = (tile & 1) * 256 + wc * 32 + 4 * fq;
            bf16_t* dst = Qb + (size_t)kind * (16u * 1024u * 1024u / 2u);
            float* of = outK + (size_t)(kind >= 1 ? kind - 1 : 0) * 16777216u;
#pragma unroll
            for (int ai = 0; ai < 2; ++ai)
#pragma unroll
                for (int m = 0; m < 4; ++m) {
                    const int r = u.pm * 256 + ai * 128 + wr * 64 + m * 16 + fr;
#pragma unroll
                    for (int bj = 0; bj < 2; ++bj) {
                        f32x4 a = acc[ai][bj][m][0], b = acc[ai][bj][m][1]; const int cc = cb + bj * 128;
                        if (!sample && kind >= 1) { float* o = of + ((size_t)((r >> 8) * 4 + layer) * 256 + (r & 255)) * 512 + cc; *(f32x4*)o = a; *(f32x4*)(o + 16) = b; }
                        if (sample && kind < 2) {
                            const int t = (r - 8192) & 4095; const int pos = (wc & 1) ? (t & 63) : (t >> 6); const f32x2* rp = rope + pos * 16 + 4 * fq;
#pragma unroll
                            for (int j = 0; j < 4; ++j) { const f32x2 cs = rp[j]; const float x1 = a[j], x2 = b[j]; a[j] = x1 * cs.x - x2 * cs.y; b[j] = x2 * cs.x + x1 * cs.y; }
                        }
                        if (kind == 0) { a = a * QSCALE; b = b * QSCALE; }
                        *(u32x2*)(dst + (size_t)r * 512 + cc) = pack4(a); *(u32x2*)(dst + (size_t)r * 512 + cc + 16) = pack4(b);
                    }
                    asm volatile("" ::: "memory");
                }
        } else {
#pragma unroll
            for (int ai = 0; ai < 2; ++ai)
#pragma unroll
                for (int m = 0; m < 4; ++m) {
                    const int r = u.pm * 256 + ai * 128 + wr * 64 + m * 16 + fr;
#pragma unroll
                    for (int bj = 0; bj < 2; ++bj)
#pragma unroll
                        for (int n = 0; n < 2; ++n) { const int c = (tile - 6) * 256 + bj * 128 + wc * 32 + 16 * n + 4 * fq; if (c < ZLD) *(u32x2*)(zb + (size_t)r * ZLD + c) = pack4(acc[ai][bj][m][n]); }
                    asm volatile("" ::: "memory");
                }
        }
    }
};
struct EpiRes {
    float* x; const float* gate;
    DI void operator()(const f32x4 (&acc)[2][2][4][2], const pg8::Unit& u, int wr, int wc, int fr, int fq) const {
        const float* gv = gate + row_mod(u.pm * 256) * 6144;
#pragma unroll
        for (int ai = 0; ai < 2; ++ai)
#pragma unroll
            for (int m = 0; m < 4; ++m) {
                const int r = u.pm * 256 + ai * 128 + wr * 64 + m * 16 + fr;
#pragma unroll
                for (int bj = 0; bj < 2; ++bj)
#pragma unroll
                    for (int n = 0; n < 2; ++n) { const int c = u.pn * 256 + bj * 128 + wc * 32 + 16 * n + 4 * fq; const f32x4 g4 = *(const f32x4*)(gv + c); float* xp = x + (size_t)r * DM + c; const f32x4 xv = *(const f32x4*)xp; *(f32x4*)xp = xv * ALPHA + g4 * acc[ai][bj][m][n]; }
            }
    }
};
struct EpiFfn {
    bf16_t* act;
    DI void operator()(const f32x4 (&acc)[2][2][4][2], const pg8::Unit& u, int wr, int wc, int fr, int fq) const {
#pragma unroll
        for (int ai = 0; ai < 2; ++ai)
#pragma unroll
            for (int m = 0; m < 4; ++m) {
                const int r = u.pm * 256 + ai * 128 + wr * 64 + m * 16 + fr;
#pragma unroll
                for (int n = 0; n < 2; ++n) { const f32x4 gt = acc[ai][0][m][n], up = acc[ai][1][m][n]; f32x4 o;
#pragma unroll
                    for (int j = 0; j < 4; ++j) o[j] = siluf_(gt[j]) * up[j];
                    *(u32x2*)(act + (size_t)r * DFF + u.pn * 128 + wc * 32 + 16 * n + 4 * fq) = pack4(o); }
            }
    }
};

struct Ctx {
    const Params* p; LAS unsigned char* lds; float* L; int tid, lane, wave, G, gw, NGW;
    unsigned char* ws; float* out;
};

DI void tr_item(const float* W, int K, int N, bf16_t* WT, int mode, float* scr, int item, int lane) {
    const int nblk = (N + 31) / 32, kb = item / nblk, nb = item % nblk, k0 = 64 * kb, n0 = 32 * nb;
    const int nn = n0 + (lane & 31);
#pragma unroll 8
    for (int i = 0; i < 32; ++i) { const int kk = 2 * i + (lane >> 5); scr[kk * 33 + (lane & 31)] = (nn < N) ? W[(size_t)(k0 + kk) * N + nn] : 0.f; }
    __builtin_amdgcn_wave_barrier();
    const int c = lane & 7;
#pragma unroll
    for (int j = 0; j < 4; ++j) {
        const int nl = (lane >> 3) + 8 * j, n = n0 + nl; const float* s = scr + (8 * c) * 33 + nl;
        if (n < N) {
            int dst = n; if (mode == 1) { if (n < DFF) dst = (n >> 7) * 256 + (n & 127); else { const int jj = n - DFF; dst = (jj >> 7) * 256 + 128 + (jj & 127); } }
            u32x4 o; o.x = cvt_pk_bf16(s[0 * 33], s[1 * 33]); o.y = cvt_pk_bf16(s[2 * 33], s[3 * 33]); o.z = cvt_pk_bf16(s[4 * 33], s[5 * 33]); o.w = cvt_pk_bf16(s[6 * 33], s[7 * 33]);
            *(u32x4*)(WT + (size_t)dst * K + k0 + 8 * c) = o;
        }
    }
    __builtin_amdgcn_wave_barrier();
}
DI void convert_layer_weights(const Ctx& C, int layer) {
    const Params& p = *C.p;
    unsigned char* wb = C.ws + WS_W + (size_t)(layer & 1) * WBUF;
    bf16_t* Win = (bf16_t*)(wb + W_IN); bf16_t* Wout = (bf16_t*)(wb + W_OUT); bf16_t* Wffi = (bf16_t*)(wb + W_FFI); bf16_t* Wffo = (bf16_t*)(wb + W_FFO);
    float* scr = C.L + C.wave * (64 * 33);
    constexpr int I_IN = 16 * 121, I_OUT = 16 * 32, I_FFI = 16 * 176, I_FFO = 44 * 32, NIT = I_IN + I_OUT + I_FFI + I_FFO;
    for (int it = C.gw; it < NIT; it += C.NGW) {
        int r = it;
        if (r < I_IN) { tr_item(p.in[10] + (size_t)layer * DM * DIN, DM, DIN, Win, 0, scr, r, C.lane); continue; } r -= I_IN;
        if (r < I_OUT) { tr_item(p.in[19] + (size_t)layer * DM * DM, DM, DM, Wout, 0, scr, r, C.lane); continue; } r -= I_OUT;
        if (r < I_FFI) { tr_item(p.in[22] + (size_t)layer * DM * 2 * DFF, DM, 2 * DFF, Wffi, 1, scr, r, C.lane); continue; } r -= I_FFI;
        tr_item(p.in[23] + (size_t)layer * DFF * DM, DFF, DM, Wffo, 0, scr, r, C.lane);
    }
    u32x4* z = (u32x4*)(Win + (size_t)DIN * DM); const int nz = 240 * DM * 2 / 16;
    for (int i = blockIdx.x * 512 + C.tid; i < nz; i += C.G * 512) z[i] = (u32x4){0u, 0u, 0u, 0u};
}

DI void mod_unit(const Ctx& C, int u) {
    const Params& p = *C.p; const int tid = C.tid;
    float* cs = C.L; float* red = C.L + 3072;
    const int layer = u >> 6, col0 = (u & 63) * 96;
    __syncthreads();
    for (int i = tid; i < 3072; i += 512) { const int v = i >> 10, k = i & 1023; const float c = (v == 0) ? p.in[7][k] : p.in[6][(v - 1) * 1024 + k]; cs[i] = siluf_(c); }
    __syncthreads();
    if (tid < 504) {
        const int cgp = tid % 24, rs = tid / 24;
        f32x4 a0 = {0, 0, 0, 0}, a1 = a0, a2 = a0;
        const float* Wp = p.in[8] + (size_t)layer * DM * 6144 + col0 + cgp * 4;
        for (int k = rs; k < 1024; k += 21) { const f32x4 w = *(const f32x4*)(Wp + (size_t)k * 6144); a0 += w * cs[k]; a1 += w * cs[1024 + k]; a2 += w * cs[2048 + k]; }
        float* rr = red + rs * 288 + cgp * 4;
#pragma unroll
        for (int j = 0; j < 4; ++j) { rr[j] = a0[j]; rr[96 + j] = a1[j]; rr[192 + j] = a2[j]; }
    }
    __syncthreads();
    if (tid < 288) {
        const int v = tid / 96, cc = tid % 96; float s = 0.f;
        for (int rs = 0; rs < 21; ++rs) s += red[rs * 288 + tid];
        ((float*)(C.ws + WS_MOD))[(size_t)(layer * 3 + v) * 6144 + col0 + cc] = s + p.in[9][layer * 6144 + col0 + cc];
    }
}

DI void phase0a(const Ctx& C) {
    const Params& p = *C.p;
    for (int u = blockIdx.x; u < 256; u += C.G) mod_unit(C, u);
    __syncthreads();
    convert_layer_weights(C, 0);
    const int gt = blockIdx.x * 512 + C.tid, NT = C.G * 512;
    float* tab = (float*)(C.ws + WS_TAB);
    if (gt < 1024) { const int pos = gt >> 4, i = gt & 15; const float inv = __builtin_amdgcn_exp2f(-(float)i * (13.287712379549449f / 16.0f)); float rev = (float)pos * inv * 0.15915494309189535f; rev -= floorf(rev);
        tab[2 * gt] = __builtin_amdgcn_cosf(rev); tab[2 * gt + 1] = __builtin_amdgcn_sinf(rev); }
    if (gt >= 1024 && gt < 1028) { const int l = gt - 1024; const float* dl = p.in[17] + l * 256; float s01 = 0.f, s23 = 0.f; for (int i = 0; i < 64; ++i) { s01 += dl[i] * dl[64 + i]; s23 += dl[128 + i] * dl[192 + i]; }
        tab[2048 + l] = __expf(s01) - __expf(s23) + (0.8f - 0.6f * __expf(-0.3f * (float)l)); }
    if (gt >= 2048 && gt < 2560) { const int dir = (gt - 2048) >> 8, c = gt & 255; const float* lb = p.in[15] + dir * 1024 + c; float v[4], mx = -1e30f; for (int l = 0; l < 4; ++l) { v[l] = lb[l * 256]; mx = fmaxf(mx, v[l]); }
        float s = 0.f; for (int l = 0; l < 4; ++l) { v[l] = __expf(v[l] - mx); s += v[l]; } float cum = 0.f; for (int l = 0; l < 4; ++l) { if (l > 0) cum += v[l] / s; tab[4096 + (dir * 4 + l) * 256 + c] = cum; } }
    bf16_t* ck = (bf16_t*)(C.ws + WS_CK); bf16_t* cv = (bf16_t*)(C.ws + WS_CV);
    for (int i = gt; i < 2 * 4 * 256 * 512 / 4; i += NT) { const int e = i * 4; const int c = e & 511, j = (e >> 9) & 255, l = (e >> 17) & 3, b = e >> 19;
        const size_t dst = ((size_t)((l * 2 + b) * 256 + j)) * 512 + c;
        *(u32x2*)(ck + dst) = pack4(*(const f32x4*)(p.in[2] + e)); *(u32x2*)(cv + dst) = pack4(*(const f32x4*)(p.in[3] + e)); }
}

DI void row_pass(const Ctx& C, int mode, const float* lng, const float* lnb, const float* modl, int sc_off, int sh_off, bool write_xm) {
    const Params& p = *C.p; float* x = C.out; bf16_t* xm = (bf16_t*)(C.ws + WS_XM);
    for (int r = C.gw; r < MROWS; r += C.NGW) {
        const float* src = mode == 0 ? (r < 8192 ? p.in[0] + (size_t)r * DM : p.in[1] + (size_t)(r - 8192) * DM) : x + (size_t)r * DM;
        f32x4 v[4];
#pragma unroll
        for (int j = 0; j < 4; ++j) v[j] = *(const f32x4*)(src + 4 * C.lane + 256 * j);
        if (mode == 1) {
            float s = 0.f;
#pragma unroll
            for (int j = 0; j < 4; ++j) s += (v[j][0] + v[j][1]) + (v[j][2] + v[j][3]);
            const float mean = wave_sum(s) * (1.f / DM); float s2 = 0.f;
#pragma unroll
            for (int j = 0; j < 4; ++j) { v[j] = v[j] - mean; s2 += (v[j][0] * v[j][0] + v[j][1] * v[j][1]) + (v[j][2] * v[j][2] + v[j][3] * v[j][3]); }
            const float rstd = 1.0f / sqrtf(wave_sum(s2) * (1.f / DM) + LN_EPS);
#pragma unroll
            for (int j = 0; j < 4; ++j) { const f32x4 g4 = *(const f32x4*)(lng + 4 * C.lane + 256 * j), b4 = *(const f32x4*)(lnb + 4 * C.lane + 256 * j); v[j] = v[j] * rstd * g4 + b4; }
        }
#pragma unroll
        for (int j = 0; j < 4; ++j) *(f32x4*)(x + (size_t)r * DM + 4 * C.lane + 256 * j) = v[j];
        if (write_xm) {
            const float* mv = modl + row_mod(r) * 6144;
#pragma unroll
            for (int j = 0; j < 4; ++j) { const int c = 4 * C.lane + 256 * j; const f32x4 sc = *(const f32x4*)(mv + sc_off + c), sh = *(const f32x4*)(mv + sh_off + c);
                *(u32x2*)(xm + (size_t)r * DM + c) = pack4(v[j] * (sc + 1.0f) + sh); }
        }
    }
}

#define MFMA32(a, b, c) __builtin_amdgcn_mfma_f32_32x32x16_bf16((a), (b), (c), 0, 0, 0)
#define MFMA16(a, b, c) __builtin_amdgcn_mfma_f32_16x16x32_bf16((a), (b), (c), 0, 0, 0)
constexpr int AK_LD = 72, AV_LD = 136;
template <int PASS>
DI void attn_pass(int tid, int q, int hi, int half, int h, int nst, int nlat, const bf16_t* Klat, const bf16_t* Vlat, const bf16_t* Kctx, const bf16_t* Vctx,
                  LAS bf16_t* K1s, LAS bf16_t* K2s, LAS bf16_t* VTs, const bf16x8 (&q1)[4], const bf16x8 (&q2)[4],
                  float& m1, float& l1, float& m2, float& l2, float iL1, float iL2, f32x16 (&o)[4]) {
        u32x4 kreg[4], vreg[4];
        {
            const bf16_t* kb0 = (0 < nlat) ? Klat : Kctx; const bf16_t* vb0 = (0 < nlat) ? Vlat : Vctx;
#pragma unroll
            for (int i = 0; i < 2; ++i) { const int id = tid + 512 * i, key = id >> 3, ch = id & 7; kreg[i] = *(const u32x4*)(kb0 + (size_t)key * 512 + h * 128 + ch * 8); kreg[2 + i] = *(const u32x4*)(kb0 + (size_t)key * 512 + h * 128 + 64 + ch * 8); }
            if (PASS == 1) {
#pragma unroll
                for (int i = 0; i < 4; ++i) { const int id = tid + 512 * i, key = id >> 4, ch = id & 15; vreg[i] = *(const u32x4*)(vb0 + (size_t)key * 512 + h * 128 + ch * 8); }
            }
        }
        for (int st = 0; st < nst; ++st) {
            __syncthreads();
#pragma unroll
            for (int i = 0; i < 2; ++i) { const int id = tid + 512 * i, key = id >> 3, ch = id & 7; *(LAS u32x4*)(K1s + key * AK_LD + ch * 8) = kreg[i]; *(LAS u32x4*)(K2s + key * AK_LD + ch * 8) = kreg[2 + i]; }
            if (PASS == 1) {
#pragma unroll
                for (int i = 0; i < 4; ++i) { const int id = tid + 512 * i, key = id >> 4, ch = id & 15; const u32x4 vv = vreg[i];
#pragma unroll
                    for (int e = 0; e < 4; ++e) { VTs[(ch * 8 + 2 * e) * AV_LD + key] = (bf16_t)(vv[e] & 0xffffu); VTs[(ch * 8 + 2 * e + 1) * AV_LD + key] = (bf16_t)(vv[e] >> 16); } }
            }
            __syncthreads();
            if (st + 1 < nst) {
                const int sn = st + 1; const bf16_t* kbn = (sn < nlat) ? Klat + (size_t)sn * 128 * 512 : Kctx + (size_t)(sn - nlat) * 128 * 512; const bf16_t* vbn = (sn < nlat) ? Vlat + (size_t)sn * 128 * 512 : Vctx + (size_t)(sn - nlat) * 128 * 512;
#pragma unroll
                for (int i = 0; i < 2; ++i) { const int id = tid + 512 * i, key = id >> 3, ch = id & 7; kreg[i] = *(const u32x4*)(kbn + (size_t)key * 512 + h * 128 + ch * 8); kreg[2 + i] = *(const u32x4*)(kbn + (size_t)key * 512 + h * 128 + 64 + ch * 8); }
                if (PASS == 1) {
#pragma unroll
                    for (int i = 0; i < 4; ++i) { const int id = tid + 512 * i, key = id >> 4, ch = id & 15; vreg[i] = *(const u32x4*)(vbn + (size_t)key * 512 + h * 128 + ch * 8); }
                }
            }
#pragma unroll
            for (int kbk = 0; kbk < 2; ++kbk) {
                const int keyrow = half * 64 + kbk * 32 + q;
                f32x16 s1, pr;
#pragma unroll
                for (int r = 0; r < 16; ++r) s1[r] = 0.f;
#pragma unroll
                for (int ks = 0; ks < 4; ++ks) { const bf16x8 a1 = *(const LAS bf16x8*)(K1s + keyrow * AK_LD + 16 * ks + 8 * hi); s1 = MFMA32(a1, q1[ks], s1); }
                if (PASS == 0) {
                    float mx1 = s1[0];
#pragma unroll
                    for (int r = 1; r < 16; ++r) mx1 = fmaxf(mx1, s1[r]);
                    const float n1 = fmaxf(m1, mx1); float a1s = 0.f;
#pragma unroll
                    for (int r = 0; r < 16; ++r) a1s += __builtin_amdgcn_exp2f(s1[r] - n1);
                    l1 = l1 * __builtin_amdgcn_exp2f(m1 - n1) + a1s; m1 = n1;
                } else {
#pragma unroll
                    for (int r = 0; r < 16; ++r) pr[r] = __builtin_amdgcn_exp2f(s1[r] - m1) * iL1;
                }
#pragma unroll
                for (int r = 0; r < 16; ++r) s1[r] = 0.f;
#pragma unroll
                for (int ks = 0; ks < 4; ++ks) { const bf16x8 a2 = *(const LAS bf16x8*)(K2s + keyrow * AK_LD + 16 * ks + 8 * hi); s1 = MFMA32(a2, q2[ks], s1); }
                if (PASS == 0) {
                    float mx2 = s1[0];
#pragma unroll
                    for (int r = 1; r < 16; ++r) mx2 = fmaxf(mx2, s1[r]);
                    const float n2 = fmaxf(m2, mx2); float a2s = 0.f;
#pragma unroll
                    for (int r = 0; r < 16; ++r) a2s += __builtin_amdgcn_exp2f(s1[r] - n2);
                    l2 = l2 * __builtin_amdgcn_exp2f(m2 - n2) + a2s; m2 = n2;
                } else {
#pragma unroll
                    for (int r = 0; r < 16; ++r) pr[r] -= __builtin_amdgcn_exp2f(s1[r] - m2) * iL2;
                    bf16x8 pb[2];
                    { u32x4 t0, t1; t0.x = cvt_pk_bf16(pr[0], pr[1]); t0.y = cvt_pk_bf16(pr[2], pr[3]); t0.z = cvt_pk_bf16(pr[4], pr[5]); t0.w = cvt_pk_bf16(pr[6], pr[7]);
                      t1.x = cvt_pk_bf16(pr[8], pr[9]); t1.y = cvt_pk_bf16(pr[10], pr[11]); t1.z = cvt_pk_bf16(pr[12], pr[13]); t1.w = cvt_pk_bf16(pr[14], pr[15]);
                      pb[0] = __builtin_bit_cast(bf16x8, t0); pb[1] = __builtin_bit_cast(bf16x8, t1); }
#pragma unroll
                    for (int blk = 0; blk < 4; ++blk)
#pragma unroll
                        for (int s = 0; s < 2; ++s) {
                            const LAS bf16_t* vp = VTs + (blk * 32 + q) * AV_LD + half * 64 + kbk * 32 + 16 * s + 4 * hi;
                            const s16x4 lo = *(const LAS s16x4*)vp, hh = *(const LAS s16x4*)(vp + 8);
                            const bf16x8 av = __builtin_shufflevector(lo, hh, 0, 1, 2, 3, 4, 5, 6, 7);
                            o[blk] = MFMA32(av, pb[s], o[blk]);
                        }
                }
            }
        }
}
DI void attn_unit(const Ctx& C, int layer, int uidx) {
    int tid = C.tid; asm volatile("" : "+v"(tid)); const int lane = tid & 63, w = __builtin_amdgcn_readfirstlane(tid >> 6), wq = w & 3, half = w >> 2, q = lane & 31, hi = lane >> 5;
    const bf16_t* Qb = (const bf16_t*)(C.ws + WS_Q); const bf16_t* Kb = (const bf16_t*)(C.ws + WS_K); const bf16_t* Vb = (const bf16_t*)(C.ws + WS_V);
    const bf16_t* cK = (const bf16_t*)(C.ws + WS_CK); const bf16_t* cV = (const bf16_t*)(C.ws + WS_CV);
    int b, h, rowq0, nst, nlat; const bf16_t *Klat, *Vlat, *Kctx = nullptr, *Vctx = nullptr;
    if (uidx < 256) { b = uidx >> 7; h = (uidx >> 5) & 3; const int qb = uidx & 31; rowq0 = 8192 + b * 4096 + qb * 128; nst = 34; nlat = 32;
        Klat = Kb + (size_t)(8192 + b * 4096) * 512; Vlat = Vb + (size_t)(8192 + b * 4096) * 512; Kctx = cK + (size_t)((layer * 2 + b) * 256) * 512; Vctx = cV + (size_t)((layer * 2 + b) * 256) * 512; }
    else { const int v = uidx - 256; b = v >> 3; h = (v >> 1) & 3; const int qb = v & 1; rowq0 = b * 256 + qb * 128; nst = 2; nlat = 2; Klat = Kb + (size_t)(b * 256) * 512; Vlat = Vb + (size_t)(b * 256) * 512; }
    LAS bf16_t* K1s = (LAS bf16_t*)C.lds; LAS bf16_t* K2s = K1s + 128 * AK_LD; LAS bf16_t* VTs = K2s + 128 * AK_LD;
    LAS float* ex = (LAS float*)(C.lds + 73728);
    const float lam = ((const float*)(C.ws + WS_TAB))[2048 + layer];
    bf16x8 q1[4], q2[4];
    { const bf16_t* qp = Qb + (size_t)(rowq0 + 32 * wq + q) * 512 + h * 128 + 8 * hi;
#pragma unroll
      for (int ks = 0; ks < 4; ++ks) { q1[ks] = *(const bf16x8*)(qp + 16 * ks); q2[ks] = *(const bf16x8*)(qp + 64 + 16 * ks); } }
    float m1 = -1e30f, l1 = 0.f, m2 = -1e30f, l2 = 0.f, iL1 = 0.f, iL2 = 0.f;
    f32x16 o[4];
#pragma unroll
    for (int i = 0; i < 4; ++i)
#pragma unroll
        for (int r = 0; r < 16; ++r) o[i][r] = 0.f;
    attn_pass<0>(tid, q, hi, half, h, nst, nlat, Klat, Vlat, Kctx, Vctx, K1s, K2s, VTs, q1, q2, m1, l1, m2, l2, iL1, iL2, o);
    {
        {
            { const float om = __shfl_xor(m1, 32), ol = __shfl_xor(l1, 32); const float nm = fmaxf(m1, om); l1 = l1 * __builtin_amdgcn_exp2f(m1 - nm) + ol * __builtin_amdgcn_exp2f(om - nm); m1 = nm; }
            { const float om = __shfl_xor(m2, 32), ol = __shfl_xor(l2, 32); const float nm = fmaxf(m2, om); l2 = l2 * __builtin_amdgcn_exp2f(m2 - nm) + ol * __builtin_amdgcn_exp2f(om - nm); m2 = nm; }
            if (hi == 0) { ex[(w * 4 + 0) * 32 + q] = m1; ex[(w * 4 + 1) * 32 + q] = l1; ex[(w * 4 + 2) * 32 + q] = m2; ex[(w * 4 + 3) * 32 + q] = l2; }
            __syncthreads();
            { const int ow = w ^ 4; const float om1 = ex[(ow * 4 + 0) * 32 + q], ol1 = ex[(ow * 4 + 1) * 32 + q], om2 = ex[(ow * 4 + 2) * 32 + q], ol2 = ex[(ow * 4 + 3) * 32 + q];
              float nm = fmaxf(m1, om1); l1 = l1 * __builtin_amdgcn_exp2f(m1 - nm) + ol1 * __builtin_amdgcn_exp2f(om1 - nm); m1 = nm;
              nm = fmaxf(m2, om2); l2 = l2 * __builtin_amdgcn_exp2f(m2 - nm) + ol2 * __builtin_amdgcn_exp2f(om2 - nm); m2 = nm; }
            iL1 = 1.0f / l1; iL2 = lam / l2;
        }
    }
    attn_pass<1>(tid, q, hi, half, h, nst, nlat, Klat, Vlat, Kctx, Vctx, K1s, K2s, VTs, q1, q2, m1, l1, m2, l2, iL1, iL2, o);
    __syncthreads();
    LAS float* comb = (LAS float*)C.lds;
    if (half == 1) {
#pragma unroll
        for (int blk = 0; blk < 4; ++blk)
#pragma unroll
            for (int r = 0; r < 16; ++r) comb[(wq * 64 + blk * 16 + r) * 64 + lane] = o[blk][r];
    }
    __syncthreads();
    if (half == 0) {
        float ss = 0.f;
#pragma unroll
        for (int blk = 0; blk < 4; ++blk)
#pragma unroll
            for (int r = 0; r < 16; ++r) { const float v = o[blk][r] + comb[(wq * 64 + blk * 16 + r) * 64 + lane]; o[blk][r] = v; ss += v * v; }
        ss += __shfl_xor(ss, 32);
        const float lam_init = 0.8f - 0.6f * __expf(-0.3f * (float)layer);
        const float sc = (1.0f / sqrtf(ss * (1.0f / 128.0f) + RMS_EPS)) * (1.0f - lam_init);
        const float* dn = C.p->in[18] + layer * 128;
        bf16_t* ob = (bf16_t*)(C.ws + WS_O) + (size_t)(rowq0 + 32 * wq + q) * DM + h * 128;
#pragma unroll
        for (int blk = 0; blk < 4; ++blk)
#pragma unroll
            for (int r = 0; r < 16; ++r) { const int dv = blk * 32 + (r & 3) + 8 * (r >> 2) + 4 * hi; ob[dv] = f2bf(o[blk][r] * sc * dn[dv]); }
    }
    __syncthreads();
}

DI void delta_prep_unit(const Ctx& C, int layer, int unit) {
    const Params& p = *C.p; int tid = C.tid; asm volatile("" : "+v"(tid)); const int lane = tid & 63, w = __builtin_amdgcn_readfirstlane(tid >> 6);
    const int tc = unit >> 2, h = unit & 3, row0 = tc * 64;
    int ci, nch; if (tc < 128) { ci = tc & 3; nch = 4; } else { ci = (tc - 128) & 63; nch = 64; }
    const bool has_prev = ci > 0, has_next = ci < nch - 1;
    float* qs = C.L; float* kk = C.L + 4160; float* vv = C.L + 8320; float* KK0 = C.L + 12480; float* QK0 = KK0 + 4096; float* Ms = QK0 + 4096; float* bc = Ms + 8192; float* be = bc + 128;
    const bf16_t* zb = (const bf16_t*)(C.ws + WS_ZB);
    const float* cw = p.in[11] + layer * 3 * 768;
    __syncthreads();
#pragma unroll 1
    for (int i = 0; i < 24; ++i) {
        const int idx = tid + 512 * i, t = idx / 192, c = idx % 192, which = c >> 6, d = c & 63, col = which * 256 + h * 64 + d;
        float acc = 0.f;
#pragma unroll
        for (int j = 0; j < 3; ++j) { const int tt = t + j - 1; const bool ok = (tt >= 0 || has_prev) && (tt < 64 || has_next); if (ok) acc += cw[j * 768 + col] * bf2f(zb[(size_t)(row0 + tt) * ZLD + col]); }
        (which == 0 ? qs : (which == 1 ? kk : vv))[t * 65 + d] = siluf_(acc);
    }
    __syncthreads();
    { const int r = tid >> 2, part = tid & 3; float* base = (r < 64 ? qs + r * 65 : kk + (r - 64) * 65) + part * 16; float ss = 0.f;
#pragma unroll
      for (int i = 0; i < 16; ++i) ss += base[i] * base[i];
      ss += __shfl_xor(ss, 1); ss += __shfl_xor(ss, 2);
      const float sc = (1.0f / sqrtf(ss + 1e-6f)) * (r < 64 ? 0.125f : 1.0f);
#pragma unroll
      for (int i = 0; i < 16; ++i) base[i] *= sc; }
    if (w < 2) {
        const int dir = w, i = lane, tt = dir ? 63 - i : i; const size_t row = (size_t)(row0 + tt);
        const float braw = bf2f(zb[row * ZLD + ZB_BBETA + dir * 4 + h]), araw = bf2f(zb[row * ZLD + ZB_BA + dir * 4 + h]);
        const float A = __expf(p.in[12][layer * 8 + dir * 4 + h]); const float x = araw + p.in[13][layer * 8 + dir * 4 + h];
        const float sp = x > 20.f ? x : log1pf(__expf(x)); float g = -A * sp;
#pragma unroll
        for (int off = 1; off < 64; off <<= 1) { const float t = __shfl_up(g, off); if (lane >= off) g += t; }
        bc[dir * 64 + i] = g; const float bt = sigmoidf_(braw); be[dir * 64 + i] = bt; be[128 + dir * 64 + i] = bt * __expf(g);
    }
    __syncthreads();
    { const int a = tid >> 3, b0 = (tid & 7) * 8; float ka[8], qa[8];
#pragma unroll
      for (int j = 0; j < 8; ++j) { ka[j] = 0.f; qa[j] = 0.f; }
#pragma unroll 2
      for (int d = 0; d < 64; ++d) { const float kav = kk[a * 65 + d], qav = qs[a * 65 + d];
#pragma unroll
          for (int j = 0; j < 8; ++j) { const float kb = kk[(b0 + j) * 65 + d]; ka[j] += kav * kb; qa[j] += qav * kb; } }
#pragma unroll
      for (int j = 0; j < 8; ++j) { KK0[a * 64 + b0 + j] = ka[j]; QK0[a * 64 + b0 + j] = qa[j]; } }
    __syncthreads();
    bf16_t* dpW = (bf16_t*)(C.ws + WS_DPW); bf16_t* dpQD = (bf16_t*)(C.ws + WS_DPQD); bf16_t* dpQK = (bf16_t*)(C.ws + WS_DPQK); bf16_t* dpKD = (bf16_t*)(C.ws + WS_DPKD); bf16_t* dpU = (bf16_t*)(C.ws + WS_DPU);
    float* dpGL = (float*)(C.ws + WS_GL);
    { const int i = tid >> 3, j0 = (tid & 7) * 8;
#pragma unroll
      for (int dir = 0; dir < 2; ++dir) {
          const size_t ud = ((size_t)tc * 4 + h) * 2 + dir;
          const float bi = bc[dir * 64 + i], betai = be[dir * 64 + i]; const int ai = dir ? 63 - i : i;
#pragma unroll
          for (int jj = 0; jj < 8; ++jj) { const int j = j0 + jj, aj = dir ? 63 - j : j;
              const float dec = (j <= i) ? __expf(bi - bc[dir * 64 + j]) : 0.f;
              Ms[dir * 4096 + j * 64 + i] = (j < i) ? betai * KK0[ai * 64 + aj] * dec : 0.f;
              dpQK[ud * 4096 + i * 64 + pinv(j)] = f2bf(QK0[ai * 64 + aj] * dec); }
      } }
    __syncthreads();
    if (w < 4) {
        const int dir = w >> 1, c = (w & 1) * 64 + lane; const size_t ud = ((size_t)tc * 4 + h) * 2 + dir;
        const float* Msd = Ms + dir * 4096; const bool isU = (w & 1) == 0; const float* scp = be + (isU ? 0 : 128) + dir * 64; const float* srcp = (isU ? vv : kk) + lane;
        float x[64];
#pragma unroll
        for (int rb = 0; rb < 4; ++rb) {
            float r[16];
#pragma unroll
            for (int ii = 0; ii < 16; ++ii) { const int i = 16 * rb + ii, tt = dir ? 63 - i : i; r[ii] = scp[i] * srcp[tt * 65]; }
            asm volatile("" ::: "memory");
#pragma unroll
            for (int j = 0; j < 16 * rb; ++j) {
                const float* mp = Msd + j * 64 + 16 * rb;
                const f32x4 ma = *(const f32x4*)mp, mb = *(const f32x4*)(mp + 4), mc = *(const f32x4*)(mp + 8), md = *(const f32x4*)(mp + 12);
                const float xj = x[j];
#pragma unroll
                for (int c4 = 0; c4 < 4; ++c4) { r[c4] -= ma[c4] * xj; r[4 + c4] -= mb[c4] * xj; r[8 + c4] -= mc[c4] * xj; r[12 + c4] -= md[c4] * xj; }
                if ((j & 3) == 3) asm volatile("" ::: "memory");
            }
#pragma unroll
            for (int jj = 0; jj < 16; ++jj) {
                const float xj = r[jj]; x[16 * rb + jj] = xj;
                const float* mp = Msd + (16 * rb + jj) * 64 + 16 * rb;
#pragma unroll
                for (int ii = jj + 1; ii < 16; ++ii) r[ii] -= mp[ii] * xj;
                if ((jj & 3) == 3) asm volatile("" ::: "memory");
            }
        }
        if (c < 64) {
            bf16_t* up = dpU + ud * 4096 + c * 64;
#pragma unroll
            for (int i = 0; i < 64; i += 8) { u32x4 o; o.x = cvt_pk_bf16(x[i], x[i + 1]); o.y = cvt_pk_bf16(x[i + 2], x[i + 3]); o.z = cvt_pk_bf16(x[i + 4], x[i + 5]); o.w = cvt_pk_bf16(x[i + 6], x[i + 7]); *(u32x4*)(up + i) = o; }
        } else {
            bf16_t* wp = dpW + ud * 4096 + pinv(c - 64);
#pragma unroll
            for (int i = 0; i < 64; ++i) wp[i * 64] = f2bf(x[i]);
        }
    } else {
#pragma unroll 1
        for (int it = 0; it < 64; ++it) {
            const int e = (tid - 256) + 256 * it, dir = e >> 13, which = (e >> 12) & 1, rem = e & 4095; const size_t ud = ((size_t)tc * 4 + h) * 2 + dir;
            if (which == 0) { const int i = rem >> 6, d = rem & 63, tt = dir ? 63 - i : i; dpQD[ud * 4096 + i * 64 + pinv(d)] = f2bf(qs[tt * 65 + d] * __expf(bc[dir * 64 + i])); }
            else { const int dk = rem >> 6, i = rem & 63, tt = dir ? 63 - i : i; dpKD[ud * 4096 + dk * 64 + pinv(i)] = f2bf(kk[tt * 65 + dk] * __expf(bc[dir * 64 + 63] - bc[dir * 64 + i])); }
        }
        if (tid == 256 || tid == 257) { const int dir = tid - 256; dpGL[((size_t)tc * 4 + h) * 2 + dir] = __expf(bc[dir * 64 + 63]); }
    }
}

DI void delta_scan_unit(const Ctx& C, int layer, bool sample, int b, int h) {
    const Params& p = *C.p; int lane = C.lane; asm volatile("" : "+v"(lane)); const int w = C.wave, dir = w >> 2, sl = w & 3, col = lane & 15, g = lane >> 4;
    const int tc0 = sample ? 128 + b * 64 : b * 4, nch = sample ? 64 : 4;
    const bf16_t* dpW = (const bf16_t*)(C.ws + WS_DPW); const bf16_t* dpQD = (const bf16_t*)(C.ws + WS_DPQD); const bf16_t* dpQK = (const bf16_t*)(C.ws + WS_DPQK); const bf16_t* dpKD = (const bf16_t*)(C.ws + WS_DPKD); const bf16_t* dpU = (const bf16_t*)(C.ws + WS_DPU);
    const float* dpGL = (const float*)(C.ws + WS_GL); float* od = (float*)(C.ws + WS_OD) + (size_t)dir * MROWS * 256;
    f32x4 S[4];
    if (sample) { const float* s0 = p.in[4] + ((((size_t)b * 4 + layer) * 2 + dir) * 4 + h) * 4096;
#pragma unroll
        for (int rb = 0; rb < 4; ++rb)
#pragma unroll
            for (int ii = 0; ii < 4; ++ii) S[rb][ii] = s0[(16 * rb + 4 * g + ii) * 64 + 16 * sl + col]; }
    else {
#pragma unroll
        for (int rb = 0; rb < 4; ++rb) S[rb] = (f32x4){0.f, 0.f, 0.f, 0.f}; }
    for (int n = 0; n < nch; ++n) {
        const int tc = dir ? tc0 + nch - 1 - n : tc0 + n; const size_t ud = ((size_t)tc * 4 + h) * 2 + dir;
        const size_t fo = ud * 4096 + (size_t)col * 64 + g * 8;
        bf16x8 Wf[4][2], QDf[4][2], QKf[4][2], KDf[4][2]; f32x4 u[4];
#pragma unroll
        for (int rb = 0; rb < 4; ++rb)
#pragma unroll
            for (int ks = 0; ks < 2; ++ks) { const size_t o = fo + rb * 1024 + ks * 32; Wf[rb][ks] = *(const bf16x8*)(dpW + o); QDf[rb][ks] = *(const bf16x8*)(dpQD + o); QKf[rb][ks] = *(const bf16x8*)(dpQK + o); KDf[rb][ks] = *(const bf16x8*)(dpKD + o); }
#pragma unroll
        for (int rb = 0; rb < 4; ++rb) { const s16x4 uu = *(const s16x4*)(dpU + ud * 4096 + (16 * sl + col) * 64 + 16 * rb + 4 * g);
#pragma unroll
            for (int ii = 0; ii < 4; ++ii) u[rb][ii] = bf2f((bf16_t)uu[ii]); }
        const float gl = dpGL[ud];
        bf16x8 Sb[2]; Sb[0] = pack8(S[0], S[1]); Sb[1] = pack8(S[2], S[3]);
        f32x4 vn[4];
#pragma unroll
        for (int rb = 0; rb < 4; ++rb) { f32x4 t = (f32x4){0.f, 0.f, 0.f, 0.f}; t = MFMA16(Wf[rb][0], Sb[0], t); t = MFMA16(Wf[rb][1], Sb[1], t); vn[rb] = u[rb] - t; }
        bf16x8 vb[2]; vb[0] = pack8(vn[0], vn[1]); vb[1] = pack8(vn[2], vn[3]);
        const int rowb = tc * 64;
#pragma unroll
        for (int rb = 0; rb < 4; ++rb) { f32x4 o = (f32x4){0.f, 0.f, 0.f, 0.f}; o = MFMA16(QDf[rb][0], Sb[0], o); o = MFMA16(QDf[rb][1], Sb[1], o); o = MFMA16(QKf[rb][0], vb[0], o); o = MFMA16(QKf[rb][1], vb[1], o);
#pragma unroll
            for (int ii = 0; ii < 4; ++ii) { const int i = 16 * rb + 4 * g + ii; const int tt = dir ? 63 - i : i; od[(size_t)(rowb + tt) * 256 + h * 64 + 16 * sl + col] = o[ii]; } }
#pragma unroll
        for (int rb = 0; rb < 4; ++rb) { f32x4 sn = S[rb] * gl; sn = MFMA16(KDf[rb][0], vb[0], sn); sn = MFMA16(KDf[rb][1], vb[1], sn); S[rb] = sn; }
    }
    if (!sample) { float* so = C.out + OUT_SD + ((((size_t)b * 4 + layer) * 2 + dir) * 4 + h) * 4096;
#pragma unroll
        for (int rb = 0; rb < 4; ++rb)
#pragma unroll
            for (int ii = 0; ii < 4; ++ii) so[(16 * rb + 4 * g + ii) * 64 + 16 * sl + col] = S[rb][ii]; }
}

DI float hgrn_forget(const bf16_t* zb, size_t row, int dir, int h, int d, float lb) { const float x = bf2f(zb[row * ZLD + ZB_CF + dir * 256 + h * 64 + d]); return lb + (1.0f - lb) * sigmoidf_(x); }
DI void hgrn_local_unit(const Ctx& C, int layer, int unit) {
    int lane = C.lane; asm volatile("" : "+v"(lane)); const int dir = unit & 1, h = (unit >> 1) & 3, tc = unit >> 3, row0 = tc * 64;
    const bf16_t* zb = (const bf16_t*)(C.ws + WS_ZB);
    float* fs = C.L + C.wave * 1024;
    const float lb = ((const float*)(C.ws + WS_TAB))[4096 + (dir * 4 + layer) * 256 + h * 64 + lane];
    float S[64];
#pragma unroll
    for (int d = 0; d < 64; ++d) S[d] = 0.f;
    float Dl = 1.0f;
    for (int sb = 0; sb < 4; ++sb) {
        float vr[16];
#pragma unroll
        for (int i = 0; i < 16; ++i) { const int ti = sb * 16 + i, tt = dir ? 63 - ti : ti; const size_t row = (size_t)(row0 + tt);
            const float f = hgrn_forget(zb, row, dir, h, lane, lb); fs[i * 64 + lane] = f; Dl *= f; vr[i] = bf2f(zb[row * ZLD + ZB_CI + h * 64 + lane]); }
        __builtin_amdgcn_wave_barrier();
#pragma unroll
        for (int i = 0; i < 16; ++i) { const float v = vr[i];
#pragma unroll
            for (int d = 0; d < 64; d += 4) { const f32x4 f4 = *(const f32x4*)(fs + i * 64 + d);
#pragma unroll
                for (int c = 0; c < 4; ++c) S[d + c] = fmaf(f4[c], S[d + c] - v, v);
                if ((d & 15) == 12) asm volatile("" ::: "memory"); } }
        __builtin_amdgcn_wave_barrier();
    }
    float* hs = (float*)(C.ws + WS_HS) + (size_t)unit * 4096;
#pragma unroll
    for (int d = 0; d < 64; ++d) hs[d * 64 + lane] = S[d];
    ((float*)(C.ws + WS_HD))[(size_t)unit * 64 + lane] = Dl;
}
DI void hgrn_scan_unit(const Ctx& C, int layer, bool sample, int b, int h, int dir) {
    const Params& p = *C.p; const int tid = C.tid; const int tc0 = sample ? 128 + b * 64 : b * 4, nch = sample ? 64 : 4;
    float* HS = (float*)(C.ws + WS_HS); const float* HD = (const float*)(C.ws + WS_HD);
    f32x4 S0, S1;
    if (sample) { const float* s0 = p.in[5] + ((((size_t)b * 4 + layer) * 2 + dir) * 4 + h) * 4096 + tid * 8; S0 = *(const f32x4*)s0; S1 = *(const f32x4*)(s0 + 4); }
    else { S0 = (f32x4){0.f, 0.f, 0.f, 0.f}; S1 = S0; }
    for (int n = 0; n < nch; ++n) {
        const int tc = dir ? tc0 + nch - 1 - n : tc0 + n; const size_t uh = ((size_t)tc * 4 + h) * 2 + dir;
        float* hp = HS + uh * 4096 + tid * 8; const f32x4 l0 = *(const f32x4*)hp, l1 = *(const f32x4*)(hp + 4); const float Dd = HD[uh * 64 + (tid >> 3)];
        *(f32x4*)hp = S0; *(f32x4*)(hp + 4) = S1;
        S0 = S0 * Dd + l0; S1 = S1 * Dd + l1;
    }
    if (!sample) { float* so = C.out + OUT_SH + ((((size_t)b * 4 + layer) * 2 + dir) * 4 + h) * 4096 + tid * 8; *(f32x4*)so = S0; *(f32x4*)(so + 4) = S1; }
}
DI void hgrn_final_unit(const Ctx& C, int layer, int tc) {
    const Params& p = *C.p; int lane = C.lane; asm volatile("" : "+v"(lane)); const int w = C.wave, h = w >> 1, eh = w & 1, e = eh * 32 + (lane & 31), dh = lane >> 5, row0 = tc * 64;
    const bf16_t* zb = (const bf16_t*)(C.ws + WS_ZB); const float* HS = (const float*)(C.ws + WS_HS);
    float* otile = C.L;
    float* fs = C.L + 16384 + w * 2048; float* qst = fs + 1024;
    __syncthreads();
    for (int dir = 0; dir < 2; ++dir) {
        const size_t uh = ((size_t)tc * 4 + h) * 2 + dir;
        const float lb = ((const float*)(C.ws + WS_TAB))[4096 + (dir * 4 + layer) * 256 + h * 64 + lane];
        float S[32];
#pragma unroll
        for (int k = 0; k < 32; ++k) S[k] = HS[uh * 4096 + (32 * dh + k) * 64 + e];
        for (int sb = 0; sb < 4; ++sb) {
            float vr[16];
#pragma unroll
            for (int i = 0; i < 16; ++i) { const int ti = sb * 16 + i, tt = dir ? 63 - ti : ti; const size_t row = (size_t)(row0 + tt);
                fs[i * 64 + lane] = hgrn_forget(zb, row, dir, h, lane, lb); qst[i * 64 + lane] = siluf_(bf2f(zb[row * ZLD + ZB_CQ + h * 64 + lane])); vr[i] = bf2f(zb[row * ZLD + ZB_CI + h * 64 + e]); }
            __builtin_amdgcn_wave_barrier();
#pragma unroll
            for (int i = 0; i < 16; ++i) { const float v = vr[i]; float os = 0.f;
#pragma unroll
                for (int k = 0; k < 32; k += 4) { const f32x4 f4 = *(const f32x4*)(fs + i * 64 + 32 * dh + k), q4 = *(const f32x4*)(qst + i * 64 + 32 * dh + k);
#pragma unroll
                    for (int c = 0; c < 4; ++c) { S[k + c] = fmaf(f4[c], S[k + c] - v, v); os = fmaf(q4[c], S[k + c], os); }
                    if ((k & 15) == 12) asm volatile("" ::: "memory"); }
                os += __shfl_xor(os, 32);
                const int ti = sb * 16 + i, tt = dir ? 63 - ti : ti;
                if (dh == 0) { float* op = otile + (h * 64 + tt) * 64 + e; if (dir == 0) *op = os; else *op += os; }
                asm volatile("" ::: "memory"); }
            __builtin_amdgcn_wave_barrier();
        }
    }
    __syncthreads();
    bf16_t* ob = (bf16_t*)(C.ws + WS_O);
    const float ng = p.in[16][layer * 64 + lane];
    for (int rr = 0; rr < 32; ++rr) { const int idx = w * 32 + rr, hh = idx >> 6, tt = idx & 63; const size_t row = (size_t)(row0 + tt);
        const float v = otile[(hh * 64 + tt) * 64 + lane]; const float ss = wave_sum(v * v);
        const float gt = siluf_(bf2f(zb[row * ZLD + ZB_CG + hh * 64 + lane]));
        ob[row * DM + 768 + hh * 64 + lane] = f2bf(v * (1.0f / sqrtf(ss * (1.0f / 64.0f) + RMS_EPS)) * ng * gt); }
}
DI void delta_combine(const Ctx& C, int layer) {
    const Params& p = *C.p; const bf16_t* zb = (const bf16_t*)(C.ws + WS_ZB); const float* od = (const float*)(C.ws + WS_OD); bf16_t* ob = (bf16_t*)(C.ws + WS_O);
    const float ng = p.in[14][layer * 64 + C.lane];
    for (int it = C.gw; it < MROWS * 4; it += C.NGW) { const int h = it & 3; const size_t row = (size_t)(it >> 2);
        const float v = od[row * 256 + h * 64 + C.lane] + od[(size_t)MROWS * 256 + row * 256 + h * 64 + C.lane]; const float ss = wave_sum(v * v);
        const float gt = siluf_(bf2f(zb[row * ZLD + ZB_BG + h * 64 + C.lane]));
        ob[row * DM + 512 + h * 64 + C.lane] = f2bf(v * (1.0f / sqrtf(ss * (1.0f / 64.0f) + RMS_EPS)) * ng * gt); }
}

#define XB_TMO      128
#define XB_XCNT(j)  (256  + 64 * (j))
#define XB_XSUB(j)  (1280 + 64 * (j))
#define XB_XGEN(j)  (2304 + 64 * (j))
#define XB_TOP      3328
#define XB_TOPGEN   3392
#define XB_SPIN_CAP (1u << 22)
DI unsigned xb_ld(unsigned* p)              { return __hip_atomic_load(p, __ATOMIC_RELAXED, __HIP_MEMORY_SCOPE_AGENT); }
DI unsigned xb_add(unsigned* p, unsigned v) { return __hip_atomic_fetch_add(p, v, __ATOMIC_RELAXED, __HIP_MEMORY_SCOPE_AGENT); }
DI unsigned xb_xcc_id() { return (unsigned)__builtin_amdgcn_s_getreg((3 << 11) | 20) & 0xFu; }
#define XB_SPIN(cond, bar) do { unsigned _sp = 0; while (cond) { __builtin_amdgcn_s_sleep(1); \
    if ((++_sp & 255u) == 0u) { if (xb_ld(&(bar)[XB_TMO])) break; if (_sp > XB_SPIN_CAP) { atomicAdd(&(bar)[XB_TMO], 1u); break; } } } } while (0)
struct XcdBarrier { unsigned* bar; unsigned x; volatile LAS unsigned* st; };
DI void xcd_barrier_complete(unsigned* bar, unsigned x, unsigned& nloc, unsigned& nx) {
    const unsigned G = gridDim.x * gridDim.y * gridDim.z;
    unsigned sum, cnt, mine, sp = 0u;
    for (;;) {
        sum = 0u; cnt = 0u; mine = 0u;
#pragma unroll
        for (unsigned j = 0; j < 16; ++j) { const unsigned c = xb_ld(&bar[XB_XCNT(j)]); sum += c; cnt += (c > 0u) ? 1u : 0u; mine = (j == x) ? c : mine; }
        if (sum == G) break;
        __builtin_amdgcn_s_sleep(1);
        if ((++sp & 255u) == 0u) { if (xb_ld(&bar[XB_TMO])) break; if (sp > XB_SPIN_CAP) { atomicAdd(&bar[XB_TMO], 1u); break; } }
    }
    nloc = mine > 0u ? mine : 1u; nx = cnt > 0u ? cnt : 1u;
}
DI void xcd_barrier(const XcdBarrier& b) {
    asm volatile("s_waitcnt vmcnt(0)" ::: "memory");
    __syncthreads();
    if (threadIdx.x == 0) {
        unsigned* bar = b.bar;
        __builtin_amdgcn_s_waitcnt(0);
        unsigned nloc = b.st[0], nx = b.st[1];
        if (nloc == 0u) { xcd_barrier_complete(bar, b.x, nloc, nx); b.st[0] = nloc; b.st[1] = nx; }
        const unsigned old = xb_add(&bar[XB_XSUB(b.x)], 1u);
        const unsigned gen = old / nloc;
        if (old + 1u == (gen + 1u) * nloc) {
            __builtin_amdgcn_fence(__ATOMIC_RELEASE, "agent");
            asm volatile("s_waitcnt vmcnt(0)" ::: "memory");
            const unsigned og = xb_add(&bar[XB_TOP], 1u);
            const unsigned tg = og / nx;
            if (og + 1u == (tg + 1u) * nx) xb_add(&bar[XB_TOPGEN], 1u);
            else XB_SPIN(xb_ld(&bar[XB_TOPGEN]) == tg, bar);
            __builtin_amdgcn_fence(__ATOMIC_ACQUIRE, "agent");
            xb_add(&bar[XB_XGEN(b.x)], 1u);
            asm volatile("s_waitcnt vmcnt(0)" ::: "memory");
        } else {
            XB_SPIN(xb_ld(&bar[XB_XGEN(b.x)]) == gen, bar);
            __builtin_amdgcn_fence(__ATOMIC_ACQUIRE, "agent");
            asm volatile("s_waitcnt vmcnt(0)" ::: "memory");
        }
    }
    __syncthreads();
}

template <unsigned PHM_>
__global__ void __launch_bounds__(512) fwd_megakernel(Params p) {
    extern __shared__ __attribute__((aligned(16))) unsigned char lds_raw[];
    XcdBarrier xbar; xbar.bar = (unsigned*)(p.ws + WS_CTL) + 1024; xbar.x = xb_xcc_id(); xbar.st = (volatile LAS unsigned*)((LAS unsigned char*)lds_raw + 147400);
    if (threadIdx.x == 0) { xbar.st[0] = 0u; xbar.st[1] = 0u; (void)xb_add(&xbar.bar[XB_XCNT(xbar.x)], 1u); }
    __syncthreads();
    for (int ph = p.ph_lo; ph < p.ph_hi; ++ph) {
        int tid_ = threadIdx.x; asm volatile("" : "+v"(tid_));
        unsigned char* ws_ = p.ws; asm volatile("" : "+s"(ws_));
        float* out_ = p.out; asm volatile("" : "+s"(out_));
        Ctx C; C.p = &p; C.lds = (LAS unsigned char*)lds_raw; C.L = (float*)lds_raw; C.tid = tid_; C.lane = C.tid & 63; C.wave = __builtin_amdgcn_readfirstlane(C.tid >> 6);
        C.G = gridDim.x; C.gw = blockIdx.x * 8 + C.wave; C.NGW = C.G * 8; C.ws = ws_; C.out = out_;
        unsigned* ctl = (unsigned*)(ws_ + WS_CTL);
        const float* modbuf = (const float*)(ws_ + WS_MOD);
        bf16_t* xm = (bf16_t*)(ws_ + WS_XM); bf16_t* ob = (bf16_t*)(ws_ + WS_O); bf16_t* act = (bf16_t*)(ws_ + WS_ACT);
        if (ph == 0) { if (PHON(0)) phase0a(C); }
        else if (ph == 1) { if (PHON(1)) row_pass(C, 0, nullptr, nullptr, modbuf, 1024, 0, true); }
        else {
            const int layer = (ph - 2) / 9, sub = (ph - 2) % 9;
            unsigned char* wb = ws_ + WS_W + (size_t)(layer & 1) * WBUF;
            const float* modl = modbuf + (size_t)layer * 3 * 6144;
            if (sub == 0) { if (PHON(2)) {
                pg8::Gemm g{xm, (const bf16_t*)(wb + W_IN), MROWS, 4096, DM}; pg8::StaticOrder S; S.init(MROWS, 4096, C.G, (int)blockIdx.x);
                EpiIn E{(bf16_t*)(ws_ + WS_Q), (bf16_t*)(ws_ + WS_K), (bf16_t*)(ws_ + WS_V), (bf16_t*)(ws_ + WS_ZB), out_ + OUT_K, out_ + OUT_V, (const f32x2*)(ws_ + WS_TAB), layer};
                pg8::gemm_phase(C.lds, g, S, E, C.tid); }
            } else if (sub == 1) {
                if (PHON(3) && layer + 1 < DEPTH) convert_layer_weights(C, layer + 1);
                __syncthreads();
                if (PHON(4)) for (int u = blockIdx.x; u < 1024; u += C.G) delta_prep_unit(C, layer, u);
                __syncthreads();
                if (PHON(5)) for (int u = C.gw; u < 2048; u += C.NGW) hgrn_local_unit(C, layer, u);
            } else if (sub == 2) {
                LAS int* slot = (LAS int*)(C.lds + 147392);
                for (;;) {
                    __syncthreads();
                    if (C.tid == 0) *slot = (int)atomicAdd(ctl + 64 * (layer + 1), 1u);
                    __syncthreads();
                    const int u = *slot;
                    if (u >= 920) break;
                    if (u < 8) { if (PHON(6)) delta_scan_unit(C, layer, true, u >> 2, u & 3); }
                    else if (u < 24) { const int v = u - 8; if (PHON(7)) hgrn_scan_unit(C, layer, true, v >> 3, (v >> 1) & 3, v & 1); }
                    else if (u < 280) { if (PHON(8)) attn_unit(C, layer, u - 24); }
                    else if (u < 408) { const int v = u - 280; if (PHON(6)) delta_scan_unit(C, layer, false, v >> 2, v & 3); }
                    else if (u < 664) { if (PHON(8)) attn_unit(C, layer, 256 + (u - 408)); }
                    else { const int v = u - 664; if (PHON(7)) hgrn_scan_unit(C, layer, false, v >> 3, (v >> 1) & 3, v & 1); }
                }
            } else if (sub == 3) {
                if (PHON(9)) for (int u = blockIdx.x; u < 256; u += C.G) hgrn_final_unit(C, layer, u);
                if (PHON(10)) delta_combine(C, layer);
            } else if (sub == 4) {
                pg8::Gemm g{ob, (const bf16_t*)(wb + W_OUT), MROWS, DM, DM}; pg8::StaticOrder S; S.init(MROWS, DM, C.G, (int)blockIdx.x);
                EpiRes E{out_, modl + 2048};
                if (PHON(11)) pg8::gemm_phase(C.lds, g, S, E, C.tid);
            } else if (sub == 5) {
                if (PHON(12)) row_pass(C, 1, p.in[20] + (size_t)(layer * 2) * DM, p.in[21] + (size_t)(layer * 2) * DM, modl, 4096, 3072, true);
            } else if (sub == 6) {
                pg8::Gemm g{xm, (const bf16_t*)(wb + W_FFI), MROWS, 2 * DFF, DM}; pg8::StaticOrder S; S.init(MROWS, 2 * DFF, C.G, (int)blockIdx.x);
                EpiFfn E{act};
                if (PHON(13)) pg8::gemm_phase(C.lds, g, S, E, C.tid);
            } else if (sub == 7) {
                pg8::Gemm g{act, (const bf16_t*)(wb + W_FFO), MROWS, DM, DFF}; pg8::StaticOrder S; S.init(MROWS, DM, C.G, (int)blockIdx.x);
                EpiRes E{out_, modl + 5120};
                if (PHON(14)) pg8::gemm_phase(C.lds, g, S, E, C.tid);
            } else {
                const bool last = layer + 1 == DEPTH;
                if (PHON(12)) row_pass(C, 1, p.in[20] + (size_t)(layer * 2 + 1) * DM, p.in[21] + (size_t)(layer * 2 + 1) * DM, modbuf + (size_t)(last ? layer : layer + 1) * 3 * 6144, 1024, 0, !last);
            }
        }
        if (ph + 1 < p.ph_hi) { if (ph == p.ph_lo) { __threadfence(); cg::this_grid().sync(); } else xcd_barrier(xbar); }
    }
}

static unsigned phase_mask(int ph) {
    if (ph == 0) return 1u << 0; if (ph == 1) return 1u << 1;
    const int sub = (ph - 2) % 9;
    switch (sub) { case 0: return 1u << 2; case 1: return (1u << 3) | (1u << 4) | (1u << 5); case 2: return (1u << 6) | (1u << 7) | (1u << 8); case 3: return (1u << 9) | (1u << 10);
        case 4: return 1u << 11; case 5: return 1u << 12; case 6: return 1u << 13; case 7: return 1u << 14; default: return 1u << 12; }
}
typedef void (*kern_t)(Params);
static kern_t kernel_for_mask(unsigned m) {
    switch (m) {
        case 1u << 0: return fwd_megakernel<1u << 0>; case 1u << 1: return fwd_megakernel<1u << 1>; case 1u << 2: return fwd_megakernel<1u << 2>;
        case (1u << 3) | (1u << 4) | (1u << 5): return fwd_megakernel<(1u << 3) | (1u << 4) | (1u << 5)>;
        case (1u << 6) | (1u << 7) | (1u << 8): return fwd_megakernel<(1u << 6) | (1u << 7) | (1u << 8)>;
        case (1u << 9) | (1u << 10): return fwd_megakernel<(1u << 9) | (1u << 10)>;
        case 1u << 11: return fwd_megakernel<1u << 11>; case 1u << 12: return fwd_megakernel<1u << 12>; case 1u << 13: return fwd_megakernel<1u << 13>; default: return fwd_megakernel<1u << 14>;
    }
}
extern "C" void kernel_launch(void* const* d_in, const int* in_sizes, int n_in, void* d_out, int out_size, void* d_ws, size_t ws_size, hipStream_t stream) {
    static int grid = 0;
    if (grid == 0) {
        if (n_in != 24 || out_size != 58720256 || ws_size < WS_END) { fprintf(stderr, "kernel_launch: unexpected shapes (n_in %d out %d ws %zu)\n", n_in, out_size, ws_size); grid = -1; return; }
        int dev = 0, cus = 0;
        (void)hipGetDevice(&dev); (void)hipDeviceGetAttribute(&cus, hipDeviceAttributeMultiprocessorCount, dev);
#if MK_ONE_LAUNCH
        if (hipFuncSetAttribute((const void*)fwd_megakernel<0x7FFFu>, hipFuncAttributeMaxDynamicSharedMemorySize, LDS_BYTES) != hipSuccess) { fprintf(stderr, "kernel_launch: hipFuncSetAttribute failed\n"); grid = -1; return; }
#else
        for (int ph = 0; ph < 11; ++ph) (void)hipFuncSetAttribute((const void*)kernel_for_mask(phase_mask(ph)), hipFuncAttributeMaxDynamicSharedMemorySize, LDS_BYTES);
#endif
        (void)hipGetLastError();
        grid = cus > 0 ? cus : 256;
    }
    if (grid < 0) return;
    (void)hipMemsetAsync((char*)d_ws + WS_CTL, 0, 65536, stream);
    Params p{};
    for (int i = 0; i < 24; ++i) p.in[i] = (const float*)d_in[i];
    p.out = (float*)d_out; p.ws = (unsigned char*)d_ws;
#if MK_ONE_LAUNCH
    p.ph_lo = 0; p.ph_hi = NPHASE;
    void* args[] = {&p};
    hipError_t e = hipLaunchCooperativeKernel((const void*)fwd_megakernel<0x7FFFu>, dim3(grid), dim3(512), args, LDS_BYTES, stream);
    if (e != hipSuccess) fprintf(stderr, "cooperative launch failed: %s (grid %d)\n", hipGetErrorString(e), grid);
#else
    for (int ph = 0; ph < NPHASE; ++ph) { p.ph_lo = ph; p.ph_hi = ph + 1; hipLaunchKernelGGL(kernel_for_mask(phase_mask(ph)), dim3(grid), dim3(512), LDS_BYTES, stream, p); }
#endif
}
```

```cpp
#include <hip/hip_runtime.h>
#include <hip/hip_cooperative_groups.h>
#include <cstdio>
#include <cstdint>
namespace cg = cooperative_groups;

#define PHON(k) ((PHM_ >> (k)) & 1)
#ifndef PROBE_A
#define PROBE_A -1
#endif
#ifndef PROBE_B
#define PROBE_B -1
#endif
#ifndef MK_ONE_LAUNCH
#define MK_ONE_LAUNCH 1
#endif

#define DI __device__ __forceinline__
#define LAS __attribute__((address_space(3)))
typedef unsigned short bf16_t;
typedef short bf16x8 __attribute__((ext_vector_type(8)));
typedef short s16x4 __attribute__((ext_vector_type(4)));
typedef float f32x4 __attribute__((ext_vector_type(4)));
typedef float f32x16 __attribute__((ext_vector_type(16)));
typedef float f32x2 __attribute__((ext_vector_type(2)));
typedef unsigned u32x4 __attribute__((ext_vector_type(4)));
typedef unsigned u32x2 __attribute__((ext_vector_type(2)));

constexpr int MROWS = 16384, DM = 1024, DEPTH = 4, DFF = 2816, DIN = 3856, ZLD = 2320;
constexpr float ALPHA = 1.681792830507429f, LN_EPS = 1e-5f, RMS_EPS = 1e-6f;
constexpr float QSCALE = 0.125f * 1.4426950408889634f;
constexpr int ZB_BQ = 0, ZB_BK = 256, ZB_BV = 512, ZB_BG = 768, ZB_BBETA = 1024, ZB_BA = 1032, ZB_CQ = 1040, ZB_CF = 1296, ZB_CI = 1808, ZB_CG = 2064;
constexpr size_t OUT_K = 16777216, OUT_V = 33554432, OUT_SD = 50331648, OUT_SH = 54525952;
constexpr size_t MiB = 1u << 20;
constexpr size_t WS_CTL = 0, WS_MOD = 64 * 1024, WS_TAB = 512 * 1024, WS_CK = 1 * MiB, WS_CV = 3 * MiB, WS_W = 8 * MiB, WBUF = 27 * MiB;
constexpr size_t W_IN = 0, W_OUT = 8 * MiB, W_FFI = 10 * MiB, W_FFO = 21 * MiB;
constexpr size_t WS_XM = 62 * MiB, WS_O = 94 * MiB, WS_ZB = 126 * MiB, WS_Q = 199 * MiB, WS_K = 215 * MiB, WS_V = 231 * MiB;
constexpr size_t WS_ACT = 126 * MiB;
constexpr size_t WS_DPW = 247 * MiB, WS_DPQD = 263 * MiB, WS_DPQK = 279 * MiB, WS_DPKD = 295 * MiB;
constexpr size_t WS_DPU = WS_XM;
constexpr size_t WS_OD = 311 * MiB, WS_HS = 343 * MiB, WS_HD = 375 * MiB, WS_GL = 375 * MiB + 512 * 1024, WS_END = 376 * MiB;
constexpr int LDS_BYTES = 147456;
constexpr int NPHASE = 2 + 9 * DEPTH;

struct Params { const float* in[24]; float* out; unsigned char* ws; int ph_lo, ph_hi; };

DI unsigned cvt_pk_bf16(float lo, float hi) { unsigned r; asm volatile("v_cvt_pk_bf16_f32 %0, %1, %2" : "=v"(r) : "v"(lo), "v"(hi)); return r; }
DI bf16_t f2bf(float f) { return (bf16_t)(cvt_pk_bf16(f, 0.f) & 0xffffu); }
DI float bf2f(bf16_t b) { return __uint_as_float(((unsigned)b) << 16); }
DI float sigmoidf_(float x) { return 1.0f / (1.0f + __expf(-x)); }
DI float siluf_(float x) { return x / (1.0f + __expf(-x)); }
DI float wave_sum(float v) {
#pragma unroll
    for (int o = 1; o < 64; o <<= 1) v += __shfl_xor(v, o);
    return v;
}
DI u32x2 pack4(f32x4 v) { u32x2 w; w.x = cvt_pk_bf16(v[0], v[1]); w.y = cvt_pk_bf16(v[2], v[3]); return w; }
DI bf16x8 pack8(f32x4 a, f32x4 b) { u32x4 w; w.x = cvt_pk_bf16(a[0], a[1]); w.y = cvt_pk_bf16(a[2], a[3]); w.z = cvt_pk_bf16(b[0], b[1]); w.w = cvt_pk_bf16(b[2], b[3]); return __builtin_bit_cast(bf16x8, w); }
DI int pinv(int k) { return (k >> 5) * 32 + ((k >> 2) & 3) * 8 + ((k >> 4) & 1) * 4 + (k & 3); }
DI int row_mod(int r) { return r < 8192 ? 0 : 1 + ((r - 8192) >> 12); }

namespace pg8 {
constexpr int BM = 256, BK = 64, HALF = 128, HTB = HALF * BK * 2, STAGE_BYTES = 8 * HTB, NXCD = 8, WGM = 8;
DI int lds_byte(int r, int c) { const int st = (r >> 4) * 2 + (c >> 5), rr = r & 15, cc = c & 31, ob = rr * 64 + cc * 2; return st * 1024 + (ob ^ (((ob >> 9) & 1) << 5)); }
DI void stage_rc(int b, int& R, int& C) { const int st = b / 1024, sb = b % 1024, swz = sb ^ (((sb >> 9) & 1) << 5); R = (st >> 1) * 16 + swz / 64; C = (st & 1) * 32 + (swz % 64) / 2; }
struct Unit { int pm, pn; };
struct Gemm { const bf16_t* A; const bf16_t* Bt; int M, N, K; };
struct StaticOrder {
    int nM, nN, nwg, G, c;
    DI void init(int M, int N, int G_, int c_) { nM = M / BM; nN = N / BM; nwg = nM * nN; G = G_; c = c_; }
    DI bool next(int i, Unit& u) const {
        const long L = (long)i * G + c; if (L >= nwg) return false;
        int wgid = (int)L; { const int q = nwg / NXCD, r = nwg % NXCD, xcd = wgid % NXCD, off = wgid / NXCD; wgid = (xcd < r ? xcd * (q + 1) : r * (q + 1) + (xcd - r) * q) + off; }
        const int nig = WGM * nN, gid = wgid / nig, fm = gid * WGM, gsz = (nM - fm) < WGM ? (nM - fm) : WGM;
        u.pm = fm + ((wgid % nig) % gsz); u.pn = (wgid % nig) / gsz; return true;
    }
};

template <class Epi>
DI void gemm_phase(LAS unsigned char* lds, const Gemm g, const StaticOrder& S, const Epi& E, int tid_in) {
    const int tid = tid_in, wid = __builtin_amdgcn_readfirstlane(tid >> 6), lane = tid & 63, wr = wid >> 2, wc = wid & 3, fr = lane & 15, fq = lane >> 4;
    const int K = g.K, nt = K / BK;
    unsigned voffA[2];
#pragma unroll
    for (int i = 0; i < 2; ++i) { int R, C; stage_rc(tid * 16 + i * 8192, R, C); voffA[i] = (unsigned)(R * K + C) * 2u; }
    const size_t kstep = (size_t)(BK * 2);
    const size_t hstep = (size_t)HALF * K * 2;
    const size_t tstep = 2 * hstep;
    const unsigned ldsw = (unsigned)wid * 1024u;
    const int aoff = lds_byte(wr * 64 + fr, fq * 8), boff = lds_byte(wc * 32 + fr, fq * 8);
#define PG8_SA(b, h) (((b) * 2 + (h)) * HTB)
#define PG8_SB(b, h) ((4 + (b) * 2 + (h)) * HTB)
#define PG8_STAGE(bufoff, gbase) do { _Pragma("unroll") for (int _i = 0; _i < 2; ++_i) \
        __builtin_amdgcn_global_load_lds((const unsigned*)((const char*)(gbase) + voffA[_i]), (LAS unsigned*)(lds + (bufoff) + ldsw + _i * 8192), 16, 0, 0); } while (0)
#define PG8_LDA(dst, b, h) do { _Pragma("unroll") for (int m = 0; m < 4; ++m) _Pragma("unroll") for (int k = 0; k < 2; ++k) dst[m][k] = *(const LAS bf16x8*)(lds + PG8_SA(b, h) + aoff + m * 2048 + k * 1024); } while (0)
#define PG8_LDB(dst, b, h) do { _Pragma("unroll") for (int n = 0; n < 2; ++n) _Pragma("unroll") for (int k = 0; k < 2; ++k) dst[n][k] = *(const LAS bf16x8*)(lds + PG8_SB(b, h) + boff + n * 2048 + k * 1024); } while (0)
#define PG8_MMA(ai, bj, At, Bt) do { __builtin_amdgcn_s_setprio(1); _Pragma("unroll") for (int m = 0; m < 4; ++m) _Pragma("unroll") for (int n = 0; n < 2; ++n) _Pragma("unroll") for (int k = 0; k < 2; ++k) \
        acc[ai][bj][m][n] = __builtin_amdgcn_mfma_f32_16x16x32_bf16(Bt[n][k], At[m][k], acc[ai][bj][m][n], 0, 0, 0); __builtin_amdgcn_s_setprio(0); } while (0)
#define PG8_WAIT_V(n) asm volatile("s_waitcnt vmcnt(" #n ")" ::: "memory")
#define PG8_WAIT_L(n) asm volatile("s_waitcnt lgkmcnt(" #n ")" ::: "memory")
#define PG8_BAR __builtin_amdgcn_s_barrier()
#define PG8_SCHED __builtin_amdgcn_sched_barrier(0)
    Unit cur, nxt; int ui = 0;
    if (!S.next(0, cur)) return;
    f32x4 acc[2][2][4][2];
#pragma unroll
    for (int a = 0; a < 2; ++a)
#pragma unroll
        for (int b = 0; b < 2; ++b)
#pragma unroll
            for (int m = 0; m < 4; ++m)
#pragma unroll
                for (int n = 0; n < 2; ++n) acc[a][b][m][n] = (f32x4){0.f, 0.f, 0.f, 0.f};
    bf16x8 At[4][2], B0[2][2], B1[2][2];
    const char* cA = (const char*)g.A + (size_t)cur.pm * tstep; const char* cB = (const char*)g.Bt + (size_t)cur.pn * tstep;
    PG8_STAGE(PG8_SB(0, 0), cB); PG8_STAGE(PG8_SB(0, 1), cB + hstep); PG8_STAGE(PG8_SA(0, 0), cA); PG8_STAGE(PG8_SA(0, 1), cA + hstep);
    if (wr == 1) PG8_BAR;
    PG8_WAIT_V(2); PG8_BAR;
    PG8_STAGE(PG8_SB(1, 0), cB + kstep); PG8_STAGE(PG8_SA(1, 0), cA + kstep); PG8_STAGE(PG8_SB(1, 1), cB + hstep + kstep);
    PG8_WAIT_V(6); PG8_BAR;
    for (;;) {
        const bool has_next = S.next(ui + 1, nxt);
        const char* nA = has_next ? (const char*)g.A + (size_t)nxt.pm * tstep : cA; const char* nB = has_next ? (const char*)g.Bt + (size_t)nxt.pn * tstep : cB;
        for (int t = 0; t < nt; t += 2) {
            const bool last = (t == nt - 2);
            const char* a1 = cA + (size_t)(t + 1) * kstep;
            const char* a2 = last ? nA : cA + (size_t)(t + 2) * kstep; const char* b2 = last ? nB : cB + (size_t)(t + 2) * kstep;
            const char* a3 = a2 + kstep; const char* b3 = b2 + kstep;
            PG8_LDB(B0, 0, 0); PG8_LDB(B1, 0, 1); PG8_SCHED; PG8_LDA(At, 0, 0); PG8_STAGE(PG8_SA(1, 1), a1 + hstep);
            PG8_WAIT_V(8); PG8_WAIT_L(0); PG8_BAR; PG8_MMA(0, 0, At, B0); PG8_MMA(0, 1, At, B1); PG8_BAR; PG8_SCHED;
            PG8_LDA(At, 0, 1); PG8_STAGE(PG8_SB(0, 0), b2); PG8_STAGE(PG8_SB(0, 1), b2 + hstep); PG8_STAGE(PG8_SA(0, 0), a2);
            PG8_WAIT_V(8); PG8_WAIT_L(0); PG8_BAR; PG8_MMA(1, 0, At, B0); PG8_MMA(1, 1, At, B1); PG8_BAR; PG8_SCHED;
            PG8_LDB(B0, 1, 0); PG8_LDB(B1, 1, 1); PG8_SCHED; PG8_LDA(At, 1, 0); PG8_STAGE(PG8_SA(0, 1), a2 + hstep);
            PG8_WAIT_V(8); PG8_WAIT_L(0); PG8_BAR; PG8_MMA(0, 0, At, B0); PG8_MMA(0, 1, At, B1); PG8_BAR; PG8_SCHED;
            PG8_LDA(At, 1, 1); PG8_STAGE(PG8_SB(1, 0), b3); PG8_STAGE(PG8_SB(1, 1), b3 + hstep); PG8_STAGE(PG8_SA(1, 0), a3);
            PG8_WAIT_V(8); PG8_WAIT_L(0); PG8_BAR; PG8_MMA(1, 0, At, B0); PG8_MMA(1, 1, At, B1); PG8_BAR; PG8_SCHED;
        }
        if (wr == 0) PG8_BAR;
        E(acc, cur, wr, wc, fr, fq);
        if (!has_next) break;
#pragma unroll
        for (int a = 0; a < 2; ++a)
#pragma unroll
            for (int b = 0; b < 2; ++b)
#pragma unroll
                for (int m = 0; m < 4; ++m)
#pragma unroll
                    for (int n = 0; n < 2; ++n) acc[a][b][m][n] = (f32x4){0.f, 0.f, 0.f, 0.f};
        cur = nxt; cA = nA; cB = nB; ++ui;
        if (wr == 1) PG8_BAR;
    }
    PG8_WAIT_V(0);
    PG8_BAR;
#undef PG8_SA
#undef PG8_SB
#undef PG8_STAGE
#undef PG8_LDA
#undef PG8_LDB
#undef PG8_MMA
#undef PG8_WAIT_V
#undef PG8_WAIT_L
#undef PG8_BAR
#undef PG8_SCHED
}
}

struct EpiIn {
    bf16_t *Qb, *Kb, *Vb, *zb; float *outK, *outV; const f32x2* rope; int layer;
    DI void operator()(const f32x4 (&acc)[2][2][4][2], const pg8::Unit& u, int wr, int wc, int fr, int fq) const {
        const int tile = u.pn; const bool sample = u.pm >= 32;
        if (tile < 6) {
            const int kind = tile >> 1; const int cb = (tile & 1) * 256 + wc * 32 + 4 * fq;
            bf16_t* dst = Qb + (size_t)kind * (16u * 1024u * 1024u / 2u);
            float* of = outK + (size_t)(kind >= 1 ? kind - 1 : 0) * 16777216u;
#pragma unroll
            for (int ai = 0; ai < 2; ++ai)
#pragma unroll
                for (int m = 0; m < 4; ++m) {
                    const int r = u.pm * 256 + ai * 128 + wr * 64 + m * 16 + fr;
#pragma unroll
                    for (int bj = 0; bj < 2; ++bj) {
                        f32x4 a = acc[ai][bj][m][0], b = acc[ai][bj][m][1]; const int cc = cb + bj * 128;
                        if (!sample && kind >= 1) { float* o = of + ((size_t)((r >> 8) * 4 + layer) * 256 + (r & 255)) * 512 + cc; *(f32x4*)o = a; *(f32x4*)(o + 16) = b; }
                        if (sample && kind < 2) {
                            const int t = (r - 8192) & 4095; const int pos = (wc & 1) ? (t & 63) : (t >> 6); const f32x2* rp = rope + pos * 16 + 4 * fq;
#pragma unroll
                            for (int j = 0; j < 4; ++j) { const f32x2 cs = rp[j]; const float x1 = a[j], x2 = b[j]; a[j] = x1 * cs.x - x2 * cs.y; b[j] = x2 * cs.x + x1 * cs.y; }
                        }
                        if (kind == 0) { a = a * QSCALE; b = b * QSCALE; }
                        if (kind == 2) {
                            const int hh = cc >> 7, dv0 = cc & 127, tt = sample ? ((r - 8192) & 4095) : (r & 255);
                            bf16_t* vt = sample ? Vb + 4194304 + ((size_t)((((r - 8192) >> 12) * 4 + hh) * 32 + (tt >> 7)) * 128 + dv0) * 128 + (tt & 127)
                                                : Vb + ((size_t)(((r >> 8) * 4 + hh) * 2 + (tt >> 7)) * 128 + dv0) * 128 + (tt & 127);
#pragma unroll
                            for (int j = 0; j < 4; ++j) { vt[(size_t)j * 128] = f2bf(a[j]); vt[(size_t)(16 + j) * 128] = f2bf(b[j]); }
                        } else { *(u32x2*)(dst + (size_t)r * 512 + cc) = pack4(a); *(u32x2*)(dst + (size_t)r * 512 + cc + 16) = pack4(b); }
                    }
                    asm volatile("" ::: "memory");
                }
        } else {
#pragma unroll
            for (int ai = 0; ai < 2; ++ai)
#pragma unroll
                for (int m = 0; m < 4; ++m) {
                    const int r = u.pm * 256 + ai * 128 + wr * 64 + m * 16 + fr;
#pragma unroll
                    for (int bj = 0; bj < 2; ++bj)
#pragma unroll
                        for (int n = 0; n < 2; ++n) { const int c = (tile - 6) * 256 + bj * 128 + wc * 32 + 16 * n + 4 * fq; if (c < ZLD) *(u32x2*)(zb + (size_t)r * ZLD + c) = pack4(acc[ai][bj][m][n]); }
                    asm volatile("" ::: "memory");
                }
        }
    }
};
struct EpiRes {
    float* x; const float* gate;
    DI void operator()(const f32x4 (&acc)[2][2][4][2], const pg8::Unit& u, int wr, int wc, int fr, int fq) const {
        const float* gv = gate + row_mod(u.pm * 256) * 6144;
#pragma unroll
        for (int ai = 0; ai < 2; ++ai)
#pragma unroll
            for (int m = 0; m < 4; ++m) {
                const int r = u.pm * 256 + ai * 128 + wr * 64 + m * 16 + fr;
#pragma unroll
                for (int bj = 0; bj < 2; ++bj)
#pragma unroll
                    for (int n = 0; n < 2; ++n) { const int c = u.pn * 256 + bj * 128 + wc * 32 + 16 * n + 4 * fq; const f32x4 g4 = *(const f32x4*)(gv + c); float* xp = x + (size_t)r * DM + c; const f32x4 xv = *(const f32x4*)xp; *(f32x4*)xp = xv * ALPHA + g4 * acc[ai][bj][m][n]; }
            }
    }
};
struct EpiFfn {
    bf16_t* act;
    DI void operator()(const f32x4 (&acc)[2][2][4][2], const pg8::Unit& u, int wr, int wc, int fr, int fq) const {
#pragma unroll
        for (int ai = 0; ai < 2; ++ai)
#pragma unroll
            for (int m = 0; m < 4; ++m) {
                const int r = u.pm * 256 + ai * 128 + wr * 64 + m * 16 + fr;
#pragma unroll
                for (int n = 0; n < 2; ++n) { const f32x4 gt = acc[ai][0][m][n], up = acc[ai][1][m][n]; f32x4 o;
#pragma unroll
                    for (int j = 0; j < 4; ++j) o[j] = siluf_(gt[j]) * up[j];
                    *(u32x2*)(act + (size_t)r * DFF + u.pn * 128 + wc * 32 + 16 * n + 4 * fq) = pack4(o); }
            }
    }
};

struct Ctx {
    const Params* p; LAS unsigned char* lds; float* L; int tid, lane, wave, G, gw, NGW;
    unsigned char* ws; float* out;
};

DI void tr_item(const float* W, int K, int N, bf16_t* WT, int mode, float* scr, int item, int lane) {
    const int nblk = (N + 31) / 32, kb = item / nblk, nb = item % nblk, k0 = 64 * kb, n0 = 32 * nb;
    const int nn = n0 + (lane & 31);
#pragma unroll 8
    for (int i = 0; i < 32; ++i) { const int kk = 2 * i + (lane >> 5); scr[kk * 33 + (lane & 31)] = (nn < N) ? W[(size_t)(k0 + kk) * N + nn] : 0.f; }
    __builtin_amdgcn_wave_barrier();
    const int c = lane & 7;
#pragma unroll
    for (int j = 0; j < 4; ++j) {
        const int nl = (lane >> 3) + 8 * j, n = n0 + nl; const float* s = scr + (8 * c) * 33 + nl;
        if (n < N) {
            int dst = n; if (mode == 1) { if (n < DFF) dst = (n >> 7) * 256 + (n & 127); else { const int jj = n - DFF; dst = (jj >> 7) * 256 + 128 + (jj & 127); } }
            u32x4 o; o.x = cvt_pk_bf16(s[0 * 33], s[1 * 33]); o.y = cvt_pk_bf16(s[2 * 33], s[3 * 33]); o.z = cvt_pk_bf16(s[4 * 33], s[5 * 33]); o.w = cvt_pk_bf16(s[6 * 33], s[7 * 33]);
            *(u32x4*)(WT + (size_t)dst * K + k0 + 8 * c) = o;
        }
    }
    __builtin_amdgcn_wave_barrier();
}
DI void convert_layer_weights(const Ctx& C, int layer, int gw0 = -1, int ngw = 0, int blk = -1, int nblk = 0) {
    const Params& p = *C.p;
    unsigned char* wb = C.ws + WS_W + (size_t)(layer & 1) * WBUF;
    bf16_t* Win = (bf16_t*)(wb + W_IN); bf16_t* Wout = (bf16_t*)(wb + W_OUT); bf16_t* Wffi = (bf16_t*)(wb + W_FFI); bf16_t* Wffo = (bf16_t*)(wb + W_FFO);
    float* scr = C.L + C.wave * (64 * 33);
    constexpr int I_IN = 16 * 121, I_OUT = 16 * 32, I_FFI = 16 * 176, I_FFO = 44 * 32, NIT = I_IN + I_OUT + I_FFI + I_FFO;
    int lane_ = C.lane; asm volatile("" : "+v"(lane_));
    const int gwA = gw0 >= 0 ? gw0 : C.gw, ngwA = gw0 >= 0 ? ngw : C.NGW, blkA = blk >= 0 ? blk : (int)blockIdx.x, nblkA = blk >= 0 ? nblk : C.G;
    for (int it = gwA; it < NIT; it += ngwA) {
        int r = it;
        if (r < I_IN) { tr_item(p.in[10] + (size_t)layer * DM * DIN, DM, DIN, Win, 0, scr, r, lane_); continue; } r -= I_IN;
        if (r < I_OUT) { tr_item(p.in[19] + (size_t)layer * DM * DM, DM, DM, Wout, 0, scr, r, lane_); continue; } r -= I_OUT;
        if (r < I_FFI) { tr_item(p.in[22] + (size_t)layer * DM * 2 * DFF, DM, 2 * DFF, Wffi, 1, scr, r, lane_); continue; } r -= I_FFI;
        tr_item(p.in[23] + (size_t)layer * DFF * DM, DFF, DM, Wffo, 0, scr, r, lane_);
    }
    u32x4* z = (u32x4*)(Win + (size_t)DIN * DM); const int nz = 240 * DM * 2 / 16;
    for (int i = blkA * 512 + C.tid; i < nz; i += nblkA * 512) z[i] = (u32x4){0u, 0u, 0u, 0u};
}

DI void mod_unit(const Ctx& C, int u) {
    const Params& p = *C.p; const int tid = C.tid;
    float* cs = C.L; float* red = C.L + 3072;
    const int layer = u >> 6, col0 = (u & 63) * 96;
    __syncthreads();
    for (int i = tid; i < 3072; i += 512) { const int v = i >> 10, k = i & 1023; const float c = (v == 0) ? p.in[7][k] : p.in[6][(v - 1) * 1024 + k]; cs[i] = siluf_(c); }
    __syncthreads();
    if (tid < 504) {
        const int cgp = tid % 24, rs = tid / 24;
        f32x4 a0 = {0, 0, 0, 0}, a1 = a0, a2 = a0;
        const float* Wp = p.in[8] + (size_t)layer * DM * 6144 + col0 + cgp * 4;
#pragma unroll 7
        for (int k = rs; k < 1024; k += 21) { const f32x4 w = *(const f32x4*)(Wp + (size_t)k * 6144); a0 += w * cs[k]; a1 += w * cs[1024 + k]; a2 += w * cs[2048 + k]; }
        float* rr = red + rs * 288 + cgp * 4;
#pragma unroll
        for (int j = 0; j < 4; ++j) { rr[j] = a0[j]; rr[96 + j] = a1[j]; rr[192 + j] = a2[j]; }
    }
    __syncthreads();
    if (tid < 288) {
        const int v = tid / 96, cc = tid % 96; float s = 0.f;
        for (int rs = 0; rs < 21; ++rs) s += red[rs * 288 + tid];
        ((float*)(C.ws + WS_MOD))[(size_t)(layer * 3 + v) * 6144 + col0 + cc] = s + p.in[9][layer * 6144 + col0 + cc];
    }
}

DI void phase0a(const Ctx& C) {
    const Params& p = *C.p;
    for (int u = blockIdx.x; u < 256; u += C.G) mod_unit(C, u);
    __syncthreads();
    convert_layer_weights(C, 0);
    const int gt = blockIdx.x * 512 + C.tid, NT = C.G * 512;
    float* tab = (float*)(C.ws + WS_TAB);
    if (gt < 1024) { const int pos = gt >> 4, i = gt & 15; const float inv = __builtin_amdgcn_exp2f(-(float)i * (13.287712379549449f / 16.0f)); float rev = (float)pos * inv * 0.15915494309189535f; rev -= floorf(rev);
        tab[2 * gt] = __builtin_amdgcn_cosf(rev); tab[2 * gt + 1] = __builtin_amdgcn_sinf(rev); }
    if (gt >= 1024 && gt < 1028) { const int l = gt - 1024; const float* dl = p.in[17] + l * 256; float s01 = 0.f, s23 = 0.f; for (int i = 0; i < 64; ++i) { s01 += dl[i] * dl[64 + i]; s23 += dl[128 + i] * dl[192 + i]; }
        tab[2048 + l] = __expf(s01) - __expf(s23) + (0.8f - 0.6f * __expf(-0.3f * (float)l)); }
    if (gt >= 2048 && gt < 2560) { const int dir = (gt - 2048) >> 8, c = gt & 255; const float* lb = p.in[15] + dir * 1024 + c; float v[4], mx = -1e30f; for (int l = 0; l < 4; ++l) { v[l] = lb[l * 256]; mx = fmaxf(mx, v[l]); }
        float s = 0.f; for (int l = 0; l < 4; ++l) { v[l] = __expf(v[l] - mx); s += v[l]; } float cum = 0.f; for (int l = 0; l < 4; ++l) { if (l > 0) cum += v[l] / s; tab[4096 + (dir * 4 + l) * 256 + c] = cum; } }
    bf16_t* ck = (bf16_t*)(C.ws + WS_CK); bf16_t* cv = (bf16_t*)(C.ws + WS_CV);
    for (int i = gt; i < 2 * 4 * 256 * 512 / 4; i += NT) { const int e = i * 4; const int c = e & 511, j = (e >> 9) & 255, l = (e >> 17) & 3, b = e >> 19;
        const size_t dst = ((size_t)((l * 2 + b) * 256 + j)) * 512 + c;
        *(u32x2*)(ck + dst) = pack4(*(const f32x4*)(p.in[2] + e)); }
    for (int i = gt; i < 2 * 4 * 256 * 512; i += NT) { const int j = i & 255, dv = (i >> 8) & 127, hh = (i >> 15) & 3, b = (i >> 17) & 1, l = i >> 18;
        cv[((size_t)((((l * 2 + b) * 4 + hh) * 2 + (j >> 7)) * 128 + dv)) * 128 + (j & 127)] = f2bf(p.in[3][((size_t)((b * 4 + l) * 256 + j) * 4 + hh) * 128 + dv]); }
}

DI void row_pass(const Ctx& C, int mode, const float* lng, const float* lnb, const float* modl, int sc_off, int sh_off, bool write_xm) {
    const Params& p = *C.p; float* x = C.out; bf16_t* xm = (bf16_t*)(C.ws + WS_XM);
    for (int r0 = C.gw; r0 < MROWS; r0 += 2 * C.NGW) {
        f32x4 v[2][4];
#pragma unroll
        for (int u = 0; u < 2; ++u) { const int r = r0 + u * C.NGW;
            const float* src = mode == 0 ? (r < 8192 ? p.in[0] + (size_t)r * DM : p.in[1] + (size_t)(r - 8192) * DM) : x + (size_t)r * DM;
#pragma unroll
            for (int j = 0; j < 4; ++j) v[u][j] = *(const f32x4*)(src + 4 * C.lane + 256 * j); }
#pragma unroll
        for (int u = 0; u < 2; ++u) { const int r = r0 + u * C.NGW;
            if (mode == 1) {
                float s = 0.f;
#pragma unroll
                for (int j = 0; j < 4; ++j) s += (v[u][j][0] + v[u][j][1]) + (v[u][j][2] + v[u][j][3]);
                const float mean = wave_sum(s) * (1.f / DM); float s2 = 0.f;
#pragma unroll
                for (int j = 0; j < 4; ++j) { v[u][j] = v[u][j] - mean; s2 += (v[u][j][0] * v[u][j][0] + v[u][j][1] * v[u][j][1]) + (v[u][j][2] * v[u][j][2] + v[u][j][3] * v[u][j][3]); }
                const float rstd = 1.0f / sqrtf(wave_sum(s2) * (1.f / DM) + LN_EPS);
#pragma unroll
                for (int j = 0; j < 4; ++j) { const f32x4 g4 = *(const f32x4*)(lng + 4 * C.lane + 256 * j), b4 = *(const f32x4*)(lnb + 4 * C.lane + 256 * j); v[u][j] = v[u][j] * rstd * g4 + b4; }
            }
            if (PROBE_A >= 0 && !write_xm) { const float* tsf = (const float*)(C.ws + WS_TAB + 131072); const float sc = 1.0f + ((r >= 8192) ? tsf[12] : (PROBE_B >= 0 ? tsf[13] : 0.f));
#pragma unroll
                for (int j = 0; j < 4; ++j) v[u][j] = v[u][j] * sc; }
#pragma unroll
            for (int j = 0; j < 4; ++j) *(f32x4*)(x + (size_t)r * DM + 4 * C.lane + 256 * j) = v[u][j];
            if (write_xm) {
                const float* mv = modl + row_mod(r) * 6144;
#pragma unroll
                for (int j = 0; j < 4; ++j) { const int c = 4 * C.lane + 256 * j; const f32x4 sc = *(const f32x4*)(mv + sc_off + c), sh = *(const f32x4*)(mv + sh_off + c);
                    *(u32x2*)(xm + (size_t)r * DM + c) = pack4(v[u][j] * (sc + 1.0f) + sh); }
            }
        }
    }
}

#define MFMA32(a, b, c) __builtin_amdgcn_mfma_f32_32x32x16_bf16((a), (b), (c), 0, 0, 0)
#define MFMA16(a, b, c) __builtin_amdgcn_mfma_f32_16x16x32_bf16((a), (b), (c), 0, 0, 0)
constexpr int AK_LD = 72, AV_LD = 136;
struct AttnSrc { const bf16_t* Klat; const bf16_t* Kctx; const bf16_t* VTlat; const bf16_t* VTctx; int ldv; int nst; int nlat; int h; };
template <int PASS>
DI void attn_pass(int tid, int q, int hi, int kq, const AttnSrc& A, LAS bf16_t* K1s, LAS bf16_t* K2s, LAS bf16_t* VTs, const bf16x8 (&q1)[4], const bf16x8 (&q2)[4],
                  float& m1, float& l1, float& m2, float& l2, float iL1, float iL2, f32x16 (&o)[4]) {
    u32x4 kreg[4], vreg[4];
    const int h = A.h;
    auto issue = [&](int st) {
        const bf16_t* kb = (st < A.nlat) ? A.Klat + (size_t)st * 128 * 512 : A.Kctx + (size_t)(st - A.nlat) * 128 * 512;
#pragma unroll
        for (int i = 0; i < 2; ++i) { const int id = tid + 512 * i, key = id >> 3, ch = id & 7; kreg[i] = *(const u32x4*)(kb + (size_t)key * 512 + h * 128 + ch * 8); kreg[2 + i] = *(const u32x4*)(kb + (size_t)key * 512 + h * 128 + 64 + ch * 8); }
        if (PASS == 1) {
            const bf16_t* vb = (st < A.nlat) ? A.VTlat + (size_t)st * 128 : A.VTctx + (size_t)(st - A.nlat) * 128; const int ld = (st < A.nlat) ? A.ldv : 256;
#pragma unroll
            for (int i = 0; i < 4; ++i) { const int id = tid + 512 * i, dv = id >> 4, ch = id & 15; vreg[i] = *(const u32x4*)(vb + (size_t)dv * ld + ch * 8); }
        }
    };
    issue(0);
    for (int st = 0; st < A.nst; ++st) {
        __syncthreads();
#pragma unroll
        for (int i = 0; i < 2; ++i) { const int id = tid + 512 * i, key = id >> 3, ch = id & 7; *(LAS u32x4*)(K1s + key * AK_LD + ch * 8) = kreg[i]; *(LAS u32x4*)(K2s + key * AK_LD + ch * 8) = kreg[2 + i]; }
        if (PASS == 1) {
#pragma unroll
            for (int i = 0; i < 4; ++i) { const int id = tid + 512 * i, dv = id >> 4, ch = id & 15; *(LAS u32x4*)(VTs + dv * AV_LD + ch * 8) = vreg[i]; }
        }
        __syncthreads();
        if (st + 1 < A.nst) issue(st + 1);
        const int keyrow = kq * 32 + q;
        f32x16 s1, pr;
#pragma unroll
        for (int r = 0; r < 16; ++r) s1[r] = 0.f;
#pragma unroll
        for (int ks = 0; ks < 4; ++ks) { const bf16x8 a1 = *(const LAS bf16x8*)(K1s + keyrow * AK_LD + 16 * ks + 8 * hi); s1 = MFMA32(a1, q1[ks], s1); }
        if (PASS == 0) {
            float mx1 = s1[0];
#pragma unroll
            for (int r = 1; r < 16; ++r) mx1 = fmaxf(mx1, s1[r]);
            const float n1 = fmaxf(m1, mx1); float a1s = 0.f;
#pragma unroll
            for (int r = 0; r < 16; ++r) a1s += __builtin_amdgcn_exp2f(s1[r] - n1);
            l1 = l1 * __builtin_amdgcn_exp2f(m1 - n1) + a1s; m1 = n1;
        } else {
#pragma unroll
            for (int r = 0; r < 16; ++r) pr[r] = __builtin_amdgcn_exp2f(s1[r] - m1) * iL1;
        }
#pragma unroll
        for (int r = 0; r < 16; ++r) s1[r] = 0.f;
#pragma unroll
        for (int ks = 0; ks < 4; ++ks) { const bf16x8 a2 = *(const LAS bf16x8*)(K2s + keyrow * AK_LD + 16 * ks + 8 * hi); s1 = MFMA32(a2, q2[ks], s1); }
        if (PASS == 0) {
            float mx2 = s1[0];
#pragma unroll
            for (int r = 1; r < 16; ++r) mx2 = fmaxf(mx2, s1[r]);
            const float n2 = fmaxf(m2, mx2); float a2s = 0.f;
#pragma unroll
            for (int r = 0; r < 16; ++r) a2s += __builtin_amdgcn_exp2f(s1[r] - n2);
            l2 = l2 * __builtin_amdgcn_exp2f(m2 - n2) + a2s; m2 = n2;
        } else {
#pragma unroll
            for (int r = 0; r < 16; ++r) pr[r] -= __builtin_amdgcn_exp2f(s1[r] - m2) * iL2;
            bf16x8 pb[2];
            { u32x4 t0, t1; t0.x = cvt_pk_bf16(pr[0], pr[1]); t0.y = cvt_pk_bf16(pr[2], pr[3]); t0.z = cvt_pk_bf16(pr[4], pr[5]); t0.w = cvt_pk_bf16(pr[6], pr[7]);
              t1.x = cvt_pk_bf16(pr[8], pr[9]); t1.y = cvt_pk_bf16(pr[10], pr[11]); t1.z = cvt_pk_bf16(pr[12], pr[13]); t1.w = cvt_pk_bf16(pr[14], pr[15]);
              pb[0] = __builtin_bit_cast(bf16x8, t0); pb[1] = __builtin_bit_cast(bf16x8, t1); }
#pragma unroll
            for (int blk = 0; blk < 4; ++blk)
#pragma unroll
                for (int s = 0; s < 2; ++s) {
                    const LAS bf16_t* vp = VTs + (blk * 32 + q) * AV_LD + kq * 32 + 16 * s + 4 * hi;
                    const s16x4 lo = *(const LAS s16x4*)vp, hh = *(const LAS s16x4*)(vp + 8);
                    const bf16x8 av = __builtin_shufflevector(lo, hh, 0, 1, 2, 3, 4, 5, 6, 7);
                    o[blk] = MFMA32(av, pb[s], o[blk]);
                }
        }
    }
}
DI void attn_unit(const Ctx& C, int layer, int uidx) {
    int tid = C.tid; asm volatile("" : "+v"(tid)); const int lane = tid & 63, w = __builtin_amdgcn_readfirstlane(tid >> 6), qg = w & 3, kh = w >> 2, q = lane & 15, g = lane >> 4;
    const bf16_t* Qb = (const bf16_t*)(C.ws + WS_Q); const bf16_t* Kb = (const bf16_t*)(C.ws + WS_K); const bf16_t* VT = (const bf16_t*)(C.ws + WS_V);
    const bf16_t* cK = (const bf16_t*)(C.ws + WS_CK); const bf16_t* cVT = (const bf16_t*)(C.ws + WS_CV);
    int b, h, rowq0; AttnSrc A;
    if (uidx < 512) { b = uidx >> 8; h = (uidx >> 6) & 3; const int qb = uidx & 63; rowq0 = 8192 + b * 4096 + qb * 64; A.nst = 34; A.nlat = 32; A.ldv = 4096;
        A.Klat = Kb + (size_t)(8192 + b * 4096) * 512; A.VTlat = VT + 4194304 + (size_t)((b * 4 + h) * 32) * 16384; A.Kctx = cK + (size_t)((layer * 2 + b) * 256) * 512; A.VTctx = cVT + (size_t)(((layer * 2 + b) * 4 + h) * 2) * 16384; }
    else { const int v = uidx - 512; b = v >> 4; h = (v >> 2) & 3; const int qb = v & 3; rowq0 = b * 256 + qb * 64; A.nst = 2; A.nlat = 2; A.ldv = 256;
        A.Klat = Kb + (size_t)(b * 256) * 512; A.VTlat = VT + (size_t)((b * 4 + h) * 2) * 16384; A.Kctx = A.Klat; A.VTctx = A.VTlat; }
    A.h = h;
    LAS bf16_t* K1s = (LAS bf16_t*)C.lds; LAS bf16_t* K2s = K1s + 128 * AK_LD; LAS bf16_t* VTs = K2s + 128 * AK_LD;
    const float lam = ((const float*)(C.ws + WS_TAB))[2048 + layer];
    bf16x8 qf1[2], qf2[2];
    { const bf16_t* qp = Qb + (size_t)(rowq0 + 16 * qg + q) * 512 + h * 128 + 8 * g;
#pragma unroll
      for (int ks = 0; ks < 2; ++ks) { qf1[ks] = *(const bf16x8*)(qp + 32 * ks); qf2[ks] = *(const bf16x8*)(qp + 64 + 32 * ks); } }
    float m1 = -1e30f, l1 = 0.f, m2 = -1e30f, l2 = 0.f;
    f32x4 O1[8], O2[8];
#pragma unroll
    for (int t = 0; t < 8; ++t) { O1[t] = (f32x4){0.f, 0.f, 0.f, 0.f}; O2[t] = O1[t]; }
    u32x4 kreg[4], vreg[4];
    auto issue = [&](int st) {
        const bf16_t* kb = (st < A.nlat) ? A.Klat + (size_t)st * 128 * 512 : A.Kctx + (size_t)(st - A.nlat) * 128 * 512;
#pragma unroll
        for (int i = 0; i < 2; ++i) { const int id = tid + 512 * i, key = id >> 3, ch = id & 7; kreg[i] = *(const u32x4*)(kb + (size_t)key * 512 + h * 128 + ch * 8); kreg[2 + i] = *(const u32x4*)(kb + (size_t)key * 512 + h * 128 + 64 + ch * 8); }
        const bf16_t* vb = (st < A.nlat) ? A.VTlat + (size_t)st * 16384 : A.VTctx + (size_t)(st - A.nlat) * 16384;
#pragma unroll
        for (int i = 0; i < 4; ++i) { const int id = tid + 512 * i; vreg[i] = *(const u32x4*)(vb + (size_t)id * 8); }
    };
    issue(0);
    for (int st = 0; st < A.nst; ++st) {
        __syncthreads();
#pragma unroll
        for (int i = 0; i < 2; ++i) { const int id = tid + 512 * i, key = id >> 3, ch = id & 7; *(LAS u32x4*)(K1s + key * AK_LD + ch * 8) = kreg[i]; *(LAS u32x4*)(K2s + key * AK_LD + ch * 8) = kreg[2 + i]; }
#pragma unroll
        for (int i = 0; i < 4; ++i) { const int id = tid + 512 * i, dv = id >> 4, ch = id & 15; *(LAS u32x4*)(VTs + dv * AV_LD + ch * 8) = vreg[i]; }
        __syncthreads();
        if (st + 1 < A.nst) issue(st + 1);
#pragma unroll
        for (int kb = 0; kb < 2; ++kb) {
            const int key0 = kh * 64 + kb * 32;
            f32x4 sA0 = {0.f, 0.f, 0.f, 0.f}, sA1 = sA0, sB0 = sA0, sB1 = sA0;
#pragma unroll
            for (int ks = 0; ks < 2; ++ks) {
                const bf16x8 a10 = *(const LAS bf16x8*)(K1s + (key0 + q) * AK_LD + 32 * ks + 8 * g), a11 = *(const LAS bf16x8*)(K1s + (key0 + 16 + q) * AK_LD + 32 * ks + 8 * g);
                const bf16x8 a20 = *(const LAS bf16x8*)(K2s + (key0 + q) * AK_LD + 32 * ks + 8 * g), a21 = *(const LAS bf16x8*)(K2s + (key0 + 16 + q) * AK_LD + 32 * ks + 8 * g);
                sA0 = MFMA16(a10, qf1[ks], sA0); sA1 = MFMA16(a11, qf1[ks], sA1); sB0 = MFMA16(a20, qf2[ks], sB0); sB1 = MFMA16(a21, qf2[ks], sB1);
            }
            float t1 = fmaxf(fmaxf(fmaxf(sA0[0], sA0[1]), fmaxf(sA0[2], sA0[3])), fmaxf(fmaxf(sA1[0], sA1[1]), fmaxf(sA1[2], sA1[3])));
            float t2 = fmaxf(fmaxf(fmaxf(sB0[0], sB0[1]), fmaxf(sB0[2], sB0[3])), fmaxf(fmaxf(sB1[0], sB1[1]), fmaxf(sB1[2], sB1[3])));
            if (__any(t1 > m1 || t2 > m2)) {
                t1 = fmaxf(t1, __shfl_xor(t1, 16)); t1 = fmaxf(t1, __shfl_xor(t1, 32)); t2 = fmaxf(t2, __shfl_xor(t2, 16)); t2 = fmaxf(t2, __shfl_xor(t2, 32));
                const float n1 = fmaxf(m1, t1), n2 = fmaxf(m2, t2); const float f1 = __builtin_amdgcn_exp2f(m1 - n1), f2 = __builtin_amdgcn_exp2f(m2 - n2);
                l1 *= f1; l2 *= f2; m1 = n1; m2 = n2;
#pragma unroll
                for (int t = 0; t < 8; ++t) { O1[t] = O1[t] * f1; O2[t] = O2[t] * f2; }
            }
            f32x4 pA0, pA1, pB0, pB1;
#pragma unroll
            for (int i = 0; i < 4; ++i) { pA0[i] = __builtin_amdgcn_exp2f(sA0[i] - m1); pA1[i] = __builtin_amdgcn_exp2f(sA1[i] - m1); pB0[i] = __builtin_amdgcn_exp2f(sB0[i] - m2); pB1[i] = __builtin_amdgcn_exp2f(sB1[i] - m2); }
            l1 += (pA0[0] + pA0[1]) + (pA0[2] + pA0[3]) + (pA1[0] + pA1[1]) + (pA1[2] + pA1[3]);
            l2 += (pB0[0] + pB0[1]) + (pB0[2] + pB0[3]) + (pB1[0] + pB1[1]) + (pB1[2] + pB1[3]);
            const bf16x8 pb1 = pack8(pA0, pA1), pb2 = pack8(pB0, pB1);
#pragma unroll
            for (int t = 0; t < 8; ++t) {
                const LAS bf16_t* vp = VTs + (16 * t + q) * AV_LD + key0 + 4 * g;
                const s16x4 lo = *(const LAS s16x4*)vp, hh = *(const LAS s16x4*)(vp + 16);
                const bf16x8 av = __builtin_shufflevector(lo, hh, 0, 1, 2, 3, 4, 5, 6, 7);
                O1[t] = MFMA16(av, pb1, O1[t]); O2[t] = MFMA16(av, pb2, O2[t]);
            }
        }
    }
    l1 += __shfl_xor(l1, 16); l1 += __shfl_xor(l1, 32); l2 += __shfl_xor(l2, 16); l2 += __shfl_xor(l2, 32);
    __syncthreads();
    LAS float* comb = (LAS float*)C.lds;
    LAS float* exs = (LAS float*)(C.lds + 65536);
    if (kh == 1) {
#pragma unroll
        for (int t = 0; t < 8; ++t)
#pragma unroll
            for (int i = 0; i < 4; ++i) { comb[(qg * 64 + t * 4 + i) * 64 + lane] = O1[t][i]; comb[(qg * 64 + 32 + t * 4 + i) * 64 + lane] = O2[t][i]; }
        exs[(qg * 4 + 0) * 64 + lane] = m1; exs[(qg * 4 + 1) * 64 + lane] = l1; exs[(qg * 4 + 2) * 64 + lane] = m2; exs[(qg * 4 + 3) * 64 + lane] = l2;
    }
    __syncthreads();
    if (kh == 0) {
        const float om1 = exs[(qg * 4 + 0) * 64 + lane], ol1 = exs[(qg * 4 + 1) * 64 + lane], om2 = exs[(qg * 4 + 2) * 64 + lane], ol2 = exs[(qg * 4 + 3) * 64 + lane];
        const float n1 = fmaxf(m1, om1), n2 = fmaxf(m2, om2);
        const float fa1 = __builtin_amdgcn_exp2f(m1 - n1), fb1 = __builtin_amdgcn_exp2f(om1 - n1), fa2 = __builtin_amdgcn_exp2f(m2 - n2), fb2 = __builtin_amdgcn_exp2f(om2 - n2);
        const float L1 = l1 * fa1 + ol1 * fb1, L2 = l2 * fa2 + ol2 * fb2;
        const float c1a = fa1 / L1, c1b = fb1 / L1, c2a = lam * fa2 / L2, c2b = lam * fb2 / L2;
        float ss = 0.f;
#pragma unroll
        for (int t = 0; t < 8; ++t)
#pragma unroll
            for (int i = 0; i < 4; ++i) { const float v = O1[t][i] * c1a + comb[(qg * 64 + t * 4 + i) * 64 + lane] * c1b - O2[t][i] * c2a - comb[(qg * 64 + 32 + t * 4 + i) * 64 + lane] * c2b; O1[t][i] = v; ss += v * v; }
        ss += __shfl_xor(ss, 16); ss += __shfl_xor(ss, 32);
        const float lam_init = 0.8f - 0.6f * __expf(-0.3f * (float)layer);
        const float sc = (1.0f / sqrtf(ss * (1.0f / 128.0f) + RMS_EPS)) * (1.0f - lam_init);
        const float* dn = C.p->in[18] + layer * 128;
        bf16_t* ob = (bf16_t*)(C.ws + WS_O) + (size_t)(rowq0 + 16 * qg + q) * DM + h * 128;
#pragma unroll
        for (int t = 0; t < 8; ++t) { const int dv = 16 * t + 4 * g; const f32x4 d4 = *(const f32x4*)(dn + dv); *(u32x2*)(ob + dv) = pack4(O1[t] * sc * d4); }
    }
    __syncthreads();
}

DI void delta_prep_unit(const Ctx& C, int layer, int unit) {
    const Params& p = *C.p; int tid = C.tid; asm volatile("" : "+v"(tid)); const int lane = tid & 63, w = __builtin_amdgcn_readfirstlane(tid >> 6);
    const int tc = unit >> 2, h = unit & 3, row0 = tc * 64;
    int ci, nch; if (tc < 128) { ci = tc & 3; nch = 4; } else { ci = (tc - 128) & 63; nch = 64; }
    const bool has_prev = ci > 0, has_next = ci < nch - 1;
    float* qs = C.L; float* kk = C.L + 4160; float* vv = C.L + 8320; float* KK0 = C.L + 12480; float* QK0 = KK0 + 4096; float* Ms = QK0 + 4096; float* bc = Ms + 8192; float* be = bc + 128;
    const bf16_t* zb = (const bf16_t*)(C.ws + WS_ZB);
    const float* cw = p.in[11] + layer * 3 * 768;
    __syncthreads();
    if (tid < 384) {
        const int c = tid % 192, th = tid / 192, which = c >> 6, d = c & 63, col = which * 256 + h * 64 + d;
        const float w0 = cw[col], w1 = cw[768 + col], w2 = cw[1536 + col];
        float xin[34];
#pragma unroll
        for (int i = 0; i < 34; ++i) { const int tt = 32 * th - 1 + i; const bool ok = (tt >= 0 || has_prev) && (tt < 64 || has_next); xin[i] = ok ? bf2f(zb[(size_t)(row0 + tt) * ZLD + col]) : 0.f; }
        float* dstp = (which == 0 ? qs : (which == 1 ? kk : vv)) + d;
#pragma unroll
        for (int i = 0; i < 32; ++i) dstp[(32 * th + i) * 65] = siluf_(w0 * xin[i] + w1 * xin[i + 1] + w2 * xin[i + 2]);
    }
    __syncthreads();
    { const int r = tid >> 2, part = tid & 3; float* base = (r < 64 ? qs + r * 65 : kk + (r - 64) * 65) + part * 16; float ss = 0.f;
#pragma unroll
      for (int i = 0; i < 16; ++i) ss += base[i] * base[i];
      ss += __shfl_xor(ss, 1); ss += __shfl_xor(ss, 2);
      const float sc = (1.0f / sqrtf(ss + 1e-6f)) * (r < 64 ? 0.125f : 1.0f);
#pragma unroll
      for (int i = 0; i < 16; ++i) base[i] *= sc; }
    if (w < 2) {
        const int dir = w, i = lane, tt = dir ? 63 - i : i; const size_t row = (size_t)(row0 + tt);
        const float braw = bf2f(zb[row * ZLD + ZB_BBETA + dir * 4 + h]), araw = bf2f(zb[row * ZLD + ZB_BA + dir * 4 + h]);
        const float A = __expf(p.in[12][layer * 8 + dir * 4 + h]); const float x = araw + p.in[13][layer * 8 + dir * 4 + h];
        const float sp = x > 20.f ? x : log1pf(__expf(x)); float g = -A * sp;
#pragma unroll
        for (int off = 1; off < 64; off <<= 1) { const float t = __shfl_up(g, off); if (lane >= off) g += t; }
        bc[dir * 64 + i] = g; const float bt = sigmoidf_(braw); be[dir * 64 + i] = bt; be[128 + dir * 64 + i] = bt * __expf(g);
    }
    __syncthreads();
    { const int a = tid >> 3, b0 = (tid & 7) * 8; float ka[8], qa[8];
#pragma unroll
      for (int j = 0; j < 8; ++j) { ka[j] = 0.f; qa[j] = 0.f; }
#pragma unroll 4
      for (int d = 0; d < 64; ++d) { const float kav = kk[a * 65 + d], qav = qs[a * 65 + d];
#pragma unroll
          for (int j = 0; j < 8; ++j) { const float kb = kk[(b0 + j) * 65 + d]; ka[j] += kav * kb; qa[j] += qav * kb; } }
#pragma unroll
      for (int j = 0; j < 8; ++j) { KK0[a * 64 + b0 + j] = ka[j]; QK0[a * 64 + b0 + j] = qa[j]; } }
    __syncthreads();
    bf16_t* dpW = (bf16_t*)(C.ws + WS_DPW); bf16_t* dpQD = (bf16_t*)(C.ws + WS_DPQD); bf16_t* dpQK = (bf16_t*)(C.ws + WS_DPQK); bf16_t* dpKD = (bf16_t*)(C.ws + WS_DPKD); bf16_t* dpU = (bf16_t*)(C.ws + WS_DPU);
    float* dpGL = (float*)(C.ws + WS_GL);
    { const int i = tid >> 3, j0 = (tid & 7) * 8;
#pragma unroll
      for (int dir = 0; dir < 2; ++dir) {
          const size_t ud = ((size_t)tc * 4 + h) * 2 + dir;
          const float bi = bc[dir * 64 + i], betai = be[dir * 64 + i]; const int ai = dir ? 63 - i : i;
#pragma unroll
          for (int jj = 0; jj < 8; ++jj) { const int j = j0 + jj, aj = dir ? 63 - j : j;
              const float dec = (j <= i) ? __expf(bi - bc[dir * 64 + j]) : 0.f;
              Ms[dir * 4096 + j * 64 + i] = (j < i) ? betai * KK0[ai * 64 + aj] * dec : 0.f;
              dpQK[ud * 4096 + i * 64 + pinv(j)] = f2bf(QK0[ai * 64 + aj] * dec); }
      } }
    __syncthreads();
    if (w < 4) {
        const int dir = w >> 1, c = (w & 1) * 64 + lane; const size_t ud = ((size_t)tc * 4 + h) * 2 + dir;
        const float* Msd = Ms + dir * 4096; const bool isU = (w & 1) == 0; const float* scp = be + (isU ? 0 : 128) + dir * 64; const float* srcp = (isU ? vv : kk) + lane;
        float x[64];
#pragma unroll
        for (int rb = 0; rb < 4; ++rb) {
            float r[16];
#pragma unroll
            for (int ii = 0; ii < 16; ++ii) { const int i = 16 * rb + ii, tt = dir ? 63 - i : i; r[ii] = scp[i] * srcp[tt * 65]; }
            asm volatile("" ::: "memory");
#pragma unroll
            for (int j = 0; j < 16 * rb; ++j) {
                const float* mp = Msd + j * 64 + 16 * rb;
                const f32x4 ma = *(const f32x4*)mp, mb = *(const f32x4*)(mp + 4), mc = *(const f32x4*)(mp + 8), md = *(const f32x4*)(mp + 12);
                const float xj = x[j];
#pragma unroll
                for (int c4 = 0; c4 < 4; ++c4) { r[c4] -= ma[c4] * xj; r[4 + c4] -= mb[c4] * xj; r[8 + c4] -= mc[c4] * xj; r[12 + c4] -= md[c4] * xj; }
                if ((j & 3) == 3) asm volatile("" ::: "memory");
            }
#pragma unroll
            for (int jj = 0; jj < 16; ++jj) {
                const float xj = r[jj]; x[16 * rb + jj] = xj;
                const float* mp = Msd + (16 * rb + jj) * 64 + 16 * rb;
#pragma unroll
                for (int ii = jj + 1; ii < 16; ++ii) r[ii] -= mp[ii] * xj;
                if ((jj & 3) == 3) asm volatile("" ::: "memory");
            }
        }
        if (c < 64) {
            bf16_t* up = dpU + ud * 4096 + c * 64;
#pragma unroll
            for (int i = 0; i < 64; i += 8) { u32x4 o; o.x = cvt_pk_bf16(x[i], x[i + 1]); o.y = cvt_pk_bf16(x[i + 2], x[i + 3]); o.z = cvt_pk_bf16(x[i + 4], x[i + 5]); o.w = cvt_pk_bf16(x[i + 6], x[i + 7]); *(u32x4*)(up + i) = o; }
        } else {
            bf16_t* wp = dpW + ud * 4096 + pinv(c - 64);
#pragma unroll
            for (int i = 0; i < 64; ++i) wp[i * 64] = f2bf(x[i]);
        }
    } else {
#pragma unroll 4
        for (int it = 0; it < 64; ++it) {
            const int e = (tid - 256) + 256 * it, dir = e >> 13, which = (e >> 12) & 1, rem = e & 4095; const size_t ud = ((size_t)tc * 4 + h) * 2 + dir;
            if (which == 0) { const int i = rem >> 6, d = rem & 63, tt = dir ? 63 - i : i; dpQD[ud * 4096 + i * 64 + pinv(d)] = f2bf(qs[tt * 65 + d] * __expf(bc[dir * 64 + i])); }
            else { const int dk = rem >> 6, i = rem & 63, tt = dir ? 63 - i : i; dpKD[ud * 4096 + dk * 64 + pinv(i)] = f2bf(kk[tt * 65 + dk] * __expf(bc[dir * 64 + 63] - bc[dir * 64 + i])); }
        }
        if (tid == 256 || tid == 257) { const int dir = tid - 256; dpGL[((size_t)tc * 4 + h) * 2 + dir] = __expf(bc[dir * 64 + 63]); }
    }
}

DI void delta_scan_unit(const Ctx& C, int layer, bool sample, int b, int h) {
    const Params& p = *C.p; int tid = C.tid; asm volatile("" : "+v"(tid)); const int lane = tid & 63; const int w = C.wave, dir = w >> 2, sl = w & 3, col = lane & 15, g = lane >> 4;
    const int tc0 = sample ? 128 + b * 64 : b * 4, nch = sample ? 64 : 4;
    const bf16_t* dpU = (const bf16_t*)(C.ws + WS_DPU);
    const float* dpGL = (const float*)(C.ws + WS_GL); float* od = (float*)(C.ws + WS_OD) + (size_t)dir * MROWS * 256;
    f32x4 S[4];
    if (sample) { const float* s0 = p.in[4] + ((((size_t)b * 4 + layer) * 2 + dir) * 4 + h) * 4096;
#pragma unroll
        for (int rb = 0; rb < 4; ++rb)
#pragma unroll
            for (int ii = 0; ii < 4; ++ii) S[rb][ii] = s0[(16 * rb + 4 * g + ii) * 64 + 16 * sl + col]; }
    else {
#pragma unroll
        for (int rb = 0; rb < 4; ++rb) S[rb] = (f32x4){0.f, 0.f, 0.f, 0.f}; }
    u32x4 Ra[8], Rb[8];
#define DS_TC(d_, n_) ((d_) ? tc0 + nch - 1 - (n_) : tc0 + (n_))
#define DS_ISSUE(R, n_) do { _Pragma("unroll") for (int i = 0; i < 8; ++i) { const int id = tid + 512 * i, dm = id >> 9, dd = dm >> 2, mat = dm & 3; \
        const size_t ud_ = ((size_t)DS_TC(dd, n_) * 4 + h) * 2 + dd; R[i] = *(const u32x4*)(C.ws + WS_DPW + (size_t)mat * (16u * MiB) + ud_ * 8192 + (size_t)(id & 511) * 16); } } while (0)
#define DS_WRITE(R, buf_) do { _Pragma("unroll") for (int i = 0; i < 8; ++i) { const int id = tid + 512 * i, dm = id >> 9, row = (id >> 3) & 63, c = id & 7; \
        *(LAS u32x4*)(C.lds + (buf_) * 65536 + dm * 8192 + row * 128 + ((c ^ (row & 7)) * 16)) = R[i]; } } while (0)
#define DS_FRAG(buf_, mat_, rb_, ks_) (*(const LAS bf16x8*)(C.lds + (buf_) * 65536 + (dir * 4 + (mat_)) * 8192 + (16 * (rb_) + col) * 128 + ((((ks_) * 4 + g) ^ (col & 7)) * 16)))
    __syncthreads();
    DS_ISSUE(Ra, 0); DS_WRITE(Ra, 0); DS_ISSUE(Ra, 1);
    s16x4 uuA[4], uuB[4]; float glA, glB;
#define DS_LOADU(uu, gl, n_) do { const size_t ud_ = ((size_t)DS_TC(dir, n_) * 4 + h) * 2 + dir; _Pragma("unroll") for (int rb = 0; rb < 4; ++rb) uu[rb] = *(const s16x4*)(dpU + ud_ * 4096 + (16 * sl + col) * 64 + 16 * rb + 4 * g); gl = dpGL[ud_]; } while (0)
    DS_LOADU(uuA, glA, 0); DS_LOADU(uuB, glB, 1);
    __syncthreads();
#define DS_STEP(n, buf, Rnext, Rcur, uu, gl) do { \
        if ((n) + 2 < nch) DS_ISSUE(Rnext, (n) + 2); \
        const int tc = DS_TC(dir, (n)); \
        bf16x8 Sb[2]; Sb[0] = pack8(S[0], S[1]); Sb[1] = pack8(S[2], S[3]); \
        f32x4 vn[4]; \
        _Pragma("unroll") for (int rb = 0; rb < 4; ++rb) { f32x4 t = (f32x4){0.f, 0.f, 0.f, 0.f}; t = MFMA16(DS_FRAG(buf, 0, rb, 0), Sb[0], t); t = MFMA16(DS_FRAG(buf, 0, rb, 1), Sb[1], t); \
            _Pragma("unroll") for (int ii = 0; ii < 4; ++ii) vn[rb][ii] = bf2f((bf16_t)uu[rb][ii]) - t[ii]; } \
        const float glc = gl; \
        if ((n) + 2 < nch) DS_LOADU(uu, gl, (n) + 2); \
        bf16x8 vb[2]; vb[0] = pack8(vn[0], vn[1]); vb[1] = pack8(vn[2], vn[3]); \
        const int rowb = tc * 64; \
        _Pragma("unroll") for (int rb = 0; rb < 4; ++rb) { f32x4 o = (f32x4){0.f, 0.f, 0.f, 0.f}; o = MFMA16(DS_FRAG(buf, 1, rb, 0), Sb[0], o); o = MFMA16(DS_FRAG(buf, 1, rb, 1), Sb[1], o); o = MFMA16(DS_FRAG(buf, 2, rb, 0), vb[0], o); o = MFMA16(DS_FRAG(buf, 2, rb, 1), vb[1], o); \
            _Pragma("unroll") for (int ii = 0; ii < 4; ++ii) { const int i = 16 * rb + 4 * g + ii; const int tt = dir ? 63 - i : i; od[(size_t)(rowb + tt) * 256 + h * 64 + 16 * sl + col] = o[ii]; } } \
        _Pragma("unroll") for (int rb = 0; rb < 4; ++rb) { f32x4 sn = S[rb] * glc; sn = MFMA16(DS_FRAG(buf, 3, rb, 0), vb[0], sn); sn = MFMA16(DS_FRAG(buf, 3, rb, 1), vb[1], sn); S[rb] = sn; } \
        if ((n) + 1 < nch) DS_WRITE(Rcur, (buf) ^ 1); \
        __syncthreads(); } while (0)
    for (int n = 0; n < nch; n += 2) {
        DS_STEP(n, 0, Rb, Ra, uuA, glA);
        DS_STEP(n + 1, 1, Ra, Rb, uuB, glB);
    }
#undef DS_STEP
#undef DS_TC
#undef DS_ISSUE
#undef DS_WRITE
#undef DS_FRAG
#undef DS_LOADU
    if (!sample) { float* so = C.out + OUT_SD + ((((size_t)b * 4 + layer) * 2 + dir) * 4 + h) * 4096;
#pragma unroll
        for (int rb = 0; rb < 4; ++rb)
#pragma unroll
            for (int ii = 0; ii < 4; ++ii) so[(16 * rb + 4 * g + ii) * 64 + 16 * sl + col] = S[rb][ii]; }
}

DI float hgrn_forget(const bf16_t* zb, size_t row, int dir, int h, int d, float lb) { const float x = bf2f(zb[row * ZLD + ZB_CF + dir * 256 + h * 64 + d]); return lb + (1.0f - lb) * sigmoidf_(x); }
DI void hgrn_local_unit(const Ctx& C, int layer, int unit) {
    int lane = C.lane; asm volatile("" : "+v"(lane)); const int dir = unit & 1, h = (unit >> 1) & 3, tc = unit >> 3, row0 = tc * 64;
    const bf16_t* zb = (const bf16_t*)(C.ws + WS_ZB);
    float* fs = C.L + C.wave * 1024;
    const float lb = ((const float*)(C.ws + WS_TAB))[4096 + (dir * 4 + layer) * 256 + h * 64 + lane];
    float S[64];
#pragma unroll
    for (int d = 0; d < 64; ++d) S[d] = 0.f;
    float Dl = 1.0f;
    for (int sb = 0; sb < 4; ++sb) {
        float vr[16];
#pragma unroll
        for (int i = 0; i < 16; ++i) { const int ti = sb * 16 + i, tt = dir ? 63 - ti : ti; const size_t row = (size_t)(row0 + tt);
            const float f = hgrn_forget(zb, row, dir, h, lane, lb); fs[i * 64 + lane] = f; Dl *= f; vr[i] = bf2f(zb[row * ZLD + ZB_CI + h * 64 + lane]); }
        __builtin_amdgcn_wave_barrier();
#pragma unroll
        for (int i = 0; i < 16; ++i) { const float v = vr[i];
#pragma unroll
            for (int d = 0; d < 64; d += 4) { const f32x4 f4 = *(const f32x4*)(fs + i * 64 + d);
#pragma unroll
                for (int c = 0; c < 4; ++c) S[d + c] = fmaf(f4[c], S[d + c] - v, v);
                if ((d & 15) == 12) asm volatile("" ::: "memory"); } }
        __builtin_amdgcn_wave_barrier();
    }
    float* hs = (float*)(C.ws + WS_HS) + (size_t)unit * 4096;
#pragma unroll
    for (int d = 0; d < 64; ++d) hs[d * 64 + lane] = S[d];
    ((float*)(C.ws + WS_HD))[(size_t)unit * 64 + lane] = Dl;
}
DI void hgrn_scan_unit(const Ctx& C, int layer, bool sample, int b, int h, int dir) {
    const Params& p = *C.p; int tid = C.tid; asm volatile("" : "+v"(tid)); const int tc0 = sample ? 128 + b * 64 : b * 4, nch = sample ? 64 : 4;
    float* HS = (float*)(C.ws + WS_HS); const float* HD = (const float*)(C.ws + WS_HD);
    f32x4 S0, S1;
    if (sample) { const float* s0 = p.in[5] + ((((size_t)b * 4 + layer) * 2 + dir) * 4 + h) * 4096 + tid * 8; S0 = *(const f32x4*)s0; S1 = *(const f32x4*)(s0 + 4); }
    else { S0 = (f32x4){0.f, 0.f, 0.f, 0.f}; S1 = S0; }
    for (int n0 = 0; n0 < nch; n0 += 4) {
        f32x4 la[4], lb[4]; float Dd[4];
#pragma unroll
        for (int k = 0; k < 4; ++k) { const int tc = dir ? tc0 + nch - 1 - (n0 + k) : tc0 + n0 + k; const size_t uh = ((size_t)tc * 4 + h) * 2 + dir;
            const float* hp = HS + uh * 4096 + tid * 8; la[k] = *(const f32x4*)hp; lb[k] = *(const f32x4*)(hp + 4); Dd[k] = HD[uh * 64 + (tid >> 3)]; }
#pragma unroll
        for (int k = 0; k < 4; ++k) { const int tc = dir ? tc0 + nch - 1 - (n0 + k) : tc0 + n0 + k; const size_t uh = ((size_t)tc * 4 + h) * 2 + dir;
            float* hp = HS + uh * 4096 + tid * 8; *(f32x4*)hp = S0; *(f32x4*)(hp + 4) = S1; S0 = S0 * Dd[k] + la[k]; S1 = S1 * Dd[k] + lb[k]; }
    }
    if (!sample) { float* so = C.out + OUT_SH + ((((size_t)b * 4 + layer) * 2 + dir) * 4 + h) * 4096 + tid * 8; *(f32x4*)so = S0; *(f32x4*)(so + 4) = S1; }
}
DI void hgrn_final_unit(const Ctx& C, int layer, int tc) {
    const Params& p = *C.p; int lane = C.lane; asm volatile("" : "+v"(lane)); const int w = C.wave, h = w >> 1, dir = w & 1, ep = lane & 31, dh = lane >> 5, row0 = tc * 64;
    const bf16_t* zb = (const bf16_t*)(C.ws + WS_ZB); const float* HS = (const float*)(C.ws + WS_HS);
    float* otile = C.L;
    float* fs = C.L + 16384 + w * 2048; float* qst = fs + 1024;
    __syncthreads();
    for (int i = C.tid; i < 16384; i += 512) otile[i] = 0.f;
    __syncthreads();
    {
        const size_t uh = ((size_t)tc * 4 + h) * 2 + dir;
        const float lb = ((const float*)(C.ws + WS_TAB))[4096 + (dir * 4 + layer) * 256 + h * 64 + lane];
        f32x2 S[32];
#pragma unroll
        for (int k = 0; k < 32; ++k) S[k] = *(const f32x2*)(HS + uh * 4096 + (32 * dh + k) * 64 + 2 * ep);
        bf16_t rf[16], rq[16]; unsigned rv[16];
#define HF_LOAD(sb_) do { _Pragma("unroll") for (int i = 0; i < 16; ++i) { const int ti = (sb_) * 16 + i, tt = dir ? 63 - ti : ti; const size_t row = (size_t)(row0 + tt); \
            rf[i] = zb[row * ZLD + ZB_CF + dir * 256 + h * 64 + lane]; rq[i] = zb[row * ZLD + ZB_CQ + h * 64 + lane]; rv[i] = *(const unsigned*)(zb + row * ZLD + ZB_CI + h * 64 + 2 * ep); } } while (0)
        HF_LOAD(0);
        for (int sb = 0; sb < 4; ++sb) {
            f32x2 vr[16];
#pragma unroll
            for (int i = 0; i < 16; ++i) { fs[i * 64 + lane] = lb + (1.0f - lb) * sigmoidf_(bf2f(rf[i])); qst[i * 64 + lane] = siluf_(bf2f(rq[i])); vr[i] = (f32x2){__uint_as_float(rv[i] << 16), __uint_as_float(rv[i] & 0xffff0000u)}; }
            if (sb + 1 < 4) HF_LOAD(sb + 1);
            __builtin_amdgcn_wave_barrier();
#pragma unroll
            for (int i = 0; i < 16; ++i) { const f32x2 v = vr[i]; f32x2 osa = {0.f, 0.f}, osb = {0.f, 0.f};
#pragma unroll
                for (int k = 0; k < 32; k += 4) { const f32x4 f4 = *(const f32x4*)(fs + i * 64 + 32 * dh + k), q4 = *(const f32x4*)(qst + i * 64 + 32 * dh + k);
#pragma unroll
                    for (int c = 0; c < 4; ++c) { S[k + c] = (S[k + c] - v) * f4[c] + v; if (c & 1) osb += S[k + c] * q4[c]; else osa += S[k + c] * q4[c]; }
                    if ((k & 15) == 12) asm volatile("" ::: "memory"); }
                f32x2 os = osa + osb;
                os.x += __shfl_xor(os.x, 32); os.y += __shfl_xor(os.y, 32);
                const int ti = sb * 16 + i, tt = dir ? 63 - ti : ti;
                if (dh == 0) { float* op = otile + (h * 64 + tt) * 64 + 2 * ep; atomicAdd(op, os.x); atomicAdd(op + 1, os.y); }
                asm volatile("" ::: "memory"); }
            __builtin_amdgcn_wave_barrier();
        }
    }
#undef HF_LOAD
    __syncthreads();
    bf16_t* ob = (bf16_t*)(C.ws + WS_O);
    const float ng = p.in[16][layer * 64 + lane];
    bf16_t gts[32];
#pragma unroll
    for (int rr = 0; rr < 32; ++rr) { const int idx = w * 32 + rr, hh = idx >> 6, tt = idx & 63; gts[rr] = zb[(size_t)(row0 + tt) * ZLD + ZB_CG + hh * 64 + lane]; }
#pragma unroll
    for (int rr = 0; rr < 32; ++rr) { const int idx = w * 32 + rr, hh = idx >> 6, tt = idx & 63; const size_t row = (size_t)(row0 + tt);
        const float v = otile[(hh * 64 + tt) * 64 + lane]; const float ss = wave_sum(v * v);
        const float gt = siluf_(bf2f(gts[rr]));
        ob[row * DM + 768 + hh * 64 + lane] = f2bf(v * (1.0f / sqrtf(ss * (1.0f / 64.0f) + RMS_EPS)) * ng * gt); }
}
DI void delta_combine(const Ctx& C, int layer) {
    const Params& p = *C.p; const bf16_t* zb = (const bf16_t*)(C.ws + WS_ZB); const float* od = (const float*)(C.ws + WS_OD); bf16_t* ob = (bf16_t*)(C.ws + WS_O);
    const float ng = p.in[14][layer * 64 + C.lane];
    for (int it0 = C.gw * 4; it0 < MROWS * 4; it0 += C.NGW * 4) {
        float v[4]; bf16_t gr[4];
#pragma unroll
        for (int k = 0; k < 4; ++k) { const int it = it0 + k, h = it & 3; const size_t row = (size_t)(it >> 2);
            v[k] = od[row * 256 + h * 64 + C.lane] + od[(size_t)MROWS * 256 + row * 256 + h * 64 + C.lane]; gr[k] = zb[row * ZLD + ZB_BG + h * 64 + C.lane]; }
#pragma unroll
        for (int k = 0; k < 4; ++k) { const int it = it0 + k, h = it & 3; const size_t row = (size_t)(it >> 2);
            const float ss = wave_sum(v[k] * v[k]); const float gt = siluf_(bf2f(gr[k]));
            ob[row * DM + 512 + h * 64 + C.lane] = f2bf(v[k] * (1.0f / sqrtf(ss * (1.0f / 64.0f) + RMS_EPS)) * ng * gt); }
    }
}

#define XB_TMO      128
#define XB_XCNT(j)  (256  + 64 * (j))
#define XB_XSUB(j)  (1280 + 64 * (j))
#define XB_XGEN(j)  (2304 + 64 * (j))
#define XB_TOP      3328
#define XB_TOPGEN   3392
#define XB_SPIN_CAP (1u << 22)
DI unsigned xb_ld(unsigned* p)              { return __hip_atomic_load(p, __ATOMIC_RELAXED, __HIP_MEMORY_SCOPE_AGENT); }
DI unsigned xb_add(unsigned* p, unsigned v) { return __hip_atomic_fetch_add(p, v, __ATOMIC_RELAXED, __HIP_MEMORY_SCOPE_AGENT); }
DI unsigned xb_xcc_id() { return (unsigned)__builtin_amdgcn_s_getreg((3 << 11) | 20) & 0xFu; }
#define XB_SPIN(cond, bar) do { unsigned _sp = 0; while (cond) { __builtin_amdgcn_s_sleep(1); \
    if ((++_sp & 255u) == 0u) { if (xb_ld(&(bar)[XB_TMO])) break; if (_sp > XB_SPIN_CAP) { atomicAdd(&(bar)[XB_TMO], 1u); break; } } } } while (0)
struct XcdBarrier { unsigned* bar; unsigned x; volatile LAS unsigned* st; };
DI void xcd_barrier_complete(unsigned* bar, unsigned x, unsigned& nloc, unsigned& nx) {
    const unsigned G = gridDim.x * gridDim.y * gridDim.z;
    unsigned sum, cnt, mine, sp = 0u;
    for (;;) {
        sum = 0u; cnt = 0u; mine = 0u;
#pragma unroll
        for (unsigned j = 0; j < 16; ++j) { const unsigned c = xb_ld(&bar[XB_XCNT(j)]); sum += c; cnt += (c > 0u) ? 1u : 0u; mine = (j == x) ? c : mine; }
        if (sum == G) break;
        __builtin_amdgcn_s_sleep(1);
        if ((++sp & 255u) == 0u) { if (xb_ld(&bar[XB_TMO])) break; if (sp > XB_SPIN_CAP) { atomicAdd(&bar[XB_TMO], 1u); break; } }
    }
    nloc = mine > 0u ? mine : 1u; nx = cnt > 0u ? cnt : 1u;
}
DI void xcd_barrier(const XcdBarrier& b) {
    asm volatile("s_waitcnt vmcnt(0)" ::: "memory");
    __syncthreads();
    if (threadIdx.x == 0) {
        unsigned* bar = b.bar;
        __builtin_amdgcn_s_waitcnt(0);
        unsigned nloc = b.st[0], nx = b.st[1];
        if (nloc == 0u) { xcd_barrier_complete(bar, b.x, nloc, nx); b.st[0] = nloc; b.st[1] = nx; }
        const unsigned old = xb_add(&bar[XB_XSUB(b.x)], 1u);
        const unsigned gen = old / nloc;
        if (old + 1u == (gen + 1u) * nloc) {
            __builtin_amdgcn_fence(__ATOMIC_RELEASE, "agent");
            asm volatile("s_waitcnt vmcnt(0)" ::: "memory");
            const unsigned og = xb_add(&bar[XB_TOP], 1u);
            const unsigned tg = og / nx;
            if (og + 1u == (tg + 1u) * nx) xb_add(&bar[XB_TOPGEN], 1u);
            else XB_SPIN(xb_ld(&bar[XB_TOPGEN]) == tg, bar);
            __builtin_amdgcn_fence(__ATOMIC_ACQUIRE, "agent");
            xb_add(&bar[XB_XGEN(b.x)], 1u);
            asm volatile("s_waitcnt vmcnt(0)" ::: "memory");
        } else {
            XB_SPIN(xb_ld(&bar[XB_XGEN(b.x)]) == gen, bar);
            __builtin_amdgcn_fence(__ATOMIC_ACQUIRE, "agent");
            asm volatile("s_waitcnt vmcnt(0)" ::: "memory");
        }
    }
    __syncthreads();
}

DI void probe_stamp(unsigned char* ws, int cls) {
    if (PROBE_A >= 0 && blockIdx.x == 0 && threadIdx.x == 0) {
        volatile float* tsf = (volatile float*)(ws + WS_TAB + 131072); volatile unsigned long long* tsl = (volatile unsigned long long*)(ws + WS_TAB + 131072 + 256);
        const unsigned long long now = __builtin_amdgcn_s_memrealtime(); tsf[cls] += (float)(now - tsl[0]); tsl[0] = now; }
}
template <unsigned PHM_>
__global__ void __launch_bounds__(512) fwd_megakernel(Params p) {
    extern __shared__ __attribute__((aligned(16))) unsigned char lds_raw[];
    XcdBarrier xbar; xbar.bar = (unsigned*)(p.ws + WS_CTL) + 1024; xbar.x = xb_xcc_id(); xbar.st = (volatile LAS unsigned*)((LAS unsigned char*)lds_raw + 147400);
    if (threadIdx.x == 0) { xbar.st[0] = 0u; xbar.st[1] = 0u; (void)xb_add(&xbar.bar[XB_XCNT(xbar.x)], 1u); }
    __syncthreads();
    for (int ph = p.ph_lo; ph < p.ph_hi; ++ph) {
        if (PROBE_A >= 0 && blockIdx.x == 0 && threadIdx.x == 0) {
            volatile float* tsf = (volatile float*)(p.ws + WS_TAB + 131072); volatile unsigned long long* tsl = (volatile unsigned long long*)(p.ws + WS_TAB + 131072 + 256);
            const unsigned long long now = __builtin_amdgcn_s_memrealtime();
            if (ph == 0) { for (int i = 0; i < 16; ++i) tsf[i] = 0.f; tsl[1] = now; }
            else { const int pp = ph - 1; const int cls = pp < 2 ? 8 : (((pp - 2) % 9) == 8 ? 5 : ((pp - 2) % 9)); const float dt = (float)(now - tsl[0]); tsf[cls] += dt; }
            tsl[0] = now;
            if (ph == NPHASE - 2 && PROBE_A < 20) { const float tot = (float)(now - tsl[1]); tsf[12] = rintf(tsf[(PROBE_A >= 0 && PROBE_A < 16) ? PROBE_A : 0] / tot * 40.f) / 40.f; tsf[13] = rintf(tsf[PROBE_B >= 0 ? PROBE_B : 0] / tot * 40.f) / 40.f; }
        }
        if (PROBE_A >= 0 && ph == 0 && threadIdx.x == 0) { volatile float* tsb = (volatile float*)(p.ws + WS_TAB + 196608) + blockIdx.x * 8; for (int i = 0; i < 8; ++i) tsb[i] = 0.f; }
        if (PROBE_A >= 20 && ph == NPHASE - 2 && blockIdx.x == 0 && threadIdx.x == 0) {
            volatile float* tsf = (volatile float*)(p.ws + WS_TAB + 131072); volatile unsigned long long* tsl = (volatile unsigned long long*)(p.ws + WS_TAB + 131072 + 256);
            const float* tsb = (const float*)(p.ws + WS_TAB + 196608); float sum = 0.f; for (int b2 = 0; b2 < (int)gridDim.x; ++b2) sum += __hip_atomic_load(tsb + b2 * 8 + (PROBE_A - 20), __ATOMIC_RELAXED, __HIP_MEMORY_SCOPE_AGENT); sum *= (PROBE_A == 20 ? 32.f : (PROBE_A == 21 ? 16.f : 1.f));
            const float tot = (float)(__builtin_amdgcn_s_memrealtime() - tsl[1]); tsf[12] = rintf(sum / (float)gridDim.x / tot * 40.f) / 40.f; tsf[13] = 0.f; }
        int tid_ = threadIdx.x; asm volatile("" : "+v"(tid_));
        unsigned char* ws_ = p.ws; asm volatile("" : "+s"(ws_));
        float* out_ = p.out; asm volatile("" : "+s"(out_));
        Ctx C; C.p = &p; C.lds = (LAS unsigned char*)lds_raw; C.L = (float*)lds_raw; C.tid = tid_; C.lane = C.tid & 63; C.wave = __builtin_amdgcn_readfirstlane(C.tid >> 6);
        C.G = gridDim.x; C.gw = blockIdx.x * 8 + C.wave; C.NGW = C.G * 8; C.ws = ws_; C.out = out_;
        unsigned* ctl = (unsigned*)(ws_ + WS_CTL);
        const float* modbuf = (const float*)(ws_ + WS_MOD);
        bf16_t* xm = (bf16_t*)(ws_ + WS_XM); bf16_t* ob = (bf16_t*)(ws_ + WS_O); bf16_t* act = (bf16_t*)(ws_ + WS_ACT);
        if (ph == 0) { if (PHON(0)) phase0a(C); }
        else if (ph == 1) { if (PHON(1)) row_pass(C, 0, nullptr, nullptr, modbuf, 1024, 0, true); }
        else {
            const int layer = (ph - 2) / 9, sub = (ph - 2) % 9;
            unsigned char* wb = ws_ + WS_W + (size_t)(layer & 1) * WBUF;
            const float* modl = modbuf + (size_t)layer * 3 * 6144;
            if (sub == 0) { if (PHON(2)) {
                pg8::Gemm g{xm, (const bf16_t*)(wb + W_IN), MROWS, 4096, DM}; pg8::StaticOrder S; S.init(MROWS, 4096, C.G, (int)blockIdx.x);
                EpiIn E{(bf16_t*)(ws_ + WS_Q), (bf16_t*)(ws_ + WS_K), (bf16_t*)(ws_ + WS_V), (bf16_t*)(ws_ + WS_ZB), out_ + OUT_K, out_ + OUT_V, (const f32x2*)(ws_ + WS_TAB), layer};
                pg8::gemm_phase(C.lds, g, S, E, C.tid); }
            } else if (sub == 1) {
                __syncthreads();
                if (PHON(4)) for (int u = blockIdx.x; u < 1024; u += C.G) delta_prep_unit(C, layer, u);
                __syncthreads();
                if (PHON(5)) for (int u = C.gw; u < 2048; u += C.NGW) hgrn_local_unit(C, layer, u);
                __syncthreads();
            } else if (sub == 2) {
                LAS int* slot = (LAS int*)(C.lds + 147392);
                for (;;) {
                    __syncthreads();
                    if (C.tid == 0) *slot = (int)atomicAdd(ctl + 64 * (layer + 1), 1u);
                    __syncthreads();
                    const int u = *slot;
                    if (u >= 1432 + 256) break;
                    if (u >= 1432) { if (layer + 1 < DEPTH) convert_layer_weights(C, layer + 1, (u - 1432) * 8 + C.wave, 2048, u - 1432, 256); continue; }
                    unsigned long long pt0_ = 0; if (PROBE_A >= 0 && C.tid == 0) pt0_ = __builtin_amdgcn_s_memrealtime();
                    if (u < 8) { if (PHON(6)) delta_scan_unit(C, layer, true, u >> 2, u & 3); }
                    else if (u < 24) { const int v = u - 8; if (PHON(7)) hgrn_scan_unit(C, layer, true, v >> 3, (v >> 1) & 3, v & 1); }
                    else if (u < 536) { if (PHON(8)) attn_unit(C, layer, u - 24); }
                    else if (u < 664) { const int v = u - 536; if (PHON(6)) delta_scan_unit(C, layer, false, v >> 2, v & 3); }
                    else if (u < 1176) { if (PHON(8)) attn_unit(C, layer, 512 + (u - 664)); }
                    else { const int v = u - 1176; if (PHON(7)) hgrn_scan_unit(C, layer, false, v >> 3, (v >> 1) & 3, v & 1); }
                    if (PROBE_A >= 0) { __syncthreads(); if (C.tid == 0) { const int ty = (u < 8) ? 0 : (u < 24 ? 1 : (u < 536 ? 2 : (u < 664 ? 3 : (u < 1176 ? 4 : 5))));
                        volatile float* tsb = (volatile float*)(ws_ + WS_TAB + 196608) + blockIdx.x * 8; tsb[ty] += (float)(__builtin_amdgcn_s_memrealtime() - pt0_); } }
                }
            } else if (sub == 3) {
                if (PHON(9)) for (int u = blockIdx.x; u < 256; u += C.G) hgrn_final_unit(C, layer, u);
                __syncthreads();
                if (PHON(10)) delta_combine(C, layer);
                __syncthreads();
            } else if (sub == 4) {
                pg8::Gemm g{ob, (const bf16_t*)(wb + W_OUT), MROWS, DM, DM}; pg8::StaticOrder S; S.init(MROWS, DM, C.G, (int)blockIdx.x);
                EpiRes E{out_, modl + 2048};
                if (PHON(11)) pg8::gemm_phase(C.lds, g, S, E, C.tid);
            } else if (sub == 5) {
                if (PHON(12)) row_pass(C, 1, p.in[20] + (size_t)(layer * 2) * DM, p.in[21] + (size_t)(layer * 2) * DM, modl, 4096, 3072, true);
            } else if (sub == 6) {
                pg8::Gemm g{xm, (const bf16_t*)(wb + W_FFI), MROWS, 2 * DFF, DM}; pg8::StaticOrder S; S.init(MROWS, 2 * DFF, C.G, (int)blockIdx.x);
                EpiFfn E{act};
                if (PHON(13)) pg8::gemm_phase(C.lds, g, S, E, C.tid);
            } else if (sub == 7) {
                pg8::Gemm g{act, (const bf16_t*)(wb + W_FFO), MROWS, DM, DFF}; pg8::StaticOrder S; S.init(MROWS, DM, C.G, (int)blockIdx.x);
                EpiRes E{out_, modl + 5120};
                if (PHON(14)) pg8::gemm_phase(C.lds, g, S, E, C.tid);
            } else {
                const bool last = layer + 1 == DEPTH;
                if (PHON(12)) row_pass(C, 1, p.in[20] + (size_t)(layer * 2 + 1) * DM, p.in[21] + (size_t)(layer * 2 + 1) * DM, modbuf + (size_t)(last ? layer : layer + 1) * 3 * 6144, 1024, 0, !last);
            }
        }
        if (ph + 1 < p.ph_hi) { if (p.ph_hi > 100000) { __threadfence(); cg::this_grid().sync(); } else xcd_barrier(xbar); }
    }
}

#if !MK_ONE_LAUNCH
static unsigned phase_mask(int ph) {
    if (ph == 0) return 1u << 0; if (ph == 1) return 1u << 1;
    const int sub = (ph - 2) % 9;
    switch (sub) { case 0: return 1u << 2; case 1: return (1u << 3) | (1u << 4) | (1u << 5); case 2: return (1u << 6) | (1u << 7) | (1u << 8); case 3: return (1u << 9) | (1u << 10);
        case 4: return 1u << 11; case 5: return 1u << 12; case 6: return 1u << 13; case 7: return 1u << 14; default: return 1u << 12; }
}
typedef void (*kern_t)(Params);
static kern_t kernel_for_mask(unsigned m) {
    switch (m) {
        case 1u << 0: return fwd_megakernel<1u << 0>; case 1u << 1: return fwd_megakernel<1u << 1>; case 1u << 2: return fwd_megakernel<1u << 2>;
        case (1u << 3) | (1u << 4) | (1u << 5): return fwd_megakernel<(1u << 3) | (1u << 4) | (1u << 5)>;
        case (1u << 6) | (1u << 7) | (1u << 8): return fwd_megakernel<(1u << 6) | (1u << 7) | (1u << 8)>;
        case (1u << 9) | (1u << 10): return fwd_megakernel<(1u << 9) | (1u << 10)>;
        case 1u << 11: return fwd_megakernel<1u << 11>; case 1u << 12: return fwd_megakernel<1u << 12>; case 1u << 13: return fwd_megakernel<1u << 13>; default: return fwd_megakernel<1u << 14>;
    }
}
#endif
extern "C" void kernel_launch(void* const* d_in, const int* in_sizes, int n_in, void* d_out, int out_size, void* d_ws, size_t ws_size, hipStream_t stream) {
    static int grid = 0;
    if (grid == 0) {
        if (n_in != 24 || out_size != 58720256 || ws_size < WS_END) { fprintf(stderr, "kernel_launch: unexpected shapes (n_in %d out %d ws %zu)\n", n_in, out_size, ws_size); grid = -1; return; }
        int dev = 0, cus = 0;
        (void)hipGetDevice(&dev); (void)hipDeviceGetAttribute(&cus, hipDeviceAttributeMultiprocessorCount, dev);
#if MK_ONE_LAUNCH
        if (hipFuncSetAttribute((const void*)fwd_megakernel<0x7FFFu>, hipFuncAttributeMaxDynamicSharedMemorySize, LDS_BYTES) != hipSuccess) { fprintf(stderr, "kernel_launch: hipFuncSetAttribute failed\n"); grid = -1; return; }
#else
        for (int ph = 0; ph < 11; ++ph) (void)hipFuncSetAttribute((const void*)kernel_for_mask(phase_mask(ph)), hipFuncAttributeMaxDynamicSharedMemorySize, LDS_BYTES);
#endif
        (void)hipGetLastError();
        grid = cus > 0 ? cus : 256;
        if (grid != 256) { fprintf(stderr, "kernel_launch: expected 256 CUs, got %d\n", grid); grid = 256; }
    }
    if (grid < 0) return;
    (void)hipMemsetAsync((char*)d_ws + WS_CTL, 0, 65536, stream);
    Params p{};
    for (int i = 0; i < 24; ++i) p.in[i] = (const float*)d_in[i];
    p.out = (float*)d_out; p.ws = (unsigned char*)d_ws;
#if MK_ONE_LAUNCH
    p.ph_lo = 0; p.ph_hi = NPHASE;
    void* args[] = {&p};
    hipError_t e = hipLaunchCooperativeKernel((const void*)fwd_megakernel<0x7FFFu>, dim3(grid), dim3(512), args, LDS_BYTES, stream);
    if (e != hipSuccess) fprintf(stderr, "cooperative launch failed: %s (grid %d)\n", hipGetErrorString(e), grid);
#else
    for (int ph = 0; ph < NPHASE; ++ph) { p.ph_lo = ph; p.ph_hi = ph + 1; hipLaunchKernelGGL(kernel_for_mask(phase_mask(ph)), dim3(grid), dim3(512), LDS_BYTES, stream, p); }
#endif
}
```

```cpp
#include <hip/hip_runtime.h>
#include <hip/hip_cooperative_groups.h>
#include <cstdio>
#include <cstdint>
namespace cg = cooperative_groups;

#define PHON(k) ((PHM_ >> (k)) & 1)
#ifndef PROBE_A
#define PROBE_A -1
#endif
#ifndef PROBE_B
#define PROBE_B -1
#endif
#ifndef MK_ONE_LAUNCH
#define MK_ONE_LAUNCH 1
#endif

#define DI __device__ __forceinline__
#define LAS __attribute__((address_space(3)))
typedef unsigned short bf16_t;
typedef short bf16x8 __attribute__((ext_vector_type(8)));
typedef short s16x4 __attribute__((ext_vector_type(4)));
typedef float f32x4 __attribute__((ext_vector_type(4)));
typedef float f32x16 __attribute__((ext_vector_type(16)));
typedef float f32x2 __attribute__((ext_vector_type(2)));
typedef unsigned u32x4 __attribute__((ext_vector_type(4)));
typedef unsigned u32x2 __attribute__((ext_vector_type(2)));

constexpr int MROWS = 16384, DM = 1024, DEPTH = 4, DFF = 2816, DIN = 3856, ZLD = 2320;
constexpr float ALPHA = 1.681792830507429f, LN_EPS = 1e-5f, RMS_EPS = 1e-6f;
constexpr float QSCALE = 0.125f * 1.4426950408889634f;
constexpr int ZB_BQ = 0, ZB_BK = 256, ZB_BV = 512, ZB_BG = 768, ZB_BBETA = 1024, ZB_BA = 1032, ZB_CQ = 1040, ZB_CF = 1296, ZB_CI = 1808, ZB_CG = 2064;
constexpr size_t OUT_K = 16777216, OUT_V = 33554432, OUT_SD = 50331648, OUT_SH = 54525952;
constexpr size_t MiB = 1u << 20;
constexpr size_t WS_CTL = 0, WS_MOD = 64 * 1024, WS_TAB = 512 * 1024, WS_CK = 1 * MiB, WS_CV = 3 * MiB, WS_W = 8 * MiB, WBUF = 27 * MiB;
constexpr size_t W_IN = 0, W_OUT = 8 * MiB, W_FFI = 10 * MiB, W_FFO = 21 * MiB;
constexpr size_t WS_XM = 62 * MiB, WS_O = 94 * MiB, WS_ZB = 126 * MiB, WS_Q = 199 * MiB, WS_K = 215 * MiB, WS_V = 231 * MiB;
constexpr size_t WS_ACT = 126 * MiB;
constexpr size_t WS_DPW = 247 * MiB, WS_DPQD = 263 * MiB, WS_DPQK = 279 * MiB, WS_DPKD = 295 * MiB;
constexpr size_t WS_DPU = WS_XM;
constexpr size_t WS_OD = 311 * MiB, WS_HS = 343 * MiB, WS_HD = 375 * MiB, WS_GL = 375 * MiB + 512 * 1024, WS_END = 376 * MiB;
constexpr int LDS_BYTES = 147456;
constexpr int NPHASE = 2 + 9 * DEPTH;

struct Params { const float* in[24]; float* out; unsigned char* ws; int ph_lo, ph_hi; };

DI unsigned cvt_pk_bf16(float lo, float hi) { unsigned r; asm("v_cvt_pk_bf16_f32 %0, %1, %2" : "=v"(r) : "v"(lo), "v"(hi)); return r; }
DI bf16_t f2bf(float f) { return (bf16_t)(cvt_pk_bf16(f, 0.f) & 0xffffu); }
DI float bf2f(bf16_t b) { return __uint_as_float(((unsigned)b) << 16); }
DI float sigmoidf_(float x) { return 1.0f / (1.0f + __expf(-x)); }
DI float siluf_(float x) { return x / (1.0f + __expf(-x)); }
DI float wave_sum(float v) {
#pragma unroll
    for (int o = 1; o < 64; o <<= 1) v += __shfl_xor(v, o);
    return v;
}
DI u32x2 pack4(f32x4 v) { u32x2 w; w.x = cvt_pk_bf16(v[0], v[1]); w.y = cvt_pk_bf16(v[2], v[3]); return w; }
DI bf16x8 pack8(f32x4 a, f32x4 b) { u32x4 w; w.x = cvt_pk_bf16(a[0], a[1]); w.y = cvt_pk_bf16(a[2], a[3]); w.z = cvt_pk_bf16(b[0], b[1]); w.w = cvt_pk_bf16(b[2], b[3]); return __builtin_bit_cast(bf16x8, w); }
DI int pinv(int k) { return (k >> 5) * 32 + ((k >> 2) & 3) * 8 + ((k >> 4) & 1) * 4 + (k & 3); }
DI int row_mod(int r) { return r < 8192 ? 0 : 1 + ((r - 8192) >> 12); }

namespace pg8 {
constexpr int BM = 256, BK = 64, HALF = 128, HTB = HALF * BK * 2, STAGE_BYTES = 8 * HTB, NXCD = 8, WGM = 8;
DI int lds_byte(int r, int c) { const int st = (r >> 4) * 2 + (c >> 5), rr = r & 15, cc = c & 31, ob = rr * 64 + cc * 2; return st * 1024 + (ob ^ (((ob >> 9) & 1) << 5)); }
DI void stage_rc(int b, int& R, int& C) { const int st = b / 1024, sb = b % 1024, swz = sb ^ (((sb >> 9) & 1) << 5); R = (st >> 1) * 16 + swz / 64; C = (st & 1) * 32 + (swz % 64) / 2; }
struct Unit { int pm, pn; };
struct Gemm { const bf16_t* A; const bf16_t* Bt; int M, N, K; };
struct StaticOrder {
    int nM, nN, nwg, G, c;
    DI void init(int M, int N, int G_, int c_) { nM = M / BM; nN = N / BM; nwg = nM * nN; G = G_; c = c_; }
    DI bool next(int i, Unit& u) const {
        const long L = (long)i * G + c; if (L >= nwg) return false;
        int wgid = (int)L; { const int q = nwg / NXCD, r = nwg % NXCD, xcd = wgid % NXCD, off = wgid / NXCD; wgid = (xcd < r ? xcd * (q + 1) : r * (q + 1) + (xcd - r) * q) + off; }
        const int nig = WGM * nN, gid = wgid / nig, fm = gid * WGM, gsz = (nM - fm) < WGM ? (nM - fm) : WGM;
        u.pm = fm + ((wgid % nig) % gsz); u.pn = (wgid % nig) / gsz; return true;
    }
};

template <class Epi>
DI void gemm_phase(LAS unsigned char* lds, const Gemm g, const StaticOrder& S, const Epi& E, int tid_in) {
    const int tid = tid_in, wid = __builtin_amdgcn_readfirstlane(tid >> 6), lane = tid & 63, wr = wid >> 2, wc = wid & 3, fr = lane & 15, fq = lane >> 4;
    const int K = g.K, nt = K / BK;
    unsigned voffA[2];
#pragma unroll
    for (int i = 0; i < 2; ++i) { int R, C; stage_rc(tid * 16 + i * 8192, R, C); voffA[i] = (unsigned)(R * K + C) * 2u; }
    const size_t kstep = (size_t)(BK * 2);
    const size_t hstep = (size_t)HALF * K * 2;
    const size_t tstep = 2 * hstep;
    const unsigned ldsw = (unsigned)wid * 1024u;
    const int aoff = lds_byte(wr * 64 + fr, fq * 8), boff = lds_byte(wc * 32 + fr, fq * 8);
#define PG8_SA(b, h) (((b) * 2 + (h)) * HTB)
#define PG8_SB(b, h) ((4 + (b) * 2 + (h)) * HTB)
#define PG8_STAGE(bufoff, gbase) do { _Pragma("unroll") for (int _i = 0; _i < 2; ++_i) \
        __builtin_amdgcn_global_load_lds((const unsigned*)((const char*)(gbase) + voffA[_i]), (LAS unsigned*)(lds + (bufoff) + ldsw + _i * 8192), 16, 0, 0); } while (0)
#define PG8_LDA(dst, b, h) do { _Pragma("unroll") for (int m = 0; m < 4; ++m) _Pragma("unroll") for (int k = 0; k < 2; ++k) dst[m][k] = *(const LAS bf16x8*)(lds + PG8_SA(b, h) + aoff + m * 2048 + k * 1024); } while (0)
#define PG8_LDB(dst, b, h) do { _Pragma("unroll") for (int n = 0; n < 2; ++n) _Pragma("unroll") for (int k = 0; k < 2; ++k) dst[n][k] = *(const LAS bf16x8*)(lds + PG8_SB(b, h) + boff + n * 2048 + k * 1024); } while (0)
#define PG8_MMA(ai, bj, At, Bt) do { __builtin_amdgcn_s_setprio(1); _Pragma("unroll") for (int m = 0; m < 4; ++m) _Pragma("unroll") for (int n = 0; n < 2; ++n) _Pragma("unroll") for (int k = 0; k < 2; ++k) \
        acc[ai][bj][m][n] = __builtin_amdgcn_mfma_f32_16x16x32_bf16(Bt[n][k], At[m][k], acc[ai][bj][m][n], 0, 0, 0); __builtin_amdgcn_s_setprio(0); } while (0)
#define PG8_WAIT_V(n) asm volatile("s_waitcnt vmcnt(" #n ")" ::: "memory")
#define PG8_WAIT_L(n) asm volatile("s_waitcnt lgkmcnt(" #n ")" ::: "memory")
#define PG8_BAR __builtin_amdgcn_s_barrier()
#define PG8_SCHED __builtin_amdgcn_sched_barrier(0)
    Unit cur, nxt; int ui = 0;
    if (!S.next(0, cur)) return;
    f32x4 acc[2][2][4][2];
#pragma unroll
    for (int a = 0; a < 2; ++a)
#pragma unroll
        for (int b = 0; b < 2; ++b)
#pragma unroll
            for (int m = 0; m < 4; ++m)
#pragma unroll
                for (int n = 0; n < 2; ++n) acc[a][b][m][n] = (f32x4){0.f, 0.f, 0.f, 0.f};
    bf16x8 At[4][2], B0[2][2], B1[2][2];
    const char* cA = (const char*)g.A + (size_t)cur.pm * tstep; const char* cB = (const char*)g.Bt + (size_t)cur.pn * tstep;
    PG8_STAGE(PG8_SB(0, 0), cB); PG8_STAGE(PG8_SB(0, 1), cB + hstep); PG8_STAGE(PG8_SA(0, 0), cA); PG8_STAGE(PG8_SA(0, 1), cA + hstep);
    if (wr == 1) PG8_BAR;
    PG8_WAIT_V(2); PG8_BAR;
    PG8_STAGE(PG8_SB(1, 0), cB + kstep); PG8_STAGE(PG8_SA(1, 0), cA + kstep); PG8_STAGE(PG8_SB(1, 1), cB + hstep + kstep);
    PG8_WAIT_V(6); PG8_BAR;
    for (;;) {
        const bool has_next = S.next(ui + 1, nxt);
        const char* nA = has_next ? (const char*)g.A + (size_t)nxt.pm * tstep : cA; const char* nB = has_next ? (const char*)g.Bt + (size_t)nxt.pn * tstep : cB;
        for (int t = 0; t < nt; t += 2) {
            const bool last = (t == nt - 2);
            const char* a1 = cA + (size_t)(t + 1) * kstep;
            const char* a2 = last ? nA : cA + (size_t)(t + 2) * kstep; const char* b2 = last ? nB : cB + (size_t)(t + 2) * kstep;
            const char* a3 = a2 + kstep; const char* b3 = b2 + kstep;
            PG8_LDB(B0, 0, 0); PG8_LDB(B1, 0, 1); PG8_SCHED; PG8_LDA(At, 0, 0); PG8_STAGE(PG8_SA(1, 1), a1 + hstep);
            PG8_WAIT_V(8); PG8_WAIT_L(0); PG8_BAR; PG8_MMA(0, 0, At, B0); PG8_MMA(0, 1, At, B1); PG8_BAR; PG8_SCHED;
            PG8_LDA(At, 0, 1); PG8_STAGE(PG8_SB(0, 0), b2); PG8_STAGE(PG8_SB(0, 1), b2 + hstep); PG8_STAGE(PG8_SA(0, 0), a2);
            PG8_WAIT_V(8); PG8_WAIT_L(0); PG8_BAR; PG8_MMA(1, 0, At, B0); PG8_MMA(1, 1, At, B1); PG8_BAR; PG8_SCHED;
            PG8_LDB(B0, 1, 0); PG8_LDB(B1, 1, 1); PG8_SCHED; PG8_LDA(At, 1, 0); PG8_STAGE(PG8_SA(0, 1), a2 + hstep);
            PG8_WAIT_V(8); PG8_WAIT_L(0); PG8_BAR; PG8_MMA(0, 0, At, B0); PG8_MMA(0, 1, At, B1); PG8_BAR; PG8_SCHED;
            PG8_LDA(At, 1, 1); PG8_STAGE(PG8_SB(1, 0), b3); PG8_STAGE(PG8_SB(1, 1), b3 + hstep); PG8_STAGE(PG8_SA(1, 0), a3);
            PG8_WAIT_V(8); PG8_WAIT_L(0); PG8_BAR; PG8_MMA(1, 0, At, B0); PG8_MMA(1, 1, At, B1); PG8_BAR; PG8_SCHED;
        }
        if (wr == 0) PG8_BAR;
        E(acc, cur, wr, wc, fr, fq);
        if (!has_next) break;
#pragma unroll
        for (int a = 0; a < 2; ++a)
#pragma unroll
            for (int b = 0; b < 2; ++b)
#pragma unroll
                for (int m = 0; m < 4; ++m)
#pragma unroll
                    for (int n = 0; n < 2; ++n) acc[a][b][m][n] = (f32x4){0.f, 0.f, 0.f, 0.f};
        cur = nxt; cA = nA; cB = nB; ++ui;
        if (wr == 1) PG8_BAR;
    }
    PG8_WAIT_V(0);
    PG8_BAR;
#undef PG8_SA
#undef PG8_SB
#undef PG8_STAGE
#undef PG8_LDA
#undef PG8_LDB
#undef PG8_MMA
#undef PG8_WAIT_V
#undef PG8_WAIT_L
#undef PG8_BAR
#undef PG8_SCHED
}
}

struct EpiIn {
    bf16_t *Qb, *Kb, *Vb, *zb; float *outK, *outV; const f32x2* rope; int layer;
    DI void operator()(const f32x4 (&acc)[2][2][4][2], const pg8::Unit& u, int wr, int wc, int fr, int fq) const {
        const int tile = u.pn; const bool sample = u.pm >= 32;
        if (tile < 6) {
            const int kind = tile >> 1; const int cb = (tile & 1) * 256 + wc * 32 + 4 * fq;
            bf16_t* dst = Qb + (size_t)kind * (16u * 1024u * 1024u / 2u);
            float* of = outK + (size_t)(kind >= 1 ? kind - 1 : 0) * 16777216u;
#pragma unroll
            for (int ai = 0; ai < 2; ++ai)
#pragma unroll
                for (int m = 0; m < 4; ++m) {
                    const int r = u.pm * 256 + ai * 128 + wr * 64 + m * 16 + fr;
#pragma unroll
                    for (int bj = 0; bj < 2; ++bj) {
                        f32x4 a = acc[ai][bj][m][0], b = acc[ai][bj][m][1]; const int cc = cb + bj * 128;
                        if (!sample && kind >= 1) { float* o = of + ((size_t)((r >> 8) * 4 + layer) * 256 + (r & 255)) * 512 + cc; *(f32x4*)o = a; *(f32x4*)(o + 16) = b; }
                        if (sample && kind < 2) {
                            const int t = (r - 8192) & 4095; const int pos = (wc & 1) ? (t & 63) : (t >> 6); const f32x2* rp = rope + pos * 16 + 4 * fq;
#pragma unroll
                            for (int j = 0; j < 4; ++j) { const f32x2 cs = rp[j]; const float x1 = a[j], x2 = b[j]; a[j] = x1 * cs.x - x2 * cs.y; b[j] = x2 * cs.x + x1 * cs.y; }
                        }
                        if (kind == 0) { a = a * QSCALE; b = b * QSCALE; }
                        if (kind == 2) {
                            const int hh = cc >> 7, dv0 = cc & 127, tt = sample ? ((r - 8192) & 4095) : (r & 255);
                            bf16_t* vt = sample ? Vb + 4194304 + ((size_t)((((r - 8192) >> 12) * 4 + hh) * 32 + (tt >> 7)) * 128 + dv0) * 128 + (tt & 127)
                                                : Vb + ((size_t)(((r >> 8) * 4 + hh) * 2 + (tt >> 7)) * 128 + dv0) * 128 + (tt & 127);
#pragma unroll
                            for (int j = 0; j < 4; ++j) { vt[(size_t)j * 128] = f2bf(a[j]); vt[(size_t)(16 + j) * 128] = f2bf(b[j]); }
                        } else { *(u32x2*)(dst + (size_t)r * 512 + cc) = pack4(a); *(u32x2*)(dst + (size_t)r * 512 + cc + 16) = pack4(b); }
                    }
                    asm volatile("" ::: "memory");
                }
        } else {
#pragma unroll
            for (int ai = 0; ai < 2; ++ai)
#pragma unroll
                for (int m = 0; m < 4; ++m) {
                    const int r = u.pm * 256 + ai * 128 + wr * 64 + m * 16 + fr;
#pragma unroll
                    for (int bj = 0; bj < 2; ++bj)
#pragma unroll
                        for (int n = 0; n < 2; ++n) { const int c = (tile - 6) * 256 + bj * 128 + wc * 32 + 16 * n + 4 * fq; if (c < ZLD) *(u32x2*)(zb + (size_t)r * ZLD + c) = pack4(acc[ai][bj][m][n]); }
                    asm volatile("" ::: "memory");
                }
        }
    }
};
struct EpiRes {
    float* x; const float* gate;
    DI void operator()(const f32x4 (&acc)[2][2][4][2], const pg8::Unit& u, int wr, int wc, int fr, int fq) const {
        const float* gv = gate + row_mod(u.pm * 256) * 6144;
#pragma unroll
        for (int ai = 0; ai < 2; ++ai)
#pragma unroll
            for (int m = 0; m < 4; ++m) {
                const int r = u.pm * 256 + ai * 128 + wr * 64 + m * 16 + fr;
#pragma unroll
                for (int bj = 0; bj < 2; ++bj)
#pragma unroll
                    for (int n = 0; n < 2; ++n) { const int c = u.pn * 256 + bj * 128 + wc * 32 + 16 * n + 4 * fq; const f32x4 g4 = *(const f32x4*)(gv + c); float* xp = x + (size_t)r * DM + c; const f32x4 xv = *(const f32x4*)xp; *(f32x4*)xp = xv * ALPHA + g4 * acc[ai][bj][m][n]; }
            }
    }
};
struct EpiFfn {
    bf16_t* act;
    DI void operator()(const f32x4 (&acc)[2][2][4][2], const pg8::Unit& u, int wr, int wc, int fr, int fq) const {
#pragma unroll
        for (int ai = 0; ai < 2; ++ai)
#pragma unroll
            for (int m = 0; m < 4; ++m) {
                const int r = u.pm * 256 + ai * 128 + wr * 64 + m * 16 + fr;
#pragma unroll
                for (int n = 0; n < 2; ++n) { const f32x4 gt = acc[ai][0][m][n], up = acc[ai][1][m][n]; f32x4 o;
#pragma unroll
                    for (int j = 0; j < 4; ++j) o[j] = siluf_(gt[j]) * up[j];
                    *(u32x2*)(act + (size_t)r * DFF + u.pn * 128 + wc * 32 + 16 * n + 4 * fq) = pack4(o); }
            }
    }
};

struct Ctx {
    const Params* p; LAS unsigned char* lds; float* L; int tid, lane, wave, G, gw, NGW;
    unsigned char* ws; float* out;
};

DI void tr_item(const float* W, int K, int N, bf16_t* WT, int mode, float* scr, int item, int lane) {
    const int nblk = (N + 31) / 32, kb = item / nblk, nb = item % nblk, k0 = 64 * kb, n0 = 32 * nb;
    const int nn = n0 + (lane & 31);
#pragma unroll 8
    for (int i = 0; i < 32; ++i) { const int kk = 2 * i + (lane >> 5); scr[kk * 33 + (lane & 31)] = (nn < N) ? W[(size_t)(k0 + kk) * N + nn] : 0.f; }
    __builtin_amdgcn_wave_barrier();
    const int c = lane & 7;
#pragma unroll
    for (int j = 0; j < 4; ++j) {
        const int nl = (lane >> 3) + 8 * j, n = n0 + nl; const float* s = scr + (8 * c) * 33 + nl;
        if (n < N) {
            int dst = n; if (mode == 1) { if (n < DFF) dst = (n >> 7) * 256 + (n & 127); else { const int jj = n - DFF; dst = (jj >> 7) * 256 + 128 + (jj & 127); } }
            u32x4 o; o.x = cvt_pk_bf16(s[0 * 33], s[1 * 33]); o.y = cvt_pk_bf16(s[2 * 33], s[3 * 33]); o.z = cvt_pk_bf16(s[4 * 33], s[5 * 33]); o.w = cvt_pk_bf16(s[6 * 33], s[7 * 33]);
            *(u32x4*)(WT + (size_t)dst * K + k0 + 8 * c) = o;
        }
    }
    __builtin_amdgcn_wave_barrier();
}
DI void convert_layer_weights(const Ctx& C, int layer, int gw0 = -1, int ngw = 0, int blk = -1, int nblk = 0) {
    const Params& p = *C.p;
    unsigned char* wb = C.ws + WS_W + (size_t)(layer & 1) * WBUF;
    bf16_t* Win = (bf16_t*)(wb + W_IN); bf16_t* Wout = (bf16_t*)(wb + W_OUT); bf16_t* Wffi = (bf16_t*)(wb + W_FFI); bf16_t* Wffo = (bf16_t*)(wb + W_FFO);
    float* scr = C.L + C.wave * (64 * 33);
    constexpr int I_IN = 16 * 121, I_OUT = 16 * 32, I_FFI = 16 * 176, I_FFO = 44 * 32, NIT = I_IN + I_OUT + I_FFI + I_FFO;
    int lane_ = C.lane; asm volatile("" : "+v"(lane_));
    const int gwA = gw0 >= 0 ? gw0 : C.gw, ngwA = gw0 >= 0 ? ngw : C.NGW, blkA = blk >= 0 ? blk : (int)blockIdx.x, nblkA = blk >= 0 ? nblk : C.G;
    for (int it = gwA; it < NIT; it += ngwA) {
        int r = it;
        if (r < I_IN) { tr_item(p.in[10] + (size_t)layer * DM * DIN, DM, DIN, Win, 0, scr, r, lane_); continue; } r -= I_IN;
        if (r < I_OUT) { tr_item(p.in[19] + (size_t)layer * DM * DM, DM, DM, Wout, 0, scr, r, lane_); continue; } r -= I_OUT;
        if (r < I_FFI) { tr_item(p.in[22] + (size_t)layer * DM * 2 * DFF, DM, 2 * DFF, Wffi, 1, scr, r, lane_); continue; } r -= I_FFI;
        tr_item(p.in[23] + (size_t)layer * DFF * DM, DFF, DM, Wffo, 0, scr, r, lane_);
    }
    u32x4* z = (u32x4*)(Win + (size_t)DIN * DM); const int nz = 240 * DM * 2 / 16;
    for (int i = blkA * 512 + C.tid; i < nz; i += nblkA * 512) z[i] = (u32x4){0u, 0u, 0u, 0u};
}

DI void mod_unit(const Ctx& C, int u) {
    const Params& p = *C.p; const int tid = C.tid;
    float* cs = C.L; float* red = C.L + 3072;
    const int layer = u >> 6, col0 = (u & 63) * 96;
    __syncthreads();
    for (int i = tid; i < 3072; i += 512) { const int v = i >> 10, k = i & 1023; const float c = (v == 0) ? p.in[7][k] : p.in[6][(v - 1) * 1024 + k]; cs[i] = siluf_(c); }
    __syncthreads();
    if (tid < 504) {
        const int cgp = tid % 24, rs = tid / 24;
        f32x4 a0 = {0, 0, 0, 0}, a1 = a0, a2 = a0;
        const float* Wp = p.in[8] + (size_t)layer * DM * 6144 + col0 + cgp * 4;
#pragma unroll 7
        for (int k = rs; k < 1024; k += 21) { const f32x4 w = *(const f32x4*)(Wp + (size_t)k * 6144); a0 += w * cs[k]; a1 += w * cs[1024 + k]; a2 += w * cs[2048 + k]; }
        float* rr = red + rs * 288 + cgp * 4;
#pragma unroll
        for (int j = 0; j < 4; ++j) { rr[j] = a0[j]; rr[96 + j] = a1[j]; rr[192 + j] = a2[j]; }
    }
    __syncthreads();
    if (tid < 288) {
        const int v = tid / 96, cc = tid % 96; float s = 0.f;
        for (int rs = 0; rs < 21; ++rs) s += red[rs * 288 + tid];
        ((float*)(C.ws + WS_MOD))[(size_t)(layer * 3 + v) * 6144 + col0 + cc] = s + p.in[9][layer * 6144 + col0 + cc];
    }
}

DI void phase0a(const Ctx& C) {
    const Params& p = *C.p;
    for (int u = blockIdx.x; u < 256; u += C.G) mod_unit(C, u);
    __syncthreads();
    convert_layer_weights(C, 0);
    const int gt = blockIdx.x * 512 + C.tid, NT = C.G * 512;
    float* tab = (float*)(C.ws + WS_TAB);
    if (gt < 1024) { const int pos = gt >> 4, i = gt & 15; const float inv = __builtin_amdgcn_exp2f(-(float)i * (13.287712379549449f / 16.0f)); float rev = (float)pos * inv * 0.15915494309189535f; rev -= floorf(rev);
        tab[2 * gt] = __builtin_amdgcn_cosf(rev); tab[2 * gt + 1] = __builtin_amdgcn_sinf(rev); }
    if (gt >= 1024 && gt < 1028) { const int l = gt - 1024; const float* dl = p.in[17] + l * 256; float s01 = 0.f, s23 = 0.f; for (int i = 0; i < 64; ++i) { s01 += dl[i] * dl[64 + i]; s23 += dl[128 + i] * dl[192 + i]; }
        tab[2048 + l] = __expf(s01) - __expf(s23) + (0.8f - 0.6f * __expf(-0.3f * (float)l)); }
    if (gt >= 2048 && gt < 2560) { const int dir = (gt - 2048) >> 8, c = gt & 255; const float* lb = p.in[15] + dir * 1024 + c; float v[4], mx = -1e30f; for (int l = 0; l < 4; ++l) { v[l] = lb[l * 256]; mx = fmaxf(mx, v[l]); }
        float s = 0.f; for (int l = 0; l < 4; ++l) { v[l] = __expf(v[l] - mx); s += v[l]; } float cum = 0.f; for (int l = 0; l < 4; ++l) { if (l > 0) cum += v[l] / s; tab[4096 + (dir * 4 + l) * 256 + c] = cum; } }
    bf16_t* ck = (bf16_t*)(C.ws + WS_CK); bf16_t* cv = (bf16_t*)(C.ws + WS_CV);
    for (int i = gt; i < 2 * 4 * 256 * 512 / 4; i += NT) { const int e = i * 4; const int c = e & 511, j = (e >> 9) & 255, l = (e >> 17) & 3, b = e >> 19;
        const size_t dst = ((size_t)((l * 2 + b) * 256 + j)) * 512 + c;
        *(u32x2*)(ck + dst) = pack4(*(const f32x4*)(p.in[2] + e)); }
    for (int i = gt; i < 2 * 4 * 256 * 512; i += NT) { const int j = i & 255, dv = (i >> 8) & 127, hh = (i >> 15) & 3, b = (i >> 17) & 1, l = i >> 18;
        cv[((size_t)((((l * 2 + b) * 4 + hh) * 2 + (j >> 7)) * 128 + dv)) * 128 + (j & 127)] = f2bf(p.in[3][((size_t)((b * 4 + l) * 256 + j) * 4 + hh) * 128 + dv]); }
}

DI void row_pass(const Ctx& C, int mode, const float* lng, const float* lnb, const float* modl, int sc_off, int sh_off, bool write_xm) {
    const Params& p = *C.p; float* x = C.out; bf16_t* xm = (bf16_t*)(C.ws + WS_XM);
    for (int r0 = C.gw; r0 < MROWS; r0 += 2 * C.NGW) {
        f32x4 v[2][4];
#pragma unroll
        for (int u = 0; u < 2; ++u) { const int r = r0 + u * C.NGW;
            const float* src = mode == 0 ? (r < 8192 ? p.in[0] + (size_t)r * DM : p.in[1] + (size_t)(r - 8192) * DM) : x + (size_t)r * DM;
#pragma unroll
            for (int j = 0; j < 4; ++j) v[u][j] = *(const f32x4*)(src + 4 * C.lane + 256 * j); }
#pragma unroll
        for (int u = 0; u < 2; ++u) { const int r = r0 + u * C.NGW;
            if (mode == 1) {
                float s = 0.f;
#pragma unroll
                for (int j = 0; j < 4; ++j) s += (v[u][j][0] + v[u][j][1]) + (v[u][j][2] + v[u][j][3]);
                const float mean = wave_sum(s) * (1.f / DM); float s2 = 0.f;
#pragma unroll
                for (int j = 0; j < 4; ++j) { v[u][j] = v[u][j] - mean; s2 += (v[u][j][0] * v[u][j][0] + v[u][j][1] * v[u][j][1]) + (v[u][j][2] * v[u][j][2] + v[u][j][3] * v[u][j][3]); }
                const float rstd = 1.0f / sqrtf(wave_sum(s2) * (1.f / DM) + LN_EPS);
#pragma unroll
                for (int j = 0; j < 4; ++j) { const f32x4 g4 = *(const f32x4*)(lng + 4 * C.lane + 256 * j), b4 = *(const f32x4*)(lnb + 4 * C.lane + 256 * j); v[u][j] = v[u][j] * rstd * g4 + b4; }
            }
            if (PROBE_A >= 0 && !write_xm) { const float* tsf = (const float*)(C.ws + WS_TAB + 131072); const float sc = 1.0f + ((r >= 8192) ? tsf[12] : (PROBE_B >= 0 ? tsf[13] : 0.f));
#pragma unroll
                for (int j = 0; j < 4; ++j) v[u][j] = v[u][j] * sc; }
#pragma unroll
            for (int j = 0; j < 4; ++j) *(f32x4*)(x + (size_t)r * DM + 4 * C.lane + 256 * j) = v[u][j];
            if (write_xm) {
                const float* mv = modl + row_mod(r) * 6144;
#pragma unroll
                for (int j = 0; j < 4; ++j) { const int c = 4 * C.lane + 256 * j; const f32x4 sc = *(const f32x4*)(mv + sc_off + c), sh = *(const f32x4*)(mv + sh_off + c);
                    *(u32x2*)(xm + (size_t)r * DM + c) = pack4(v[u][j] * (sc + 1.0f) + sh); }
            }
        }
    }
}

#define MFMA32(a, b, c) __builtin_amdgcn_mfma_f32_32x32x16_bf16((a), (b), (c), 0, 0, 0)
#define MFMA16(a, b, c) __builtin_amdgcn_mfma_f32_16x16x32_bf16((a), (b), (c), 0, 0, 0)
constexpr int AK_LD = 72, AV_LD = 136;
struct AttnSrc { const bf16_t* Klat; const bf16_t* Kctx; const bf16_t* VTlat; const bf16_t* VTctx; int ldv; int nst; int nlat; int h; };
template <int PASS>
DI void attn_pass(int tid, int q, int hi, int kq, const AttnSrc& A, LAS bf16_t* K1s, LAS bf16_t* K2s, LAS bf16_t* VTs, const bf16x8 (&q1)[4], const bf16x8 (&q2)[4],
                  float& m1, float& l1, float& m2, float& l2, float iL1, float iL2, f32x16 (&o)[4]) {
    u32x4 kreg[4], vreg[4];
    const int h = A.h;
    auto issue = [&](int st) {
        const bf16_t* kb = (st < A.nlat) ? A.Klat + (size_t)st * 128 * 512 : A.Kctx + (size_t)(st - A.nlat) * 128 * 512;
#pragma unroll
        for (int i = 0; i < 2; ++i) { const int id = tid + 512 * i, key = id >> 3, ch = id & 7; kreg[i] = *(const u32x4*)(kb + (size_t)key * 512 + h * 128 + ch * 8); kreg[2 + i] = *(const u32x4*)(kb + (size_t)key * 512 + h * 128 + 64 + ch * 8); }
        if (PASS == 1) {
            const bf16_t* vb = (st < A.nlat) ? A.VTlat + (size_t)st * 128 : A.VTctx + (size_t)(st - A.nlat) * 128; const int ld = (st < A.nlat) ? A.ldv : 256;
#pragma unroll
            for (int i = 0; i < 4; ++i) { const int id = tid + 512 * i, dv = id >> 4, ch = id & 15; vreg[i] = *(const u32x4*)(vb + (size_t)dv * ld + ch * 8); }
        }
    };
    issue(0);
    for (int st = 0; st < A.nst; ++st) {
        __syncthreads();
#pragma unroll
        for (int i = 0; i < 2; ++i) { const int id = tid + 512 * i, key = id >> 3, ch = id & 7; *(LAS u32x4*)(K1s + key * AK_LD + ch * 8) = kreg[i]; *(LAS u32x4*)(K2s + key * AK_LD + ch * 8) = kreg[2 + i]; }
        if (PASS == 1) {
#pragma unroll
            for (int i = 0; i < 4; ++i) { const int id = tid + 512 * i, dv = id >> 4, ch = id & 15; *(LAS u32x4*)(VTs + dv * AV_LD + ch * 8) = vreg[i]; }
        }
        __syncthreads();
        if (st + 1 < A.nst) issue(st + 1);
        const int keyrow = kq * 32 + q;
        f32x16 s1, pr;
#pragma unroll
        for (int r = 0; r < 16; ++r) s1[r] = 0.f;
#pragma unroll
        for (int ks = 0; ks < 4; ++ks) { const bf16x8 a1 = *(const LAS bf16x8*)(K1s + keyrow * AK_LD + 16 * ks + 8 * hi); s1 = MFMA32(a1, q1[ks], s1); }
        if (PASS == 0) {
            float mx1 = s1[0];
#pragma unroll
            for (int r = 1; r < 16; ++r) mx1 = fmaxf(mx1, s1[r]);
            const float n1 = fmaxf(m1, mx1); float a1s = 0.f;
#pragma unroll
            for (int r = 0; r < 16; ++r) a1s += __builtin_amdgcn_exp2f(s1[r] - n1);
            l1 = l1 * __builtin_amdgcn_exp2f(m1 - n1) + a1s; m1 = n1;
        } else {
#pragma unroll
            for (int r = 0; r < 16; ++r) pr[r] = __builtin_amdgcn_exp2f(s1[r] - m1) * iL1;
        }
#pragma unroll
        for (int r = 0; r < 16; ++r) s1[r] = 0.f;
#pragma unroll
        for (int ks = 0; ks < 4; ++ks) { const bf16x8 a2 = *(const LAS bf16x8*)(K2s + keyrow * AK_LD + 16 * ks + 8 * hi); s1 = MFMA32(a2, q2[ks], s1); }
        if (PASS == 0) {
            float mx2 = s1[0];
#pragma unroll
            for (int r = 1; r < 16; ++r) mx2 = fmaxf(mx2, s1[r]);
            const float n2 = fmaxf(m2, mx2); float a2s = 0.f;
#pragma unroll
            for (int r = 0; r < 16; ++r) a2s += __builtin_amdgcn_exp2f(s1[r] - n2);
            l2 = l2 * __builtin_amdgcn_exp2f(m2 - n2) + a2s; m2 = n2;
        } else {
#pragma unroll
            for (int r = 0; r < 16; ++r) pr[r] -= __builtin_amdgcn_exp2f(s1[r] - m2) * iL2;
            bf16x8 pb[2];
            { u32x4 t0, t1; t0.x = cvt_pk_bf16(pr[0], pr[1]); t0.y = cvt_pk_bf16(pr[2], pr[3]); t0.z = cvt_pk_bf16(pr[4], pr[5]); t0.w = cvt_pk_bf16(pr[6], pr[7]);
              t1.x = cvt_pk_bf16(pr[8], pr[9]); t1.y = cvt_pk_bf16(pr[10], pr[11]); t1.z = cvt_pk_bf16(pr[12], pr[13]); t1.w = cvt_pk_bf16(pr[14], pr[15]);
              pb[0] = __builtin_bit_cast(bf16x8, t0); pb[1] = __builtin_bit_cast(bf16x8, t1); }
#pragma unroll
            for (int blk = 0; blk < 4; ++blk)
#pragma unroll
                for (int s = 0; s < 2; ++s) {
                    const LAS bf16_t* vp = VTs + (blk * 32 + q) * AV_LD + kq * 32 + 16 * s + 4 * hi;
                    const s16x4 lo = *(const LAS s16x4*)vp, hh = *(const LAS s16x4*)(vp + 8);
                    const bf16x8 av = __builtin_shufflevector(lo, hh, 0, 1, 2, 3, 4, 5, 6, 7);
                    o[blk] = MFMA32(av, pb[s], o[blk]);
                }
        }
    }
}
DI void attn_unit(const Ctx& C, int layer, int uidx) {
    int tid = C.tid; asm volatile("" : "+v"(tid)); const int lane = tid & 63, w = __builtin_amdgcn_readfirstlane(tid >> 6), qg = w & 3, kh = w >> 2, q = lane & 15, g = lane >> 4;
    const bf16_t* Qb = (const bf16_t*)(C.ws + WS_Q); const bf16_t* Kb = (const bf16_t*)(C.ws + WS_K); const bf16_t* VT = (const bf16_t*)(C.ws + WS_V);
    const bf16_t* cK = (const bf16_t*)(C.ws + WS_CK); const bf16_t* cVT = (const bf16_t*)(C.ws + WS_CV);
    int b, h, rowq0; AttnSrc A;
    if (uidx < 512) { b = uidx >> 8; h = (uidx >> 6) & 3; const int qb = uidx & 63; rowq0 = 8192 + b * 4096 + qb * 64; A.nst = 34; A.nlat = 32; A.ldv = 4096;
        A.Klat = Kb + (size_t)(8192 + b * 4096) * 512; A.VTlat = VT + 4194304 + (size_t)((b * 4 + h) * 32) * 16384; A.Kctx = cK + (size_t)((layer * 2 + b) * 256) * 512; A.VTctx = cVT + (size_t)(((layer * 2 + b) * 4 + h) * 2) * 16384; }
    else { const int v = uidx - 512; b = v >> 4; h = (v >> 2) & 3; const int qb = v & 3; rowq0 = b * 256 + qb * 64; A.nst = 2; A.nlat = 2; A.ldv = 256;
        A.Klat = Kb + (size_t)(b * 256) * 512; A.VTlat = VT + (size_t)((b * 4 + h) * 2) * 16384; A.Kctx = A.Klat; A.VTctx = A.VTlat; }
    A.h = h;
    LAS bf16_t* K1s = (LAS bf16_t*)C.lds; LAS bf16_t* K2s = K1s + 128 * AK_LD; LAS bf16_t* VTs = K2s + 128 * AK_LD;
    const float lam = ((const float*)(C.ws + WS_TAB))[2048 + layer];
    bf16x8 qf1[2], qf2[2];
    { const bf16_t* qp = Qb + (size_t)(rowq0 + 16 * qg + q) * 512 + h * 128 + 8 * g;
#pragma unroll
      for (int ks = 0; ks < 2; ++ks) { qf1[ks] = *(const bf16x8*)(qp + 32 * ks); qf2[ks] = *(const bf16x8*)(qp + 64 + 32 * ks); } }
    float m1 = -1e30f, l1 = 0.f, m2 = -1e30f, l2 = 0.f;
    f32x4 O1[8], O2[8];
#pragma unroll
    for (int t = 0; t < 8; ++t) { O1[t] = (f32x4){0.f, 0.f, 0.f, 0.f}; O2[t] = O1[t]; }
    u32x4 kreg[4], vreg[4];
    auto issue = [&](int st) {
        const bf16_t* kb = (st < A.nlat) ? A.Klat + (size_t)st * 128 * 512 : A.Kctx + (size_t)(st - A.nlat) * 128 * 512;
#pragma unroll
        for (int i = 0; i < 2; ++i) { const int id = tid + 512 * i, key = id >> 3, ch = id & 7; kreg[i] = *(const u32x4*)(kb + (size_t)key * 512 + h * 128 + ch * 8); kreg[2 + i] = *(const u32x4*)(kb + (size_t)key * 512 + h * 128 + 64 + ch * 8); }
        const bf16_t* vb = (st < A.nlat) ? A.VTlat + (size_t)st * 16384 : A.VTctx + (size_t)(st - A.nlat) * 16384;
#pragma unroll
        for (int i = 0; i < 4; ++i) { const int id = tid + 512 * i; vreg[i] = *(const u32x4*)(vb + (size_t)id * 8); }
    };
    issue(0);
    for (int st = 0; st < A.nst; ++st) {
        __syncthreads();
#pragma unroll
        for (int i = 0; i < 2; ++i) { const int id = tid + 512 * i, key = id >> 3, ch = id & 7; *(LAS u32x4*)(K1s + key * AK_LD + ch * 8) = kreg[i]; *(LAS u32x4*)(K2s + key * AK_LD + ch * 8) = kreg[2 + i]; }
#pragma unroll
        for (int i = 0; i < 4; ++i) { const int id = tid + 512 * i, dv = id >> 4, ch = id & 15; *(LAS u32x4*)(VTs + dv * AV_LD + ch * 8) = vreg[i]; }
        __syncthreads();
        if (st + 1 < A.nst) issue(st + 1);
#pragma unroll
        for (int kb = 0; kb < 2; ++kb) {
            const int key0 = kh * 64 + kb * 32;
            f32x4 sA0 = {0.f, 0.f, 0.f, 0.f}, sA1 = sA0, sB0 = sA0, sB1 = sA0;
#pragma unroll
            for (int ks = 0; ks < 2; ++ks) {
                const bf16x8 a10 = *(const LAS bf16x8*)(K1s + (key0 + q) * AK_LD + 32 * ks + 8 * g), a11 = *(const LAS bf16x8*)(K1s + (key0 + 16 + q) * AK_LD + 32 * ks + 8 * g);
                const bf16x8 a20 = *(const LAS bf16x8*)(K2s + (key0 + q) * AK_LD + 32 * ks + 8 * g), a21 = *(const LAS bf16x8*)(K2s + (key0 + 16 + q) * AK_LD + 32 * ks + 8 * g);
                sA0 = MFMA16(a10, qf1[ks], sA0); sA1 = MFMA16(a11, qf1[ks], sA1); sB0 = MFMA16(a20, qf2[ks], sB0); sB1 = MFMA16(a21, qf2[ks], sB1);
            }
            float t1 = fmaxf(fmaxf(fmaxf(sA0[0], sA0[1]), fmaxf(sA0[2], sA0[3])), fmaxf(fmaxf(sA1[0], sA1[1]), fmaxf(sA1[2], sA1[3])));
            float t2 = fmaxf(fmaxf(fmaxf(sB0[0], sB0[1]), fmaxf(sB0[2], sB0[3])), fmaxf(fmaxf(sB1[0], sB1[1]), fmaxf(sB1[2], sB1[3])));
            if (__any(t1 > m1 || t2 > m2)) {
                t1 = fmaxf(t1, __shfl_xor(t1, 16)); t1 = fmaxf(t1, __shfl_xor(t1, 32)); t2 = fmaxf(t2, __shfl_xor(t2, 16)); t2 = fmaxf(t2, __shfl_xor(t2, 32));
                const float n1 = fmaxf(m1, t1), n2 = fmaxf(m2, t2); const float f1 = __builtin_amdgcn_exp2f(m1 - n1), f2 = __builtin_amdgcn_exp2f(m2 - n2);
                l1 *= f1; l2 *= f2; m1 = n1; m2 = n2;
#pragma unroll
                for (int t = 0; t < 8; ++t) { O1[t] = O1[t] * f1; O2[t] = O2[t] * f2; }
            }
            f32x4 pA0, pA1, pB0, pB1;
#pragma unroll
            for (int i = 0; i < 4; ++i) { pA0[i] = __builtin_amdgcn_exp2f(sA0[i] - m1); pA1[i] = __builtin_amdgcn_exp2f(sA1[i] - m1); pB0[i] = __builtin_amdgcn_exp2f(sB0[i] - m2); pB1[i] = __builtin_amdgcn_exp2f(sB1[i] - m2); }
            l1 += (pA0[0] + pA0[1]) + (pA0[2] + pA0[3]) + (pA1[0] + pA1[1]) + (pA1[2] + pA1[3]);
            l2 += (pB0[0] + pB0[1]) + (pB0[2] + pB0[3]) + (pB1[0] + pB1[1]) + (pB1[2] + pB1[3]);
            const bf16x8 pb1 = pack8(pA0, pA1), pb2 = pack8(pB0, pB1);
#pragma unroll
            for (int t = 0; t < 8; ++t) {
                const LAS bf16_t* vp = VTs + (16 * t + q) * AV_LD + key0 + 4 * g;
                const s16x4 lo = *(const LAS s16x4*)vp, hh = *(const LAS s16x4*)(vp + 16);
                const bf16x8 av = __builtin_shufflevector(lo, hh, 0, 1, 2, 3, 4, 5, 6, 7);
                O1[t] = MFMA16(av, pb1, O1[t]); O2[t] = MFMA16(av, pb2, O2[t]);
            }
        }
    }
    l1 += __shfl_xor(l1, 16); l1 += __shfl_xor(l1, 32); l2 += __shfl_xor(l2, 16); l2 += __shfl_xor(l2, 32);
    __syncthreads();
    LAS float* comb = (LAS float*)C.lds;
    LAS float* exs = (LAS float*)(C.lds + 65536);
    if (kh == 1) {
#pragma unroll
        for (int t = 0; t < 8; ++t)
#pragma unroll
            for (int i = 0; i < 4; ++i) { comb[(qg * 64 + t * 4 + i) * 64 + lane] = O1[t][i]; comb[(qg * 64 + 32 + t * 4 + i) * 64 + lane] = O2[t][i]; }
        exs[(qg * 4 + 0) * 64 + lane] = m1; exs[(qg * 4 + 1) * 64 + lane] = l1; exs[(qg * 4 + 2) * 64 + lane] = m2; exs[(qg * 4 + 3) * 64 + lane] = l2;
    }
    __syncthreads();
    if (kh == 0) {
        const float om1 = exs[(qg * 4 + 0) * 64 + lane], ol1 = exs[(qg * 4 + 1) * 64 + lane], om2 = exs[(qg * 4 + 2) * 64 + lane], ol2 = exs[(qg * 4 + 3) * 64 + lane];
        const float n1 = fmaxf(m1, om1), n2 = fmaxf(m2, om2);
        const float fa1 = __builtin_amdgcn_exp2f(m1 - n1), fb1 = __builtin_amdgcn_exp2f(om1 - n1), fa2 = __builtin_amdgcn_exp2f(m2 - n2), fb2 = __builtin_amdgcn_exp2f(om2 - n2);
        const float L1 = l1 * fa1 + ol1 * fb1, L2 = l2 * fa2 + ol2 * fb2;
        const float c1a = fa1 / L1, c1b = fb1 / L1, c2a = lam * fa2 / L2, c2b = lam * fb2 / L2;
        float ss = 0.f;
#pragma unroll
        for (int t = 0; t < 8; ++t)
#pragma unroll
            for (int i = 0; i < 4; ++i) { const float v = O1[t][i] * c1a + comb[(qg * 64 + t * 4 + i) * 64 + lane] * c1b - O2[t][i] * c2a - comb[(qg * 64 + 32 + t * 4 + i) * 64 + lane] * c2b; O1[t][i] = v; ss += v * v; }
        ss += __shfl_xor(ss, 16); ss += __shfl_xor(ss, 32);
        const float lam_init = 0.8f - 0.6f * __expf(-0.3f * (float)layer);
        const float sc = (1.0f / sqrtf(ss * (1.0f / 128.0f) + RMS_EPS)) * (1.0f - lam_init);
        const float* dn = C.p->in[18] + layer * 128;
        bf16_t* ob = (bf16_t*)(C.ws + WS_O) + (size_t)(rowq0 + 16 * qg + q) * DM + h * 128;
#pragma unroll
        for (int t = 0; t < 8; ++t) { const int dv = 16 * t + 4 * g; const f32x4 d4 = *(const f32x4*)(dn + dv); *(u32x2*)(ob + dv) = pack4(O1[t] * sc * d4); }
    }
    __syncthreads();
}

DI void delta_prep_unit(const Ctx& C, int layer, int unit) {
    const Params& p = *C.p; int tid = C.tid; asm volatile("" : "+v"(tid)); const int lane = tid & 63, w = __builtin_amdgcn_readfirstlane(tid >> 6);
    const int tc = unit >> 2, h = unit & 3, row0 = tc * 64;
    int ci, nch; if (tc < 128) { ci = tc & 3; nch = 4; } else { ci = (tc - 128) & 63; nch = 64; }
    const bool has_prev = ci > 0, has_next = ci < nch - 1;
    float* qs = C.L; float* kk = C.L + 4160; float* vv = C.L + 8320; float* KK0 = C.L + 12480; float* QK0 = KK0 + 4096; float* Ms = QK0 + 4096; float* bc = Ms + 8192; float* be = bc + 128;
    const bf16_t* zb = (const bf16_t*)(C.ws + WS_ZB);
    const float* cw = p.in[11] + layer * 3 * 768;
    __syncthreads();
    if (tid < 384) {
        const int c = tid % 192, th = tid / 192, which = c >> 6, d = c & 63, col = which * 256 + h * 64 + d;
        const float w0 = cw[col], w1 = cw[768 + col], w2 = cw[1536 + col];
        float xin[34];
#pragma unroll
        for (int i = 0; i < 34; ++i) { const int tt = 32 * th - 1 + i; const bool ok = (tt >= 0 || has_prev) && (tt < 64 || has_next); xin[i] = ok ? bf2f(zb[(size_t)(row0 + tt) * ZLD + col]) : 0.f; }
        float* dstp = (which == 0 ? qs : (which == 1 ? kk : vv)) + d;
#pragma unroll
        for (int i = 0; i < 32; ++i) dstp[(32 * th + i) * 65] = siluf_(w0 * xin[i] + w1 * xin[i + 1] + w2 * xin[i + 2]);
    }
    __syncthreads();
    { const int r = tid >> 2, part = tid & 3; float* base = (r < 64 ? qs + r * 65 : kk + (r - 64) * 65) + part * 16; float ss = 0.f;
#pragma unroll
      for (int i = 0; i < 16; ++i) ss += base[i] * base[i];
      ss += __shfl_xor(ss, 1); ss += __shfl_xor(ss, 2);
      const float sc = (1.0f / sqrtf(ss + 1e-6f)) * (r < 64 ? 0.125f : 1.0f);
#pragma unroll
      for (int i = 0; i < 16; ++i) base[i] *= sc; }
    if (w < 2) {
        const int dir = w, i = lane, tt = dir ? 63 - i : i; const size_t row = (size_t)(row0 + tt);
        const float braw = bf2f(zb[row * ZLD + ZB_BBETA + dir * 4 + h]), araw = bf2f(zb[row * ZLD + ZB_BA + dir * 4 + h]);
        const float A = __expf(p.in[12][layer * 8 + dir * 4 + h]); const float x = araw + p.in[13][layer * 8 + dir * 4 + h];
        const float sp = x > 20.f ? x : log1pf(__expf(x)); float g = -A * sp;
#pragma unroll
        for (int off = 1; off < 64; off <<= 1) { const float t = __shfl_up(g, off); if (lane >= off) g += t; }
        bc[dir * 64 + i] = g; const float bt = sigmoidf_(braw); be[dir * 64 + i] = bt; be[128 + dir * 64 + i] = bt * __expf(g);
    }
    __syncthreads();
    { const int a = tid >> 3, b0 = (tid & 7) * 8; float ka[8], qa[8];
#pragma unroll
      for (int j = 0; j < 8; ++j) { ka[j] = 0.f; qa[j] = 0.f; }
#pragma unroll 4
      for (int d = 0; d < 64; ++d) { const float kav = kk[a * 65 + d], qav = qs[a * 65 + d];
#pragma unroll
          for (int j = 0; j < 8; ++j) { const float kb = kk[(b0 + j) * 65 + d]; ka[j] += kav * kb; qa[j] += qav * kb; } }
#pragma unroll
      for (int j = 0; j < 8; ++j) { KK0[a * 64 + b0 + j] = ka[j]; QK0[a * 64 + b0 + j] = qa[j]; } }
    __syncthreads();
    bf16_t* dpW = (bf16_t*)(C.ws + WS_DPW); bf16_t* dpQD = (bf16_t*)(C.ws + WS_DPQD); bf16_t* dpQK = (bf16_t*)(C.ws + WS_DPQK); bf16_t* dpKD = (bf16_t*)(C.ws + WS_DPKD); bf16_t* dpU = (bf16_t*)(C.ws + WS_DPU);
    float* dpGL = (float*)(C.ws + WS_GL);
    { const int i = tid >> 3, j0 = (tid & 7) * 8;
#pragma unroll
      for (int dir = 0; dir < 2; ++dir) {
          const size_t ud = ((size_t)tc * 4 + h) * 2 + dir;
          const float bi = bc[dir * 64 + i], betai = be[dir * 64 + i]; const int ai = dir ? 63 - i : i;
#pragma unroll
          for (int jj = 0; jj < 8; ++jj) { const int j = j0 + jj, aj = dir ? 63 - j : j;
              const float dec = (j <= i) ? __expf(bi - bc[dir * 64 + j]) : 0.f;
              Ms[dir * 4096 + j * 64 + i] = (j < i) ? betai * KK0[ai * 64 + aj] * dec : 0.f;
              dpQK[ud * 4096 + i * 64 + pinv(j)] = f2bf(QK0[ai * 64 + aj] * dec); }
      } }
    __syncthreads();
    if (w < 4) {
        const int dir = w >> 1, c = (w & 1) * 64 + lane; const size_t ud = ((size_t)tc * 4 + h) * 2 + dir;
        const float* Msd = Ms + dir * 4096; const bool isU = (w & 1) == 0; const float* scp = be + (isU ? 0 : 128) + dir * 64; const float* srcp = (isU ? vv : kk) + lane;
        float x[64];
#pragma unroll
        for (int rb = 0; rb < 4; ++rb) {
            float r[16];
#pragma unroll
            for (int ii = 0; ii < 16; ++ii) { const int i = 16 * rb + ii, tt = dir ? 63 - i : i; r[ii] = scp[i] * srcp[tt * 65]; }
            asm volatile("" ::: "memory");
#pragma unroll
            for (int j = 0; j < 16 * rb; ++j) {
                const float* mp = Msd + j * 64 + 16 * rb;
                const f32x4 ma = *(const f32x4*)mp, mb = *(const f32x4*)(mp + 4), mc = *(const f32x4*)(mp + 8), md = *(const f32x4*)(mp + 12);
                const float xj = x[j];
#pragma unroll
                for (int c4 = 0; c4 < 4; ++c4) { r[c4] -= ma[c4] * xj; r[4 + c4] -= mb[c4] * xj; r[8 + c4] -= mc[c4] * xj; r[12 + c4] -= md[c4] * xj; }
                if ((j & 3) == 3) asm volatile("" ::: "memory");
            }
#pragma unroll
            for (int jj = 0; jj < 16; ++jj) {
                const float xj = r[jj]; x[16 * rb + jj] = xj;
                const float* mp = Msd + (16 * rb + jj) * 64 + 16 * rb;
#pragma unroll
                for (int ii = jj + 1; ii < 16; ++ii) r[ii] -= mp[ii] * xj;
                if ((jj & 3) == 3) asm volatile("" ::: "memory");
            }
        }
        if (c < 64) {
            bf16_t* up = dpU + ud * 4096 + c * 64;
#pragma unroll
            for (int i = 0; i < 64; i += 8) { u32x4 o; o.x = cvt_pk_bf16(x[i], x[i + 1]); o.y = cvt_pk_bf16(x[i + 2], x[i + 3]); o.z = cvt_pk_bf16(x[i + 4], x[i + 5]); o.w = cvt_pk_bf16(x[i + 6], x[i + 7]); *(u32x4*)(up + i) = o; }
        } else {
            bf16_t* wp = dpW + ud * 4096 + pinv(c - 64);
#pragma unroll
            for (int i = 0; i < 64; ++i) wp[i * 64] = f2bf(x[i]);
        }
    } else {
#pragma unroll 4
        for (int it = 0; it < 64; ++it) {
            const int e = (tid - 256) + 256 * it, dir = e >> 13, which = (e >> 12) & 1, rem = e & 4095; const size_t ud = ((size_t)tc * 4 + h) * 2 + dir;
            if (which == 0) { const int i = rem >> 6, d = rem & 63, tt = dir ? 63 - i : i; dpQD[ud * 4096 + i * 64 + pinv(d)] = f2bf(qs[tt * 65 + d] * __expf(bc[dir * 64 + i])); }
            else { const int dk = rem >> 6, i = rem & 63, tt = dir ? 63 - i : i; dpKD[ud * 4096 + dk * 64 + pinv(i)] = f2bf(kk[tt * 65 + dk] * __expf(bc[dir * 64 + 63] - bc[dir * 64 + i])); }
        }
        if (tid == 256 || tid == 257) { const int dir = tid - 256; dpGL[((size_t)tc * 4 + h) * 2 + dir] = __expf(bc[dir * 64 + 63]); }
    }
}

DI void delta_scan_unit(const Ctx& C, int layer, bool sample, int b, int h) {
    const Params& p = *C.p; int tid = C.tid; asm volatile("" : "+v"(tid)); const int lane = tid & 63; const int w = C.wave, dir = w >> 2, sl = w & 3, col = lane & 15, g = lane >> 4;
    const int tc0 = sample ? 128 + b * 64 : b * 4, nch = sample ? 64 : 4;
    const bf16_t* dpU = (const bf16_t*)(C.ws + WS_DPU);
    const float* dpGL = (const float*)(C.ws + WS_GL); float* od = (float*)(C.ws + WS_OD) + (size_t)dir * MROWS * 256;
    f32x4 S[4];
    if (sample) { const float* s0 = p.in[4] + ((((size_t)b * 4 + layer) * 2 + dir) * 4 + h) * 4096;
#pragma unroll
        for (int rb = 0; rb < 4; ++rb)
#pragma unroll
            for (int ii = 0; ii < 4; ++ii) S[rb][ii] = s0[(16 * rb + 4 * g + ii) * 64 + 16 * sl + col]; }
    else {
#pragma unroll
        for (int rb = 0; rb < 4; ++rb) S[rb] = (f32x4){0.f, 0.f, 0.f, 0.f}; }
    u32x4 Ra[8], Rb[8];
#define DS_TC(d_, n_) ((d_) ? tc0 + nch - 1 - (n_) : tc0 + (n_))
#define DS_ISSUE(R, n_) do { _Pragma("unroll") for (int i = 0; i < 8; ++i) { const int id = tid + 512 * i, dm = id >> 9, dd = dm >> 2, mat = dm & 3; \
        const size_t ud_ = ((size_t)DS_TC(dd, n_) * 4 + h) * 2 + dd; R[i] = *(const u32x4*)(C.ws + WS_DPW + (size_t)mat * (16u * MiB) + ud_ * 8192 + (size_t)(id & 511) * 16); } } while (0)
#define DS_WRITE(R, buf_) do { _Pragma("unroll") for (int i = 0; i < 8; ++i) { const int id = tid + 512 * i, dm = id >> 9, row = (id >> 3) & 63, c = id & 7; \
        *(LAS u32x4*)(C.lds + (buf_) * 65536 + dm * 8192 + row * 128 + ((c ^ (row & 7)) * 16)) = R[i]; } } while (0)
#define DS_FRAG(buf_, mat_, rb_, ks_) (*(const LAS bf16x8*)(C.lds + (buf_) * 65536 + (dir * 4 + (mat_)) * 8192 + (16 * (rb_) + col) * 128 + ((((ks_) * 4 + g) ^ (col & 7)) * 16)))
    __syncthreads();
    DS_ISSUE(Ra, 0); DS_WRITE(Ra, 0); DS_ISSUE(Ra, 1);
    s16x4 uuA[4], uuB[4]; float glA, glB;
#define DS_LOADU(uu, gl, n_) do { const size_t ud_ = ((size_t)DS_TC(dir, n_) * 4 + h) * 2 + dir; _Pragma("unroll") for (int rb = 0; rb < 4; ++rb) uu[rb] = *(const s16x4*)(dpU + ud_ * 4096 + (16 * sl + col) * 64 + 16 * rb + 4 * g); gl = dpGL[ud_]; } while (0)
    DS_LOADU(uuA, glA, 0); DS_LOADU(uuB, glB, 1);
    __syncthreads();
#define DS_STEP(n, buf, Rnext, Rcur, uu, gl) do { \
        if ((n) + 2 < nch) DS_ISSUE(Rnext, (n) + 2); \
        const int tc = DS_TC(dir, (n)); \
        bf16x8 Sb[2]; Sb[0] = pack8(S[0], S[1]); Sb[1] = pack8(S[2], S[3]); \
        f32x4 vn[4]; \
        _Pragma("unroll") for (int rb = 0; rb < 4; ++rb) { f32x4 t = (f32x4){0.f, 0.f, 0.f, 0.f}; t = MFMA16(DS_FRAG(buf, 0, rb, 0), Sb[0], t); t = MFMA16(DS_FRAG(buf, 0, rb, 1), Sb[1], t); \
            _Pragma("unroll") for (int ii = 0; ii < 4; ++ii) vn[rb][ii] = bf2f((bf16_t)uu[rb][ii]) - t[ii]; } \
        const float glc = gl; \
        if ((n) + 2 < nch) DS_LOADU(uu, gl, (n) + 2); \
        bf16x8 vb[2]; vb[0] = pack8(vn[0], vn[1]); vb[1] = pack8(vn[2], vn[3]); \
        const int rowb = tc * 64; \
        _Pragma("unroll") for (int rb = 0; rb < 4; ++rb) { f32x4 o = (f32x4){0.f, 0.f, 0.f, 0.f}; o = MFMA16(DS_FRAG(buf, 1, rb, 0), Sb[0], o); o = MFMA16(DS_FRAG(buf, 1, rb, 1), Sb[1], o); o = MFMA16(DS_FRAG(buf, 2, rb, 0), vb[0], o); o = MFMA16(DS_FRAG(buf, 2, rb, 1), vb[1], o); \
            _Pragma("unroll") for (int ii = 0; ii < 4; ++ii) { const int i = 16 * rb + 4 * g + ii; const int tt = dir ? 63 - i : i; od[(size_t)(rowb + tt) * 256 + h * 64 + 16 * sl + col] = o[ii]; } } \
        _Pragma("unroll") for (int rb = 0; rb < 4; ++rb) { f32x4 sn = S[rb] * glc; sn = MFMA16(DS_FRAG(buf, 3, rb, 0), vb[0], sn); sn = MFMA16(DS_FRAG(buf, 3, rb, 1), vb[1], sn); S[rb] = sn; } \
        if ((n) + 1 < nch) DS_WRITE(Rcur, (buf) ^ 1); \
        __syncthreads(); } while (0)
    for (int n = 0; n < nch; n += 2) {
        DS_STEP(n, 0, Rb, Ra, uuA, glA);
        DS_STEP(n + 1, 1, Ra, Rb, uuB, glB);
    }
#undef DS_STEP
#undef DS_TC
#undef DS_ISSUE
#undef DS_WRITE
#undef DS_FRAG
#undef DS_LOADU
    if (!sample) { float* so = C.out + OUT_SD + ((((size_t)b * 4 + layer) * 2 + dir) * 4 + h) * 4096;
#pragma unroll
        for (int rb = 0; rb < 4; ++rb)
#pragma unroll
            for (int ii = 0; ii < 4; ++ii) so[(16 * rb + 4 * g + ii) * 64 + 16 * sl + col] = S[rb][ii]; }
}

DI float hgrn_forget(const bf16_t* zb, size_t row, int dir, int h, int d, float lb) { const float x = bf2f(zb[row * ZLD + ZB_CF + dir * 256 + h * 64 + d]); return lb + (1.0f - lb) * sigmoidf_(x); }
DI void hgrn_local_unit(const Ctx& C, int layer, int unit) {
    int lane = C.lane; asm volatile("" : "+v"(lane)); const int dir = unit & 1, h = (unit >> 1) & 3, tc = unit >> 3, row0 = tc * 64;
    const bf16_t* zb = (const bf16_t*)(C.ws + WS_ZB);
    float* fs = C.L + C.wave * 1024;
    const float lb = ((const float*)(C.ws + WS_TAB))[4096 + (dir * 4 + layer) * 256 + h * 64 + lane];
    float S[64];
#pragma unroll
    for (int d = 0; d < 64; ++d) S[d] = 0.f;
    float Dl = 1.0f;
    for (int sb = 0; sb < 4; ++sb) {
        float vr[16];
#pragma unroll
        for (int i = 0; i < 16; ++i) { const int ti = sb * 16 + i, tt = dir ? 63 - ti : ti; const size_t row = (size_t)(row0 + tt);
            const float f = hgrn_forget(zb, row, dir, h, lane, lb); fs[i * 64 + lane] = f; Dl *= f; vr[i] = bf2f(zb[row * ZLD + ZB_CI + h * 64 + lane]); }
        __builtin_amdgcn_wave_barrier();
#pragma unroll
        for (int i = 0; i < 16; ++i) { const float v = vr[i];
#pragma unroll
            for (int d = 0; d < 64; d += 4) { const f32x4 f4 = *(const f32x4*)(fs + i * 64 + d);
#pragma unroll
                for (int c = 0; c < 4; ++c) S[d + c] = fmaf(f4[c], S[d + c] - v, v);
                if ((d & 15) == 12) asm volatile("" ::: "memory"); } }
        __builtin_amdgcn_wave_barrier();
    }
    float* hs = (float*)(C.ws + WS_HS) + (size_t)unit * 4096;
#pragma unroll
    for (int d = 0; d < 64; ++d) hs[d * 64 + lane] = S[d];
    ((float*)(C.ws + WS_HD))[(size_t)unit * 64 + lane] = Dl;
}
DI void hgrn_scan_unit(const Ctx& C, int layer, bool sample, int b, int h, int dir) {
    const Params& p = *C.p; int tid = C.tid; asm volatile("" : "+v"(tid)); const int tc0 = sample ? 128 + b * 64 : b * 4, nch = sample ? 64 : 4;
    float* HS = (float*)(C.ws + WS_HS); const float* HD = (const float*)(C.ws + WS_HD);
    f32x4 S0, S1;
    if (sample) { const float* s0 = p.in[5] + ((((size_t)b * 4 + layer) * 2 + dir) * 4 + h) * 4096 + tid * 8; S0 = *(const f32x4*)s0; S1 = *(const f32x4*)(s0 + 4); }
    else { S0 = (f32x4){0.f, 0.f, 0.f, 0.f}; S1 = S0; }
    for (int n0 = 0; n0 < nch; n0 += 4) {
        f32x4 la[4], lb[4]; float Dd[4];
#pragma unroll
        for (int k = 0; k < 4; ++k) { const int tc = dir ? tc0 + nch - 1 - (n0 + k) : tc0 + n0 + k; const size_t uh = ((size_t)tc * 4 + h) * 2 + dir;
            const float* hp = HS + uh * 4096 + tid * 8; la[k] = *(const f32x4*)hp; lb[k] = *(const f32x4*)(hp + 4); Dd[k] = HD[uh * 64 + (tid >> 3)]; }
#pragma unroll
        for (int k = 0; k < 4; ++k) { const int tc = dir ? tc0 + nch - 1 - (n0 + k) : tc0 + n0 + k; const size_t uh = ((size_t)tc * 4 + h) * 2 + dir;
            float* hp = HS + uh * 4096 + tid * 8; *(f32x4*)hp = S0; *(f32x4*)(hp + 4) = S1; S0 = S0 * Dd[k] + la[k]; S1 = S1 * Dd[k] + lb[k]; }
    }
    if (!sample) { float* so = C.out + OUT_SH + ((((size_t)b * 4 + layer) * 2 + dir) * 4 + h) * 4096 + tid * 8; *(f32x4*)so = S0; *(f32x4*)(so + 4) = S1; }
}
DI void hgrn_final_unit(const Ctx& C, int layer, int tc) {
    const Params& p = *C.p; int lane = C.lane; asm volatile("" : "+v"(lane)); const int w = C.wave, h = w >> 1, dir = w & 1, ep = lane & 31, dh = lane >> 5, row0 = tc * 64;
    const bf16_t* zb = (const bf16_t*)(C.ws + WS_ZB); const float* HS = (const float*)(C.ws + WS_HS);
    float* otile = C.L;
    float* fs = C.L + 16384 + w * 2048; float* qst = fs + 1024;
    __syncthreads();
    for (int i = C.tid; i < 16384; i += 512) otile[i] = 0.f;
    __syncthreads();
    {
        const size_t uh = ((size_t)tc * 4 + h) * 2 + dir;
        const float lb = ((const float*)(C.ws + WS_TAB))[4096 + (dir * 4 + layer) * 256 + h * 64 + lane];
        f32x2 S[32];
#pragma unroll
        for (int k = 0; k < 32; ++k) S[k] = *(const f32x2*)(HS + uh * 4096 + (32 * dh + k) * 64 + 2 * ep);
        bf16_t rf[16], rq[16]; unsigned rv[16];
#define HF_LOAD(sb_) do { _Pragma("unroll") for (int i = 0; i < 16; ++i) { const int ti = (sb_) * 16 + i, tt = dir ? 63 - ti : ti; const size_t row = (size_t)(row0 + tt); \
            rf[i] = zb[row * ZLD + ZB_CF + dir * 256 + h * 64 + lane]; rq[i] = zb[row * ZLD + ZB_CQ + h * 64 + lane]; rv[i] = *(const unsigned*)(zb + row * ZLD + ZB_CI + h * 64 + 2 * ep); } } while (0)
        HF_LOAD(0);
        for (int sb = 0; sb < 4; ++sb) {
            f32x2 vr[16];
#pragma unroll
            for (int i = 0; i < 16; ++i) { fs[i * 64 + lane] = lb + (1.0f - lb) * sigmoidf_(bf2f(rf[i])); qst[i * 64 + lane] = siluf_(bf2f(rq[i])); vr[i] = (f32x2){__uint_as_float(rv[i] << 16), __uint_as_float(rv[i] & 0xffff0000u)}; }
            if (sb + 1 < 4) HF_LOAD(sb + 1);
            __builtin_amdgcn_wave_barrier();
#pragma unroll
            for (int i = 0; i < 16; ++i) { const f32x2 v = vr[i]; f32x2 osa = {0.f, 0.f}, osb = {0.f, 0.f};
#pragma unroll
                for (int k = 0; k < 32; k += 4) { const f32x4 f4 = *(const f32x4*)(fs + i * 64 + 32 * dh + k), q4 = *(const f32x4*)(qst + i * 64 + 32 * dh + k);
#pragma unroll
                    for (int c = 0; c < 4; ++c) { S[k + c] = (S[k + c] - v) * f4[c] + v; if (c & 1) osb += S[k + c] * q4[c]; else osa += S[k + c] * q4[c]; }
                    if ((k & 15) == 12) asm volatile("" ::: "memory"); }
                f32x2 os = osa + osb;
                os.x += __shfl_xor(os.x, 32); os.y += __shfl_xor(os.y, 32);
                const int ti = sb * 16 + i, tt = dir ? 63 - ti : ti;
                if (dh == 0) { float* op = otile + (h * 64 + tt) * 64 + 2 * ep; atomicAdd(op, os.x); atomicAdd(op + 1, os.y); }
                asm volatile("" ::: "memory"); }
            __builtin_amdgcn_wave_barrier();
        }
    }
#undef HF_LOAD
    __syncthreads();
    bf16_t* ob = (bf16_t*)(C.ws + WS_O);
    const float ng = p.in[16][layer * 64 + lane];
    bf16_t gts[32];
#pragma unroll
    for (int rr = 0; rr < 32; ++rr) { const int idx = w * 32 + rr, hh = idx >> 6, tt = idx & 63; gts[rr] = zb[(size_t)(row0 + tt) * ZLD + ZB_CG + hh * 64 + lane]; }
#pragma unroll
    for (int rr = 0; rr < 32; ++rr) { const int idx = w * 32 + rr, hh = idx >> 6, tt = idx & 63; const size_t row = (size_t)(row0 + tt);
        const float v = otile[(hh * 64 + tt) * 64 + lane]; const float ss = wave_sum(v * v);
        const float gt = siluf_(bf2f(gts[rr]));
        ob[row * DM + 768 + hh * 64 + lane] = f2bf(v * (1.0f / sqrtf(ss * (1.0f / 64.0f) + RMS_EPS)) * ng * gt); }
}
DI void delta_combine(const Ctx& C, int layer) {
    const Params& p = *C.p; const bf16_t* zb = (const bf16_t*)(C.ws + WS_ZB); const float* od = (const float*)(C.ws + WS_OD); bf16_t* ob = (bf16_t*)(C.ws + WS_O);
    const float ng = p.in[14][layer * 64 + C.lane];
    for (int it0 = C.gw * 4; it0 < MROWS * 4; it0 += C.NGW * 4) {
        float v[4]; bf16_t gr[4];
#pragma unroll
        for (int k = 0; k < 4; ++k) { const int it = it0 + k, h = it & 3; const size_t row = (size_t)(it >> 2);
            v[k] = od[row * 256 + h * 64 + C.lane] + od[(size_t)MROWS * 256 + row * 256 + h * 64 + C.lane]; gr[k] = zb[row * ZLD + ZB_BG + h * 64 + C.lane]; }
#pragma unroll
        for (int k = 0; k < 4; ++k) { const int it = it0 + k, h = it & 3; const size_t row = (size_t)(it >> 2);
            const float ss = wave_sum(v[k] * v[k]); const float gt = siluf_(bf2f(gr[k]));
            ob[row * DM + 512 + h * 64 + C.lane] = f2bf(v[k] * (1.0f / sqrtf(ss * (1.0f / 64.0f) + RMS_EPS)) * ng * gt); }
    }
}

#define XB_TMO      128
#define XB_XCNT(j)  (256  + 64 * (j))
#define XB_XSUB(j)  (1280 + 64 * (j))
#define XB_XGEN(j)  (2304 + 64 * (j))
#define XB_TOP      3328
#define XB_TOPGEN   3392
#define XB_SPIN_CAP (1u << 22)
DI unsigned xb_ld(unsigned* p)              { return __hip_atomic_load(p, __ATOMIC_RELAXED, __HIP_MEMORY_SCOPE_AGENT); }
DI unsigned xb_add(unsigned* p, unsigned v) { return __hip_atomic_fetch_add(p, v, __ATOMIC_RELAXED, __HIP_MEMORY_SCOPE_AGENT); }
DI unsigned xb_xcc_id() { return (unsigned)__builtin_amdgcn_s_getreg((3 << 11) | 20) & 0xFu; }
#define XB_SPIN(cond, bar) do { unsigned _sp = 0; while (cond) { __builtin_amdgcn_s_sleep(1); \
    if ((++_sp & 255u) == 0u) { if (xb_ld(&(bar)[XB_TMO])) break; if (_sp > XB_SPIN_CAP) { atomicAdd(&(bar)[XB_TMO], 1u); break; } } } } while (0)
struct XcdBarrier { unsigned* bar; unsigned x; volatile LAS unsigned* st; };
DI void xcd_barrier_complete(unsigned* bar, unsigned x, unsigned& nloc, unsigned& nx) {
    const unsigned G = gridDim.x * gridDim.y * gridDim.z;
    unsigned sum, cnt, mine, sp = 0u;
    for (;;) {
        sum = 0u; cnt = 0u; mine = 0u;
#pragma unroll
        for (unsigned j = 0; j < 16; ++j) { const unsigned c = xb_ld(&bar[XB_XCNT(j)]); sum += c; cnt += (c > 0u) ? 1u : 0u; mine = (j == x) ? c : mine; }
        if (sum == G) break;
        __builtin_amdgcn_s_sleep(1);
        if ((++sp & 255u) == 0u) { if (xb_ld(&bar[XB_TMO])) break; if (sp > XB_SPIN_CAP) { atomicAdd(&bar[XB_TMO], 1u); break; } }
    }
    nloc = mine > 0u ? mine : 1u; nx = cnt > 0u ? cnt : 1u;
}
DI void xcd_barrier(const XcdBarrier& b) {
    asm volatile("s_waitcnt vmcnt(0)" ::: "memory");
    __syncthreads();
    if (threadIdx.x == 0) {
        unsigned* bar = b.bar;
        __builtin_amdgcn_s_waitcnt(0);
        unsigned nloc = b.st[0], nx = b.st[1];
        if (nloc == 0u) { xcd_barrier_complete(bar, b.x, nloc, nx); b.st[0] = nloc; b.st[1] = nx; }
        const unsigned old = xb_add(&bar[XB_XSUB(b.x)], 1u);
        const unsigned gen = old / nloc;
        if (old + 1u == (gen + 1u) * nloc) {
            __builtin_amdgcn_fence(__ATOMIC_RELEASE, "agent");
            asm volatile("s_waitcnt vmcnt(0)" ::: "memory");
            const unsigned og = xb_add(&bar[XB_TOP], 1u);
            const unsigned tg = og / nx;
            if (og + 1u == (tg + 1u) * nx) xb_add(&bar[XB_TOPGEN], 1u);
            else XB_SPIN(xb_ld(&bar[XB_TOPGEN]) == tg, bar);
            __builtin_amdgcn_fence(__ATOMIC_ACQUIRE, "agent");
            xb_add(&bar[XB_XGEN(b.x)], 1u);
            asm volatile("s_waitcnt vmcnt(0)" ::: "memory");
        } else {
            XB_SPIN(xb_ld(&bar[XB_XGEN(b.x)]) == gen, bar);
            __builtin_amdgcn_fence(__ATOMIC_ACQUIRE, "agent");
            asm volatile("s_waitcnt vmcnt(0)" ::: "memory");
        }
    }
    __syncthreads();
}

DI void probe_stamp(unsigned char* ws, int cls) {
    if (PROBE_A >= 0 && blockIdx.x == 0 && threadIdx.x == 0) {
        volatile float* tsf = (volatile float*)(ws + WS_TAB + 131072); volatile unsigned long long* tsl = (volatile unsigned long long*)(ws + WS_TAB + 131072 + 256);
        const unsigned long long now = __builtin_amdgcn_s_memrealtime(); tsf[cls] += (float)(now - tsl[0]); tsl[0] = now; }
}
template <unsigned PHM_>
__global__ void __launch_bounds__(512) fwd_megakernel(Params p) {
    extern __shared__ __attribute__((aligned(16))) unsigned char lds_raw[];
    XcdBarrier xbar; xbar.bar = (unsigned*)(p.ws + WS_CTL) + 1024; xbar.x = xb_xcc_id(); xbar.st = (volatile LAS unsigned*)((LAS unsigned char*)lds_raw + 147400);
    if (threadIdx.x == 0) { xbar.st[0] = 0u; xbar.st[1] = 0u; (void)xb_add(&xbar.bar[XB_XCNT(xbar.x)], 1u); }
    __syncthreads();
    for (int ph = p.ph_lo; ph < p.ph_hi; ++ph) {
        if (PROBE_A >= 0 && blockIdx.x == 0 && threadIdx.x == 0) {
            volatile float* tsf = (volatile float*)(p.ws + WS_TAB + 131072); volatile unsigned long long* tsl = (volatile unsigned long long*)(p.ws + WS_TAB + 131072 + 256);
            const unsigned long long now = __builtin_amdgcn_s_memrealtime();
            if (ph == 0) { for (int i = 0; i < 16; ++i) tsf[i] = 0.f; tsl[1] = now; }
            else { const int pp = ph - 1; const int cls = pp < 2 ? 8 : (((pp - 2) % 9) == 8 ? 5 : ((pp - 2) % 9)); const float dt = (float)(now - tsl[0]); tsf[cls] += dt; }
            tsl[0] = now;
            if (ph == NPHASE - 2 && PROBE_A < 20) { const float tot = (float)(now - tsl[1]); tsf[12] = rintf(tsf[(PROBE_A >= 0 && PROBE_A < 16) ? PROBE_A : 0] / tot * 40.f) / 40.f; tsf[13] = rintf(tsf[PROBE_B >= 0 ? PROBE_B : 0] / tot * 40.f) / 40.f; }
        }
        if (PROBE_A >= 0 && ph == 0 && threadIdx.x == 0) { volatile float* tsb = (volatile float*)(p.ws + WS_TAB + 196608) + blockIdx.x * 8; for (int i = 0; i < 8; ++i) tsb[i] = 0.f; }
        if (PROBE_A >= 20 && ph == NPHASE - 2 && blockIdx.x == 0 && threadIdx.x == 0) {
            volatile float* tsf = (volatile float*)(p.ws + WS_TAB + 131072); volatile unsigned long long* tsl = (volatile unsigned long long*)(p.ws + WS_TAB + 131072 + 256);
            const float* tsb = (const float*)(p.ws + WS_TAB + 196608); float sum = 0.f; for (int b2 = 0; b2 < (int)gridDim.x; ++b2) sum += __hip_atomic_load(tsb + b2 * 8 + (PROBE_A - 20), __ATOMIC_RELAXED, __HIP_MEMORY_SCOPE_AGENT); sum *= (PROBE_A == 20 ? 32.f : (PROBE_A == 21 ? 16.f : 1.f));
            const float tot = (float)(__builtin_amdgcn_s_memrealtime() - tsl[1]); tsf[12] = rintf(sum / (float)gridDim.x / tot * 40.f) / 40.f; tsf[13] = 0.f; }
        int tid_ = threadIdx.x; asm volatile("" : "+v"(tid_));
        unsigned char* ws_ = p.ws; asm volatile("" : "+s"(ws_));
        float* out_ = p.out; asm volatile("" : "+s"(out_));
        Ctx C; C.p = &p; C.lds = (LAS unsigned char*)lds_raw; C.L = (float*)lds_raw; C.tid = tid_; C.lane = C.tid & 63; C.wave = __builtin_amdgcn_readfirstlane(C.tid >> 6);
        C.G = gridDim.x; C.gw = blockIdx.x * 8 + C.wave; C.NGW = C.G * 8; C.ws = ws_; C.out = out_;
        unsigned* ctl = (unsigned*)(ws_ + WS_CTL);
        const float* modbuf = (const float*)(ws_ + WS_MOD);
        bf16_t* xm = (bf16_t*)(ws_ + WS_XM); bf16_t* ob = (bf16_t*)(ws_ + WS_O); bf16_t* act = (bf16_t*)(ws_ + WS_ACT);
        if (ph == 0) { if (PHON(0)) phase0a(C); }
        else if (ph == 1) { if (PHON(1)) row_pass(C, 0, nullptr, nullptr, modbuf, 1024, 0, true); }
        else {
            const int layer = (ph - 2) / 9, sub = (ph - 2) % 9;
            unsigned char* wb = ws_ + WS_W + (size_t)(layer & 1) * WBUF;
            const float* modl = modbuf + (size_t)layer * 3 * 6144;
            if (sub == 0) { if (PHON(2)) {
                pg8::Gemm g{xm, (const bf16_t*)(wb + W_IN), MROWS, 4096, DM}; pg8::StaticOrder S; S.init(MROWS, 4096, C.G, (int)blockIdx.x);
                EpiIn E{(bf16_t*)(ws_ + WS_Q), (bf16_t*)(ws_ + WS_K), (bf16_t*)(ws_ + WS_V), (bf16_t*)(ws_ + WS_ZB), out_ + OUT_K, out_ + OUT_V, (const f32x2*)(ws_ + WS_TAB), layer};
                pg8::gemm_phase(C.lds, g, S, E, C.tid); }
            } else if (sub == 1) {
                __syncthreads();
                if (PHON(4)) for (int u = blockIdx.x; u < 1024; u += C.G) delta_prep_unit(C, layer, u);
                __syncthreads();
                if (PHON(5)) for (int u = C.gw; u < 2048; u += C.NGW) hgrn_local_unit(C, layer, u);
                __syncthreads();
            } else if (sub == 2) {
                LAS int* slot = (LAS int*)(C.lds + 147392);
                for (;;) {
                    __syncthreads();
                    if (C.tid == 0) *slot = (int)atomicAdd(ctl + 64 * (layer + 1), 1u);
                    __syncthreads();
                    const int u = *slot;
                    if (u >= 1432 + 256) break;
                    if (u >= 1432) { if (layer + 1 < DEPTH) convert_layer_weights(C, layer + 1, (u - 1432) * 8 + C.wave, 2048, u - 1432, 256); continue; }
                    unsigned long long pt0_ = 0; if (PROBE_A >= 0 && C.tid == 0) pt0_ = __builtin_amdgcn_s_memrealtime();
                    if (u < 8) { if (PHON(6)) delta_scan_unit(C, layer, true, u >> 2, u & 3); }
                    else if (u < 24) { const int v = u - 8; if (PHON(7)) hgrn_scan_unit(C, layer, true, v >> 3, (v >> 1) & 3, v & 1); }
                    else if (u < 536) { if (PHON(8)) attn_unit(C, layer, u - 24); }
                    else if (u < 664) { const int v = u - 536; if (PHON(6)) delta_scan_unit(C, layer, false, v >> 2, v & 3); }
                    else if (u < 1176) { if (PHON(8)) attn_unit(C, layer, 512 + (u - 664)); }
                    else { const int v = u - 1176; if (PHON(7)) hgrn_scan_unit(C, layer, false, v >> 3, (v >> 1) & 3, v & 1); }
                    if (PROBE_A >= 0) { __syncthreads(); if (C.tid == 0) { const int ty = (u < 8) ? 0 : (u < 24 ? 1 : (u < 536 ? 2 : (u < 664 ? 3 : (u < 1176 ? 4 : 5))));
                        volatile float* tsb = (volatile float*)(ws_ + WS_TAB + 196608) + blockIdx.x * 8; tsb[ty] += (float)(__builtin_amdgcn_s_memrealtime() - pt0_); } }
                }
            } else if (sub == 3) {
                if (PHON(9)) for (int u = blockIdx.x; u < 256; u += C.G) hgrn_final_unit(C, layer, u);
                __syncthreads();
                if (PHON(10)) delta_combine(C, layer);
                __syncthreads();
            } else if (sub == 4) {
                pg8::Gemm g{ob, (const bf16_t*)(wb + W_OUT), MROWS, DM, DM}; pg8::StaticOrder S; S.init(MROWS, DM, C.G, (int)blockIdx.x);
                EpiRes E{out_, modl + 2048};
                if (PHON(11)) pg8::gemm_phase(C.lds, g, S, E, C.tid);
            } else if (sub == 5) {
                if (PHON(12)) row_pass(C, 1, p.in[20] + (size_t)(layer * 2) * DM, p.in[21] + (size_t)(layer * 2) * DM, modl, 4096, 3072, true);
            } else if (sub == 6) {
                pg8::Gemm g{xm, (const bf16_t*)(wb + W_FFI), MROWS, 2 * DFF, DM}; pg8::StaticOrder S; S.init(MROWS, 2 * DFF, C.G, (int)blockIdx.x);
                EpiFfn E{act};
                if (PHON(13)) pg8::gemm_phase(C.lds, g, S, E, C.tid);
            } else if (sub == 7) {
                pg8::Gemm g{act, (const bf16_t*)(wb + W_FFO), MROWS, DM, DFF}; pg8::StaticOrder S; S.init(MROWS, DM, C.G, (int)blockIdx.x);
                EpiRes E{out_, modl + 5120};
                if (PHON(14)) pg8::gemm_phase(C.lds, g, S, E, C.tid);
            } else {
                const bool last = layer + 1 == DEPTH;
                if (PHON(12)) row_pass(C, 1, p.in[20] + (size_t)(layer * 2 + 1) * DM, p.in[21] + (size_t)(layer * 2 + 1) * DM, modbuf + (size_t)(last ? layer : layer + 1) * 3 * 6144, 1024, 0, !last);
            }
        }
        if (ph + 1 < p.ph_hi) { if (p.ph_hi > 100000) { __threadfence(); cg::this_grid().sync(); } else xcd_barrier(xbar); }
    }
}

#if !MK_ONE_LAUNCH
static unsigned phase_mask(int ph) {
    if (ph == 0) return 1u << 0; if (ph == 1) return 1u << 1;
    const int sub = (ph - 2) % 9;
    switch (sub) { case 0: return 1u << 2; case 1: return (1u << 3) | (1u << 4) | (1u << 5); case 2: return (1u << 6) | (1u << 7) | (1u << 8); case 3: return (1u << 9) | (1u << 10);
        case 4: return 1u << 11; case 5: return 1u << 12; case 6: return 1u << 13; case 7: return 1u << 14; default: return 1u << 12; }
}
typedef void (*kern_t)(Params);
static kern_t kernel_for_mask(unsigned m) {
    switch (m) {
        case 1u << 0: return fwd_megakernel<1u << 0>; case 1u << 1: return fwd_megakernel<1u << 1>; case 1u << 2: return fwd_megakernel<1u << 2>;
        case (1u << 3) | (1u << 4) | (1u << 5): return fwd_megakernel<(1u << 3) | (1u << 4) | (1u << 5)>;
        case (1u << 6) | (1u << 7) | (1u << 8): return fwd_megakernel<(1u << 6) | (1u << 7) | (1u << 8)>;
        case (1u << 9) | (1u << 10): return fwd_megakernel<(1u << 9) | (1u << 10)>;
        case 1u << 11: return fwd_megakernel<1u << 11>; case 1u << 12: return fwd_megakernel<1u << 12>; case 1u << 13: return fwd_megakernel<1u << 13>; default: return fwd_megakernel<1u << 14>;
    }
}
#endif
extern "C" void kernel_launch(void* const* d_in, const int* in_sizes, int n_in, void* d_out, int out_size, void* d_ws, size_t ws_size, hipStream_t stream) {
    static int grid = 0;
    if (grid == 0) {
        if (n_in != 24 || out_size != 58720256 || ws_size < WS_END) { fprintf(stderr, "kernel_launch: unexpected shapes (n_in %d out %d ws %zu)\n", n_in, out_size, ws_size); grid = -1; return; }
        int dev = 0, cus = 0;
        (void)hipGetDevice(&dev); (void)hipDeviceGetAttribute(&cus, hipDeviceAttributeMultiprocessorCount, dev);
#if MK_ONE_LAUNCH
        if (hipFuncSetAttribute((const void*)fwd_megakernel<0x7FFFu>, hipFuncAttributeMaxDynamicSharedMemorySize, LDS_BYTES) != hipSuccess) { fprintf(stderr, "kernel_launch: hipFuncSetAttribute failed\n"); grid = -1; return; }
#else
        for (int ph = 0; ph < 11; ++ph) (void)hipFuncSetAttribute((const void*)kernel_for_mask(phase_mask(ph)), hipFuncAttributeMaxDynamicSharedMemorySize, LDS_BYTES);
#endif
        (void)hipGetLastError();
        grid = cus > 0 ? cus : 256;
        if (grid != 256) { fprintf(stderr, "kernel_launch: expected 256 CUs, got %d\n", grid); grid = 256; }
    }
    if (grid < 0) return;
    (void)hipMemsetAsync((char*)d_ws + WS_CTL, 0, 65536, stream);
    Params p{};
    for (int i = 0; i < 24; ++i) p.in[i] = (const float*)d_in[i];
    p.out = (float*)d_out; p.ws = (unsigned char*)d_ws;
#if MK_ONE_LAUNCH
    p.ph_lo = 0; p.ph_hi = NPHASE;
    void* args[] = {&p};
    hipError_t e = hipLaunchCooperativeKernel((const void*)fwd_megakernel<0x7FFFu>, dim3(grid), dim3(512), args, LDS_BYTES, stream);
    if (e != hipSuccess) fprintf(stderr, "cooperative launch failed: %s (grid %d)\n", hipGetErrorString(e), grid);
#else
    for (int ph = 0; ph < NPHASE; ++ph) { p.ph_lo = ph; p.ph_hi = ph + 1; hipLaunchKernelGGL(kernel_for_mask(phase_mask(ph)), dim3(grid), dim3(512), LDS_BYTES, stream, p); }
#endif
}
```

```cpp
#include <hip/hip_runtime.h>
#include <hip/hip_cooperative_groups.h>
#include <cstdio>
#include <cstdint>
namespace cg = cooperative_groups;

#define PHON(k) ((PHM_ >> (k)) & 1)
#ifndef PROBE_A
#define PROBE_A -1
#endif
#ifndef PROBE_B
#define PROBE_B -1
#endif
#ifndef MK_ONE_LAUNCH
#define MK_ONE_LAUNCH 1
#endif

#define DI __device__ __forceinline__
#define LAS __attribute__((address_space(3)))
typedef unsigned short bf16_t;
typedef short bf16x8 __attribute__((ext_vector_type(8)));
typedef short s16x4 __attribute__((ext_vector_type(4)));
typedef float f32x4 __attribute__((ext_vector_type(4)));
typedef float f32x16 __attribute__((ext_vector_type(16)));
typedef float f32x2 __attribute__((ext_vector_type(2)));
typedef unsigned u32x4 __attribute__((ext_vector_type(4)));
typedef unsigned u32x2 __attribute__((ext_vector_type(2)));

constexpr int MROWS = 16384, DM = 1024, DEPTH = 4, DFF = 2816, DIN = 3856, ZLD = 2320;
constexpr float ALPHA = 1.681792830507429f, LN_EPS = 1e-5f, RMS_EPS = 1e-6f;
constexpr float QSCALE = 0.125f * 1.4426950408889634f;
constexpr int ZB_BQ = 0, ZB_BK = 256, ZB_BV = 512, ZB_BG = 768, ZB_BBETA = 1024, ZB_BA = 1032, ZB_CQ = 1040, ZB_CF = 1296, ZB_CI = 1808, ZB_CG = 2064;
constexpr size_t OUT_K = 16777216, OUT_V = 33554432, OUT_SD = 50331648, OUT_SH = 54525952;
constexpr size_t MiB = 1u << 20;
constexpr size_t WS_CTL = 0, WS_MOD = 64 * 1024, WS_TAB = 512 * 1024, WS_CK = 1 * MiB, WS_CV = 3 * MiB, WS_W = 8 * MiB, WBUF = 27 * MiB;
constexpr size_t W_IN = 0, W_OUT = 8 * MiB, W_FFI = 10 * MiB, W_FFO = 21 * MiB;
constexpr size_t WS_XM = 62 * MiB, WS_O = 94 * MiB, WS_ZB = 126 * MiB, WS_Q = 199 * MiB, WS_K = 215 * MiB, WS_V = 231 * MiB;
constexpr size_t WS_ACT = 126 * MiB;
constexpr size_t WS_DPW = 247 * MiB, WS_DPQD = 263 * MiB, WS_DPQK = 279 * MiB, WS_DPKD = 295 * MiB;
constexpr size_t WS_DPU = WS_XM;
constexpr size_t WS_OD = 311 * MiB, WS_HS = 343 * MiB, WS_HD = 375 * MiB, WS_GL = 375 * MiB + 512 * 1024, WS_END = 376 * MiB;
constexpr int LDS_BYTES = 147456;
constexpr int NPHASE = 2 + 9 * DEPTH;

struct Params { const float* in[24]; float* out; unsigned char* ws; int ph_lo, ph_hi; };

DI unsigned cvt_pk_bf16(float lo, float hi) { unsigned r; asm("v_cvt_pk_bf16_f32 %0, %1, %2" : "=v"(r) : "v"(lo), "v"(hi)); return r; }
DI bf16_t f2bf(float f) { return (bf16_t)(cvt_pk_bf16(f, 0.f) & 0xffffu); }
DI float bf2f(bf16_t b) { return __uint_as_float(((unsigned)b) << 16); }
DI float sigmoidf_(float x) { return 1.0f / (1.0f + __expf(-x)); }
DI float siluf_(float x) { return x / (1.0f + __expf(-x)); }
DI float wave_sum(float v) {
#pragma unroll
    for (int o = 1; o < 64; o <<= 1) v += __shfl_xor(v, o);
    return v;
}
DI u32x2 pack4(f32x4 v) { u32x2 w; w.x = cvt_pk_bf16(v[0], v[1]); w.y = cvt_pk_bf16(v[2], v[3]); return w; }
DI bf16x8 pack8(f32x4 a, f32x4 b) { u32x4 w; w.x = cvt_pk_bf16(a[0], a[1]); w.y = cvt_pk_bf16(a[2], a[3]); w.z = cvt_pk_bf16(b[0], b[1]); w.w = cvt_pk_bf16(b[2], b[3]); return __builtin_bit_cast(bf16x8, w); }
DI int pinv(int k) { return (k >> 5) * 32 + ((k >> 2) & 3) * 8 + ((k >> 4) & 1) * 4 + (k & 3); }
DI int row_mod(int r) { return r < 8192 ? 0 : 1 + ((r - 8192) >> 12); }

namespace pg8 {
constexpr int BM = 256, BK = 64, HALF = 128, HTB = HALF * BK * 2, STAGE_BYTES = 8 * HTB, NXCD = 8, WGM = 8;
DI int lds_byte(int r, int c) { const int st = (r >> 4) * 2 + (c >> 5), rr = r & 15, cc = c & 31, ob = rr * 64 + cc * 2; return st * 1024 + (ob ^ (((ob >> 9) & 1) << 5)); }
DI void stage_rc(int b, int& R, int& C) { const int st = b / 1024, sb = b % 1024, swz = sb ^ (((sb >> 9) & 1) << 5); R = (st >> 1) * 16 + swz / 64; C = (st & 1) * 32 + (swz % 64) / 2; }
struct Unit { int pm, pn; };
struct Gemm { const bf16_t* A; const bf16_t* Bt; int M, N, K; };
struct StaticOrder {
    int nM, nN, nwg, G, c;
    DI void init(int M, int N, int G_, int c_) { nM = M / BM; nN = N / BM; nwg = nM * nN; G = G_; c = c_; }
    DI bool next(int i, Unit& u) const {
        const long L = (long)i * G + c; if (L >= nwg) return false;
        int wgid = (int)L; { const int q = nwg / NXCD, r = nwg % NXCD, xcd = wgid % NXCD, off = wgid / NXCD; wgid = (xcd < r ? xcd * (q + 1) : r * (q + 1) + (xcd - r) * q) + off; }
        const int nig = WGM * nN, gid = wgid / nig, fm = gid * WGM, gsz = (nM - fm) < WGM ? (nM - fm) : WGM;
        u.pm = fm + ((wgid % nig) % gsz); u.pn = (wgid % nig) / gsz; return true;
    }
};

template <class Epi>
DI void gemm_phase(LAS unsigned char* lds, const Gemm g, const StaticOrder& S, const Epi& E, int tid_in) {
    const int tid = tid_in, wid = __builtin_amdgcn_readfirstlane(tid >> 6), lane = tid & 63, wr = wid >> 2, wc = wid & 3, fr = lane & 15, fq = lane >> 4;
    const int K = g.K, nt = K / BK;
    unsigned voffA[2];
#pragma unroll
    for (int i = 0; i < 2; ++i) { int R, C; stage_rc(tid * 16 + i * 8192, R, C); voffA[i] = (unsigned)(R * K + C) * 2u; }
    const size_t kstep = (size_t)(BK * 2);
    const size_t hstep = (size_t)HALF * K * 2;
    const size_t tstep = 2 * hstep;
    const unsigned ldsw = (unsigned)wid * 1024u;
    const int aoff = lds_byte(wr * 64 + fr, fq * 8), boff = lds_byte(wc * 32 + fr, fq * 8);
#define PG8_SA(b, h) (((b) * 2 + (h)) * HTB)
#define PG8_SB(b, h) ((4 + (b) * 2 + (h)) * HTB)
#define PG8_STAGE(bufoff, gbase) do { _Pragma("unroll") for (int _i = 0; _i < 2; ++_i) \
        __builtin_amdgcn_global_load_lds((const unsigned*)((const char*)(gbase) + voffA[_i]), (LAS unsigned*)(lds + (bufoff) + ldsw + _i * 8192), 16, 0, 0); } while (0)
#define PG8_LDA(dst, b, h) do { _Pragma("unroll") for (int m = 0; m < 4; ++m) _Pragma("unroll") for (int k = 0; k < 2; ++k) dst[m][k] = *(const LAS bf16x8*)(lds + PG8_SA(b, h) + aoff + m * 2048 + k * 1024); } while (0)
#define PG8_LDB(dst, b, h) do { _Pragma("unroll") for (int n = 0; n < 2; ++n) _Pragma("unroll") for (int k = 0; k < 2; ++k) dst[n][k] = *(const LAS bf16x8*)(lds + PG8_SB(b, h) + boff + n * 2048 + k * 1024); } while (0)
#define PG8_MMA(ai, bj, At, Bt) do { __builtin_amdgcn_s_setprio(1); _Pragma("unroll") for (int m = 0; m < 4; ++m) _Pragma("unroll") for (int n = 0; n < 2; ++n) _Pragma("unroll") for (int k = 0; k < 2; ++k) \
        acc[ai][bj][m][n] = __builtin_amdgcn_mfma_f32_16x16x32_bf16(Bt[n][k], At[m][k], acc[ai][bj][m][n], 0, 0, 0); __builtin_amdgcn_s_setprio(0); } while (0)
#define PG8_WAIT_V(n) asm volatile("s_waitcnt vmcnt(" #n ")" ::: "memory")
#define PG8_WAIT_L(n) asm volatile("s_waitcnt lgkmcnt(" #n ")" ::: "memory")
#define PG8_BAR __builtin_amdgcn_s_barrier()
#define PG8_SCHED __builtin_amdgcn_sched_barrier(0)
    Unit cur, nxt; int ui = 0;
    if (!S.next(0, cur)) return;
    f32x4 acc[2][2][4][2];
#pragma unroll
    for (int a = 0; a < 2; ++a)
#pragma unroll
        for (int b = 0; b < 2; ++b)
#pragma unroll
            for (int m = 0; m < 4; ++m)
#pragma unroll
                for (int n = 0; n < 2; ++n) acc[a][b][m][n] = (f32x4){0.f, 0.f, 0.f, 0.f};
    bf16x8 At[4][2], B0[2][2], B1[2][2];
    const char* cA = (const char*)g.A + (size_t)cur.pm * tstep; const char* cB = (const char*)g.Bt + (size_t)cur.pn * tstep;
    PG8_STAGE(PG8_SB(0, 0), cB); PG8_STAGE(PG8_SB(0, 1), cB + hstep); PG8_STAGE(PG8_SA(0, 0), cA); PG8_STAGE(PG8_SA(0, 1), cA + hstep);
    if (wr == 1) PG8_BAR;
    PG8_WAIT_V(2); PG8_BAR;
    PG8_STAGE(PG8_SB(1, 0), cB + kstep); PG8_STAGE(PG8_SA(1, 0), cA + kstep); PG8_STAGE(PG8_SB(1, 1), cB + hstep + kstep);
    PG8_WAIT_V(6); PG8_BAR;
    for (;;) {
        const bool has_next = S.next(ui + 1, nxt);
        const char* nA = has_next ? (const char*)g.A + (size_t)nxt.pm * tstep : cA; const char* nB = has_next ? (const char*)g.Bt + (size_t)nxt.pn * tstep : cB;
        for (int t = 0; t < nt; t += 2) {
            const bool last = (t == nt - 2);
            const char* a1 = cA + (size_t)(t + 1) * kstep;
            const char* a2 = last ? nA : cA + (size_t)(t + 2) * kstep; const char* b2 = last ? nB : cB + (size_t)(t + 2) * kstep;
            const char* a3 = a2 + kstep; const char* b3 = b2 + kstep;
            PG8_LDB(B0, 0, 0); PG8_LDB(B1, 0, 1); PG8_SCHED; PG8_LDA(At, 0, 0); PG8_STAGE(PG8_SA(1, 1), a1 + hstep);
            PG8_WAIT_V(8); PG8_WAIT_L(0); PG8_BAR; PG8_MMA(0, 0, At, B0); PG8_MMA(0, 1, At, B1); PG8_BAR; PG8_SCHED;
            PG8_LDA(At, 0, 1); PG8_STAGE(PG8_SB(0, 0), b2); PG8_STAGE(PG8_SB(0, 1), b2 + hstep); PG8_STAGE(PG8_SA(0, 0), a2);
            PG8_WAIT_V(8); PG8_WAIT_L(0); PG8_BAR; PG8_MMA(1, 0, At, B0); PG8_MMA(1, 1, At, B1); PG8_BAR; PG8_SCHED;
            PG8_LDB(B0, 1, 0); PG8_LDB(B1, 1, 1); PG8_SCHED; PG8_LDA(At, 1, 0); PG8_STAGE(PG8_SA(0, 1), a2 + hstep);
            PG8_WAIT_V(8); PG8_WAIT_L(0); PG8_BAR; PG8_MMA(0, 0, At, B0); PG8_MMA(0, 1, At, B1); PG8_BAR; PG8_SCHED;
            PG8_LDA(At, 1, 1); PG8_STAGE(PG8_SB(1, 0), b3); PG8_STAGE(PG8_SB(1, 1), b3 + hstep); PG8_STAGE(PG8_SA(1, 0), a3);
            PG8_WAIT_V(8); PG8_WAIT_L(0); PG8_BAR; PG8_MMA(1, 0, At, B0); PG8_MMA(1, 1, At, B1); PG8_BAR; PG8_SCHED;
        }
        if (wr == 0) PG8_BAR;
        E(acc, cur, wr, wc, fr, fq);
        if (!has_next) break;
#pragma unroll
        for (int a = 0; a < 2; ++a)
#pragma unroll
            for (int b = 0; b < 2; ++b)
#pragma unroll
                for (int m = 0; m < 4; ++m)
#pragma unroll
                    for (int n = 0; n < 2; ++n) acc[a][b][m][n] = (f32x4){0.f, 0.f, 0.f, 0.f};
        cur = nxt; cA = nA; cB = nB; ++ui;
        if (wr == 1) PG8_BAR;
    }
    PG8_WAIT_V(0);
    PG8_BAR;
#undef PG8_SA
#undef PG8_SB
#undef PG8_STAGE
#undef PG8_LDA
#undef PG8_LDB
#undef PG8_MMA
#undef PG8_WAIT_V
#undef PG8_WAIT_L
#undef PG8_BAR
#undef PG8_SCHED
}
}

struct EpiIn {
    bf16_t *Qb, *Kb, *Vb, *zb; float *outK, *outV; const f32x2* rope; int layer;
    DI void operator()(const f32x4 (&acc)[2][2][4][2], const pg8::Unit& u, int wr, int wc, int fr, int fq) const {
        const int tile = u.pn; const bool sample = u.pm >= 32;
        if (tile < 6) {
            const int kind = tile >> 1; const int cb = (tile & 1) * 256 + wc * 32 + 4 * fq;
            bf16_t* dst = Qb + (size_t)kind * (16u * 1024u * 1024u / 2u);
            float* of = outK + (size_t)(kind >= 1 ? kind - 1 : 0) * 16777216u;
#pragma unroll
            for (int ai = 0; ai < 2; ++ai)
#pragma unroll
                for (int m = 0; m < 4; ++m) {
                    const int r = u.pm * 256 + ai * 128 + wr * 64 + m * 16 + fr;
#pragma unroll
                    for (int bj = 0; bj < 2; ++bj) {
                        f32x4 a = acc[ai][bj][m][0], b = acc[ai][bj][m][1]; const int cc = cb + bj * 128;
                        if (!sample && kind >= 1) { float* o = of + ((size_t)((r >> 8) * 4 + layer) * 256 + (r & 255)) * 512 + cc; *(f32x4*)o = a; *(f32x4*)(o + 16) = b; }
                        if (sample && kind < 2) {
                            const int t = (r - 8192) & 4095; const int pos = (wc & 1) ? (t & 63) : (t >> 6); const f32x2* rp = rope + pos * 16 + 4 * fq;
#pragma unroll
                            for (int j = 0; j < 4; ++j) { const f32x2 cs = rp[j]; const float x1 = a[j], x2 = b[j]; a[j] = x1 * cs.x - x2 * cs.y; b[j] = x2 * cs.x + x1 * cs.y; }
                        }
                        if (kind == 0) { a = a * QSCALE; b = b * QSCALE; }
                        if (kind == 2) {
                            const int hh = cc >> 7, dv0 = cc & 127, tt = sample ? ((r - 8192) & 4095) : (r & 255);
                            bf16_t* vt = sample ? Vb + 4194304 + ((size_t)((((r - 8192) >> 12) * 4 + hh) * 32 + (tt >> 7)) * 128 + dv0) * 128 + (tt & 127)
                                                : Vb + ((size_t)(((r >> 8) * 4 + hh) * 2 + (tt >> 7)) * 128 + dv0) * 128 + (tt & 127);
#pragma unroll
                            for (int j = 0; j < 4; ++j) { vt[(size_t)j * 128] = f2bf(a[j]); vt[(size_t)(16 + j) * 128] = f2bf(b[j]); }
                        } else { *(u32x2*)(dst + (size_t)r * 512 + cc) = pack4(a); *(u32x2*)(dst + (size_t)r * 512 + cc + 16) = pack4(b); }
                    }
                    asm volatile("" ::: "memory");
                }
        } else {
#pragma unroll
            for (int ai = 0; ai < 2; ++ai)
#pragma unroll
                for (int m = 0; m < 4; ++m) {
                    const int r = u.pm * 256 + ai * 128 + wr * 64 + m * 16 + fr;
#pragma unroll
                    for (int bj = 0; bj < 2; ++bj)
#pragma unroll
                        for (int n = 0; n < 2; ++n) { const int c = (tile - 6) * 256 + bj * 128 + wc * 32 + 16 * n + 4 * fq; if (c < ZLD) *(u32x2*)(zb + (size_t)r * ZLD + c) = pack4(acc[ai][bj][m][n]); }
                    asm volatile("" ::: "memory");
                }
        }
    }
};
struct EpiRes {
    float* x; const float* gate; bf16_t* vb;
    DI void operator()(const f32x4 (&acc)[2][2][4][2], const pg8::Unit& u, int wr, int wc, int fr, int fq) const {
        const float* gv = gate + row_mod(u.pm * 256) * 6144;
#pragma unroll
        for (int ai = 0; ai < 2; ++ai)
#pragma unroll
            for (int m = 0; m < 4; ++m) {
                const int r = u.pm * 256 + ai * 128 + wr * 64 + m * 16 + fr;
#pragma unroll
                for (int bj = 0; bj < 2; ++bj)
#pragma unroll
                    for (int n = 0; n < 2; ++n) { const int c = u.pn * 256 + bj * 128 + wc * 32 + 16 * n + 4 * fq; const f32x4 g4 = *(const f32x4*)(gv + c); const u32x2 xw = *(const u32x2*)((const bf16_t*)x + (size_t)r * DM + c); const f32x4 xv = (f32x4){__uint_as_float(xw.x << 16), __uint_as_float(xw.x & 0xffff0000u), __uint_as_float(xw.y << 16), __uint_as_float(xw.y & 0xffff0000u)}; *(u32x2*)(vb + (size_t)r * DM + c) = pack4(xv * ALPHA + g4 * acc[ai][bj][m][n]); }
            }
    }
};
struct EpiFfn {
    bf16_t* act;
    DI void operator()(const f32x4 (&acc)[2][2][4][2], const pg8::Unit& u, int wr, int wc, int fr, int fq) const {
#pragma unroll
        for (int ai = 0; ai < 2; ++ai)
#pragma unroll
            for (int m = 0; m < 4; ++m) {
                const int r = u.pm * 256 + ai * 128 + wr * 64 + m * 16 + fr;
#pragma unroll
                for (int n = 0; n < 2; ++n) { const f32x4 gt = acc[ai][0][m][n], up = acc[ai][1][m][n]; f32x4 o;
#pragma unroll
                    for (int j = 0; j < 4; ++j) o[j] = siluf_(gt[j]) * up[j];
                    *(u32x2*)(act + (size_t)r * DFF + u.pn * 128 + wc * 32 + 16 * n + 4 * fq) = pack4(o); }
            }
    }
};

struct Ctx {
    const Params* p; LAS unsigned char* lds; float* L; int tid, lane, wave, G, gw, NGW;
    unsigned char* ws; float* out;
};

DI void tr_item(const float* W, int K, int N, bf16_t* WT, int mode, float* scr, int item, int lane) {
    const int nblk = (N + 31) / 32, kb = item / nblk, nb = item % nblk, k0 = 64 * kb, n0 = 32 * nb;
    const int nn = n0 + (lane & 31);
#pragma unroll 8
    for (int i = 0; i < 32; ++i) { const int kk = 2 * i + (lane >> 5); scr[kk * 33 + (lane & 31)] = (nn < N) ? W[(size_t)(k0 + kk) * N + nn] : 0.f; }
    __builtin_amdgcn_wave_barrier();
    const int c = lane & 7;
#pragma unroll
    for (int j = 0; j < 4; ++j) {
        const int nl = (lane >> 3) + 8 * j, n = n0 + nl; const float* s = scr + (8 * c) * 33 + nl;
        if (n < N) {
            int dst = n; if (mode == 1) { if (n < DFF) dst = (n >> 7) * 256 + (n & 127); else { const int jj = n - DFF; dst = (jj >> 7) * 256 + 128 + (jj & 127); } }
            u32x4 o; o.x = cvt_pk_bf16(s[0 * 33], s[1 * 33]); o.y = cvt_pk_bf16(s[2 * 33], s[3 * 33]); o.z = cvt_pk_bf16(s[4 * 33], s[5 * 33]); o.w = cvt_pk_bf16(s[6 * 33], s[7 * 33]);
            *(u32x4*)(WT + (size_t)dst * K + k0 + 8 * c) = o;
        }
    }
    __builtin_amdgcn_wave_barrier();
}
DI void convert_layer_weights(const Ctx& C, int layer, int gw0 = -1, int ngw = 0, int blk = -1, int nblk = 0) {
    const Params& p = *C.p;
    unsigned char* wb = C.ws + WS_W + (size_t)(layer & 1) * WBUF;
    bf16_t* Win = (bf16_t*)(wb + W_IN); bf16_t* Wout = (bf16_t*)(wb + W_OUT); bf16_t* Wffi = (bf16_t*)(wb + W_FFI); bf16_t* Wffo = (bf16_t*)(wb + W_FFO);
    float* scr = C.L + C.wave * (64 * 33);
    constexpr int I_IN = 16 * 121, I_OUT = 16 * 32, I_FFI = 16 * 176, I_FFO = 44 * 32, NIT = I_IN + I_OUT + I_FFI + I_FFO;
    int lane_ = C.lane; asm volatile("" : "+v"(lane_));
    const int gwA = gw0 >= 0 ? gw0 : C.gw, ngwA = gw0 >= 0 ? ngw : C.NGW, blkA = blk >= 0 ? blk : (int)blockIdx.x, nblkA = blk >= 0 ? nblk : C.G;
    for (int it = gwA; it < NIT; it += ngwA) {
        int r = it;
        if (r < I_IN) { tr_item(p.in[10] + (size_t)layer * DM * DIN, DM, DIN, Win, 0, scr, r, lane_); continue; } r -= I_IN;
        if (r < I_OUT) { tr_item(p.in[19] + (size_t)layer * DM * DM, DM, DM, Wout, 0, scr, r, lane_); continue; } r -= I_OUT;
        if (r < I_FFI) { tr_item(p.in[22] + (size_t)layer * DM * 2 * DFF, DM, 2 * DFF, Wffi, 1, scr, r, lane_); continue; } r -= I_FFI;
        tr_item(p.in[23] + (size_t)layer * DFF * DM, DFF, DM, Wffo, 0, scr, r, lane_);
    }
    u32x4* z = (u32x4*)(Win + (size_t)DIN * DM); const int nz = 240 * DM * 2 / 16;
    for (int i = blkA * 512 + C.tid; i < nz; i += nblkA * 512) z[i] = (u32x4){0u, 0u, 0u, 0u};
}

DI void mod_unit(const Ctx& C, int u) {
    const Params& p = *C.p; const int tid = C.tid;
    float* cs = C.L; float* red = C.L + 3072;
    const int layer = u >> 6, col0 = (u & 63) * 96;
    __syncthreads();
    for (int i = tid; i < 3072; i += 512) { const int v = i >> 10, k = i & 1023; const float c = (v == 0) ? p.in[7][k] : p.in[6][(v - 1) * 1024 + k]; cs[i] = siluf_(c); }
    __syncthreads();
    if (tid < 504) {
        const int cgp = tid % 24, rs = tid / 24;
        f32x4 a0 = {0, 0, 0, 0}, a1 = a0, a2 = a0;
        const float* Wp = p.in[8] + (size_t)layer * DM * 6144 + col0 + cgp * 4;
#pragma unroll 7
        for (int k = rs; k < 1024; k += 21) { const f32x4 w = *(const f32x4*)(Wp + (size_t)k * 6144); a0 += w * cs[k]; a1 += w * cs[1024 + k]; a2 += w * cs[2048 + k]; }
        float* rr = red + rs * 288 + cgp * 4;
#pragma unroll
        for (int j = 0; j < 4; ++j) { rr[j] = a0[j]; rr[96 + j] = a1[j]; rr[192 + j] = a2[j]; }
    }
    __syncthreads();
    if (tid < 288) {
        const int v = tid / 96, cc = tid % 96; float s = 0.f;
        for (int rs = 0; rs < 21; ++rs) s += red[rs * 288 + tid];
        ((float*)(C.ws + WS_MOD))[(size_t)(layer * 3 + v) * 6144 + col0 + cc] = s + p.in[9][layer * 6144 + col0 + cc];
    }
}

DI void phase0a(const Ctx& C) {
    const Params& p = *C.p;
    for (int u = blockIdx.x; u < 256; u += C.G) mod_unit(C, u);
    __syncthreads();
    convert_layer_weights(C, 0);
    const int gt = blockIdx.x * 512 + C.tid, NT = C.G * 512;
    float* tab = (float*)(C.ws + WS_TAB);
    if (gt < 1024) { const int pos = gt >> 4, i = gt & 15; const float inv = __builtin_amdgcn_exp2f(-(float)i * (13.287712379549449f / 16.0f)); float rev = (float)pos * inv * 0.15915494309189535f; rev -= floorf(rev);
        tab[2 * gt] = __builtin_amdgcn_cosf(rev); tab[2 * gt + 1] = __builtin_amdgcn_sinf(rev); }
    if (gt >= 1024 && gt < 1028) { const int l = gt - 1024; const float* dl = p.in[17] + l * 256; float s01 = 0.f, s23 = 0.f; for (int i = 0; i < 64; ++i) { s01 += dl[i] * dl[64 + i]; s23 += dl[128 + i] * dl[192 + i]; }
        tab[2048 + l] = __expf(s01) - __expf(s23) + (0.8f - 0.6f * __expf(-0.3f * (float)l)); }
    if (gt >= 2048 && gt < 2560) { const int dir = (gt - 2048) >> 8, c = gt & 255; const float* lb = p.in[15] + dir * 1024 + c; float v[4], mx = -1e30f; for (int l = 0; l < 4; ++l) { v[l] = lb[l * 256]; mx = fmaxf(mx, v[l]); }
        float s = 0.f; for (int l = 0; l < 4; ++l) { v[l] = __expf(v[l] - mx); s += v[l]; } float cum = 0.f; for (int l = 0; l < 4; ++l) { if (l > 0) cum += v[l] / s; tab[4096 + (dir * 4 + l) * 256 + c] = cum; } }
    bf16_t* ck = (bf16_t*)(C.ws + WS_CK); bf16_t* cv = (bf16_t*)(C.ws + WS_CV);
    for (int i = gt; i < 2 * 4 * 256 * 512 / 4; i += NT) { const int e = i * 4; const int c = e & 511, j = (e >> 9) & 255, l = (e >> 17) & 3, b = e >> 19;
        const size_t dst = ((size_t)((l * 2 + b) * 256 + j)) * 512 + c;
        *(u32x2*)(ck + dst) = pack4(*(const f32x4*)(p.in[2] + e)); }
    for (int i = gt; i < 2 * 4 * 256 * 512; i += NT) { const int j = i & 255, dv = (i >> 8) & 127, hh = (i >> 15) & 3, b = (i >> 17) & 1, l = i >> 18;
        cv[((size_t)((((l * 2 + b) * 4 + hh) * 2 + (j >> 7)) * 128 + dv)) * 128 + (j & 127)] = f2bf(p.in[3][((size_t)((b * 4 + l) * 256 + j) * 4 + hh) * 128 + dv]); }
}

DI void row_pass(const Ctx& C, int mode, const float* lng, const float* lnb, const float* modl, int sc_off, int sh_off, bool write_xm) {
    const Params& p = *C.p; float* x = C.out; bf16_t* xm = (bf16_t*)(C.ws + WS_XM);
    for (int r0 = C.gw; r0 < MROWS; r0 += 2 * C.NGW) {
        f32x4 v[2][4];
#pragma unroll
        for (int u = 0; u < 2; ++u) { const int r = r0 + u * C.NGW;
            if (mode == 0) { const float* src = (r < 8192 ? p.in[0] + (size_t)r * DM : p.in[1] + (size_t)(r - 8192) * DM);
#pragma unroll
                for (int j = 0; j < 4; ++j) v[u][j] = *(const f32x4*)(src + 4 * C.lane + 256 * j); }
            else {
#pragma unroll
                for (int j = 0; j < 4; ++j) { const u32x2 w2 = *(const u32x2*)(xm + (size_t)r * DM + 4 * C.lane + 256 * j);
                    v[u][j] = (f32x4){__uint_as_float(w2.x << 16), __uint_as_float(w2.x & 0xffff0000u), __uint_as_float(w2.y << 16), __uint_as_float(w2.y & 0xffff0000u)}; } } }
#pragma unroll
        for (int u = 0; u < 2; ++u) { const int r = r0 + u * C.NGW;
            if (mode == 1) {
                float s = 0.f;
#pragma unroll
                for (int j = 0; j < 4; ++j) s += (v[u][j][0] + v[u][j][1]) + (v[u][j][2] + v[u][j][3]);
                const float mean = wave_sum(s) * (1.f / DM); float s2 = 0.f;
#pragma unroll
                for (int j = 0; j < 4; ++j) { v[u][j] = v[u][j] - mean; s2 += (v[u][j][0] * v[u][j][0] + v[u][j][1] * v[u][j][1]) + (v[u][j][2] * v[u][j][2] + v[u][j][3] * v[u][j][3]); }
                const float rstd = 1.0f / sqrtf(wave_sum(s2) * (1.f / DM) + LN_EPS);
#pragma unroll
                for (int j = 0; j < 4; ++j) { const f32x4 g4 = *(const f32x4*)(lng + 4 * C.lane + 256 * j), b4 = *(const f32x4*)(lnb + 4 * C.lane + 256 * j); v[u][j] = v[u][j] * rstd * g4 + b4; }
            }
            if (PROBE_A >= 0 && !write_xm) { const float* tsf = (const float*)(C.ws + WS_TAB + 131072); const float sc = 1.0f + ((r >= 8192) ? tsf[12] : (PROBE_B >= 0 ? tsf[13] : 0.f));
#pragma unroll
                for (int j = 0; j < 4; ++j) v[u][j] = v[u][j] * sc; }
            if (!write_xm) {
#pragma unroll
                for (int j = 0; j < 4; ++j) *(f32x4*)(x + (size_t)r * DM + 4 * C.lane + 256 * j) = v[u][j];
            } else {
#pragma unroll
                for (int j = 0; j < 4; ++j) *(u32x2*)((bf16_t*)x + (size_t)r * DM + 4 * C.lane + 256 * j) = pack4(v[u][j]);
            }
            if (write_xm) {
                const float* mv = modl + row_mod(r) * 6144;
#pragma unroll
                for (int j = 0; j < 4; ++j) { const int c = 4 * C.lane + 256 * j; const f32x4 sc = *(const f32x4*)(mv + sc_off + c), sh = *(const f32x4*)(mv + sh_off + c);
                    *(u32x2*)(xm + (size_t)r * DM + c) = pack4(v[u][j] * (sc + 1.0f) + sh); }
            }
        }
    }
}

#define MFMA32(a, b, c) __builtin_amdgcn_mfma_f32_32x32x16_bf16((a), (b), (c), 0, 0, 0)
#define MFMA16(a, b, c) __builtin_amdgcn_mfma_f32_16x16x32_bf16((a), (b), (c), 0, 0, 0)
constexpr int AK_LD = 72, AV_LD = 136;
struct AttnSrc { const bf16_t* Klat; const bf16_t* Kctx; const bf16_t* VTlat; const bf16_t* VTctx; int ldv; int nst; int nlat; int h; };
template <int PASS>
DI void attn_pass(int tid, int q, int hi, int kq, const AttnSrc& A, LAS bf16_t* K1s, LAS bf16_t* K2s, LAS bf16_t* VTs, const bf16x8 (&q1)[4], const bf16x8 (&q2)[4],
                  float& m1, float& l1, float& m2, float& l2, float iL1, float iL2, f32x16 (&o)[4]) {
    u32x4 kreg[4], vreg[4];
    const int h = A.h;
    auto issue = [&](int st) {
        const bf16_t* kb = (st < A.nlat) ? A.Klat + (size_t)st * 128 * 512 : A.Kctx + (size_t)(st - A.nlat) * 128 * 512;
#pragma unroll
        for (int i = 0; i < 2; ++i) { const int id = tid + 512 * i, key = id >> 3, ch = id & 7; kreg[i] = *(const u32x4*)(kb + (size_t)key * 512 + h * 128 + ch * 8); kreg[2 + i] = *(const u32x4*)(kb + (size_t)key * 512 + h * 128 + 64 + ch * 8); }
        if (PASS == 1) {
            const bf16_t* vb = (st < A.nlat) ? A.VTlat + (size_t)st * 128 : A.VTctx + (size_t)(st - A.nlat) * 128; const int ld = (st < A.nlat) ? A.ldv : 256;
#pragma unroll
            for (int i = 0; i < 4; ++i) { const int id = tid + 512 * i, dv = id >> 4, ch = id & 15; vreg[i] = *(const u32x4*)(vb + (size_t)dv * ld + ch * 8); }
        }
    };
    issue(0);
    for (int st = 0; st < A.nst; ++st) {
        __syncthreads();
#pragma unroll
        for (int i = 0; i < 2; ++i) { const int id = tid + 512 * i, key = id >> 3, ch = id & 7; *(LAS u32x4*)(K1s + key * AK_LD + ch * 8) = kreg[i]; *(LAS u32x4*)(K2s + key * AK_LD + ch * 8) = kreg[2 + i]; }
        if (PASS == 1) {
#pragma unroll
            for (int i = 0; i < 4; ++i) { const int id = tid + 512 * i, dv = id >> 4, ch = id & 15; *(LAS u32x4*)(VTs + dv * AV_LD + ch * 8) = vreg[i]; }
        }
        __syncthreads();
        if (st + 1 < A.nst) issue(st + 1);
        const int keyrow = kq * 32 + q;
        f32x16 s1, pr;
#pragma unroll
        for (int r = 0; r < 16; ++r) s1[r] = 0.f;
#pragma unroll
        for (int ks = 0; ks < 4; ++ks) { const bf16x8 a1 = *(const LAS bf16x8*)(K1s + keyrow * AK_LD + 16 * ks + 8 * hi); s1 = MFMA32(a1, q1[ks], s1); }
        if (PASS == 0) {
            float mx1 = s1[0];
#pragma unroll
            for (int r = 1; r < 16; ++r) mx1 = fmaxf(mx1, s1[r]);
            const float n1 = fmaxf(m1, mx1); float a1s = 0.f;
#pragma unroll
            for (int r = 0; r < 16; ++r) a1s += __builtin_amdgcn_exp2f(s1[r] - n1);
            l1 = l1 * __builtin_amdgcn_exp2f(m1 - n1) + a1s; m1 = n1;
        } else {
#pragma unroll
            for (int r = 0; r < 16; ++r) pr[r] = __builtin_amdgcn_exp2f(s1[r] - m1) * iL1;
        }
#pragma unroll
        for (int r = 0; r < 16; ++r) s1[r] = 0.f;
#pragma unroll
        for (int ks = 0; ks < 4; ++ks) { const bf16x8 a2 = *(const LAS bf16x8*)(K2s + keyrow * AK_LD + 16 * ks + 8 * hi); s1 = MFMA32(a2, q2[ks], s1); }
        if (PASS == 0) {
            float mx2 = s1[0];
#pragma unroll
            for (int r = 1; r < 16; ++r) mx2 = fmaxf(mx2, s1[r]);
            const float n2 = fmaxf(m2, mx2); float a2s = 0.f;
#pragma unroll
            for (int r = 0; r < 16; ++r) a2s += __builtin_amdgcn_exp2f(s1[r] - n2);
            l2 = l2 * __builtin_amdgcn_exp2f(m2 - n2) + a2s; m2 = n2;
        } else {
#pragma unroll
            for (int r = 0; r < 16; ++r) pr[r] -= __builtin_amdgcn_exp2f(s1[r] - m2) * iL2;
            bf16x8 pb[2];
            { u32x4 t0, t1; t0.x = cvt_pk_bf16(pr[0], pr[1]); t0.y = cvt_pk_bf16(pr[2], pr[3]); t0.z = cvt_pk_bf16(pr[4], pr[5]); t0.w = cvt_pk_bf16(pr[6], pr[7]);
              t1.x = cvt_pk_bf16(pr[8], pr[9]); t1.y = cvt_pk_bf16(pr[10], pr[11]); t1.z = cvt_pk_bf16(pr[12], pr[13]); t1.w = cvt_pk_bf16(pr[14], pr[15]);
              pb[0] = __builtin_bit_cast(bf16x8, t0); pb[1] = __builtin_bit_cast(bf16x8, t1); }
#pragma unroll
            for (int blk = 0; blk < 4; ++blk)
#pragma unroll
                for (int s = 0; s < 2; ++s) {
                    const LAS bf16_t* vp = VTs + (blk * 32 + q) * AV_LD + kq * 32 + 16 * s + 4 * hi;
                    const s16x4 lo = *(const LAS s16x4*)vp, hh = *(const LAS s16x4*)(vp + 8);
                    const bf16x8 av = __builtin_shufflevector(lo, hh, 0, 1, 2, 3, 4, 5, 6, 7);
                    o[blk] = MFMA32(av, pb[s], o[blk]);
                }
        }
    }
}
DI void attn_unit(const Ctx& C, int layer, int uidx) {
    int tid = C.tid; asm volatile("" : "+v"(tid)); const int lane = tid & 63, w = __builtin_amdgcn_readfirstlane(tid >> 6), qg = w & 3, kh = w >> 2, q = lane & 15, g = lane >> 4;
    const bf16_t* Qb = (const bf16_t*)(C.ws + WS_Q); const bf16_t* Kb = (const bf16_t*)(C.ws + WS_K); const bf16_t* VT = (const bf16_t*)(C.ws + WS_V);
    const bf16_t* cK = (const bf16_t*)(C.ws + WS_CK); const bf16_t* cVT = (const bf16_t*)(C.ws + WS_CV);
    int b, h, rowq0; AttnSrc A;
    if (uidx < 512) { b = uidx >> 8; h = (uidx >> 6) & 3; const int qb = uidx & 63; rowq0 = 8192 + b * 4096 + qb * 64; A.nst = 34; A.nlat = 32; A.ldv = 4096;
        A.Klat = Kb + (size_t)(8192 + b * 4096) * 512; A.VTlat = VT + 4194304 + (size_t)((b * 4 + h) * 32) * 16384; A.Kctx = cK + (size_t)((layer * 2 + b) * 256) * 512; A.VTctx = cVT + (size_t)(((layer * 2 + b) * 4 + h) * 2) * 16384; }
    else { const int v = uidx - 512; b = v >> 4; h = (v >> 2) & 3; const int qb = v & 3; rowq0 = b * 256 + qb * 64; A.nst = 2; A.nlat = 2; A.ldv = 256;
        A.Klat = Kb + (size_t)(b * 256) * 512; A.VTlat = VT + (size_t)((b * 4 + h) * 2) * 16384; A.Kctx = A.Klat; A.VTctx = A.VTlat; }
    A.h = h;
    LAS bf16_t* K1s = (LAS bf16_t*)C.lds; LAS bf16_t* K2s = K1s + 128 * AK_LD; LAS bf16_t* VTs = K2s + 128 * AK_LD;
    const float lam = ((const float*)(C.ws + WS_TAB))[2048 + layer];
    bf16x8 qf1[2], qf2[2];
    { const bf16_t* qp = Qb + (size_t)(rowq0 + 16 * qg + q) * 512 + h * 128 + 8 * g;
#pragma unroll
      for (int ks = 0; ks < 2; ++ks) { qf1[ks] = *(const bf16x8*)(qp + 32 * ks); qf2[ks] = *(const bf16x8*)(qp + 64 + 32 * ks); } }
    float m1 = -1e30f, l1 = 0.f, m2 = -1e30f, l2 = 0.f;
    f32x4 O1[8], O2[8];
#pragma unroll
    for (int t = 0; t < 8; ++t) { O1[t] = (f32x4){0.f, 0.f, 0.f, 0.f}; O2[t] = O1[t]; }
    u32x4 kreg[4], vreg[4];
    auto issue = [&](int st) {
        const bf16_t* kb = (st < A.nlat) ? A.Klat + (size_t)st * 128 * 512 : A.Kctx + (size_t)(st - A.nlat) * 128 * 512;
#pragma unroll
        for (int i = 0; i < 2; ++i) { const int id = tid + 512 * i, key = id >> 3, ch = id & 7; kreg[i] = *(const u32x4*)(kb + (size_t)key * 512 + h * 128 + ch * 8); kreg[2 + i] = *(const u32x4*)(kb + (size_t)key * 512 + h * 128 + 64 + ch * 8); }
        const bf16_t* vb = (st < A.nlat) ? A.VTlat + (size_t)st * 16384 : A.VTctx + (size_t)(st - A.nlat) * 16384;
#pragma unroll
        for (int i = 0; i < 4; ++i) { const int id = tid + 512 * i; vreg[i] = *(const u32x4*)(vb + (size_t)id * 8); }
    };
    issue(0);
    for (int st = 0; st < A.nst; ++st) {
        __syncthreads();
#pragma unroll
        for (int i = 0; i < 2; ++i) { const int id = tid + 512 * i, key = id >> 3, ch = id & 7; *(LAS u32x4*)(K1s + key * AK_LD + ch * 8) = kreg[i]; *(LAS u32x4*)(K2s + key * AK_LD + ch * 8) = kreg[2 + i]; }
#pragma unroll
        for (int i = 0; i < 4; ++i) { const int id = tid + 512 * i, dv = id >> 4, ch = id & 15; *(LAS u32x4*)(VTs + dv * AV_LD + ch * 8) = vreg[i]; }
        __syncthreads();
        if (st + 1 < A.nst) issue(st + 1);
#pragma unroll
        for (int kb = 0; kb < 2; ++kb) {
            const int key0 = kh * 64 + kb * 32;
            f32x4 sA0 = {0.f, 0.f, 0.f, 0.f}, sA1 = sA0, sB0 = sA0, sB1 = sA0;
#pragma unroll
            for (int ks = 0; ks < 2; ++ks) {
                const bf16x8 a10 = *(const LAS bf16x8*)(K1s + (key0 + q) * AK_LD + 32 * ks + 8 * g), a11 = *(const LAS bf16x8*)(K1s + (key0 + 16 + q) * AK_LD + 32 * ks + 8 * g);
                const bf16x8 a20 = *(const LAS bf16x8*)(K2s + (key0 + q) * AK_LD + 32 * ks + 8 * g), a21 = *(const LAS bf16x8*)(K2s + (key0 + 16 + q) * AK_LD + 32 * ks + 8 * g);
                sA0 = MFMA16(a10, qf1[ks], sA0); sA1 = MFMA16(a11, qf1[ks], sA1); sB0 = MFMA16(a20, qf2[ks], sB0); sB1 = MFMA16(a21, qf2[ks], sB1);
            }
            float t1 = fmaxf(fmaxf(fmaxf(sA0[0], sA0[1]), fmaxf(sA0[2], sA0[3])), fmaxf(fmaxf(sA1[0], sA1[1]), fmaxf(sA1[2], sA1[3])));
            float t2 = fmaxf(fmaxf(fmaxf(sB0[0], sB0[1]), fmaxf(sB0[2], sB0[3])), fmaxf(fmaxf(sB1[0], sB1[1]), fmaxf(sB1[2], sB1[3])));
            if (__any(t1 > m1 || t2 > m2)) {
                t1 = fmaxf(t1, __shfl_xor(t1, 16)); t1 = fmaxf(t1, __shfl_xor(t1, 32)); t2 = fmaxf(t2, __shfl_xor(t2, 16)); t2 = fmaxf(t2, __shfl_xor(t2, 32));
                const float n1 = fmaxf(m1, t1), n2 = fmaxf(m2, t2); const float f1 = __builtin_amdgcn_exp2f(m1 - n1), f2 = __builtin_amdgcn_exp2f(m2 - n2);
                l1 *= f1; l2 *= f2; m1 = n1; m2 = n2;
#pragma unroll
                for (int t = 0; t < 8; ++t) { O1[t] = O1[t] * f1; O2[t] = O2[t] * f2; }
            }
            f32x4 pA0, pA1, pB0, pB1;
#pragma unroll
            for (int i = 0; i < 4; ++i) { pA0[i] = __builtin_amdgcn_exp2f(sA0[i] - m1); pA1[i] = __builtin_amdgcn_exp2f(sA1[i] - m1); pB0[i] = __builtin_amdgcn_exp2f(sB0[i] - m2); pB1[i] = __builtin_amdgcn_exp2f(sB1[i] - m2); }
            l1 += (pA0[0] + pA0[1]) + (pA0[2] + pA0[3]) + (pA1[0] + pA1[1]) + (pA1[2] + pA1[3]);
            l2 += (pB0[0] + pB0[1]) + (pB0[2] + pB0[3]) + (pB1[0] + pB1[1]) + (pB1[2] + pB1[3]);
            const bf16x8 pb1 = pack8(pA0, pA1), pb2 = pack8(pB0, pB1);
#pragma unroll
            for (int t = 0; t < 8; ++t) {
                const LAS bf16_t* vp = VTs + (16 * t + q) * AV_LD + key0 + 4 * g;
                const s16x4 lo = *(const LAS s16x4*)vp, hh = *(const LAS s16x4*)(vp + 16);
                const bf16x8 av = __builtin_shufflevector(lo, hh, 0, 1, 2, 3, 4, 5, 6, 7);
                O1[t] = MFMA16(av, pb1, O1[t]); O2[t] = MFMA16(av, pb2, O2[t]);
            }
        }
    }
    l1 += __shfl_xor(l1, 16); l1 += __shfl_xor(l1, 32); l2 += __shfl_xor(l2, 16); l2 += __shfl_xor(l2, 32);
    __syncthreads();
    LAS float* comb = (LAS float*)C.lds;
    LAS float* exs = (LAS float*)(C.lds + 65536);
    if (kh == 1) {
#pragma unroll
        for (int t = 0; t < 8; ++t)
#pragma unroll
            for (int i = 0; i < 4; ++i) { comb[(qg * 64 + t * 4 + i) * 64 + lane] = O1[t][i]; comb[(qg * 64 + 32 + t * 4 + i) * 64 + lane] = O2[t][i]; }
        exs[(qg * 4 + 0) * 64 + lane] = m1; exs[(qg * 4 + 1) * 64 + lane] = l1; exs[(qg * 4 + 2) * 64 + lane] = m2; exs[(qg * 4 + 3) * 64 + lane] = l2;
    }
    __syncthreads();
    if (kh == 0) {
        const float om1 = exs[(qg * 4 + 0) * 64 + lane], ol1 = exs[(qg * 4 + 1) * 64 + lane], om2 = exs[(qg * 4 + 2) * 64 + lane], ol2 = exs[(qg * 4 + 3) * 64 + lane];
        const float n1 = fmaxf(m1, om1), n2 = fmaxf(m2, om2);
        const float fa1 = __builtin_amdgcn_exp2f(m1 - n1), fb1 = __builtin_amdgcn_exp2f(om1 - n1), fa2 = __builtin_amdgcn_exp2f(m2 - n2), fb2 = __builtin_amdgcn_exp2f(om2 - n2);
        const float L1 = l1 * fa1 + ol1 * fb1, L2 = l2 * fa2 + ol2 * fb2;
        const float c1a = fa1 / L1, c1b = fb1 / L1, c2a = lam * fa2 / L2, c2b = lam * fb2 / L2;
        float ss = 0.f;
#pragma unroll
        for (int t = 0; t < 8; ++t)
#pragma unroll
            for (int i = 0; i < 4; ++i) { const float v = O1[t][i] * c1a + comb[(qg * 64 + t * 4 + i) * 64 + lane] * c1b - O2[t][i] * c2a - comb[(qg * 64 + 32 + t * 4 + i) * 64 + lane] * c2b; O1[t][i] = v; ss += v * v; }
        ss += __shfl_xor(ss, 16); ss += __shfl_xor(ss, 32);
        const float lam_init = 0.8f - 0.6f * __expf(-0.3f * (float)layer);
        const float sc = (1.0f / sqrtf(ss * (1.0f / 128.0f) + RMS_EPS)) * (1.0f - lam_init);
        const float* dn = C.p->in[18] + layer * 128;
        bf16_t* ob = (bf16_t*)(C.ws + WS_O) + (size_t)(rowq0 + 16 * qg + q) * DM + h * 128;
#pragma unroll
        for (int t = 0; t < 8; ++t) { const int dv = 16 * t + 4 * g; const f32x4 d4 = *(const f32x4*)(dn + dv); *(u32x2*)(ob + dv) = pack4(O1[t] * sc * d4); }
    }
    __syncthreads();
}

DI void delta_prep_unit(const Ctx& C, int layer, int unit) {
    const Params& p = *C.p; int tid = C.tid; asm volatile("" : "+v"(tid)); const int lane = tid & 63, w = __builtin_amdgcn_readfirstlane(tid >> 6);
    const int tc = unit >> 2, h = unit & 3, row0 = tc * 64;
    int ci, nch; if (tc < 128) { ci = tc & 3; nch = 4; } else { ci = (tc - 128) & 63; nch = 64; }
    const bool has_prev = ci > 0, has_next = ci < nch - 1;
    float* qs = C.L; float* kk = C.L + 4160; float* vv = C.L + 8320; float* KK0 = C.L + 12480; float* QK0 = KK0 + 4096; float* Ms = QK0 + 4096; float* bc = Ms + 8192; float* be = bc + 128;
    const bf16_t* zb = (const bf16_t*)(C.ws + WS_ZB);
    const float* cw = p.in[11] + layer * 3 * 768;
    __syncthreads();
    if (tid < 384) {
        const int c = tid % 192, th = tid / 192, which = c >> 6, d = c & 63, col = which * 256 + h * 64 + d;
        const float w0 = cw[col], w1 = cw[768 + col], w2 = cw[1536 + col];
        float xin[34];
#pragma unroll
        for (int i = 0; i < 34; ++i) { const int tt = 32 * th - 1 + i; const bool ok = (tt >= 0 || has_prev) && (tt < 64 || has_next); xin[i] = ok ? bf2f(zb[(size_t)(row0 + tt) * ZLD + col]) : 0.f; }
        float* dstp = (which == 0 ? qs : (which == 1 ? kk : vv)) + d;
#pragma unroll
        for (int i = 0; i < 32; ++i) dstp[(32 * th + i) * 65] = siluf_(w0 * xin[i] + w1 * xin[i + 1] + w2 * xin[i + 2]);
    }
    __syncthreads();
    { const int r = tid >> 2, part = tid & 3; float* base = (r < 64 ? qs + r * 65 : kk + (r - 64) * 65) + part * 16; float ss = 0.f;
#pragma unroll
      for (int i = 0; i < 16; ++i) ss += base[i] * base[i];
      ss += __shfl_xor(ss, 1); ss += __shfl_xor(ss, 2);
      const float sc = (1.0f / sqrtf(ss + 1e-6f)) * (r < 64 ? 0.125f : 1.0f);
#pragma unroll
      for (int i = 0; i < 16; ++i) base[i] *= sc; }
    if (w < 2) {
        const int dir = w, i = lane, tt = dir ? 63 - i : i; const size_t row = (size_t)(row0 + tt);
        const float braw = bf2f(zb[row * ZLD + ZB_BBETA + dir * 4 + h]), araw = bf2f(zb[row * ZLD + ZB_BA + dir * 4 + h]);
        const float A = __expf(p.in[12][layer * 8 + dir * 4 + h]); const float x = araw + p.in[13][layer * 8 + dir * 4 + h];
        const float sp = x > 20.f ? x : log1pf(__expf(x)); float g = -A * sp;
#pragma unroll
        for (int off = 1; off < 64; off <<= 1) { const float t = __shfl_up(g, off); if (lane >= off) g += t; }
        bc[dir * 64 + i] = g; const float bt = sigmoidf_(braw); be[dir * 64 + i] = bt; be[128 + dir * 64 + i] = bt * __expf(g);
    }
    __syncthreads();
    { const int a = tid >> 3, b0 = (tid & 7) * 8; float ka[8], qa[8];
#pragma unroll
      for (int j = 0; j < 8; ++j) { ka[j] = 0.f; qa[j] = 0.f; }
#pragma unroll 4
      for (int d = 0; d < 64; ++d) { const float kav = kk[a * 65 + d], qav = qs[a * 65 + d];
#pragma unroll
          for (int j = 0; j < 8; ++j) { const float kb = kk[(b0 + j) * 65 + d]; ka[j] += kav * kb; qa[j] += qav * kb; } }
#pragma unroll
      for (int j = 0; j < 8; ++j) { KK0[a * 64 + b0 + j] = ka[j]; QK0[a * 64 + b0 + j] = qa[j]; } }
    __syncthreads();
    bf16_t* dpW = (bf16_t*)(C.ws + WS_DPW); bf16_t* dpQD = (bf16_t*)(C.ws + WS_DPQD); bf16_t* dpQK = (bf16_t*)(C.ws + WS_DPQK); bf16_t* dpKD = (bf16_t*)(C.ws + WS_DPKD); bf16_t* dpU = (bf16_t*)(C.ws + WS_DPU);
    float* dpGL = (float*)(C.ws + WS_GL);
    { const int i = tid >> 3, j0 = (tid & 7) * 8;
#pragma unroll
      for (int dir = 0; dir < 2; ++dir) {
          const size_t ud = ((size_t)tc * 4 + h) * 2 + dir;
          const float bi = bc[dir * 64 + i], betai = be[dir * 64 + i]; const int ai = dir ? 63 - i : i;
#pragma unroll
          for (int jj = 0; jj < 8; ++jj) { const int j = j0 + jj, aj = dir ? 63 - j : j;
              const float dec = (j <= i) ? __expf(bi - bc[dir * 64 + j]) : 0.f;
              Ms[dir * 4096 + j * 64 + i] = (j < i) ? betai * KK0[ai * 64 + aj] * dec : 0.f;
              dpQK[ud * 4096 + i * 64 + pinv(j)] = f2bf(QK0[ai * 64 + aj] * dec); }
      } }
    __syncthreads();
    if (w < 4) {
        const int dir = w >> 1, c = (w & 1) * 64 + lane; const size_t ud = ((size_t)tc * 4 + h) * 2 + dir;
        const float* Msd = Ms + dir * 4096; const bool isU = (w & 1) == 0; const float* scp = be + (isU ? 0 : 128) + dir * 64; const float* srcp = (isU ? vv : kk) + lane;
        float x[64];
#pragma unroll
        for (int rb = 0; rb < 4; ++rb) {
            float r[16];
#pragma unroll
            for (int ii = 0; ii < 16; ++ii) { const int i = 16 * rb + ii, tt = dir ? 63 - i : i; r[ii] = scp[i] * srcp[tt * 65]; }
            asm volatile("" ::: "memory");
#pragma unroll
            for (int j = 0; j < 16 * rb; ++j) {
                const float* mp = Msd + j * 64 + 16 * rb;
                const f32x4 ma = *(const f32x4*)mp, mb = *(const f32x4*)(mp + 4), mc = *(const f32x4*)(mp + 8), md = *(const f32x4*)(mp + 12);
                const float xj = x[j];
#pragma unroll
                for (int c4 = 0; c4 < 4; ++c4) { r[c4] -= ma[c4] * xj; r[4 + c4] -= mb[c4] * xj; r[8 + c4] -= mc[c4] * xj; r[12 + c4] -= md[c4] * xj; }
                if ((j & 3) == 3) asm volatile("" ::: "memory");
            }
#pragma unroll
            for (int jj = 0; jj < 16; ++jj) {
                const float xj = r[jj]; x[16 * rb + jj] = xj;
                const float* mp = Msd + (16 * rb + jj) * 64 + 16 * rb;
#pragma unroll
                for (int ii = jj + 1; ii < 16; ++ii) r[ii] -= mp[ii] * xj;
                if ((jj & 3) == 3) asm volatile("" ::: "memory");
            }
        }
        if (c < 64) {
            bf16_t* up = dpU + ud * 4096 + c * 64;
#pragma unroll
            for (int i = 0; i < 64; i += 8) { u32x4 o; o.x = cvt_pk_bf16(x[i], x[i + 1]); o.y = cvt_pk_bf16(x[i + 2], x[i + 3]); o.z = cvt_pk_bf16(x[i + 4], x[i + 5]); o.w = cvt_pk_bf16(x[i + 6], x[i + 7]); *(u32x4*)(up + i) = o; }
        } else {
            bf16_t* wp = dpW + ud * 4096 + pinv(c - 64);
#pragma unroll
            for (int i = 0; i < 64; ++i) wp[i * 64] = f2bf(x[i]);
        }
    } else {
#pragma unroll 4
        for (int it = 0; it < 64; ++it) {
            const int e = (tid - 256) + 256 * it, dir = e >> 13, which = (e >> 12) & 1, rem = e & 4095; const size_t ud = ((size_t)tc * 4 + h) * 2 + dir;
            if (which == 0) { const int i = rem >> 6, d = rem & 63, tt = dir ? 63 - i : i; dpQD[ud * 4096 + i * 64 + pinv(d)] = f2bf(qs[tt * 65 + d] * __expf(bc[dir * 64 + i])); }
            else { const int dk = rem >> 6, i = rem & 63, tt = dir ? 63 - i : i; dpKD[ud * 4096 + dk * 64 + pinv(i)] = f2bf(kk[tt * 65 + dk] * __expf(bc[dir * 64 + 63] - bc[dir * 64 + i])); }
        }
        if (tid == 256 || tid == 257) { const int dir = tid - 256; dpGL[((size_t)tc * 4 + h) * 2 + dir] = __expf(bc[dir * 64 + 63]); }
    }
}

DI void delta_scan_unit(const Ctx& C, int layer, bool sample, int b, int h) {
    const Params& p = *C.p; int tid = C.tid; asm volatile("" : "+v"(tid)); const int lane = tid & 63; const int w = C.wave, dir = w >> 2, sl = w & 3, col = lane & 15, g = lane >> 4;
    const int tc0 = sample ? 128 + b * 64 : b * 4, nch = sample ? 64 : 4;
    const bf16_t* dpU = (const bf16_t*)(C.ws + WS_DPU);
    const float* dpGL = (const float*)(C.ws + WS_GL); float* od = (float*)(C.ws + WS_OD) + (size_t)dir * MROWS * 256;
    f32x4 S[4];
    if (sample) { const float* s0 = p.in[4] + ((((size_t)b * 4 + layer) * 2 + dir) * 4 + h) * 4096;
#pragma unroll
        for (int rb = 0; rb < 4; ++rb)
#pragma unroll
            for (int ii = 0; ii < 4; ++ii) S[rb][ii] = s0[(16 * rb + 4 * g + ii) * 64 + 16 * sl + col]; }
    else {
#pragma unroll
        for (int rb = 0; rb < 4; ++rb) S[rb] = (f32x4){0.f, 0.f, 0.f, 0.f}; }
    u32x4 Ra[8], Rb[8];
#define DS_TC(d_, n_) ((d_) ? tc0 + nch - 1 - (n_) : tc0 + (n_))
#define DS_ISSUE(R, n_) do { _Pragma("unroll") for (int i = 0; i < 8; ++i) { const int id = tid + 512 * i, dm = id >> 9, dd = dm >> 2, mat = dm & 3; \
        const size_t ud_ = ((size_t)DS_TC(dd, n_) * 4 + h) * 2 + dd; R[i] = *(const u32x4*)(C.ws + WS_DPW + (size_t)mat * (16u * MiB) + ud_ * 8192 + (size_t)(id & 511) * 16); } } while (0)
#define DS_WRITE(R, buf_) do { _Pragma("unroll") for (int i = 0; i < 8; ++i) { const int id = tid + 512 * i, dm = id >> 9, row = (id >> 3) & 63, c = id & 7; \
        *(LAS u32x4*)(C.lds + (buf_) * 65536 + dm * 8192 + row * 128 + ((c ^ (row & 7)) * 16)) = R[i]; } } while (0)
#define DS_FRAG(buf_, mat_, rb_, ks_) (*(const LAS bf16x8*)(C.lds + (buf_) * 65536 + (dir * 4 + (mat_)) * 8192 + (16 * (rb_) + col) * 128 + ((((ks_) * 4 + g) ^ (col & 7)) * 16)))
    __syncthreads();
    DS_ISSUE(Ra, 0); DS_WRITE(Ra, 0); DS_ISSUE(Ra, 1);
    s16x4 uuA[4], uuB[4]; float glA, glB;
#define DS_LOADU(uu, gl, n_) do { const size_t ud_ = ((size_t)DS_TC(dir, n_) * 4 + h) * 2 + dir; _Pragma("unroll") for (int rb = 0; rb < 4; ++rb) uu[rb] = *(const s16x4*)(dpU + ud_ * 4096 + (16 * sl + col) * 64 + 16 * rb + 4 * g); gl = dpGL[ud_]; } while (0)
    DS_LOADU(uuA, glA, 0); DS_LOADU(uuB, glB, 1);
    __syncthreads();
#define DS_STEP(n, buf, Rnext, Rcur, uu, gl) do { \
        if ((n) + 2 < nch) DS_ISSUE(Rnext, (n) + 2); \
        const int tc = DS_TC(dir, (n)); \
        bf16x8 Sb[2]; Sb[0] = pack8(S[0], S[1]); Sb[1] = pack8(S[2], S[3]); \
        f32x4 vn[4]; \
        _Pragma("unroll") for (int rb = 0; rb < 4; ++rb) { f32x4 t = (f32x4){0.f, 0.f, 0.f, 0.f}; t = MFMA16(DS_FRAG(buf, 0, rb, 0), Sb[0], t); t = MFMA16(DS_FRAG(buf, 0, rb, 1), Sb[1], t); \
            _Pragma("unroll") for (int ii = 0; ii < 4; ++ii) vn[rb][ii] = bf2f((bf16_t)uu[rb][ii]) - t[ii]; } \
        const float glc = gl; \
        if ((n) + 2 < nch) DS_LOADU(uu, gl, (n) + 2); \
        bf16x8 vb[2]; vb[0] = pack8(vn[0], vn[1]); vb[1] = pack8(vn[2], vn[3]); \
        const int rowb = tc * 64; \
        _Pragma("unroll") for (int rb = 0; rb < 4; ++rb) { f32x4 o = (f32x4){0.f, 0.f, 0.f, 0.f}; o = MFMA16(DS_FRAG(buf, 1, rb, 0), Sb[0], o); o = MFMA16(DS_FRAG(buf, 1, rb, 1), Sb[1], o); o = MFMA16(DS_FRAG(buf, 2, rb, 0), vb[0], o); o = MFMA16(DS_FRAG(buf, 2, rb, 1), vb[1], o); \
            _Pragma("unroll") for (int ii = 0; ii < 4; ++ii) { const int i = 16 * rb + 4 * g + ii; const int tt = dir ? 63 - i : i; od[(size_t)(rowb + tt) * 256 + h * 64 + 16 * sl + col] = o[ii]; } } \
        _Pragma("unroll") for (int rb = 0; rb < 4; ++rb) { f32x4 sn = S[rb] * glc; sn = MFMA16(DS_FRAG(buf, 3, rb, 0), vb[0], sn); sn = MFMA16(DS_FRAG(buf, 3, rb, 1), vb[1], sn); S[rb] = sn; } \
        if ((n) + 1 < nch) DS_WRITE(Rcur, (buf) ^ 1); \
        __syncthreads(); } while (0)
    for (int n = 0; n < nch; n += 2) {
        DS_STEP(n, 0, Rb, Ra, uuA, glA);
        DS_STEP(n + 1, 1, Ra, Rb, uuB, glB);
    }
#undef DS_STEP
#undef DS_TC
#undef DS_ISSUE
#undef DS_WRITE
#undef DS_FRAG
#undef DS_LOADU
    if (!sample) { float* so = C.out + OUT_SD + ((((size_t)b * 4 + layer) * 2 + dir) * 4 + h) * 4096;
#pragma unroll
        for (int rb = 0; rb < 4; ++rb)
#pragma unroll
            for (int ii = 0; ii < 4; ++ii) so[(16 * rb + 4 * g + ii) * 64 + 16 * sl + col] = S[rb][ii]; }
}

DI float hgrn_forget(const bf16_t* zb, size_t row, int dir, int h, int d, float lb) { const float x = bf2f(zb[row * ZLD + ZB_CF + dir * 256 + h * 64 + d]); return lb + (1.0f - lb) * sigmoidf_(x); }
DI void hgrn_local_unit(const Ctx& C, int layer, int unit) {
    int lane = C.lane; asm volatile("" : "+v"(lane)); const int dir = unit & 1, h = (unit >> 1) & 3, tc = unit >> 3, row0 = tc * 64;
    const bf16_t* zb = (const bf16_t*)(C.ws + WS_ZB);
    float* fs = C.L + C.wave * 1024;
    const float lb = ((const float*)(C.ws + WS_TAB))[4096 + (dir * 4 + layer) * 256 + h * 64 + lane];
    float S[64];
#pragma unroll
    for (int d = 0; d < 64; ++d) S[d] = 0.f;
    float Dl = 1.0f;
    for (int sb = 0; sb < 4; ++sb) {
        float vr[16];
#pragma unroll
        for (int i = 0; i < 16; ++i) { const int ti = sb * 16 + i, tt = dir ? 63 - ti : ti; const size_t row = (size_t)(row0 + tt);
            const float f = hgrn_forget(zb, row, dir, h, lane, lb); fs[i * 64 + lane] = f; Dl *= f; vr[i] = bf2f(zb[row * ZLD + ZB_CI + h * 64 + lane]); }
        __builtin_amdgcn_wave_barrier();
#pragma unroll
        for (int i = 0; i < 16; ++i) { const float v = vr[i];
#pragma unroll
            for (int d = 0; d < 64; d += 4) { const f32x4 f4 = *(const f32x4*)(fs + i * 64 + d);
#pragma unroll
                for (int c = 0; c < 4; ++c) S[d + c] = fmaf(f4[c], S[d + c] - v, v);
                if ((d & 15) == 12) asm volatile("" ::: "memory"); } }
        __builtin_amdgcn_wave_barrier();
    }
    float* hs = (float*)(C.ws + WS_HS) + (size_t)unit * 4096;
#pragma unroll
    for (int d = 0; d < 64; ++d) hs[d * 64 + lane] = S[d];
    ((float*)(C.ws + WS_HD))[(size_t)unit * 64 + lane] = Dl;
}
DI void hgrn_scan_unit(const Ctx& C, int layer, bool sample, int b, int h, int dir) {
    const Params& p = *C.p; int tid = C.tid; asm volatile("" : "+v"(tid)); const int tc0 = sample ? 128 + b * 64 : b * 4, nch = sample ? 64 : 4;
    float* HS = (float*)(C.ws + WS_HS); const float* HD = (const float*)(C.ws + WS_HD);
    f32x4 S0, S1;
    if (sample) { const float* s0 = p.in[5] + ((((size_t)b * 4 + layer) * 2 + dir) * 4 + h) * 4096 + tid * 8; S0 = *(const f32x4*)s0; S1 = *(const f32x4*)(s0 + 4); }
    else { S0 = (f32x4){0.f, 0.f, 0.f, 0.f}; S1 = S0; }
    for (int n0 = 0; n0 < nch; n0 += 4) {
        f32x4 la[4], lb[4]; float Dd[4];
#pragma unroll
        for (int k = 0; k < 4; ++k) { const int tc = dir ? tc0 + nch - 1 - (n0 + k) : tc0 + n0 + k; const size_t uh = ((size_t)tc * 4 + h) * 2 + dir;
            const float* hp = HS + uh * 4096 + tid * 8; la[k] = *(const f32x4*)hp; lb[k] = *(const f32x4*)(hp + 4); Dd[k] = HD[uh * 64 + (tid >> 3)]; }
#pragma unroll
        for (int k = 0; k < 4; ++k) { const int tc = dir ? tc0 + nch - 1 - (n0 + k) : tc0 + n0 + k; const size_t uh = ((size_t)tc * 4 + h) * 2 + dir;
            float* hp = HS + uh * 4096 + tid * 8; *(f32x4*)hp = S0; *(f32x4*)(hp + 4) = S1; S0 = S0 * Dd[k] + la[k]; S1 = S1 * Dd[k] + lb[k]; }
    }
    if (!sample) { float* so = C.out + OUT_SH + ((((size_t)b * 4 + layer) * 2 + dir) * 4 + h) * 4096 + tid * 8; *(f32x4*)so = S0; *(f32x4*)(so + 4) = S1; }
}
DI void hgrn_final_unit(const Ctx& C, int layer, int tc) {
    const Params& p = *C.p; int lane = C.lane; asm volatile("" : "+v"(lane)); const int w = C.wave, h = w >> 1, dir = w & 1, ep = lane & 31, dh = lane >> 5, row0 = tc * 64;
    const bf16_t* zb = (const bf16_t*)(C.ws + WS_ZB); const float* HS = (const float*)(C.ws + WS_HS);
    float* otile = C.L;
    float* fs = C.L + 16384 + w * 2048; float* qst = fs + 1024;
    __syncthreads();
    for (int i = C.tid; i < 16384; i += 512) otile[i] = 0.f;
    __syncthreads();
    {
        const size_t uh = ((size_t)tc * 4 + h) * 2 + dir;
        const float lb = ((const float*)(C.ws + WS_TAB))[4096 + (dir * 4 + layer) * 256 + h * 64 + lane];
        f32x2 S[32];
#pragma unroll
        for (int k = 0; k < 32; ++k) S[k] = *(const f32x2*)(HS + uh * 4096 + (32 * dh + k) * 64 + 2 * ep);
        bf16_t rf[16], rq[16]; unsigned rv[16];
#define HF_LOAD(sb_) do { _Pragma("unroll") for (int i = 0; i < 16; ++i) { const int ti = (sb_) * 16 + i, tt = dir ? 63 - ti : ti; const size_t row = (size_t)(row0 + tt); \
            rf[i] = zb[row * ZLD + ZB_CF + dir * 256 + h * 64 + lane]; rq[i] = zb[row * ZLD + ZB_CQ + h * 64 + lane]; rv[i] = *(const unsigned*)(zb + row * ZLD + ZB_CI + h * 64 + 2 * ep); } } while (0)
        HF_LOAD(0);
        for (int sb = 0; sb < 4; ++sb) {
            f32x2 vr[16];
#pragma unroll
            for (int i = 0; i < 16; ++i) { fs[i * 64 + lane] = lb + (1.0f - lb) * sigmoidf_(bf2f(rf[i])); qst[i * 64 + lane] = siluf_(bf2f(rq[i])); vr[i] = (f32x2){__uint_as_float(rv[i] << 16), __uint_as_float(rv[i] & 0xffff0000u)}; }
            if (sb + 1 < 4) HF_LOAD(sb + 1);
            __builtin_amdgcn_wave_barrier();
#pragma unroll
            for (int i = 0; i < 16; ++i) { const f32x2 v = vr[i]; f32x2 osa = {0.f, 0.f}, osb = {0.f, 0.f};
#pragma unroll
                for (int k = 0; k < 32; k += 4) { const f32x4 f4 = *(const f32x4*)(fs + i * 64 + 32 * dh + k), q4 = *(const f32x4*)(qst + i * 64 + 32 * dh + k);
#pragma unroll
                    for (int c = 0; c < 4; ++c) { S[k + c] = (S[k + c] - v) * f4[c] + v; if (c & 1) osb += S[k + c] * q4[c]; else osa += S[k + c] * q4[c]; }
                    if ((k & 15) == 12) asm volatile("" ::: "memory"); }
                f32x2 os = osa + osb;
                os.x += __shfl_xor(os.x, 32); os.y += __shfl_xor(os.y, 32);
                const int ti = sb * 16 + i, tt = dir ? 63 - ti : ti;
                if (dh == 0) { float* op = otile + (h * 64 + tt) * 64 + 2 * ep; atomicAdd(op, os.x); atomicAdd(op + 1, os.y); }
                asm volatile("" ::: "memory"); }
            __builtin_amdgcn_wave_barrier();
        }
    }
#undef HF_LOAD
    __syncthreads();
    bf16_t* ob = (bf16_t*)(C.ws + WS_O);
    const float ng = p.in[16][layer * 64 + lane];
    bf16_t gts[32];
#pragma unroll
    for (int rr = 0; rr < 32; ++rr) { const int idx = w * 32 + rr, hh = idx >> 6, tt = idx & 63; gts[rr] = zb[(size_t)(row0 + tt) * ZLD + ZB_CG + hh * 64 + lane]; }
#pragma unroll
    for (int rr = 0; rr < 32; ++rr) { const int idx = w * 32 + rr, hh = idx >> 6, tt = idx & 63; const size_t row = (size_t)(row0 + tt);
        const float v = otile[(hh * 64 + tt) * 64 + lane]; const float ss = wave_sum(v * v);
        const float gt = siluf_(bf2f(gts[rr]));
        ob[row * DM + 768 + hh * 64 + lane] = f2bf(v * (1.0f / sqrtf(ss * (1.0f / 64.0f) + RMS_EPS)) * ng * gt); }
}
DI void delta_combine(const Ctx& C, int layer) {
    const Params& p = *C.p; const bf16_t* zb = (const bf16_t*)(C.ws + WS_ZB); const float* od = (const float*)(C.ws + WS_OD); bf16_t* ob = (bf16_t*)(C.ws + WS_O);
    const float ng = p.in[14][layer * 64 + C.lane];
    for (int it0 = C.gw * 4; it0 < MROWS * 4; it0 += C.NGW * 4) {
        float v[4]; bf16_t gr[4];
#pragma unroll
        for (int k = 0; k < 4; ++k) { const int it = it0 + k, h = it & 3; const size_t row = (size_t)(it >> 2);
            v[k] = od[row * 256 + h * 64 + C.lane] + od[(size_t)MROWS * 256 + row * 256 + h * 64 + C.lane]; gr[k] = zb[row * ZLD + ZB_BG + h * 64 + C.lane]; }
#pragma unroll
        for (int k = 0; k < 4; ++k) { const int it = it0 + k, h = it & 3; const size_t row = (size_t)(it >> 2);
            const float ss = wave_sum(v[k] * v[k]); const float gt = siluf_(bf2f(gr[k]));
            ob[row * DM + 512 + h * 64 + C.lane] = f2bf(v[k] * (1.0f / sqrtf(ss * (1.0f / 64.0f) + RMS_EPS)) * ng * gt); }
    }
}

#define XB_TMO      128
#define XB_XCNT(j)  (256  + 64 * (j))
#define XB_XSUB(j)  (1280 + 64 * (j))
#define XB_XGEN(j)  (2304 + 64 * (j))
#define XB_TOP      3328
#define XB_TOPGEN   3392
#define XB_SPIN_CAP (1u << 22)
DI unsigned xb_ld(unsigned* p)              { return __hip_atomic_load(p, __ATOMIC_RELAXED, __HIP_MEMORY_SCOPE_AGENT); }
DI unsigned xb_add(unsigned* p, unsigned v) { return __hip_atomic_fetch_add(p, v, __ATOMIC_RELAXED, __HIP_MEMORY_SCOPE_AGENT); }
DI unsigned xb_xcc_id() { return (unsigned)__builtin_amdgcn_s_getreg((3 << 11) | 20) & 0xFu; }
#define XB_SPIN(cond, bar) do { unsigned _sp = 0; while (cond) { __builtin_amdgcn_s_sleep(1); \
    if ((++_sp & 255u) == 0u) { if (xb_ld(&(bar)[XB_TMO])) break; if (_sp > XB_SPIN_CAP) { atomicAdd(&(bar)[XB_TMO], 1u); break; } } } } while (0)
struct XcdBarrier { unsigned* bar; unsigned x; volatile LAS unsigned* st; };
DI void xcd_barrier_complete(unsigned* bar, unsigned x, unsigned& nloc, unsigned& nx) {
    const unsigned G = gridDim.x * gridDim.y * gridDim.z;
    unsigned sum, cnt, mine, sp = 0u;
    for (;;) {
        sum = 0u; cnt = 0u; mine = 0u;
#pragma unroll
        for (unsigned j = 0; j < 16; ++j) { const unsigned c = xb_ld(&bar[XB_XCNT(j)]); sum += c; cnt += (c > 0u) ? 1u : 0u; mine = (j == x) ? c : mine; }
        if (sum == G) break;
        __builtin_amdgcn_s_sleep(1);
        if ((++sp & 255u) == 0u) { if (xb_ld(&bar[XB_TMO])) break; if (sp > XB_SPIN_CAP) { atomicAdd(&bar[XB_TMO], 1u); break; } }
    }
    nloc = mine > 0u ? mine : 1u; nx = cnt > 0u ? cnt : 1u;
}
DI void xcd_barrier(const XcdBarrier& b) {
    asm volatile("s_waitcnt vmcnt(0)" ::: "memory");
    __syncthreads();
    if (threadIdx.x == 0) {
        unsigned* bar = b.bar;
        __builtin_amdgcn_s_waitcnt(0);
        unsigned nloc = b.st[0], nx = b.st[1];
        if (nloc == 0u) { xcd_barrier_complete(bar, b.x, nloc, nx); b.st[0] = nloc; b.st[1] = nx; }
        const unsigned old = xb_add(&bar[XB_XSUB(b.x)], 1u);
        const unsigned gen = old / nloc;
        if (old + 1u == (gen + 1u) * nloc) {
            __builtin_amdgcn_fence(__ATOMIC_RELEASE, "agent");
            asm volatile("s_waitcnt vmcnt(0)" ::: "memory");
            const unsigned og = xb_add(&bar[XB_TOP], 1u);
            const unsigned tg = og / nx;
            if (og + 1u == (tg + 1u) * nx) xb_add(&bar[XB_TOPGEN], 1u);
            else XB_SPIN(xb_ld(&bar[XB_TOPGEN]) == tg, bar);
            __builtin_amdgcn_fence(__ATOMIC_ACQUIRE, "agent");
            xb_add(&bar[XB_XGEN(b.x)], 1u);
            asm volatile("s_waitcnt vmcnt(0)" ::: "memory");
        } else {
            XB_SPIN(xb_ld(&bar[XB_XGEN(b.x)]) == gen, bar);
            __builtin_amdgcn_fence(__ATOMIC_ACQUIRE, "agent");
            asm volatile("s_waitcnt vmcnt(0)" ::: "memory");
        }
    }
    __syncthreads();
}

DI void probe_stamp(unsigned char* ws, int cls) {
    if (PROBE_A >= 0 && blockIdx.x == 0 && threadIdx.x == 0) {
        volatile float* tsf = (volatile float*)(ws + WS_TAB + 131072); volatile unsigned long long* tsl = (volatile unsigned long long*)(ws + WS_TAB + 131072 + 256);
        const unsigned long long now = __builtin_amdgcn_s_memrealtime(); tsf[cls] += (float)(now - tsl[0]); tsl[0] = now; }
}
template <unsigned PHM_>
__global__ void __launch_bounds__(512) fwd_megakernel(Params p) {
    extern __shared__ __attribute__((aligned(16))) unsigned char lds_raw[];
    XcdBarrier xbar; xbar.bar = (unsigned*)(p.ws + WS_CTL) + 1024; xbar.x = xb_xcc_id(); xbar.st = (volatile LAS unsigned*)((LAS unsigned char*)lds_raw + 147400);
    if (threadIdx.x == 0) { xbar.st[0] = 0u; xbar.st[1] = 0u; (void)xb_add(&xbar.bar[XB_XCNT(xbar.x)], 1u); }
    __syncthreads();
    for (int ph = p.ph_lo; ph < p.ph_hi; ++ph) {
        if (PROBE_A >= 0 && blockIdx.x == 0 && threadIdx.x == 0) {
            volatile float* tsf = (volatile float*)(p.ws + WS_TAB + 131072); volatile unsigned long long* tsl = (volatile unsigned long long*)(p.ws + WS_TAB + 131072 + 256);
            const unsigned long long now = __builtin_amdgcn_s_memrealtime();
            if (ph == 0) { for (int i = 0; i < 16; ++i) tsf[i] = 0.f; tsl[1] = now; }
            else { const int pp = ph - 1; const int cls = pp < 2 ? 8 : (((pp - 2) % 9) == 8 ? 5 : ((pp - 2) % 9)); const float dt = (float)(now - tsl[0]); tsf[cls] += dt; }
            tsl[0] = now;
            if (ph == NPHASE - 2 && PROBE_A < 20) { const float tot = (float)(now - tsl[1]); tsf[12] = rintf(tsf[(PROBE_A >= 0 && PROBE_A < 16) ? PROBE_A : 0] / tot * 40.f) / 40.f; tsf[13] = rintf(tsf[PROBE_B >= 0 ? PROBE_B : 0] / tot * 40.f) / 40.f; }
        }
        if (PROBE_A >= 0 && ph == 0 && threadIdx.x == 0) { volatile float* tsb = (volatile float*)(p.ws + WS_TAB + 196608) + blockIdx.x * 8; for (int i = 0; i < 8; ++i) tsb[i] = 0.f; }
        if (PROBE_A >= 20 && ph == NPHASE - 2 && blockIdx.x == 0 && threadIdx.x == 0) {
            volatile float* tsf = (volatile float*)(p.ws + WS_TAB + 131072); volatile unsigned long long* tsl = (volatile unsigned long long*)(p.ws + WS_TAB + 131072 + 256);
            const float* tsb = (const float*)(p.ws + WS_TAB + 196608); float sum = 0.f; for (int b2 = 0; b2 < (int)gridDim.x; ++b2) sum += __hip_atomic_load(tsb + b2 * 8 + (PROBE_A - 20), __ATOMIC_RELAXED, __HIP_MEMORY_SCOPE_AGENT); sum *= (PROBE_A == 20 ? 32.f : (PROBE_A == 21 ? 16.f : 1.f));
            const float tot = (float)(__builtin_amdgcn_s_memrealtime() - tsl[1]); tsf[12] = rintf(sum / (float)gridDim.x / tot * 40.f) / 40.f; tsf[13] = 0.f; }
        int tid_ = threadIdx.x; asm volatile("" : "+v"(tid_));
        unsigned char* ws_ = p.ws; asm volatile("" : "+s"(ws_));
        float* out_ = p.out; asm volatile("" : "+s"(out_));
        Ctx C; C.p = &p; C.lds = (LAS unsigned char*)lds_raw; C.L = (float*)lds_raw; C.tid = tid_; C.lane = C.tid & 63; C.wave = __builtin_amdgcn_readfirstlane(C.tid >> 6);
        C.G = gridDim.x; C.gw = blockIdx.x * 8 + C.wave; C.NGW = C.G * 8; C.ws = ws_; C.out = out_;
        unsigned* ctl = (unsigned*)(ws_ + WS_CTL);
        const float* modbuf = (const float*)(ws_ + WS_MOD);
        bf16_t* xm = (bf16_t*)(ws_ + WS_XM); bf16_t* ob = (bf16_t*)(ws_ + WS_O); bf16_t* act = (bf16_t*)(ws_ + WS_ACT);
        if (ph == 0) { if (PHON(0)) phase0a(C); }
        else if (ph == 1) { if (PHON(1)) row_pass(C, 0, nullptr, nullptr, modbuf, 1024, 0, true); }
        else {
            const int layer = (ph - 2) / 9, sub = (ph - 2) % 9;
            unsigned char* wb = ws_ + WS_W + (size_t)(layer & 1) * WBUF;
            const float* modl = modbuf + (size_t)layer * 3 * 6144;
            if (sub == 0) { if (PHON(2)) {
                pg8::Gemm g{xm, (const bf16_t*)(wb + W_IN), MROWS, 4096, DM}; pg8::StaticOrder S; S.init(MROWS, 4096, C.G, (int)blockIdx.x);
                EpiIn E{(bf16_t*)(ws_ + WS_Q), (bf16_t*)(ws_ + WS_K), (bf16_t*)(ws_ + WS_V), (bf16_t*)(ws_ + WS_ZB), out_ + OUT_K, out_ + OUT_V, (const f32x2*)(ws_ + WS_TAB), layer};
                pg8::gemm_phase(C.lds, g, S, E, C.tid); }
            } else if (sub == 1) {
                __syncthreads();
                if (PHON(4)) for (int u = blockIdx.x; u < 1024; u += C.G) delta_prep_unit(C, layer, u);
                __syncthreads();
                if (PHON(5)) for (int u = C.gw; u < 2048; u += C.NGW) hgrn_local_unit(C, layer, u);
                __syncthreads();
            } else if (sub == 2) {
                LAS int* slot = (LAS int*)(C.lds + 147392);
                for (;;) {
                    __syncthreads();
                    if (C.tid == 0) *slot = (int)atomicAdd(ctl + 64 * (layer + 1), 1u);
                    __syncthreads();
                    const int u = *slot;
                    if (u >= 1432 + 256) break;
                    if (u >= 1432) { if (layer + 1 < DEPTH) convert_layer_weights(C, layer + 1, (u - 1432) * 8 + C.wave, 2048, u - 1432, 256); continue; }
                    unsigned long long pt0_ = 0; if (PROBE_A >= 0 && C.tid == 0) pt0_ = __builtin_amdgcn_s_memrealtime();
                    if (u < 8) { if (PHON(6)) delta_scan_unit(C, layer, true, u >> 2, u & 3); }
                    else if (u < 24) { const int v = u - 8; if (PHON(7)) hgrn_scan_unit(C, layer, true, v >> 3, (v >> 1) & 3, v & 1); }
                    else if (u < 536) { if (PHON(8)) attn_unit(C, layer, u - 24); }
                    else if (u < 664) { const int v = u - 536; if (PHON(6)) delta_scan_unit(C, layer, false, v >> 2, v & 3); }
                    else if (u < 1176) { if (PHON(8)) attn_unit(C, layer, 512 + (u - 664)); }
                    else { const int v = u - 1176; if (PHON(7)) hgrn_scan_unit(C, layer, false, v >> 3, (v >> 1) & 3, v & 1); }
                    if (PROBE_A >= 0) { __syncthreads(); if (C.tid == 0) { const int ty = (u < 8) ? 0 : (u < 24 ? 1 : (u < 536 ? 2 : (u < 664 ? 3 : (u < 1176 ? 4 : 5))));
                        volatile float* tsb = (volatile float*)(ws_ + WS_TAB + 196608) + blockIdx.x * 8; tsb[ty] += (float)(__builtin_amdgcn_s_memrealtime() - pt0_); } }
                }
            } else if (sub == 3) {
                if (PHON(9)) for (int u = blockIdx.x; u < 256; u += C.G) hgrn_final_unit(C, layer, u);
                __syncthreads();
                if (PHON(10)) delta_combine(C, layer);
                __syncthreads();
            } else if (sub == 4) {
                pg8::Gemm g{ob, (const bf16_t*)(wb + W_OUT), MROWS, DM, DM}; pg8::StaticOrder S; S.init(MROWS, DM, C.G, (int)blockIdx.x);
                EpiRes E{out_, modl + 2048, xm};
                if (PHON(11)) pg8::gemm_phase(C.lds, g, S, E, C.tid);
            } else if (sub == 5) {
                if (PHON(12)) row_pass(C, 1, p.in[20] + (size_t)(layer * 2) * DM, p.in[21] + (size_t)(layer * 2) * DM, modl, 4096, 3072, true);
            } else if (sub == 6) {
                pg8::Gemm g{xm, (const bf16_t*)(wb + W_FFI), MROWS, 2 * DFF, DM}; pg8::StaticOrder S; S.init(MROWS, 2 * DFF, C.G, (int)blockIdx.x);
                EpiFfn E{act};
                if (PHON(13)) pg8::gemm_phase(C.lds, g, S, E, C.tid);
            } else if (sub == 7) {
                pg8::Gemm g{act, (const bf16_t*)(wb + W_FFO), MROWS, DM, DFF}; pg8::StaticOrder S; S.init(MROWS, DM, C.G, (int)blockIdx.x);
                EpiRes E{out_, modl + 5120, xm};
                if (PHON(14)) pg8::gemm_phase(C.lds, g, S, E, C.tid);
            } else {
                const bool last = layer + 1 == DEPTH;
                if (PHON(12)) row_pass(C, 1, p.in[20] + (size_t)(layer * 2 + 1) * DM, p.in[21] + (size_t)(layer * 2 + 1) * DM, modbuf + (size_t)(last ? layer : layer + 1) * 3 * 6144, 1024, 0, !last);
            }
        }
        if (ph + 1 < p.ph_hi) { if (p.ph_hi > 100000) { __threadfence(); cg::this_grid().sync(); } else xcd_barrier(xbar); }
    }
}

#if !MK_ONE_LAUNCH
static unsigned phase_mask(int ph) {
    if (ph == 0) return 1u << 0; if (ph == 1) return 1u << 1;
    const int sub = (ph - 2) % 9;
    switch (sub) { case 0: return 1u << 2; case 1: return (1u << 3) | (1u << 4) | (1u << 5); case 2: return (1u << 6) | (1u << 7) | (1u << 8); case 3: return (1u << 9) | (1u << 10);
        case 4: return 1u << 11; case 5: return 1u << 12; case 6: return 1u << 13; case 7: return 1u << 14; default: return 1u << 12; }
}
typedef void (*kern_t)(Params);
static kern_t kernel_for_mask(unsigned m) {
    switch (m) {
        case 1u << 0: return fwd_megakernel<1u << 0>; case 1u << 1: return fwd_megakernel<1u << 1>; case 1u << 2: return fwd_megakernel<1u << 2>;
        case (1u << 3) | (1u << 4) | (1u << 5): return fwd_megakernel<(1u << 3) | (1u << 4) | (1u << 5)>;
        case (1u << 6) | (1u << 7) | (1u << 8): return fwd_megakernel<(1u << 6) | (1u << 7) | (1u << 8)>;
        case (1u << 9) | (1u << 10): return fwd_megakernel<(1u << 9) | (1u << 10)>;
        case 1u << 11: return fwd_megakernel<1u << 11>; case 1u << 12: return fwd_megakernel<1u << 12>; case 1u << 13: return fwd_megakernel<1u << 13>; default: return fwd_megakernel<1u << 14>;
    }
}
#endif
extern "C" void kernel_launch(void* const* d_in, const int* in_sizes, int n_in, void* d_out, int out_size, void* d_ws, size_t ws_size, hipStream_t stream) {
    static int grid = 0;
    if (grid == 0) {
        if (n_in != 24 || out_size != 58720256 || ws_size < WS_END) { fprintf(stderr, "kernel_launch: unexpected shapes (n_in %d out %d ws %zu)\n", n_in, out_size, ws_size); grid = -1; return; }
        int dev = 0, cus = 0;
        (void)hipGetDevice(&dev); (void)hipDeviceGetAttribute(&cus, hipDeviceAttributeMultiprocessorCount, dev);
#if MK_ONE_LAUNCH
        if (hipFuncSetAttribute((const void*)fwd_megakernel<0x7FFFu>, hipFuncAttributeMaxDynamicSharedMemorySize, LDS_BYTES) != hipSuccess) { fprintf(stderr, "kernel_launch: hipFuncSetAttribute failed\n"); grid = -1; return; }
#else
        for (int ph = 0; ph < 11; ++ph) (void)hipFuncSetAttribute((const void*)kernel_for_mask(phase_mask(ph)), hipFuncAttributeMaxDynamicSharedMemorySize, LDS_BYTES);
#endif
        (void)hipGetLastError();
        grid = cus > 0 ? cus : 256;
        if (grid != 256) { fprintf(stderr, "kernel_launch: expected 256 CUs, got %d\n", grid); grid = 256; }
    }
    if (grid < 0) return;
    (void)hipMemsetAsync((char*)d_ws + WS_CTL, 0, 65536, stream);
    Params p{};
    for (int i = 0; i < 24; ++i) p.in[i] = (const float*)d_in[i];
    p.out = (float*)d_out; p.ws = (unsigned char*)d_ws;
#if MK_ONE_LAUNCH
    p.ph_lo = 0; p.ph_hi = NPHASE;
    void* args[] = {&p};
    hipError_t e = hipLaunchCooperativeKernel((const void*)fwd_megakernel<0x7FFFu>, dim3(grid), dim3(512), args, LDS_BYTES, stream);
    if (e != hipSuccess) fprintf(stderr, "cooperative launch failed: %s (grid %d)\n", hipGetErrorString(e), grid);
#else
    for (int ph = 0; ph < NPHASE; ++ph) { p.ph_lo = ph; p.ph_hi = ph + 1; hipLaunchKernelGGL(kernel_for_mask(phase_mask(ph)), dim3(grid), dim3(512), LDS_BYTES, stream, p); }
#endif
}
```

```cpp
#include <hip/hip_runtime.h>
#include <hip/hip_cooperative_groups.h>
#include <cstdio>
#include <cstdint>
namespace cg = cooperative_groups;

#define PHON(k) ((PHM_ >> (k)) & 1)
#ifndef PROBE_A
#define PROBE_A -1
#endif
#ifndef PROBE_B
#define PROBE_B -1
#endif
#ifndef MK_ONE_LAUNCH
#define MK_ONE_LAUNCH 1
#endif

#define DI __device__ __forceinline__
#define LAS __attribute__((address_space(3)))
typedef unsigned short bf16_t;
typedef short bf16x8 __attribute__((ext_vector_type(8)));
typedef short s16x4 __attribute__((ext_vector_type(4)));
typedef float f32x4 __attribute__((ext_vector_type(4)));
typedef float f32x16 __attribute__((ext_vector_type(16)));
typedef float f32x2 __attribute__((ext_vector_type(2)));
typedef unsigned u32x4 __attribute__((ext_vector_type(4)));
typedef unsigned u32x2 __attribute__((ext_vector_type(2)));

constexpr int MROWS = 16384, DM = 1024, DEPTH = 4, DFF = 2816, DIN = 3856, ZLD = 2320;
constexpr float ALPHA = 1.681792830507429f, LN_EPS = 1e-5f, RMS_EPS = 1e-6f;
constexpr float QSCALE = 0.125f * 1.4426950408889634f;
constexpr int ZB_BQ = 0, ZB_BK = 256, ZB_BV = 512, ZB_BG = 768, ZB_BBETA = 1024, ZB_BA = 1032, ZB_CQ = 1040, ZB_CF = 1296, ZB_CI = 1808, ZB_CG = 2064;
constexpr size_t OUT_K = 16777216, OUT_V = 33554432, OUT_SD = 50331648, OUT_SH = 54525952;
constexpr size_t MiB = 1u << 20;
constexpr size_t WS_CTL = 0, WS_MOD = 64 * 1024, WS_TAB = 512 * 1024, WS_CK = 1 * MiB, WS_CV = 3 * MiB, WS_W = 8 * MiB, WBUF = 27 * MiB;
constexpr size_t W_IN = 0, W_OUT = 8 * MiB, W_FFI = 10 * MiB, W_FFO = 21 * MiB;
constexpr size_t WS_XM = 62 * MiB, WS_O = 94 * MiB, WS_ZB = 126 * MiB, WS_Q = 199 * MiB, WS_K = 215 * MiB, WS_V = 231 * MiB;
constexpr size_t WS_ACT = 126 * MiB;
constexpr size_t WS_DPW = 247 * MiB, WS_DPQD = 263 * MiB, WS_DPQK = 279 * MiB, WS_DPKD = 295 * MiB;
constexpr size_t WS_DPU = WS_XM;
constexpr size_t WS_OD = 311 * MiB, WS_HS = 343 * MiB, WS_HD = 375 * MiB, WS_GL = 375 * MiB + 512 * 1024, WS_END = 376 * MiB;
constexpr int LDS_BYTES = 147456;
constexpr int NPHASE = 2 + 9 * DEPTH;

struct Params { const float* in[24]; float* out; unsigned char* ws; int ph_lo, ph_hi; };

DI unsigned cvt_pk_bf16(float lo, float hi) { unsigned r; asm("v_cvt_pk_bf16_f32 %0, %1, %2" : "=v"(r) : "v"(lo), "v"(hi)); return r; }
DI bf16_t f2bf(float f) { return (bf16_t)(cvt_pk_bf16(f, 0.f) & 0xffffu); }
DI float bf2f(bf16_t b) { return __uint_as_float(((unsigned)b) << 16); }
DI float sigmoidf_(float x) { return 1.0f / (1.0f + __expf(-x)); }
DI float siluf_(float x) { return x / (1.0f + __expf(-x)); }
DI float wave_sum(float v) {
#pragma unroll
    for (int o = 1; o < 64; o <<= 1) v += __shfl_xor(v, o);
    return v;
}
DI u32x2 pack4(f32x4 v) { u32x2 w; w.x = cvt_pk_bf16(v[0], v[1]); w.y = cvt_pk_bf16(v[2], v[3]); return w; }
DI bf16x8 pack8(f32x4 a, f32x4 b) { u32x4 w; w.x = cvt_pk_bf16(a[0], a[1]); w.y = cvt_pk_bf16(a[2], a[3]); w.z = cvt_pk_bf16(b[0], b[1]); w.w = cvt_pk_bf16(b[2], b[3]); return __builtin_bit_cast(bf16x8, w); }
DI int pinv(int k) { return (k >> 5) * 32 + ((k >> 2) & 3) * 8 + ((k >> 4) & 1) * 4 + (k & 3); }
DI int row_mod(int r) { return r < 8192 ? 0 : 1 + ((r - 8192) >> 12); }

namespace pg8 {
constexpr int BM = 256, BK = 64, HALF = 128, HTB = HALF * BK * 2, STAGE_BYTES = 8 * HTB, NXCD = 8, WGM = 8;
DI int lds_byte(int r, int c) { const int st = (r >> 4) * 2 + (c >> 5), rr = r & 15, cc = c & 31, ob = rr * 64 + cc * 2; return st * 1024 + (ob ^ (((ob >> 9) & 1) << 5)); }
DI void stage_rc(int b, int& R, int& C) { const int st = b / 1024, sb = b % 1024, swz = sb ^ (((sb >> 9) & 1) << 5); R = (st >> 1) * 16 + swz / 64; C = (st & 1) * 32 + (swz % 64) / 2; }
struct Unit { int pm, pn; };
struct Gemm { const bf16_t* A; const bf16_t* Bt; int M, N, K; };
struct StaticOrder {
    int nM, nN, nwg, G, c;
    DI void init(int M, int N, int G_, int c_) { nM = M / BM; nN = N / BM; nwg = nM * nN; G = G_; c = c_; }
    DI bool next(int i, Unit& u) const {
        const long L = (long)i * G + c; if (L >= nwg) return false;
        int wgid = (int)L; { const int q = nwg / NXCD, r = nwg % NXCD, xcd = wgid % NXCD, off = wgid / NXCD; wgid = (xcd < r ? xcd * (q + 1) : r * (q + 1) + (xcd - r) * q) + off; }
        const int nig = WGM * nN, gid = wgid / nig, fm = gid * WGM, gsz = (nM - fm) < WGM ? (nM - fm) : WGM;
        u.pm = fm + ((wgid % nig) % gsz); u.pn = (wgid % nig) / gsz; return true;
    }
};

template <class Epi>
DI void gemm_phase(LAS unsigned char* lds, const Gemm g, const StaticOrder& S, const Epi& E, int tid_in) {
    const int tid = tid_in, wid = __builtin_amdgcn_readfirstlane(tid >> 6), lane = tid & 63, wr = wid >> 2, wc = wid & 3, fr = lane & 15, fq = lane >> 4;
    const int K = g.K, nt = K / BK;
    unsigned voffA[2];
#pragma unroll
    for (int i = 0; i < 2; ++i) { int R, C; stage_rc(tid * 16 + i * 8192, R, C); voffA[i] = (unsigned)(R * K + C) * 2u; }
    const size_t kstep = (size_t)(BK * 2);
    const size_t hstep = (size_t)HALF * K * 2;
    const size_t tstep = 2 * hstep;
    const unsigned ldsw = (unsigned)wid * 1024u;
    const int aoff = lds_byte(wr * 64 + fr, fq * 8), boff = lds_byte(wc * 32 + fr, fq * 8);
#define PG8_SA(b, h) (((b) * 2 + (h)) * HTB)
#define PG8_SB(b, h) ((4 + (b) * 2 + (h)) * HTB)
#define PG8_STAGE(bufoff, gbase) do { _Pragma("unroll") for (int _i = 0; _i < 2; ++_i) \
        __builtin_amdgcn_global_load_lds((const unsigned*)((const char*)(gbase) + voffA[_i]), (LAS unsigned*)(lds + (bufoff) + ldsw + _i * 8192), 16, 0, 0); } while (0)
#define PG8_LDA(dst, b, h) do { _Pragma("unroll") for (int m = 0; m < 4; ++m) _Pragma("unroll") for (int k = 0; k < 2; ++k) dst[m][k] = *(const LAS bf16x8*)(lds + PG8_SA(b, h) + aoff + m * 2048 + k * 1024); } while (0)
#define PG8_LDB(dst, b, h) do { _Pragma("unroll") for (int n = 0; n < 2; ++n) _Pragma("unroll") for (int k = 0; k < 2; ++k) dst[n][k] = *(const LAS bf16x8*)(lds + PG8_SB(b, h) + boff + n * 2048 + k * 1024); } while (0)
#define PG8_MMA(ai, bj, At, Bt) do { __builtin_amdgcn_s_setprio(1); _Pragma("unroll") for (int m = 0; m < 4; ++m) _Pragma("unroll") for (int n = 0; n < 2; ++n) _Pragma("unroll") for (int k = 0; k < 2; ++k) \
        acc[ai][bj][m][n] = __builtin_amdgcn_mfma_f32_16x16x32_bf16(Bt[n][k], At[m][k], acc[ai][bj][m][n], 0, 0, 0); __builtin_amdgcn_s_setprio(0); } while (0)
#define PG8_WAIT_V(n) asm volatile("s_waitcnt vmcnt(" #n ")" ::: "memory")
#define PG8_WAIT_L(n) asm volatile("s_waitcnt lgkmcnt(" #n ")" ::: "memory")
#define PG8_BAR __builtin_amdgcn_s_barrier()
#define PG8_SCHED __builtin_amdgcn_sched_barrier(0)
    Unit cur, nxt; int ui = 0;
    if (!S.next(0, cur)) return;
    f32x4 acc[2][2][4][2];
#pragma unroll
    for (int a = 0; a < 2; ++a)
#pragma unroll
        for (int b = 0; b < 2; ++b)
#pragma unroll
            for (int m = 0; m < 4; ++m)
#pragma unroll
                for (int n = 0; n < 2; ++n) acc[a][b][m][n] = (f32x4){0.f, 0.f, 0.f, 0.f};
    bf16x8 At[4][2], B0[2][2], B1[2][2];
    const char* cA = (const char*)g.A + (size_t)cur.pm * tstep; const char* cB = (const char*)g.Bt + (size_t)cur.pn * tstep;
    PG8_STAGE(PG8_SB(0, 0), cB); PG8_STAGE(PG8_SB(0, 1), cB + hstep); PG8_STAGE(PG8_SA(0, 0), cA); PG8_STAGE(PG8_SA(0, 1), cA + hstep);
    if (wr == 1) PG8_BAR;
    PG8_WAIT_V(2); PG8_BAR;
    PG8_STAGE(PG8_SB(1, 0), cB + kstep); PG8_STAGE(PG8_SA(1, 0), cA + kstep); PG8_STAGE(PG8_SB(1, 1), cB + hstep + kstep);
    PG8_WAIT_V(6); PG8_BAR;
    for (;;) {
        const bool has_next = S.next(ui + 1, nxt);
        const char* nA = has_next ? (const char*)g.A + (size_t)nxt.pm * tstep : cA; const char* nB = has_next ? (const char*)g.Bt + (size_t)nxt.pn * tstep : cB;
        for (int t = 0; t < nt; t += 2) {
            const bool last = (t == nt - 2);
            const char* a1 = cA + (size_t)(t + 1) * kstep;
            const char* a2 = last ? nA : cA + (size_t)(t + 2) * kstep; const char* b2 = last ? nB : cB + (size_t)(t + 2) * kstep;
            const char* a3 = a2 + kstep; const char* b3 = b2 + kstep;
            PG8_LDB(B0, 0, 0); PG8_LDB(B1, 0, 1); PG8_SCHED; PG8_LDA(At, 0, 0); PG8_STAGE(PG8_SA(1, 1), a1 + hstep);
            PG8_WAIT_V(8); PG8_WAIT_L(0); PG8_BAR; PG8_MMA(0, 0, At, B0); PG8_MMA(0, 1, At, B1); PG8_BAR; PG8_SCHED;
            PG8_LDA(At, 0, 1); PG8_STAGE(PG8_SB(0, 0), b2); PG8_STAGE(PG8_SB(0, 1), b2 + hstep); PG8_STAGE(PG8_SA(0, 0), a2);
            PG8_WAIT_V(8); PG8_WAIT_L(0); PG8_BAR; PG8_MMA(1, 0, At, B0); PG8_MMA(1, 1, At, B1); PG8_BAR; PG8_SCHED;
            PG8_LDB(B0, 1, 0); PG8_LDB(B1, 1, 1); PG8_SCHED; PG8_LDA(At, 1, 0); PG8_STAGE(PG8_SA(0, 1), a2 + hstep);
            PG8_WAIT_V(8); PG8_WAIT_L(0); PG8_BAR; PG8_MMA(0, 0, At, B0); PG8_MMA(0, 1, At, B1); PG8_BAR; PG8_SCHED;
            PG8_LDA(At, 1, 1); PG8_STAGE(PG8_SB(1, 0), b3); PG8_STAGE(PG8_SB(1, 1), b3 + hstep); PG8_STAGE(PG8_SA(1, 0), a3);
            PG8_WAIT_V(8); PG8_WAIT_L(0); PG8_BAR; PG8_MMA(1, 0, At, B0); PG8_MMA(1, 1, At, B1); PG8_BAR; PG8_SCHED;
        }
        if (wr == 0) PG8_BAR;
        E(acc, cur, wr, wc, fr, fq);
        if (!has_next) break;
#pragma unroll
        for (int a = 0; a < 2; ++a)
#pragma unroll
            for (int b = 0; b < 2; ++b)
#pragma unroll
                for (int m = 0; m < 4; ++m)
#pragma unroll
                    for (int n = 0; n < 2; ++n) acc[a][b][m][n] = (f32x4){0.f, 0.f, 0.f, 0.f};
        cur = nxt; cA = nA; cB = nB; ++ui;
        if (wr == 1) PG8_BAR;
    }
    PG8_WAIT_V(0);
    PG8_BAR;
#undef PG8_SA
#undef PG8_SB
#undef PG8_STAGE
#undef PG8_LDA
#undef PG8_LDB
#undef PG8_MMA
#undef PG8_WAIT_V
#undef PG8_WAIT_L
#undef PG8_BAR
#undef PG8_SCHED
}
}

struct EpiIn {
    bf16_t *Qb, *Kb, *Vb, *zb; float *outK, *outV; const f32x2* rope; int layer;
    DI void operator()(const f32x4 (&acc)[2][2][4][2], const pg8::Unit& u, int wr, int wc, int fr, int fq) const {
        const int tile = u.pn; const bool sample = u.pm >= 32;
        if (tile < 6) {
            const int kind = tile >> 1; const int cb = (tile & 1) * 256 + wc * 32 + 4 * fq;
            bf16_t* dst = Qb + (size_t)kind * (16u * 1024u * 1024u / 2u);
            float* of = outK + (size_t)(kind >= 1 ? kind - 1 : 0) * 16777216u;
#pragma unroll
            for (int ai = 0; ai < 2; ++ai)
#pragma unroll
                for (int m = 0; m < 4; ++m) {
                    const int r = u.pm * 256 + ai * 128 + wr * 64 + m * 16 + fr;
#pragma unroll
                    for (int bj = 0; bj < 2; ++bj) {
                        f32x4 a = acc[ai][bj][m][0], b = acc[ai][bj][m][1]; const int cc = cb + bj * 128;
                        if (!sample && kind >= 1) { float* o = of + ((size_t)((r >> 8) * 4 + layer) * 256 + (r & 255)) * 512 + cc; *(f32x4*)o = a; *(f32x4*)(o + 16) = b; }
                        if (sample && kind < 2) {
                            const int t = (r - 8192) & 4095; const int pos = (wc & 1) ? (t & 63) : (t >> 6); const f32x2* rp = rope + pos * 16 + 4 * fq;
#pragma unroll
                            for (int j = 0; j < 4; ++j) { const f32x2 cs = rp[j]; const float x1 = a[j], x2 = b[j]; a[j] = x1 * cs.x - x2 * cs.y; b[j] = x2 * cs.x + x1 * cs.y; }
                        }
                        if (kind == 0) { a = a * QSCALE; b = b * QSCALE; }
                        if (kind == 2) {
                            const int hh = cc >> 7, dv0 = cc & 127, tt = sample ? ((r - 8192) & 4095) : (r & 255);
                            bf16_t* vt = sample ? Vb + 4194304 + ((size_t)((((r - 8192) >> 12) * 4 + hh) * 32 + (tt >> 7)) * 128 + dv0) * 128 + (tt & 127)
                                                : Vb + ((size_t)(((r >> 8) * 4 + hh) * 2 + (tt >> 7)) * 128 + dv0) * 128 + (tt & 127);
#pragma unroll
                            for (int j = 0; j < 4; ++j) { vt[(size_t)j * 128] = f2bf(a[j]); vt[(size_t)(16 + j) * 128] = f2bf(b[j]); }
                        } else { *(u32x2*)(dst + (size_t)r * 512 + cc) = pack4(a); *(u32x2*)(dst + (size_t)r * 512 + cc + 16) = pack4(b); }
                    }
                    asm volatile("" ::: "memory");
                }
        } else {
#pragma unroll
            for (int ai = 0; ai < 2; ++ai)
#pragma unroll
                for (int m = 0; m < 4; ++m) {
                    const int r = u.pm * 256 + ai * 128 + wr * 64 + m * 16 + fr;
#pragma unroll
                    for (int bj = 0; bj < 2; ++bj)
#pragma unroll
                        for (int n = 0; n < 2; ++n) { const int c = (tile - 6) * 256 + bj * 128 + wc * 32 + 16 * n + 4 * fq; if (c < ZLD) *(u32x2*)(zb + (size_t)r * ZLD + c) = pack4(acc[ai][bj][m][n]); }
                    asm volatile("" ::: "memory");
                }
        }
    }
};
struct EpiRes {
    float* x; const float* gate; bf16_t* vb;
    DI void operator()(const f32x4 (&acc)[2][2][4][2], const pg8::Unit& u, int wr, int wc, int fr, int fq) const {
        const float* gv = gate + row_mod(u.pm * 256) * 6144;
#pragma unroll
        for (int ai = 0; ai < 2; ++ai)
#pragma unroll
            for (int m = 0; m < 4; ++m) {
                const int r = u.pm * 256 + ai * 128 + wr * 64 + m * 16 + fr;
#pragma unroll
                for (int bj = 0; bj < 2; ++bj)
#pragma unroll
                    for (int n = 0; n < 2; ++n) { const int c = u.pn * 256 + bj * 128 + wc * 32 + 16 * n + 4 * fq; const f32x4 g4 = *(const f32x4*)(gv + c); const u32x2 xw = *(const u32x2*)((const bf16_t*)x + (size_t)r * DM + c); const f32x4 xv = (f32x4){__uint_as_float(xw.x << 16), __uint_as_float(xw.x & 0xffff0000u), __uint_as_float(xw.y << 16), __uint_as_float(xw.y & 0xffff0000u)}; *(u32x2*)(vb + (size_t)r * DM + c) = pack4(xv * ALPHA + g4 * acc[ai][bj][m][n]); }
            }
    }
};
struct EpiFfn {
    bf16_t* act;
    DI void operator()(const f32x4 (&acc)[2][2][4][2], const pg8::Unit& u, int wr, int wc, int fr, int fq) const {
#pragma unroll
        for (int ai = 0; ai < 2; ++ai)
#pragma unroll
            for (int m = 0; m < 4; ++m) {
                const int r = u.pm * 256 + ai * 128 + wr * 64 + m * 16 + fr;
#pragma unroll
                for (int n = 0; n < 2; ++n) { const f32x4 gt = acc[ai][0][m][n], up = acc[ai][1][m][n]; f32x4 o;
#pragma unroll
                    for (int j = 0; j < 4; ++j) o[j] = siluf_(gt[j]) * up[j];
                    *(u32x2*)(act + (size_t)r * DFF + u.pn * 128 + wc * 32 + 16 * n + 4 * fq) = pack4(o); }
            }
    }
};

struct Ctx {
    const Params* p; LAS unsigned char* lds; float* L; int tid, lane, wave, G, gw, NGW;
    unsigned char* ws; float* out;
};

DI void tr_item(const float* W, int K, int N, bf16_t* WT, int mode, float* scr, int item, int lane) {
    const int nblk = (N + 31) / 32, kb = item / nblk, nb = item % nblk, k0 = 64 * kb, n0 = 32 * nb;
    const int nn = n0 + (lane & 31);
#pragma unroll 8
    for (int i = 0; i < 32; ++i) { const int kk = 2 * i + (lane >> 5); scr[kk * 33 + (lane & 31)] = (nn < N) ? W[(size_t)(k0 + kk) * N + nn] : 0.f; }
    __builtin_amdgcn_wave_barrier();
    const int c = lane & 7;
#pragma unroll
    for (int j = 0; j < 4; ++j) {
        const int nl = (lane >> 3) + 8 * j, n = n0 + nl; const float* s = scr + (8 * c) * 33 + nl;
        if (n < N) {
            int dst = n; if (mode == 1) { if (n < DFF) dst = (n >> 7) * 256 + (n & 127); else { const int jj = n - DFF; dst = (jj >> 7) * 256 + 128 + (jj & 127); } }
            u32x4 o; o.x = cvt_pk_bf16(s[0 * 33], s[1 * 33]); o.y = cvt_pk_bf16(s[2 * 33], s[3 * 33]); o.z = cvt_pk_bf16(s[4 * 33], s[5 * 33]); o.w = cvt_pk_bf16(s[6 * 33], s[7 * 33]);
            *(u32x4*)(WT + (size_t)dst * K + k0 + 8 * c) = o;
        }
    }
    __builtin_amdgcn_wave_barrier();
}
DI void convert_layer_weights(const Ctx& C, int layer, int gw0 = -1, int ngw = 0, int blk = -1, int nblk = 0) {
    const Params& p = *C.p;
    unsigned char* wb = C.ws + WS_W + (size_t)(layer & 1) * WBUF;
    bf16_t* Win = (bf16_t*)(wb + W_IN); bf16_t* Wout = (bf16_t*)(wb + W_OUT); bf16_t* Wffi = (bf16_t*)(wb + W_FFI); bf16_t* Wffo = (bf16_t*)(wb + W_FFO);
    float* scr = C.L + C.wave * (64 * 33);
    constexpr int I_IN = 16 * 121, I_OUT = 16 * 32, I_FFI = 16 * 176, I_FFO = 44 * 32, NIT = I_IN + I_OUT + I_FFI + I_FFO;
    int lane_ = C.lane; asm volatile("" : "+v"(lane_));
    const int gwA = gw0 >= 0 ? gw0 : C.gw, ngwA = gw0 >= 0 ? ngw : C.NGW, blkA = blk >= 0 ? blk : (int)blockIdx.x, nblkA = blk >= 0 ? nblk : C.G;
    for (int it = gwA; it < NIT; it += ngwA) {
        int r = it;
        if (r < I_IN) { tr_item(p.in[10] + (size_t)layer * DM * DIN, DM, DIN, Win, 0, scr, r, lane_); continue; } r -= I_IN;
        if (r < I_OUT) { tr_item(p.in[19] + (size_t)layer * DM * DM, DM, DM, Wout, 0, scr, r, lane_); continue; } r -= I_OUT;
        if (r < I_FFI) { tr_item(p.in[22] + (size_t)layer * DM * 2 * DFF, DM, 2 * DFF, Wffi, 1, scr, r, lane_); continue; } r -= I_FFI;
        tr_item(p.in[23] + (size_t)layer * DFF * DM, DFF, DM, Wffo, 0, scr, r, lane_);
    }
    u32x4* z = (u32x4*)(Win + (size_t)DIN * DM); const int nz = 240 * DM * 2 / 16;
    for (int i = blkA * 512 + C.tid; i < nz; i += nblkA * 512) z[i] = (u32x4){0u, 0u, 0u, 0u};
}

DI void mod_unit(const Ctx& C, int u) {
    const Params& p = *C.p; const int tid = C.tid;
    float* cs = C.L; float* red = C.L + 3072;
    const int layer = u >> 6, col0 = (u & 63) * 96;
    __syncthreads();
    for (int i = tid; i < 3072; i += 512) { const int v = i >> 10, k = i & 1023; const float c = (v == 0) ? p.in[7][k] : p.in[6][(v - 1) * 1024 + k]; cs[i] = siluf_(c); }
    __syncthreads();
    if (tid < 504) {
        const int cgp = tid % 24, rs = tid / 24;
        f32x4 a0 = {0, 0, 0, 0}, a1 = a0, a2 = a0;
        const float* Wp = p.in[8] + (size_t)layer * DM * 6144 + col0 + cgp * 4;
#pragma unroll 7
        for (int k = rs; k < 1024; k += 21) { const f32x4 w = *(const f32x4*)(Wp + (size_t)k * 6144); a0 += w * cs[k]; a1 += w * cs[1024 + k]; a2 += w * cs[2048 + k]; }
        float* rr = red + rs * 288 + cgp * 4;
#pragma unroll
        for (int j = 0; j < 4; ++j) { rr[j] = a0[j]; rr[96 + j] = a1[j]; rr[192 + j] = a2[j]; }
    }
    __syncthreads();
    if (tid < 288) {
        const int v = tid / 96, cc = tid % 96; float s = 0.f;
        for (int rs = 0; rs < 21; ++rs) s += red[rs * 288 + tid];
        ((float*)(C.ws + WS_MOD))[(size_t)(layer * 3 + v) * 6144 + col0 + cc] = s + p.in[9][layer * 6144 + col0 + cc];
    }
}

DI void phase0a(const Ctx& C) {
    const Params& p = *C.p;
    for (int u = blockIdx.x; u < 256; u += C.G) mod_unit(C, u);
    __syncthreads();
    convert_layer_weights(C, 0);
    const int gt = blockIdx.x * 512 + C.tid, NT = C.G * 512;
    float* tab = (float*)(C.ws + WS_TAB);
    if (gt < 1024) { const int pos = gt >> 4, i = gt & 15; const float inv = __builtin_amdgcn_exp2f(-(float)i * (13.287712379549449f / 16.0f)); float rev = (float)pos * inv * 0.15915494309189535f; rev -= floorf(rev);
        tab[2 * gt] = __builtin_amdgcn_cosf(rev); tab[2 * gt + 1] = __builtin_amdgcn_sinf(rev); }
    if (gt >= 1024 && gt < 1028) { const int l = gt - 1024; const float* dl = p.in[17] + l * 256; float s01 = 0.f, s23 = 0.f; for (int i = 0; i < 64; ++i) { s01 += dl[i] * dl[64 + i]; s23 += dl[128 + i] * dl[192 + i]; }
        tab[2048 + l] = __expf(s01) - __expf(s23) + (0.8f - 0.6f * __expf(-0.3f * (float)l)); }
    if (gt >= 2048 && gt < 2560) { const int dir = (gt - 2048) >> 8, c = gt & 255; const float* lb = p.in[15] + dir * 1024 + c; float v[4], mx = -1e30f; for (int l = 0; l < 4; ++l) { v[l] = lb[l * 256]; mx = fmaxf(mx, v[l]); }
        float s = 0.f; for (int l = 0; l < 4; ++l) { v[l] = __expf(v[l] - mx); s += v[l]; } float cum = 0.f; for (int l = 0; l < 4; ++l) { if (l > 0) cum += v[l] / s; tab[4096 + (dir * 4 + l) * 256 + c] = cum; } }
    bf16_t* ck = (bf16_t*)(C.ws + WS_CK); bf16_t* cv = (bf16_t*)(C.ws + WS_CV);
    for (int i = gt; i < 2 * 4 * 256 * 512 / 4; i += NT) { const int e = i * 4; const int c = e & 511, j = (e >> 9) & 255, l = (e >> 17) & 3, b = e >> 19;
        const size_t dst = ((size_t)((l * 2 + b) * 256 + j)) * 512 + c;
        *(u32x2*)(ck + dst) = pack4(*(const f32x4*)(p.in[2] + e)); }
    for (int i = gt; i < 2 * 4 * 256 * 512; i += NT) { const int j = i & 255, dv = (i >> 8) & 127, hh = (i >> 15) & 3, b = (i >> 17) & 1, l = i >> 18;
        cv[((size_t)((((l * 2 + b) * 4 + hh) * 2 + (j >> 7)) * 128 + dv)) * 128 + (j & 127)] = f2bf(p.in[3][((size_t)((b * 4 + l) * 256 + j) * 4 + hh) * 128 + dv]); }
}

DI void row_pass(const Ctx& C, int mode, const float* lng, const float* lnb, const float* modl, int sc_off, int sh_off, bool write_xm) {
    const Params& p = *C.p; float* x = C.out; bf16_t* xm = (bf16_t*)(C.ws + WS_XM);
    for (int r0 = C.gw; r0 < MROWS; r0 += 2 * C.NGW) {
        f32x4 v[2][4];
#pragma unroll
        for (int u = 0; u < 2; ++u) { const int r = r0 + u * C.NGW;
            if (mode == 0) { const float* src = (r < 8192 ? p.in[0] + (size_t)r * DM : p.in[1] + (size_t)(r - 8192) * DM);
#pragma unroll
                for (int j = 0; j < 4; ++j) v[u][j] = *(const f32x4*)(src + 4 * C.lane + 256 * j); }
            else {
#pragma unroll
                for (int j = 0; j < 4; ++j) { const u32x2 w2 = *(const u32x2*)(xm + (size_t)r * DM + 4 * C.lane + 256 * j);
                    v[u][j] = (f32x4){__uint_as_float(w2.x << 16), __uint_as_float(w2.x & 0xffff0000u), __uint_as_float(w2.y << 16), __uint_as_float(w2.y & 0xffff0000u)}; } } }
#pragma unroll
        for (int u = 0; u < 2; ++u) { const int r = r0 + u * C.NGW;
            if (mode == 1) {
                float s = 0.f;
#pragma unroll
                for (int j = 0; j < 4; ++j) s += (v[u][j][0] + v[u][j][1]) + (v[u][j][2] + v[u][j][3]);
                const float mean = wave_sum(s) * (1.f / DM); float s2 = 0.f;
#pragma unroll
                for (int j = 0; j < 4; ++j) { v[u][j] = v[u][j] - mean; s2 += (v[u][j][0] * v[u][j][0] + v[u][j][1] * v[u][j][1]) + (v[u][j][2] * v[u][j][2] + v[u][j][3] * v[u][j][3]); }
                const float rstd = 1.0f / sqrtf(wave_sum(s2) * (1.f / DM) + LN_EPS);
#pragma unroll
                for (int j = 0; j < 4; ++j) { const f32x4 g4 = *(const f32x4*)(lng + 4 * C.lane + 256 * j), b4 = *(const f32x4*)(lnb + 4 * C.lane + 256 * j); v[u][j] = v[u][j] * rstd * g4 + b4; }
            }
            if (PROBE_A >= 0 && !write_xm) { const float* tsf = (const float*)(C.ws + WS_TAB + 131072); const float sc = 1.0f + ((r >= 8192) ? tsf[12] : (PROBE_B >= 0 ? tsf[13] : 0.f));
#pragma unroll
                for (int j = 0; j < 4; ++j) v[u][j] = v[u][j] * sc; }
            if (!write_xm) {
#pragma unroll
                for (int j = 0; j < 4; ++j) *(f32x4*)(x + (size_t)r * DM + 4 * C.lane + 256 * j) = v[u][j];
            } else {
#pragma unroll
                for (int j = 0; j < 4; ++j) *(u32x2*)((bf16_t*)x + (size_t)r * DM + 4 * C.lane + 256 * j) = pack4(v[u][j]);
            }
            if (write_xm) {
                const float* mv = modl + row_mod(r) * 6144;
#pragma unroll
                for (int j = 0; j < 4; ++j) { const int c = 4 * C.lane + 256 * j; const f32x4 sc = *(const f32x4*)(mv + sc_off + c), sh = *(const f32x4*)(mv + sh_off + c);
                    *(u32x2*)(xm + (size_t)r * DM + c) = pack4(v[u][j] * (sc + 1.0f) + sh); }
            }
        }
    }
}

#define MFMA32(a, b, c) __builtin_amdgcn_mfma_f32_32x32x16_bf16((a), (b), (c), 0, 0, 0)
#define MFMA16(a, b, c) __builtin_amdgcn_mfma_f32_16x16x32_bf16((a), (b), (c), 0, 0, 0)
constexpr int AK_LD = 72, AV_LD = 136;
struct AttnSrc { const bf16_t* Klat; const bf16_t* Kctx; const bf16_t* VTlat; const bf16_t* VTctx; int ldv; int nst; int nlat; int h; };
template <int PASS>
DI void attn_pass(int tid, int q, int hi, int kq, const AttnSrc& A, LAS bf16_t* K1s, LAS bf16_t* K2s, LAS bf16_t* VTs, const bf16x8 (&q1)[4], const bf16x8 (&q2)[4],
                  float& m1, float& l1, float& m2, float& l2, float iL1, float iL2, f32x16 (&o)[4]) {
    u32x4 kreg[4], vreg[4];
    const int h = A.h;
    auto issue = [&](int st) {
        const bf16_t* kb = (st < A.nlat) ? A.Klat + (size_t)st * 128 * 512 : A.Kctx + (size_t)(st - A.nlat) * 128 * 512;
#pragma unroll
        for (int i = 0; i < 2; ++i) { const int id = tid + 512 * i, key = id >> 3, ch = id & 7; kreg[i] = *(const u32x4*)(kb + (size_t)key * 512 + h * 128 + ch * 8); kreg[2 + i] = *(const u32x4*)(kb + (size_t)key * 512 + h * 128 + 64 + ch * 8); }
        if (PASS == 1) {
            const bf16_t* vb = (st < A.nlat) ? A.VTlat + (size_t)st * 128 : A.VTctx + (size_t)(st - A.nlat) * 128; const int ld = (st < A.nlat) ? A.ldv : 256;
#pragma unroll
            for (int i = 0; i < 4; ++i) { const int id = tid + 512 * i, dv = id >> 4, ch = id & 15; vreg[i] = *(const u32x4*)(vb + (size_t)dv * ld + ch * 8); }
        }
    };
    issue(0);
    for (int st = 0; st < A.nst; ++st) {
        __syncthreads();
#pragma unroll
        for (int i = 0; i < 2; ++i) { const int id = tid + 512 * i, key = id >> 3, ch = id & 7; *(LAS u32x4*)(K1s + key * AK_LD + ch * 8) = kreg[i]; *(LAS u32x4*)(K2s + key * AK_LD + ch * 8) = kreg[2 + i]; }
        if (PASS == 1) {
#pragma unroll
            for (int i = 0; i < 4; ++i) { const int id = tid + 512 * i, dv = id >> 4, ch = id & 15; *(LAS u32x4*)(VTs + dv * AV_LD + ch * 8) = vreg[i]; }
        }
        __syncthreads();
        if (st + 1 < A.nst) issue(st + 1);
        const int keyrow = kq * 32 + q;
        f32x16 s1, pr;
#pragma unroll
        for (int r = 0; r < 16; ++r) s1[r] = 0.f;
#pragma unroll
        for (int ks = 0; ks < 4; ++ks) { const bf16x8 a1 = *(const LAS bf16x8*)(K1s + keyrow * AK_LD + 16 * ks + 8 * hi); s1 = MFMA32(a1, q1[ks], s1); }
        if (PASS == 0) {
            float mx1 = s1[0];
#pragma unroll
            for (int r = 1; r < 16; ++r) mx1 = fmaxf(mx1, s1[r]);
            const float n1 = fmaxf(m1, mx1); float a1s = 0.f;
#pragma unroll
            for (int r = 0; r < 16; ++r) a1s += __builtin_amdgcn_exp2f(s1[r] - n1);
            l1 = l1 * __builtin_amdgcn_exp2f(m1 - n1) + a1s; m1 = n1;
        } else {
#pragma unroll
            for (int r = 0; r < 16; ++r) pr[r] = __builtin_amdgcn_exp2f(s1[r] - m1) * iL1;
        }
#pragma unroll
        for (int r = 0; r < 16; ++r) s1[r] = 0.f;
#pragma unroll
        for (int ks = 0; ks < 4; ++ks) { const bf16x8 a2 = *(const LAS bf16x8*)(K2s + keyrow * AK_LD + 16 * ks + 8 * hi); s1 = MFMA32(a2, q2[ks], s1); }
        if (PASS == 0) {
            float mx2 = s1[0];
#pragma unroll
            for (int r = 1; r < 16; ++r) mx2 = fmaxf(mx2, s1[r]);
            const float n2 = fmaxf(m2, mx2); float a2s = 0.f;
#pragma unroll
            for (int r = 0; r < 16; ++r) a2s += __builtin_amdgcn_exp2f(s1[r] - n2);
            l2 = l2 * __builtin_amdgcn_exp2f(m2 - n2) + a2s; m2 = n2;
        } else {
#pragma unroll
            for (int r = 0; r < 16; ++r) pr[r] -= __builtin_amdgcn_exp2f(s1[r] - m2) * iL2;
            bf16x8 pb[2];
            { u32x4 t0, t1; t0.x = cvt_pk_bf16(pr[0], pr[1]); t0.y = cvt_pk_bf16(pr[2], pr[3]); t0.z = cvt_pk_bf16(pr[4], pr[5]); t0.w = cvt_pk_bf16(pr[6], pr[7]);
              t1.x = cvt_pk_bf16(pr[8], pr[9]); t1.y = cvt_pk_bf16(pr[10], pr[11]); t1.z = cvt_pk_bf16(pr[12], pr[13]); t1.w = cvt_pk_bf16(pr[14], pr[15]);
              pb[0] = __builtin_bit_cast(bf16x8, t0); pb[1] = __builtin_bit_cast(bf16x8, t1); }
#pragma unroll
            for (int blk = 0; blk < 4; ++blk)
#pragma unroll
                for (int s = 0; s < 2; ++s) {
                    const LAS bf16_t* vp = VTs + (blk * 32 + q) * AV_LD + kq * 32 + 16 * s + 4 * hi;
                    const s16x4 lo = *(const LAS s16x4*)vp, hh = *(const LAS s16x4*)(vp + 8);
                    const bf16x8 av = __builtin_shufflevector(lo, hh, 0, 1, 2, 3, 4, 5, 6, 7);
                    o[blk] = MFMA32(av, pb[s], o[blk]);
                }
        }
    }
}
DI void attn_unit(const Ctx& C, int layer, int uidx) {
    int tid = C.tid; asm volatile("" : "+v"(tid)); const int lane = tid & 63, w = __builtin_amdgcn_readfirstlane(tid >> 6), qg = w & 3, kh = w >> 2, q = lane & 15, g = lane >> 4;
    const bf16_t* Qb = (const bf16_t*)(C.ws + WS_Q); const bf16_t* Kb = (const bf16_t*)(C.ws + WS_K); const bf16_t* VT = (const bf16_t*)(C.ws + WS_V);
    const bf16_t* cK = (const bf16_t*)(C.ws + WS_CK); const bf16_t* cVT = (const bf16_t*)(C.ws + WS_CV);
    int b, h, rowq0; AttnSrc A;
    if (uidx < 512) { b = uidx >> 8; h = (uidx >> 6) & 3; const int qb = uidx & 63; rowq0 = 8192 + b * 4096 + qb * 64; A.nst = 34; A.nlat = 32; A.ldv = 4096;
        A.Klat = Kb + (size_t)(8192 + b * 4096) * 512; A.VTlat = VT + 4194304 + (size_t)((b * 4 + h) * 32) * 16384; A.Kctx = cK + (size_t)((layer * 2 + b) * 256) * 512; A.VTctx = cVT + (size_t)(((layer * 2 + b) * 4 + h) * 2) * 16384; }
    else { const int v = uidx - 512; b = v >> 4; h = (v >> 2) & 3; const int qb = v & 3; rowq0 = b * 256 + qb * 64; A.nst = 2; A.nlat = 2; A.ldv = 256;
        A.Klat = Kb + (size_t)(b * 256) * 512; A.VTlat = VT + (size_t)((b * 4 + h) * 2) * 16384; A.Kctx = A.Klat; A.VTctx = A.VTlat; }
    A.h = h;
    LAS bf16_t* K1s = (LAS bf16_t*)C.lds; LAS bf16_t* K2s = K1s + 128 * AK_LD; LAS bf16_t* VTs = K2s + 128 * AK_LD;
    const float lam = ((const float*)(C.ws + WS_TAB))[2048 + layer];
    bf16x8 qf1[2], qf2[2];
    { const bf16_t* qp = Qb + (size_t)(rowq0 + 16 * qg + q) * 512 + h * 128 + 8 * g;
#pragma unroll
      for (int ks = 0; ks < 2; ++ks) { qf1[ks] = *(const bf16x8*)(qp + 32 * ks); qf2[ks] = *(const bf16x8*)(qp + 64 + 32 * ks); } }
    float m1 = -1e30f, l1 = 0.f, m2 = -1e30f, l2 = 0.f;
    f32x4 O1[8], O2[8];
#pragma unroll
    for (int t = 0; t < 8; ++t) { O1[t] = (f32x4){0.f, 0.f, 0.f, 0.f}; O2[t] = O1[t]; }
    u32x4 kreg[4], vreg[4];
    auto issue = [&](int st) {
        const bf16_t* kb = (st < A.nlat) ? A.Klat + (size_t)st * 128 * 512 : A.Kctx + (size_t)(st - A.nlat) * 128 * 512;
#pragma unroll
        for (int i = 0; i < 2; ++i) { const int id = tid + 512 * i, key = id >> 3, ch = id & 7; kreg[i] = *(const u32x4*)(kb + (size_t)key * 512 + h * 128 + ch * 8); kreg[2 + i] = *(const u32x4*)(kb + (size_t)key * 512 + h * 128 + 64 + ch * 8); }
        const bf16_t* vb = (st < A.nlat) ? A.VTlat + (size_t)st * 16384 : A.VTctx + (size_t)(st - A.nlat) * 16384;
#pragma unroll
        for (int i = 0; i < 4; ++i) { const int id = tid + 512 * i; vreg[i] = *(const u32x4*)(vb + (size_t)id * 8); }
    };
    issue(0);
    for (int st = 0; st < A.nst; ++st) {
        __syncthreads();
#pragma unroll
        for (int i = 0; i < 2; ++i) { const int id = tid + 512 * i, key = id >> 3, ch = id & 7; *(LAS u32x4*)(K1s + key * AK_LD + ch * 8) = kreg[i]; *(LAS u32x4*)(K2s + key * AK_LD + ch * 8) = kreg[2 + i]; }
#pragma unroll
        for (int i = 0; i < 4; ++i) { const int id = tid + 512 * i, dv = id >> 4, ch = id & 15; *(LAS u32x4*)(VTs + dv * AV_LD + ch * 8) = vreg[i]; }
        __syncthreads();
        if (st + 1 < A.nst) issue(st + 1);
#pragma unroll
        for (int kb = 0; kb < 2; ++kb) {
            const int key0 = kh * 64 + kb * 32;
            f32x4 sA0 = {0.f, 0.f, 0.f, 0.f}, sA1 = sA0, sB0 = sA0, sB1 = sA0;
#pragma unroll
            for (int ks = 0; ks < 2; ++ks) {
                const bf16x8 a10 = *(const LAS bf16x8*)(K1s + (key0 + q) * AK_LD + 32 * ks + 8 * g), a11 = *(const LAS bf16x8*)(K1s + (key0 + 16 + q) * AK_LD + 32 * ks + 8 * g);
                const bf16x8 a20 = *(const LAS bf16x8*)(K2s + (key0 + q) * AK_LD + 32 * ks + 8 * g), a21 = *(const LAS bf16x8*)(K2s + (key0 + 16 + q) * AK_LD + 32 * ks + 8 * g);
                sA0 = MFMA16(a10, qf1[ks], sA0); sA1 = MFMA16(a11, qf1[ks], sA1); sB0 = MFMA16(a20, qf2[ks], sB0); sB1 = MFMA16(a21, qf2[ks], sB1);
            }
            float t1 = fmaxf(fmaxf(fmaxf(sA0[0], sA0[1]), fmaxf(sA0[2], sA0[3])), fmaxf(fmaxf(sA1[0], sA1[1]), fmaxf(sA1[2], sA1[3])));
            float t2 = fmaxf(fmaxf(fmaxf(sB0[0], sB0[1]), fmaxf(sB0[2], sB0[3])), fmaxf(fmaxf(sB1[0], sB1[1]), fmaxf(sB1[2], sB1[3])));
            if (__any(t1 > m1 || t2 > m2)) {
                t1 = fmaxf(t1, __shfl_xor(t1, 16)); t1 = fmaxf(t1, __shfl_xor(t1, 32)); t2 = fmaxf(t2, __shfl_xor(t2, 16)); t2 = fmaxf(t2, __shfl_xor(t2, 32));
                const float n1 = fmaxf(m1, t1), n2 = fmaxf(m2, t2); const float f1 = __builtin_amdgcn_exp2f(m1 - n1), f2 = __builtin_amdgcn_exp2f(m2 - n2);
                l1 *= f1; l2 *= f2; m1 = n1; m2 = n2;
#pragma unroll
                for (int t = 0; t < 8; ++t) { O1[t] = O1[t] * f1; O2[t] = O2[t] * f2; }
            }
            f32x4 pA0, pA1, pB0, pB1;
#pragma unroll
            for (int i = 0; i < 4; ++i) { pA0[i] = __builtin_amdgcn_exp2f(sA0[i] - m1); pA1[i] = __builtin_amdgcn_exp2f(sA1[i] - m1); pB0[i] = __builtin_amdgcn_exp2f(sB0[i] - m2); pB1[i] = __builtin_amdgcn_exp2f(sB1[i] - m2); }
            l1 += (pA0[0] + pA0[1]) + (pA0[2] + pA0[3]) + (pA1[0] + pA1[1]) + (pA1[2] + pA1[3]);
            l2 += (pB0[0] + pB0[1]) + (pB0[2] + pB0[3]) + (pB1[0] + pB1[1]) + (pB1[2] + pB1[3]);
            const bf16x8 pb1 = pack8(pA0, pA1), pb2 = pack8(pB0, pB1);
#pragma unroll
            for (int t = 0; t < 8; ++t) {
                const LAS bf16_t* vp = VTs + (16 * t + q) * AV_LD + key0 + 4 * g;
                const s16x4 lo = *(const LAS s16x4*)vp, hh = *(const LAS s16x4*)(vp + 16);
                const bf16x8 av = __builtin_shufflevector(lo, hh, 0, 1, 2, 3, 4, 5, 6, 7);
                O1[t] = MFMA16(av, pb1, O1[t]); O2[t] = MFMA16(av, pb2, O2[t]);
            }
        }
    }
    l1 += __shfl_xor(l1, 16); l1 += __shfl_xor(l1, 32); l2 += __shfl_xor(l2, 16); l2 += __shfl_xor(l2, 32);
    __syncthreads();
    LAS float* comb = (LAS float*)C.lds;
    LAS float* exs = (LAS float*)(C.lds + 65536);
    if (kh == 1) {
#pragma unroll
        for (int t = 0; t < 8; ++t)
#pragma unroll
            for (int i = 0; i < 4; ++i) { comb[(qg * 64 + t * 4 + i) * 64 + lane] = O1[t][i]; comb[(qg * 64 + 32 + t * 4 + i) * 64 + lane] = O2[t][i]; }
        exs[(qg * 4 + 0) * 64 + lane] = m1; exs[(qg * 4 + 1) * 64 + lane] = l1; exs[(qg * 4 + 2) * 64 + lane] = m2; exs[(qg * 4 + 3) * 64 + lane] = l2;
    }
    __syncthreads();
    if (kh == 0) {
        const float om1 = exs[(qg * 4 + 0) * 64 + lane], ol1 = exs[(qg * 4 + 1) * 64 + lane], om2 = exs[(qg * 4 + 2) * 64 + lane], ol2 = exs[(qg * 4 + 3) * 64 + lane];
        const float n1 = fmaxf(m1, om1), n2 = fmaxf(m2, om2);
        const float fa1 = __builtin_amdgcn_exp2f(m1 - n1), fb1 = __builtin_amdgcn_exp2f(om1 - n1), fa2 = __builtin_amdgcn_exp2f(m2 - n2), fb2 = __builtin_amdgcn_exp2f(om2 - n2);
        const float L1 = l1 * fa1 + ol1 * fb1, L2 = l2 * fa2 + ol2 * fb2;
        const float c1a = fa1 / L1, c1b = fb1 / L1, c2a = lam * fa2 / L2, c2b = lam * fb2 / L2;
        float ss = 0.f;
#pragma unroll
        for (int t = 0; t < 8; ++t)
#pragma unroll
            for (int i = 0; i < 4; ++i) { const float v = O1[t][i] * c1a + comb[(qg * 64 + t * 4 + i) * 64 + lane] * c1b - O2[t][i] * c2a - comb[(qg * 64 + 32 + t * 4 + i) * 64 + lane] * c2b; O1[t][i] = v; ss += v * v; }
        ss += __shfl_xor(ss, 16); ss += __shfl_xor(ss, 32);
        const float lam_init = 0.8f - 0.6f * __expf(-0.3f * (float)layer);
        const float sc = (1.0f / sqrtf(ss * (1.0f / 128.0f) + RMS_EPS)) * (1.0f - lam_init);
        const float* dn = C.p->in[18] + layer * 128;
        bf16_t* ob = (bf16_t*)(C.ws + WS_O) + (size_t)(rowq0 + 16 * qg + q) * DM + h * 128;
#pragma unroll
        for (int t = 0; t < 8; ++t) { const int dv = 16 * t + 4 * g; const f32x4 d4 = *(const f32x4*)(dn + dv); *(u32x2*)(ob + dv) = pack4(O1[t] * sc * d4); }
    }
    __syncthreads();
}

DI void delta_prep_unit(const Ctx& C, int layer, int unit) {
    const Params& p = *C.p; int tid = C.tid; asm volatile("" : "+v"(tid)); const int lane = tid & 63, w = __builtin_amdgcn_readfirstlane(tid >> 6);
    const int tc = unit >> 2, h = unit & 3, row0 = tc * 64;
    int ci, nch; if (tc < 128) { ci = tc & 3; nch = 4; } else { ci = (tc - 128) & 63; nch = 64; }
    const bool has_prev = ci > 0, has_next = ci < nch - 1;
    float* qs = C.L; float* kk = C.L + 4160; float* vv = C.L + 8320; float* KK0 = C.L + 12480; float* QK0 = KK0 + 4096; float* Ms = QK0 + 4096; float* bc = Ms + 8192; float* be = bc + 128;
    const bf16_t* zb = (const bf16_t*)(C.ws + WS_ZB);
    const float* cw = p.in[11] + layer * 3 * 768;
    __syncthreads();
    if (tid < 384) {
        const int c = tid % 192, th = tid / 192, which = c >> 6, d = c & 63, col = which * 256 + h * 64 + d;
        const float w0 = cw[col], w1 = cw[768 + col], w2 = cw[1536 + col];
        float xin[34];
#pragma unroll
        for (int i = 0; i < 34; ++i) { const int tt = 32 * th - 1 + i; const bool ok = (tt >= 0 || has_prev) && (tt < 64 || has_next); xin[i] = ok ? bf2f(zb[(size_t)(row0 + tt) * ZLD + col]) : 0.f; }
        float* dstp = (which == 0 ? qs : (which == 1 ? kk : vv)) + d;
#pragma unroll
        for (int i = 0; i < 32; ++i) dstp[(32 * th + i) * 65] = siluf_(w0 * xin[i] + w1 * xin[i + 1] + w2 * xin[i + 2]);
    }
    __syncthreads();
    { const int r = tid >> 2, part = tid & 3; float* base = (r < 64 ? qs + r * 65 : kk + (r - 64) * 65) + part * 16; float ss = 0.f;
#pragma unroll
      for (int i = 0; i < 16; ++i) ss += base[i] * base[i];
      ss += __shfl_xor(ss, 1); ss += __shfl_xor(ss, 2);
      const float sc = (1.0f / sqrtf(ss + 1e-6f)) * (r < 64 ? 0.125f : 1.0f);
#pragma unroll
      for (int i = 0; i < 16; ++i) base[i] *= sc; }
    if (w < 2) {
        const int dir = w, i = lane, tt = dir ? 63 - i : i; const size_t row = (size_t)(row0 + tt);
        const float braw = bf2f(zb[row * ZLD + ZB_BBETA + dir * 4 + h]), araw = bf2f(zb[row * ZLD + ZB_BA + dir * 4 + h]);
        const float A = __expf(p.in[12][layer * 8 + dir * 4 + h]); const float x = araw + p.in[13][layer * 8 + dir * 4 + h];
        const float sp = x > 20.f ? x : log1pf(__expf(x)); float g = -A * sp;
#pragma unroll
        for (int off = 1; off < 64; off <<= 1) { const float t = __shfl_up(g, off); if (lane >= off) g += t; }
        bc[dir * 64 + i] = g; const float bt = sigmoidf_(braw); be[dir * 64 + i] = bt; be[128 + dir * 64 + i] = bt * __expf(g);
    }
    __syncthreads();
    {
        const int rbm = w & 3, cb0 = (w >> 2) * 2, r16 = lane & 15, g4 = lane >> 4;
        bf16x8 kA[2], qA[2], kB[2][2];
#pragma unroll
        for (int ks = 0; ks < 2; ++ks) {
            const float* kp = kk + (16 * rbm + r16) * 65 + 32 * ks + 8 * g4; const float* qp = qs + (16 * rbm + r16) * 65 + 32 * ks + 8 * g4;
            kA[ks] = pack8((f32x4){kp[0], kp[1], kp[2], kp[3]}, (f32x4){kp[4], kp[5], kp[6], kp[7]});
            qA[ks] = pack8((f32x4){qp[0], qp[1], qp[2], qp[3]}, (f32x4){qp[4], qp[5], qp[6], qp[7]});
#pragma unroll
            for (int c = 0; c < 2; ++c) { const float* bp = kk + (16 * (cb0 + c) + r16) * 65 + 32 * ks + 8 * g4;
                kB[c][ks] = pack8((f32x4){bp[0], bp[1], bp[2], bp[3]}, (f32x4){bp[4], bp[5], bp[6], bp[7]}); }
        }
#pragma unroll
        for (int c = 0; c < 2; ++c) {
            f32x4 ak = {0.f, 0.f, 0.f, 0.f}, aq = ak;
#pragma unroll
            for (int ks = 0; ks < 2; ++ks) { ak = MFMA16(kA[ks], kB[c][ks], ak); aq = MFMA16(qA[ks], kB[c][ks], aq); }
#pragma unroll
            for (int i = 0; i < 4; ++i) { const int o = (16 * rbm + 4 * g4 + i) * 64 + 16 * (cb0 + c) + r16; KK0[o] = ak[i]; QK0[o] = aq[i]; }
        }
    }
    __syncthreads();
    bf16_t* dpW = (bf16_t*)(C.ws + WS_DPW); bf16_t* dpQD = (bf16_t*)(C.ws + WS_DPQD); bf16_t* dpQK = (bf16_t*)(C.ws + WS_DPQK); bf16_t* dpKD = (bf16_t*)(C.ws + WS_DPKD); bf16_t* dpU = (bf16_t*)(C.ws + WS_DPU);
    float* dpGL = (float*)(C.ws + WS_GL);
    { const int i = tid >> 3, j0 = (tid & 7) * 8;
#pragma unroll
      for (int dir = 0; dir < 2; ++dir) {
          const size_t ud = ((size_t)tc * 4 + h) * 2 + dir;
          const float bi = bc[dir * 64 + i], betai = be[dir * 64 + i]; const int ai = dir ? 63 - i : i;
#pragma unroll
          for (int jj = 0; jj < 8; ++jj) { const int j = j0 + jj, aj = dir ? 63 - j : j;
              const float dec = (j <= i) ? __expf(bi - bc[dir * 64 + j]) : 0.f;
              Ms[dir * 4096 + j * 64 + i] = (j < i) ? betai * KK0[ai * 64 + aj] * dec : 0.f;
              dpQK[ud * 4096 + i * 64 + pinv(j)] = f2bf(QK0[ai * 64 + aj] * dec); }
      } }
    __syncthreads();
    if (w < 4) {
        const int dir = w >> 1, c = (w & 1) * 64 + lane; const size_t ud = ((size_t)tc * 4 + h) * 2 + dir;
        const float* Msd = Ms + dir * 4096; const bool isU = (w & 1) == 0; const float* scp = be + (isU ? 0 : 128) + dir * 64; const float* srcp = (isU ? vv : kk) + lane;
        float x[64];
#pragma unroll
        for (int rb = 0; rb < 4; ++rb) {
            float r[16];
#pragma unroll
            for (int ii = 0; ii < 16; ++ii) { const int i = 16 * rb + ii, tt = dir ? 63 - i : i; r[ii] = scp[i] * srcp[tt * 65]; }
            asm volatile("" ::: "memory");
#pragma unroll
            for (int j = 0; j < 16 * rb; ++j) {
                const float* mp = Msd + j * 64 + 16 * rb;
                const f32x4 ma = *(const f32x4*)mp, mb = *(const f32x4*)(mp + 4), mc = *(const f32x4*)(mp + 8), md = *(const f32x4*)(mp + 12);
                const float xj = x[j];
#pragma unroll
                for (int c4 = 0; c4 < 4; ++c4) { r[c4] -= ma[c4] * xj; r[4 + c4] -= mb[c4] * xj; r[8 + c4] -= mc[c4] * xj; r[12 + c4] -= md[c4] * xj; }
                if ((j & 3) == 3) asm volatile("" ::: "memory");
            }
#pragma unroll
            for (int jj = 0; jj < 16; ++jj) {
                const float xj = r[jj]; x[16 * rb + jj] = xj;
                const float* mp = Msd + (16 * rb + jj) * 64 + 16 * rb;
#pragma unroll
                for (int ii = jj + 1; ii < 16; ++ii) r[ii] -= mp[ii] * xj;
                if ((jj & 3) == 3) asm volatile("" ::: "memory");
            }
        }
        if (c < 64) {
            bf16_t* up = dpU + ud * 4096 + c * 64;
#pragma unroll
            for (int i = 0; i < 64; i += 8) { u32x4 o; o.x = cvt_pk_bf16(x[i], x[i + 1]); o.y = cvt_pk_bf16(x[i + 2], x[i + 3]); o.z = cvt_pk_bf16(x[i + 4], x[i + 5]); o.w = cvt_pk_bf16(x[i + 6], x[i + 7]); *(u32x4*)(up + i) = o; }
        } else {
            bf16_t* wp = dpW + ud * 4096 + pinv(c - 64);
#pragma unroll
            for (int i = 0; i < 64; ++i) wp[i * 64] = f2bf(x[i]);
        }
    } else {
#pragma unroll 4
        for (int it = 0; it < 64; ++it) {
            const int e = (tid - 256) + 256 * it, dir = e >> 13, which = (e >> 12) & 1, rem = e & 4095; const size_t ud = ((size_t)tc * 4 + h) * 2 + dir;
            if (which == 0) { const int i = rem >> 6, d = rem & 63, tt = dir ? 63 - i : i; dpQD[ud * 4096 + i * 64 + pinv(d)] = f2bf(qs[tt * 65 + d] * __expf(bc[dir * 64 + i])); }
            else { const int dk = rem >> 6, i = rem & 63, tt = dir ? 63 - i : i; dpKD[ud * 4096 + dk * 64 + pinv(i)] = f2bf(kk[tt * 65 + dk] * __expf(bc[dir * 64 + 63] - bc[dir * 64 + i])); }
        }
        if (tid == 256 || tid == 257) { const int dir = tid - 256; dpGL[((size_t)tc * 4 + h) * 2 + dir] = __expf(bc[dir * 64 + 63]); }
    }
}

DI void delta_scan_unit(const Ctx& C, int layer, bool sample, int b, int h) {
    const Params& p = *C.p; int tid = C.tid; asm volatile("" : "+v"(tid)); const int lane = tid & 63; const int w = C.wave, dir = w >> 2, sl = w & 3, col = lane & 15, g = lane >> 4;
    const int tc0 = sample ? 128 + b * 64 : b * 4, nch = sample ? 64 : 4;
    const bf16_t* dpU = (const bf16_t*)(C.ws + WS_DPU);
    const float* dpGL = (const float*)(C.ws + WS_GL); float* od = (float*)(C.ws + WS_OD) + (size_t)dir * MROWS * 256;
    f32x4 S[4];
    if (sample) { const float* s0 = p.in[4] + ((((size_t)b * 4 + layer) * 2 + dir) * 4 + h) * 4096;
#pragma unroll
        for (int rb = 0; rb < 4; ++rb)
#pragma unroll
            for (int ii = 0; ii < 4; ++ii) S[rb][ii] = s0[(16 * rb + 4 * g + ii) * 64 + 16 * sl + col]; }
    else {
#pragma unroll
        for (int rb = 0; rb < 4; ++rb) S[rb] = (f32x4){0.f, 0.f, 0.f, 0.f}; }
    u32x4 Ra[8], Rb[8];
#define DS_TC(d_, n_) ((d_) ? tc0 + nch - 1 - (n_) : tc0 + (n_))
#define DS_ISSUE(R, n_) do { _Pragma("unroll") for (int i = 0; i < 8; ++i) { const int id = tid + 512 * i, dm = id >> 9, dd = dm >> 2, mat = dm & 3; \
        const size_t ud_ = ((size_t)DS_TC(dd, n_) * 4 + h) * 2 + dd; R[i] = *(const u32x4*)(C.ws + WS_DPW + (size_t)mat * (16u * MiB) + ud_ * 8192 + (size_t)(id & 511) * 16); } } while (0)
#define DS_WRITE(R, buf_) do { _Pragma("unroll") for (int i = 0; i < 8; ++i) { const int id = tid + 512 * i, dm = id >> 9, row = (id >> 3) & 63, c = id & 7; \
        *(LAS u32x4*)(C.lds + (buf_) * 65536 + dm * 8192 + row * 128 + ((c ^ (row & 7)) * 16)) = R[i]; } } while (0)
#define DS_FRAG(buf_, mat_, rb_, ks_) (*(const LAS bf16x8*)(C.lds + (buf_) * 65536 + (dir * 4 + (mat_)) * 8192 + (16 * (rb_) + col) * 128 + ((((ks_) * 4 + g) ^ (col & 7)) * 16)))
    __syncthreads();
    DS_ISSUE(Ra, 0); DS_WRITE(Ra, 0); DS_ISSUE(Ra, 1);
    s16x4 uuA[4], uuB[4]; float glA, glB;
#define DS_LOADU(uu, gl, n_) do { const size_t ud_ = ((size_t)DS_TC(dir, n_) * 4 + h) * 2 + dir; _Pragma("unroll") for (int rb = 0; rb < 4; ++rb) uu[rb] = *(const s16x4*)(dpU + ud_ * 4096 + (16 * sl + col) * 64 + 16 * rb + 4 * g); gl = dpGL[ud_]; } while (0)
    DS_LOADU(uuA, glA, 0); DS_LOADU(uuB, glB, 1);
    __syncthreads();
#define DS_STEP(n, buf, Rnext, Rcur, uu, gl) do { \
        if ((n) + 2 < nch) DS_ISSUE(Rnext, (n) + 2); \
        const int tc = DS_TC(dir, (n)); \
        bf16x8 Sb[2]; Sb[0] = pack8(S[0], S[1]); Sb[1] = pack8(S[2], S[3]); \
        f32x4 vn[4]; \
        _Pragma("unroll") for (int rb = 0; rb < 4; ++rb) { f32x4 t = (f32x4){0.f, 0.f, 0.f, 0.f}; t = MFMA16(DS_FRAG(buf, 0, rb, 0), Sb[0], t); t = MFMA16(DS_FRAG(buf, 0, rb, 1), Sb[1], t); \
            _Pragma("unroll") for (int ii = 0; ii < 4; ++ii) vn[rb][ii] = bf2f((bf16_t)uu[rb][ii]) - t[ii]; } \
        const float glc = gl; \
        if ((n) + 2 < nch) DS_LOADU(uu, gl, (n) + 2); \
        bf16x8 vb[2]; vb[0] = pack8(vn[0], vn[1]); vb[1] = pack8(vn[2], vn[3]); \
        const int rowb = tc * 64; \
        _Pragma("unroll") for (int rb = 0; rb < 4; ++rb) { f32x4 o = (f32x4){0.f, 0.f, 0.f, 0.f}; o = MFMA16(DS_FRAG(buf, 1, rb, 0), Sb[0], o); o = MFMA16(DS_FRAG(buf, 1, rb, 1), Sb[1], o); o = MFMA16(DS_FRAG(buf, 2, rb, 0), vb[0], o); o = MFMA16(DS_FRAG(buf, 2, rb, 1), vb[1], o); \
            _Pragma("unroll") for (int ii = 0; ii < 4; ++ii) { const int i = 16 * rb + 4 * g + ii; const int tt = dir ? 63 - i : i; od[(size_t)(rowb + tt) * 256 + h * 64 + 16 * sl + col] = o[ii]; } } \
        _Pragma("unroll") for (int rb = 0; rb < 4; ++rb) { f32x4 sn = S[rb] * glc; sn = MFMA16(DS_FRAG(buf, 3, rb, 0), vb[0], sn); sn = MFMA16(DS_FRAG(buf, 3, rb, 1), vb[1], sn); S[rb] = sn; } \
        if ((n) + 1 < nch) DS_WRITE(Rcur, (buf) ^ 1); \
        __syncthreads(); } while (0)
    for (int n = 0; n < nch; n += 2) {
        DS_STEP(n, 0, Rb, Ra, uuA, glA);
        DS_STEP(n + 1, 1, Ra, Rb, uuB, glB);
    }
#undef DS_STEP
#undef DS_TC
#undef DS_ISSUE
#undef DS_WRITE
#undef DS_FRAG
#undef DS_LOADU
    if (!sample) { float* so = C.out + OUT_SD + ((((size_t)b * 4 + layer) * 2 + dir) * 4 + h) * 4096;
#pragma unroll
        for (int rb = 0; rb < 4; ++rb)
#pragma unroll
            for (int ii = 0; ii < 4; ++ii) so[(16 * rb + 4 * g + ii) * 64 + 16 * sl + col] = S[rb][ii]; }
}

DI float hgrn_forget(const bf16_t* zb, size_t row, int dir, int h, int d, float lb) { const float x = bf2f(zb[row * ZLD + ZB_CF + dir * 256 + h * 64 + d]); return lb + (1.0f - lb) * sigmoidf_(x); }
DI void hgrn_local_unit(const Ctx& C, int layer, int unit) {
    int lane = C.lane; asm volatile("" : "+v"(lane)); const int dir = unit & 1, h = (unit >> 1) & 3, tc = unit >> 3, row0 = tc * 64;
    const bf16_t* zb = (const bf16_t*)(C.ws + WS_ZB);
    float* fs = C.L + C.wave * 1024;
    const float lb = ((const float*)(C.ws + WS_TAB))[4096 + (dir * 4 + layer) * 256 + h * 64 + lane];
    float S[64];
#pragma unroll
    for (int d = 0; d < 64; ++d) S[d] = 0.f;
    float Dl = 1.0f;
    for (int sb = 0; sb < 4; ++sb) {
        float vr[16];
#pragma unroll
        for (int i = 0; i < 16; ++i) { const int ti = sb * 16 + i, tt = dir ? 63 - ti : ti; const size_t row = (size_t)(row0 + tt);
            const float f = hgrn_forget(zb, row, dir, h, lane, lb); fs[i * 64 + lane] = f; Dl *= f; vr[i] = bf2f(zb[row * ZLD + ZB_CI + h * 64 + lane]); }
        __builtin_amdgcn_wave_barrier();
#pragma unroll
        for (int i = 0; i < 16; ++i) { const float v = vr[i];
#pragma unroll
            for (int d = 0; d < 64; d += 4) { const f32x4 f4 = *(const f32x4*)(fs + i * 64 + d);
#pragma unroll
                for (int c = 0; c < 4; ++c) S[d + c] = fmaf(f4[c], S[d + c] - v, v);
                if ((d & 15) == 12) asm volatile("" ::: "memory"); } }
        __builtin_amdgcn_wave_barrier();
    }
    float* hs = (float*)(C.ws + WS_HS) + (size_t)unit * 4096;
#pragma unroll
    for (int d = 0; d < 64; ++d) hs[d * 64 + lane] = S[d];
    ((float*)(C.ws + WS_HD))[(size_t)unit * 64 + lane] = Dl;
}
DI void hgrn_scan_unit(const Ctx& C, int layer, bool sample, int b, int h, int dir) {
    const Params& p = *C.p; int tid = C.tid; asm volatile("" : "+v"(tid)); const int tc0 = sample ? 128 + b * 64 : b * 4, nch = sample ? 64 : 4;
    float* HS = (float*)(C.ws + WS_HS); const float* HD = (const float*)(C.ws + WS_HD);
    f32x4 S0, S1;
    if (sample) { const float* s0 = p.in[5] + ((((size_t)b * 4 + layer) * 2 + dir) * 4 + h) * 4096 + tid * 8; S0 = *(const f32x4*)s0; S1 = *(const f32x4*)(s0 + 4); }
    else { S0 = (f32x4){0.f, 0.f, 0.f, 0.f}; S1 = S0; }
    for (int n0 = 0; n0 < nch; n0 += 4) {
        f32x4 la[4], lb[4]; float Dd[4];
#pragma unroll
        for (int k = 0; k < 4; ++k) { const int tc = dir ? tc0 + nch - 1 - (n0 + k) : tc0 + n0 + k; const size_t uh = ((size_t)tc * 4 + h) * 2 + dir;
            const float* hp = HS + uh * 4096 + tid * 8; la[k] = *(const f32x4*)hp; lb[k] = *(const f32x4*)(hp + 4); Dd[k] = HD[uh * 64 + (tid >> 3)]; }
#pragma unroll
        for (int k = 0; k < 4; ++k) { const int tc = dir ? tc0 + nch - 1 - (n0 + k) : tc0 + n0 + k; const size_t uh = ((size_t)tc * 4 + h) * 2 + dir;
            float* hp = HS + uh * 4096 + tid * 8; *(f32x4*)hp = S0; *(f32x4*)(hp + 4) = S1; S0 = S0 * Dd[k] + la[k]; S1 = S1 * Dd[k] + lb[k]; }
    }
    if (!sample) { float* so = C.out + OUT_SH + ((((size_t)b * 4 + layer) * 2 + dir) * 4 + h) * 4096 + tid * 8; *(f32x4*)so = S0; *(f32x4*)(so + 4) = S1; }
}
DI void hgrn_final_unit(const Ctx& C, int layer, int tc) {
    const Params& p = *C.p; int lane = C.lane; asm volatile("" : "+v"(lane)); const int w = C.wave, h = w >> 1, dir = w & 1, ep = lane & 31, dh = lane >> 5, row0 = tc * 64;
    const bf16_t* zb = (const bf16_t*)(C.ws + WS_ZB); const float* HS = (const float*)(C.ws + WS_HS);
    float* otile = C.L;
    float* fs = C.L + 16384 + w * 2048; float* qst = fs + 1024;
    __syncthreads();
    for (int i = C.tid; i < 16384; i += 512) otile[i] = 0.f;
    __syncthreads();
    {
        const size_t uh = ((size_t)tc * 4 + h) * 2 + dir;
        const float lb = ((const float*)(C.ws + WS_TAB))[4096 + (dir * 4 + layer) * 256 + h * 64 + lane];
        f32x2 S[32];
#pragma unroll
        for (int k = 0; k < 32; ++k) S[k] = *(const f32x2*)(HS + uh * 4096 + (32 * dh + k) * 64 + 2 * ep);
        bf16_t rf[16], rq[16]; unsigned rv[16];
#define HF_LOAD(sb_) do { _Pragma("unroll") for (int i = 0; i < 16; ++i) { const int ti = (sb_) * 16 + i, tt = dir ? 63 - ti : ti; const size_t row = (size_t)(row0 + tt); \
            rf[i] = zb[row * ZLD + ZB_CF + dir * 256 + h * 64 + lane]; rq[i] = zb[row * ZLD + ZB_CQ + h * 64 + lane]; rv[i] = *(const unsigned*)(zb + row * ZLD + ZB_CI + h * 64 + 2 * ep); } } while (0)
        HF_LOAD(0);
        for (int sb = 0; sb < 4; ++sb) {
            f32x2 vr[16];
#pragma unroll
            for (int i = 0; i < 16; ++i) { fs[i * 64 + lane] = lb + (1.0f - lb) * sigmoidf_(bf2f(rf[i])); qst[i * 64 + lane] = siluf_(bf2f(rq[i])); vr[i] = (f32x2){__uint_as_float(rv[i] << 16), __uint_as_float(rv[i] & 0xffff0000u)}; }
            if (sb + 1 < 4) HF_LOAD(sb + 1);
            __builtin_amdgcn_wave_barrier();
#pragma unroll
            for (int i = 0; i < 16; ++i) { const f32x2 v = vr[i]; f32x2 osa = {0.f, 0.f}, osb = {0.f, 0.f};
#pragma unroll
                for (int k = 0; k < 32; k += 4) { const f32x4 f4 = *(const f32x4*)(fs + i * 64 + 32 * dh + k), q4 = *(const f32x4*)(qst + i * 64 + 32 * dh + k);
#pragma unroll
                    for (int c = 0; c < 4; ++c) { S[k + c] = (S[k + c] - v) * f4[c] + v; if (c & 1) osb += S[k + c] * q4[c]; else osa += S[k + c] * q4[c]; }
                    if ((k & 15) == 12) asm volatile("" ::: "memory"); }
                f32x2 os = osa + osb;
                os.x += __shfl_xor(os.x, 32); os.y += __shfl_xor(os.y, 32);
                const int ti = sb * 16 + i, tt = dir ? 63 - ti : ti;
                if (dh == 0) { float* op = otile + (h * 64 + tt) * 64 + 2 * ep; atomicAdd(op, os.x); atomicAdd(op + 1, os.y); }
                asm volatile("" ::: "memory"); }
            __builtin_amdgcn_wave_barrier();
        }
    }
#undef HF_LOAD
    __syncthreads();
    bf16_t* ob = (bf16_t*)(C.ws + WS_O);
    const float ng = p.in[16][layer * 64 + lane];
    bf16_t gts[32];
#pragma unroll
    for (int rr = 0; rr < 32; ++rr) { const int idx = w * 32 + rr, hh = idx >> 6, tt = idx & 63; gts[rr] = zb[(size_t)(row0 + tt) * ZLD + ZB_CG + hh * 64 + lane]; }
#pragma unroll
    for (int rr = 0; rr < 32; ++rr) { const int idx = w * 32 + rr, hh = idx >> 6, tt = idx & 63; const size_t row = (size_t)(row0 + tt);
        const float v = otile[(hh * 64 + tt) * 64 + lane]; const float ss = wave_sum(v * v);
        const float gt = siluf_(bf2f(gts[rr]));
        ob[row * DM + 768 + hh * 64 + lane] = f2bf(v * (1.0f / sqrtf(ss * (1.0f / 64.0f) + RMS_EPS)) * ng * gt); }
}
DI void delta_combine(const Ctx& C, int layer) {
    const Params& p = *C.p; const bf16_t* zb = (const bf16_t*)(C.ws + WS_ZB); const float* od = (const float*)(C.ws + WS_OD); bf16_t* ob = (bf16_t*)(C.ws + WS_O);
    const float ng = p.in[14][layer * 64 + C.lane];
    for (int it0 = C.gw * 4; it0 < MROWS * 4; it0 += C.NGW * 4) {
        float v[4]; bf16_t gr[4];
#pragma unroll
        for (int k = 0; k < 4; ++k) { const int it = it0 + k, h = it & 3; const size_t row = (size_t)(it >> 2);
            v[k] = od[row * 256 + h * 64 + C.lane] + od[(size_t)MROWS * 256 + row * 256 + h * 64 + C.lane]; gr[k] = zb[row * ZLD + ZB_BG + h * 64 + C.lane]; }
#pragma unroll
        for (int k = 0; k < 4; ++k) { const int it = it0 + k, h = it & 3; const size_t row = (size_t)(it >> 2);
            const float ss = wave_sum(v[k] * v[k]); const float gt = siluf_(bf2f(gr[k]));
            ob[row * DM + 512 + h * 64 + C.lane] = f2bf(v[k] * (1.0f / sqrtf(ss * (1.0f / 64.0f) + RMS_EPS)) * ng * gt); }
    }
}

#define XB_TMO      128
#define XB_XCNT(j)  (256  + 64 * (j))
#define XB_XSUB(j)  (1280 + 64 * (j))
#define XB_XGEN(j)  (2304 + 64 * (j))
#define XB_TOP      3328
#define XB_TOPGEN   3392
#define XB_SPIN_CAP (1u << 22)
DI unsigned xb_ld(unsigned* p)              { return __hip_atomic_load(p, __ATOMIC_RELAXED, __HIP_MEMORY_SCOPE_AGENT); }
DI unsigned xb_add(unsigned* p, unsigned v) { return __hip_atomic_fetch_add(p, v, __ATOMIC_RELAXED, __HIP_MEMORY_SCOPE_AGENT); }
DI unsigned xb_xcc_id() { return (unsigned)__builtin_amdgcn_s_getreg((3 << 11) | 20) & 0xFu; }
#define XB_SPIN(cond, bar) do { unsigned _sp = 0; while (cond) { __builtin_amdgcn_s_sleep(1); \
    if ((++_sp & 255u) == 0u) { if (xb_ld(&(bar)[XB_TMO])) break; if (_sp > XB_SPIN_CAP) { atomicAdd(&(bar)[XB_TMO], 1u); break; } } } } while (0)
struct XcdBarrier { unsigned* bar; unsigned x; volatile LAS unsigned* st; };
DI void xcd_barrier_complete(unsigned* bar, unsigned x, unsigned& nloc, unsigned& nx) {
    const unsigned G = gridDim.x * gridDim.y * gridDim.z;
    unsigned sum, cnt, mine, sp = 0u;
    for (;;) {
        sum = 0u; cnt = 0u; mine = 0u;
#pragma unroll
        for (unsigned j = 0; j < 16; ++j) { const unsigned c = xb_ld(&bar[XB_XCNT(j)]); sum += c; cnt += (c > 0u) ? 1u : 0u; mine = (j == x) ? c : mine; }
        if (sum == G) break;
        __builtin_amdgcn_s_sleep(1);
        if ((++sp & 255u) == 0u) { if (xb_ld(&bar[XB_TMO])) break; if (sp > XB_SPIN_CAP) { atomicAdd(&bar[XB_TMO], 1u); break; } }
    }
    nloc = mine > 0u ? mine : 1u; nx = cnt > 0u ? cnt : 1u;
}
DI void xcd_barrier(const XcdBarrier& b) {
    asm volatile("s_waitcnt vmcnt(0)" ::: "memory");
    __syncthreads();
    if (threadIdx.x == 0) {
        unsigned* bar = b.bar;
        __builtin_amdgcn_s_waitcnt(0);
        unsigned nloc = b.st[0], nx = b.st[1];
        if (nloc == 0u) { xcd_barrier_complete(bar, b.x, nloc, nx); b.st[0] = nloc; b.st[1] = nx; }
        const unsigned old = xb_add(&bar[XB_XSUB(b.x)], 1u);
        const unsigned gen = old / nloc;
        if (old + 1u == (gen + 1u) * nloc) {
            __builtin_amdgcn_fence(__ATOMIC_RELEASE, "agent");
            asm volatile("s_waitcnt vmcnt(0)" ::: "memory");
            const unsigned og = xb_add(&bar[XB_TOP], 1u);
            const unsigned tg = og / nx;
            if (og + 1u == (tg + 1u) * nx) xb_add(&bar[XB_TOPGEN], 1u);
            else XB_SPIN(xb_ld(&bar[XB_TOPGEN]) == tg, bar);
            __builtin_amdgcn_fence(__ATOMIC_ACQUIRE, "agent");
            xb_add(&bar[XB_XGEN(b.x)], 1u);
            asm volatile("s_waitcnt vmcnt(0)" ::: "memory");
        } else {
            XB_SPIN(xb_ld(&bar[XB_XGEN(b.x)]) == gen, bar);
            __builtin_amdgcn_fence(__ATOMIC_ACQUIRE, "agent");
            asm volatile("s_waitcnt vmcnt(0)" ::: "memory");
        }
    }
    __syncthreads();
}

DI void probe_stamp(unsigned char* ws, int cls) {
    if (PROBE_A >= 0 && blockIdx.x == 0 && threadIdx.x == 0) {
        volatile float* tsf = (volatile float*)(ws + WS_TAB + 131072); volatile unsigned long long* tsl = (volatile unsigned long long*)(ws + WS_TAB + 131072 + 256);
        const unsigned long long now = __builtin_amdgcn_s_memrealtime(); tsf[cls] += (float)(now - tsl[0]); tsl[0] = now; }
}
template <unsigned PHM_>
__global__ void __launch_bounds__(512) fwd_megakernel(Params p) {
    extern __shared__ __attribute__((aligned(16))) unsigned char lds_raw[];
    XcdBarrier xbar; xbar.bar = (unsigned*)(p.ws + WS_CTL) + 1024; xbar.x = xb_xcc_id(); xbar.st = (volatile LAS unsigned*)((LAS unsigned char*)lds_raw + 147400);
    if (threadIdx.x == 0) { xbar.st[0] = 0u; xbar.st[1] = 0u; (void)xb_add(&xbar.bar[XB_XCNT(xbar.x)], 1u); }
    __syncthreads();
    for (int ph = p.ph_lo; ph < p.ph_hi; ++ph) {
        if (PROBE_A >= 0 && blockIdx.x == 0 && threadIdx.x == 0) {
            volatile float* tsf = (volatile float*)(p.ws + WS_TAB + 131072); volatile unsigned long long* tsl = (volatile unsigned long long*)(p.ws + WS_TAB + 131072 + 256);
            const unsigned long long now = __builtin_amdgcn_s_memrealtime();
            if (ph == 0) { for (int i = 0; i < 16; ++i) tsf[i] = 0.f; tsl[1] = now; }
            else { const int pp = ph - 1; const int cls = pp < 2 ? 8 : (((pp - 2) % 9) == 8 ? 5 : ((pp - 2) % 9)); const float dt = (float)(now - tsl[0]); tsf[cls] += dt; }
            tsl[0] = now;
            if (ph == NPHASE - 2 && PROBE_A < 20) { const float tot = (float)(now - tsl[1]); tsf[12] = rintf(tsf[(PROBE_A >= 0 && PROBE_A < 16) ? PROBE_A : 0] / tot * 40.f) / 40.f; tsf[13] = rintf(tsf[PROBE_B >= 0 ? PROBE_B : 0] / tot * 40.f) / 40.f; }
        }
        if (PROBE_A >= 0 && ph == 0 && threadIdx.x == 0) { volatile float* tsb = (volatile float*)(p.ws + WS_TAB + 196608) + blockIdx.x * 8; for (int i = 0; i < 8; ++i) tsb[i] = 0.f; }
        if (PROBE_A >= 20 && ph == NPHASE - 2 && blockIdx.x == 0 && threadIdx.x == 0) {
            volatile float* tsf = (volatile float*)(p.ws + WS_TAB + 131072); volatile unsigned long long* tsl = (volatile unsigned long long*)(p.ws + WS_TAB + 131072 + 256);
            const float* tsb = (const float*)(p.ws + WS_TAB + 196608); float sum = 0.f; for (int b2 = 0; b2 < (int)gridDim.x; ++b2) sum += __hip_atomic_load(tsb + b2 * 8 + (PROBE_A - 20), __ATOMIC_RELAXED, __HIP_MEMORY_SCOPE_AGENT); sum *= (PROBE_A == 20 ? 32.f : (PROBE_A == 21 ? 16.f : 1.f));
            const float tot = (float)(__builtin_amdgcn_s_memrealtime() - tsl[1]); tsf[12] = rintf(sum / (float)gridDim.x / tot * 40.f) / 40.f; tsf[13] = 0.f; }
        int tid_ = threadIdx.x; asm volatile("" : "+v"(tid_));
        unsigned char* ws_ = p.ws; asm volatile("" : "+s"(ws_));
        float* out_ = p.out; asm volatile("" : "+s"(out_));
        Ctx C; C.p = &p; C.lds = (LAS unsigned char*)lds_raw; C.L = (float*)lds_raw; C.tid = tid_; C.lane = C.tid & 63; C.wave = __builtin_amdgcn_readfirstlane(C.tid >> 6);
        C.G = gridDim.x; C.gw = blockIdx.x * 8 + C.wave; C.NGW = C.G * 8; C.ws = ws_; C.out = out_;
        unsigned* ctl = (unsigned*)(ws_ + WS_CTL);
        const float* modbuf = (const float*)(ws_ + WS_MOD);
        bf16_t* xm = (bf16_t*)(ws_ + WS_XM); bf16_t* ob = (bf16_t*)(ws_ + WS_O); bf16_t* act = (bf16_t*)(ws_ + WS_ACT);
        if (ph == 0) { if (PHON(0)) phase0a(C); }
        else if (ph == 1) { if (PHON(1)) row_pass(C, 0, nullptr, nullptr, modbuf, 1024, 0, true); }
        else {
            const int layer = (ph - 2) / 9, sub = (ph - 2) % 9;
            unsigned char* wb = ws_ + WS_W + (size_t)(layer & 1) * WBUF;
            const float* modl = modbuf + (size_t)layer * 3 * 6144;
            if (sub == 0) { if (PHON(2)) {
                pg8::Gemm g{xm, (const bf16_t*)(wb + W_IN), MROWS, 4096, DM}; pg8::StaticOrder S; S.init(MROWS, 4096, C.G, (int)blockIdx.x);
                EpiIn E{(bf16_t*)(ws_ + WS_Q), (bf16_t*)(ws_ + WS_K), (bf16_t*)(ws_ + WS_V), (bf16_t*)(ws_ + WS_ZB), out_ + OUT_K, out_ + OUT_V, (const f32x2*)(ws_ + WS_TAB), layer};
                pg8::gemm_phase(C.lds, g, S, E, C.tid); }
            } else if (sub == 1) {
                __syncthreads();
                if (PHON(4)) for (int u = blockIdx.x; u < 1024; u += C.G) delta_prep_unit(C, layer, u);
                __syncthreads();
                if (PHON(5)) for (int u = C.gw; u < 2048; u += C.NGW) hgrn_local_unit(C, layer, u);
                __syncthreads();
            } else if (sub == 2) {
                LAS int* slot = (LAS int*)(C.lds + 147392);
                for (;;) {
                    __syncthreads();
                    if (C.tid == 0) *slot = (int)atomicAdd(ctl + 64 * (layer + 1), 1u);
                    __syncthreads();
                    const int u = *slot;
                    if (u >= 1432 + 256) break;
                    if (u >= 1432) { if (layer + 1 < DEPTH) convert_layer_weights(C, layer + 1, (u - 1432) * 8 + C.wave, 2048, u - 1432, 256); continue; }
                    unsigned long long pt0_ = 0; if (PROBE_A >= 0 && C.tid == 0) pt0_ = __builtin_amdgcn_s_memrealtime();
                    if (u < 8) { if (PHON(6)) delta_scan_unit(C, layer, true, u >> 2, u & 3); }
                    else if (u < 24) { const int v = u - 8; if (PHON(7)) hgrn_scan_unit(C, layer, true, v >> 3, (v >> 1) & 3, v & 1); }
                    else if (u < 536) { if (PHON(8)) attn_unit(C, layer, u - 24); }
                    else if (u < 664) { const int v = u - 536; if (PHON(6)) delta_scan_unit(C, layer, false, v >> 2, v & 3); }
                    else if (u < 1176) { if (PHON(8)) attn_unit(C, layer, 512 + (u - 664)); }
                    else { const int v = u - 1176; if (PHON(7)) hgrn_scan_unit(C, layer, false, v >> 3, (v >> 1) & 3, v & 1); }
                    if (PROBE_A >= 0) { __syncthreads(); if (C.tid == 0) { const int ty = (u < 8) ? 0 : (u < 24 ? 1 : (u < 536 ? 2 : (u < 664 ? 3 : (u < 1176 ? 4 : 5))));
                        volatile float* tsb = (volatile float*)(ws_ + WS_TAB + 196608) + blockIdx.x * 8; tsb[ty] += (float)(__builtin_amdgcn_s_memrealtime() - pt0_); } }
                }
            } else if (sub == 3) {
                if (PHON(9)) for (int u = blockIdx.x; u < 256; u += C.G) hgrn_final_unit(C, layer, u);
                __syncthreads();
                if (PHON(10)) delta_combine(C, layer);
                __syncthreads();
            } else if (sub == 4) {
                pg8::Gemm g{ob, (const bf16_t*)(wb + W_OUT), MROWS, DM, DM}; pg8::StaticOrder S; S.init(MROWS, DM, C.G, (int)blockIdx.x);
                EpiRes E{out_, modl + 2048, xm};
                if (PHON(11)) pg8::gemm_phase(C.lds, g, S, E, C.tid);
            } else if (sub == 5) {
                if (PHON(12)) row_pass(C, 1, p.in[20] + (size_t)(layer * 2) * DM, p.in[21] + (size_t)(layer * 2) * DM, modl, 4096, 3072, true);
            } else if (sub == 6) {
                pg8::Gemm g{xm, (const bf16_t*)(wb + W_FFI), MROWS, 2 * DFF, DM}; pg8::StaticOrder S; S.init(MROWS, 2 * DFF, C.G, (int)blockIdx.x);
                EpiFfn E{act};
                if (PHON(13)) pg8::gemm_phase(C.lds, g, S, E, C.tid);
            } else if (sub == 7) {
                pg8::Gemm g{act, (const bf16_t*)(wb + W_FFO), MROWS, DM, DFF}; pg8::StaticOrder S; S.init(MROWS, DM, C.G, (int)blockIdx.x);
                EpiRes E{out_, modl + 5120, xm};
                if (PHON(14)) pg8::gemm_phase(C.lds, g, S, E, C.tid);
            } else {
                const bool last = layer + 1 == DEPTH;
                if (PHON(12)) row_pass(C, 1, p.in[20] + (size_t)(layer * 2 + 1) * DM, p.in[21] + (size_t)(layer * 2 + 1) * DM, modbuf + (size_t)(last ? layer : layer + 1) * 3 * 6144, 1024, 0, !last);
            }
        }
        if (ph + 1 < p.ph_hi) { if (p.ph_hi > 100000) { __threadfence(); cg::this_grid().sync(); } else xcd_barrier(xbar); }
    }
}

#if !MK_ONE_LAUNCH
static unsigned phase_mask(int ph) {
    if (ph == 0) return 1u << 0; if (ph == 1) return 1u << 1;
    const int sub = (ph - 2) % 9;
    switch (sub) { case 0: return 1u << 2; case 1: return (1u << 3) | (1u << 4) | (1u << 5); case 2: return (1u << 6) | (1u << 7) | (1u << 8); case 3: return (1u << 9) | (1u << 10);
        case 4: return 1u << 11; case 5: return 1u << 12; case 6: return 1u << 13; case 7: return 1u << 14; default: return 1u << 12; }
}
typedef void (*kern_t)(Params);
static kern_t kernel_for_mask(unsigned m) {
    switch (m) {
        case 1u << 0: return fwd_megakernel<1u << 0>; case 1u << 1: return fwd_megakernel<1u << 1>; case 1u << 2: return fwd_megakernel<1u << 2>;
        case (1u << 3) | (1u << 4) | (1u << 5): return fwd_megakernel<(1u << 3) | (1u << 4) | (1u << 5)>;
        case (1u << 6) | (1u << 7) | (1u << 8): return fwd_megakernel<(1u << 6) | (1u << 7) | (1u << 8)>;
        case (1u << 9) | (1u << 10): return fwd_megakernel<(1u << 9) | (1u << 10)>;
        case 1u << 11: return fwd_megakernel<1u << 11>; case 1u << 12: return fwd_megakernel<1u << 12>; case 1u << 13: return fwd_megakernel<1u << 13>; default: return fwd_megakernel<1u << 14>;
    }
}
#endif
extern "C" void kernel_launch(void* const* d_in, const int* in_sizes, int n_in, void* d_out, int out_size, void* d_ws, size_t ws_size, hipStream_t stream) {
    static int grid = 0;
    if (grid == 0) {
        if (n_in != 24 || out_size != 58720256 || ws_size < WS_END) { fprintf(stderr, "kernel_launch: unexpected shapes (n_in %d out %d ws %zu)\n", n_in, out_size, ws_size); grid = -1; return; }
        int dev = 0, cus = 0;
        (void)hipGetDevice(&dev); (void)hipDeviceGetAttribute(&cus, hipDeviceAttributeMultiprocessorCount, dev);
#if MK_ONE_LAUNCH
        if (hipFuncSetAttribute((const void*)fwd_megakernel<0x7FFFu>, hipFuncAttributeMaxDynamicSharedMemorySize, LDS_BYTES) != hipSuccess) { fprintf(stderr, "kernel_launch: hipFuncSetAttribute failed\n"); grid = -1; return; }
#else
        for (int ph = 0; ph < 11; ++ph) (void)hipFuncSetAttribute((const void*)kernel_for_mask(phase_mask(ph)), hipFuncAttributeMaxDynamicSharedMemorySize, LDS_BYTES);
#endif
        (void)hipGetLastError();
        grid = cus > 0 ? cus : 256;
        if (grid != 256) { fprintf(stderr, "kernel_launch: expected 256 CUs, got %d\n", grid); grid = 256; }
    }
    if (grid < 0) return;
    (void)hipMemsetAsync((char*)d_ws + WS_CTL, 0, 65536, stream);
    Params p{};
    for (int i = 0; i < 24; ++i) p.in[i] = (const float*)d_in[i];
    p.out = (float*)d_out; p.ws = (unsigned char*)d_ws;
#if MK_ONE_LAUNCH
    p.ph_lo = 0; p.ph_hi = NPHASE;
    void* args[] = {&p};
    hipError_t e = hipLaunchCooperativeKernel((const void*)fwd_megakernel<0x7FFFu>, dim3(grid), dim3(512), args, LDS_BYTES, stream);
    if (e != hipSuccess) fprintf(stderr, "cooperative launch failed: %s (grid %d)\n", hipGetErrorString(e), grid);
#else
    for (int ph = 0; ph < NPHASE; ++ph) { p.ph_lo = ph; p.ph_hi = ph + 1; hipLaunchKernelGGL(kernel_for_mask(phase_mask(ph)), dim3(grid), dim3(512), LDS_BYTES, stream, p); }
#endif
}
```

```cpp
#include <hip/hip_runtime.h>
#include <hip/hip_cooperative_groups.h>
#include <cstdio>
#include <cstdint>
namespace cg = cooperative_groups;

#define PHON(k) ((PHM_ >> (k)) & 1)
#ifndef PROBE_A
#define PROBE_A -1
#endif
#ifndef PROBE_B
#define PROBE_B -1
#endif
#ifndef MK_ONE_LAUNCH
#define MK_ONE_LAUNCH 1
#endif

#define DI __device__ __forceinline__
#define LAS __attribute__((address_space(3)))
typedef unsigned short bf16_t;
typedef short bf16x8 __attribute__((ext_vector_type(8)));
typedef short s16x4 __attribute__((ext_vector_type(4)));
typedef float f32x4 __attribute__((ext_vector_type(4)));
typedef float f32x16 __attribute__((ext_vector_type(16)));
typedef float f32x2 __attribute__((ext_vector_type(2)));
typedef unsigned u32x4 __attribute__((ext_vector_type(4)));
typedef unsigned u32x2 __attribute__((ext_vector_type(2)));

constexpr int MROWS = 16384, DM = 1024, DEPTH = 4, DFF = 2816, DIN = 3856, ZLD = 2320;
constexpr float ALPHA = 1.681792830507429f, LN_EPS = 1e-5f, RMS_EPS = 1e-6f;
constexpr float QSCALE = 0.125f * 1.4426950408889634f;
constexpr int ZB_BQ = 0, ZB_BK = 256, ZB_BV = 512, ZB_BG = 768, ZB_BBETA = 1024, ZB_BA = 1032, ZB_CQ = 1040, ZB_CF = 1296, ZB_CI = 1808, ZB_CG = 2064;
constexpr size_t OUT_K = 16777216, OUT_V = 33554432, OUT_SD = 50331648, OUT_SH = 54525952;
constexpr size_t MiB = 1u << 20;
constexpr size_t WS_CTL = 0, WS_MOD = 64 * 1024, WS_TAB = 512 * 1024, WS_CK = 1 * MiB, WS_CV = 3 * MiB, WS_W = 8 * MiB, WBUF = 27 * MiB;
constexpr size_t W_IN = 0, W_OUT = 8 * MiB, W_FFI = 10 * MiB, W_FFO = 21 * MiB;
constexpr size_t WS_XM = 62 * MiB, WS_O = 94 * MiB, WS_ZB = 126 * MiB, WS_Q = 199 * MiB, WS_K = 215 * MiB, WS_V = 231 * MiB;
constexpr size_t WS_ACT = 126 * MiB;
constexpr size_t WS_DPW = 247 * MiB, WS_DPQD = 263 * MiB, WS_DPQK = 279 * MiB, WS_DPKD = 295 * MiB;
constexpr size_t WS_DPU = WS_XM;
constexpr size_t WS_OD = 311 * MiB, WS_HS = 343 * MiB, WS_HD = 375 * MiB, WS_GL = 375 * MiB + 512 * 1024, WS_END = 376 * MiB;
constexpr int LDS_BYTES = 147456;
constexpr int NPHASE = 2 + 9 * DEPTH;

struct Params { const float* in[24]; float* out; unsigned char* ws; int ph_lo, ph_hi; };

DI unsigned cvt_pk_bf16(float lo, float hi) { unsigned r; asm("v_cvt_pk_bf16_f32 %0, %1, %2" : "=v"(r) : "v"(lo), "v"(hi)); return r; }
DI bf16_t f2bf(float f) { return (bf16_t)(cvt_pk_bf16(f, 0.f) & 0xffffu); }
DI float bf2f(bf16_t b) { return __uint_as_float(((unsigned)b) << 16); }
DI float sigmoidf_(float x) { return __builtin_amdgcn_rcpf(1.0f + __expf(-x)); }
DI float siluf_(float x) { return x * __builtin_amdgcn_rcpf(1.0f + __expf(-x)); }
DI float wave_sum(float v) {
#pragma unroll
    for (int o = 1; o < 64; o <<= 1) v += __shfl_xor(v, o);
    return v;
}
DI u32x2 pack4(f32x4 v) { u32x2 w; w.x = cvt_pk_bf16(v[0], v[1]); w.y = cvt_pk_bf16(v[2], v[3]); return w; }
DI bf16x8 pack8(f32x4 a, f32x4 b) { u32x4 w; w.x = cvt_pk_bf16(a[0], a[1]); w.y = cvt_pk_bf16(a[2], a[3]); w.z = cvt_pk_bf16(b[0], b[1]); w.w = cvt_pk_bf16(b[2], b[3]); return __builtin_bit_cast(bf16x8, w); }
DI int pinv(int k) { return (k >> 5) * 32 + ((k >> 2) & 3) * 8 + ((k >> 4) & 1) * 4 + (k & 3); }
DI int row_mod(int r) { return r < 8192 ? 0 : 1 + ((r - 8192) >> 12); }

namespace pg8 {
constexpr int BM = 256, BK = 64, HALF = 128, HTB = HALF * BK * 2, STAGE_BYTES = 8 * HTB, NXCD = 8, WGM = 8;
DI int lds_byte(int r, int c) { const int st = (r >> 4) * 2 + (c >> 5), rr = r & 15, cc = c & 31, ob = rr * 64 + cc * 2; return st * 1024 + (ob ^ (((ob >> 9) & 1) << 5)); }
DI void stage_rc(int b, int& R, int& C) { const int st = b / 1024, sb = b % 1024, swz = sb ^ (((sb >> 9) & 1) << 5); R = (st >> 1) * 16 + swz / 64; C = (st & 1) * 32 + (swz % 64) / 2; }
struct Unit { int pm, pn; };
struct Gemm { const bf16_t* A; const bf16_t* Bt; int M, N, K; };
struct StaticOrder {
    int nM, nN, nwg, G, c;
    DI void init(int M, int N, int G_, int c_) { nM = M / BM; nN = N / BM; nwg = nM * nN; G = G_; c = c_; }
    DI bool next(int i, Unit& u) const {
        const long L = (long)i * G + c; if (L >= nwg) return false;
        int wgid = (int)L; { const int q = nwg / NXCD, r = nwg % NXCD, xcd = wgid % NXCD, off = wgid / NXCD; wgid = (xcd < r ? xcd * (q + 1) : r * (q + 1) + (xcd - r) * q) + off; }
        const int nig = WGM * nN, gid = wgid / nig, fm = gid * WGM, gsz = (nM - fm) < WGM ? (nM - fm) : WGM;
        u.pm = fm + ((wgid % nig) % gsz); u.pn = (wgid % nig) / gsz; return true;
    }
};

template <class Epi>
DI void gemm_phase(LAS unsigned char* lds, const Gemm g, const StaticOrder& S, const Epi& E, int tid_in) {
    const int tid = tid_in, wid = __builtin_amdgcn_readfirstlane(tid >> 6), lane = tid & 63, wr = wid >> 2, wc = wid & 3, fr = lane & 15, fq = lane >> 4;
    const int K = g.K, nt = K / BK;
    unsigned voffA[2];
#pragma unroll
    for (int i = 0; i < 2; ++i) { int R, C; stage_rc(tid * 16 + i * 8192, R, C); voffA[i] = (unsigned)(R * K + C) * 2u; }
    const size_t kstep = (size_t)(BK * 2);
    const size_t hstep = (size_t)HALF * K * 2;
    const size_t tstep = 2 * hstep;
    const unsigned ldsw = (unsigned)wid * 1024u;
    const int aoff = lds_byte(wr * 64 + fr, fq * 8), boff = lds_byte(wc * 32 + fr, fq * 8);
#define PG8_SA(b, h) (((b) * 2 + (h)) * HTB)
#define PG8_SB(b, h) ((4 + (b) * 2 + (h)) * HTB)
#define PG8_STAGE(bufoff, gbase) do { _Pragma("unroll") for (int _i = 0; _i < 2; ++_i) \
        __builtin_amdgcn_global_load_lds((const unsigned*)((const char*)(gbase) + voffA[_i]), (LAS unsigned*)(lds + (bufoff) + ldsw + _i * 8192), 16, 0, 0); } while (0)
#define PG8_LDA(dst, b, h) do { _Pragma("unroll") for (int m = 0; m < 4; ++m) _Pragma("unroll") for (int k = 0; k < 2; ++k) dst[m][k] = *(const LAS bf16x8*)(lds + PG8_SA(b, h) + aoff + m * 2048 + k * 1024); } while (0)
#define PG8_LDB(dst, b, h) do { _Pragma("unroll") for (int n = 0; n < 2; ++n) _Pragma("unroll") for (int k = 0; k < 2; ++k) dst[n][k] = *(const LAS bf16x8*)(lds + PG8_SB(b, h) + boff + n * 2048 + k * 1024); } while (0)
#define PG8_MMA(ai, bj, At, Bt) do { __builtin_amdgcn_s_setprio(1); _Pragma("unroll") for (int m = 0; m < 4; ++m) _Pragma("unroll") for (int n = 0; n < 2; ++n) _Pragma("unroll") for (int k = 0; k < 2; ++k) \
        acc[ai][bj][m][n] = __builtin_amdgcn_mfma_f32_16x16x32_bf16(Bt[n][k], At[m][k], acc[ai][bj][m][n], 0, 0, 0); __builtin_amdgcn_s_setprio(0); } while (0)
#define PG8_WAIT_V(n) asm volatile("s_waitcnt vmcnt(" #n ")" ::: "memory")
#define PG8_WAIT_L(n) asm volatile("s_waitcnt lgkmcnt(" #n ")" ::: "memory")
#define PG8_BAR __builtin_amdgcn_s_barrier()
#define PG8_SCHED __builtin_amdgcn_sched_barrier(0)
    Unit cur, nxt; int ui = 0;
    if (!S.next(0, cur)) return;
    f32x4 acc[2][2][4][2];
#pragma unroll
    for (int a = 0; a < 2; ++a)
#pragma unroll
        for (int b = 0; b < 2; ++b)
#pragma unroll
            for (int m = 0; m < 4; ++m)
#pragma unroll
                for (int n = 0; n < 2; ++n) acc[a][b][m][n] = (f32x4){0.f, 0.f, 0.f, 0.f};
    bf16x8 At[4][2], B0[2][2], B1[2][2];
    const char* cA = (const char*)g.A + (size_t)cur.pm * tstep; const char* cB = (const char*)g.Bt + (size_t)cur.pn * tstep;
    PG8_STAGE(PG8_SB(0, 0), cB); PG8_STAGE(PG8_SB(0, 1), cB + hstep); PG8_STAGE(PG8_SA(0, 0), cA); PG8_STAGE(PG8_SA(0, 1), cA + hstep);
    if (wr == 1) PG8_BAR;
    PG8_WAIT_V(2); PG8_BAR;
    PG8_STAGE(PG8_SB(1, 0), cB + kstep); PG8_STAGE(PG8_SA(1, 0), cA + kstep); PG8_STAGE(PG8_SB(1, 1), cB + hstep + kstep);
    PG8_WAIT_V(6); PG8_BAR;
    for (;;) {
        const bool has_next = S.next(ui + 1, nxt);
        const char* nA = has_next ? (const char*)g.A + (size_t)nxt.pm * tstep : cA; const char* nB = has_next ? (const char*)g.Bt + (size_t)nxt.pn * tstep : cB;
        for (int t = 0; t < nt; t += 2) {
            const bool last = (t == nt - 2);
            const char* a1 = cA + (size_t)(t + 1) * kstep;
            const char* a2 = last ? nA : cA + (size_t)(t + 2) * kstep; const char* b2 = last ? nB : cB + (size_t)(t + 2) * kstep;
            const char* a3 = a2 + kstep; const char* b3 = b2 + kstep;
            PG8_LDB(B0, 0, 0); PG8_LDB(B1, 0, 1); PG8_SCHED; PG8_LDA(At, 0, 0); PG8_STAGE(PG8_SA(1, 1), a1 + hstep);
            PG8_WAIT_V(8); PG8_WAIT_L(0); PG8_BAR; PG8_MMA(0, 0, At, B0); PG8_MMA(0, 1, At, B1); PG8_BAR; PG8_SCHED;
            PG8_LDA(At, 0, 1); PG8_STAGE(PG8_SB(0, 0), b2); PG8_STAGE(PG8_SB(0, 1), b2 + hstep); PG8_STAGE(PG8_SA(0, 0), a2);
            PG8_WAIT_V(8); PG8_WAIT_L(0); PG8_BAR; PG8_MMA(1, 0, At, B0); PG8_MMA(1, 1, At, B1); PG8_BAR; PG8_SCHED;
            PG8_LDB(B0, 1, 0); PG8_LDB(B1, 1, 1); PG8_SCHED; PG8_LDA(At, 1, 0); PG8_STAGE(PG8_SA(0, 1), a2 + hstep);
            PG8_WAIT_V(8); PG8_WAIT_L(0); PG8_BAR; PG8_MMA(0, 0, At, B0); PG8_MMA(0, 1, At, B1); PG8_BAR; PG8_SCHED;
            PG8_LDA(At, 1, 1); PG8_STAGE(PG8_SB(1, 0), b3); PG8_STAGE(PG8_SB(1, 1), b3 + hstep); PG8_STAGE(PG8_SA(1, 0), a3);
            PG8_WAIT_V(8); PG8_WAIT_L(0); PG8_BAR; PG8_MMA(1, 0, At, B0); PG8_MMA(1, 1, At, B1); PG8_BAR; PG8_SCHED;
        }
        if (wr == 0) PG8_BAR;
        E(acc, cur, wr, wc, fr, fq);
        if (!has_next) break;
#pragma unroll
        for (int a = 0; a < 2; ++a)
#pragma unroll
            for (int b = 0; b < 2; ++b)
#pragma unroll
                for (int m = 0; m < 4; ++m)
#pragma unroll
                    for (int n = 0; n < 2; ++n) acc[a][b][m][n] = (f32x4){0.f, 0.f, 0.f, 0.f};
        cur = nxt; cA = nA; cB = nB; ++ui;
        if (wr == 1) PG8_BAR;
    }
    PG8_WAIT_V(0);
    PG8_BAR;
#undef PG8_SA
#undef PG8_SB
#undef PG8_STAGE
#undef PG8_LDA
#undef PG8_LDB
#undef PG8_MMA
#undef PG8_WAIT_V
#undef PG8_WAIT_L
#undef PG8_BAR
#undef PG8_SCHED
}
}

struct EpiIn {
    bf16_t *Qb, *Kb, *Vb, *zb; float *outK, *outV; const f32x2* rope; int layer;
    DI void operator()(const f32x4 (&acc)[2][2][4][2], const pg8::Unit& u, int wr, int wc, int fr, int fq) const {
        const int tile = u.pn; const bool sample = u.pm >= 32;
        if (tile < 6) {
            const int kind = tile >> 1; const int cb = (tile & 1) * 256 + wc * 32 + 4 * fq;
            bf16_t* dst = Qb + (size_t)kind * (16u * 1024u * 1024u / 2u);
            float* of = outK + (size_t)(kind >= 1 ? kind - 1 : 0) * 16777216u;
#pragma unroll
            for (int ai = 0; ai < 2; ++ai)
#pragma unroll
                for (int m = 0; m < 4; ++m) {
                    const int r = u.pm * 256 + ai * 128 + wr * 64 + m * 16 + fr;
#pragma unroll
                    for (int bj = 0; bj < 2; ++bj) {
                        f32x4 a = acc[ai][bj][m][0], b = acc[ai][bj][m][1]; const int cc = cb + bj * 128;
                        if (!sample && kind >= 1) { float* o = of + ((size_t)((r >> 8) * 4 + layer) * 256 + (r & 255)) * 512 + cc; *(f32x4*)o = a; *(f32x4*)(o + 16) = b; }
                        if (sample && kind < 2) {
                            const int t = (r - 8192) & 4095; const int pos = (wc & 1) ? (t & 63) : (t >> 6); const f32x2* rp = rope + pos * 16 + 4 * fq;
#pragma unroll
                            for (int j = 0; j < 4; ++j) { const f32x2 cs = rp[j]; const float x1 = a[j], x2 = b[j]; a[j] = x1 * cs.x - x2 * cs.y; b[j] = x2 * cs.x + x1 * cs.y; }
                        }
                        if (kind == 0) { a = a * QSCALE; b = b * QSCALE; }
                        if (kind == 2) {
                            const int hh = cc >> 7, dv0 = cc & 127, tt = sample ? ((r - 8192) & 4095) : (r & 255);
                            bf16_t* vt = sample ? Vb + 4194304 + ((size_t)((((r - 8192) >> 12) * 4 + hh) * 32 + (tt >> 7)) * 128 + dv0) * 128 + (tt & 127)
                                                : Vb + ((size_t)(((r >> 8) * 4 + hh) * 2 + (tt >> 7)) * 128 + dv0) * 128 + (tt & 127);
#pragma unroll
                            for (int j = 0; j < 4; ++j) { vt[(size_t)j * 128] = f2bf(a[j]); vt[(size_t)(16 + j) * 128] = f2bf(b[j]); }
                        } else { *(u32x2*)(dst + (size_t)r * 512 + cc) = pack4(a); *(u32x2*)(dst + (size_t)r * 512 + cc + 16) = pack4(b); }
                    }
                    asm volatile("" ::: "memory");
                }
        } else {
#pragma unroll
            for (int ai = 0; ai < 2; ++ai)
#pragma unroll
                for (int m = 0; m < 4; ++m) {
                    const int r = u.pm * 256 + ai * 128 + wr * 64 + m * 16 + fr;
#pragma unroll
                    for (int bj = 0; bj < 2; ++bj)
#pragma unroll
                        for (int n = 0; n < 2; ++n) { const int c = (tile - 6) * 256 + bj * 128 + wc * 32 + 16 * n + 4 * fq; if (c < ZLD) *(u32x2*)(zb + (size_t)r * ZLD + c) = pack4(acc[ai][bj][m][n]); }
                    asm volatile("" ::: "memory");
                }
        }
    }
};
struct EpiRes {
    float* x; const float* gate; bf16_t* vb;
    DI void operator()(const f32x4 (&acc)[2][2][4][2], const pg8::Unit& u, int wr, int wc, int fr, int fq) const {
        const float* gv = gate + row_mod(u.pm * 256) * 6144;
#pragma unroll
        for (int ai = 0; ai < 2; ++ai)
#pragma unroll
            for (int m = 0; m < 4; ++m) {
                const int r = u.pm * 256 + ai * 128 + wr * 64 + m * 16 + fr;
#pragma unroll
                for (int bj = 0; bj < 2; ++bj)
#pragma unroll
                    for (int n = 0; n < 2; ++n) { const int c = u.pn * 256 + bj * 128 + wc * 32 + 16 * n + 4 * fq; const f32x4 g4 = *(const f32x4*)(gv + c); const u32x2 xw = *(const u32x2*)((const bf16_t*)x + (size_t)r * DM + c); const f32x4 xv = (f32x4){__uint_as_float(xw.x << 16), __uint_as_float(xw.x & 0xffff0000u), __uint_as_float(xw.y << 16), __uint_as_float(xw.y & 0xffff0000u)}; *(u32x2*)(vb + (size_t)r * DM + c) = pack4(xv * ALPHA + g4 * acc[ai][bj][m][n]); }
            }
    }
};
struct EpiFfn {
    bf16_t* act;
    DI void operator()(const f32x4 (&acc)[2][2][4][2], const pg8::Unit& u, int wr, int wc, int fr, int fq) const {
#pragma unroll
        for (int ai = 0; ai < 2; ++ai)
#pragma unroll
            for (int m = 0; m < 4; ++m) {
                const int r = u.pm * 256 + ai * 128 + wr * 64 + m * 16 + fr;
#pragma unroll
                for (int n = 0; n < 2; ++n) { const f32x4 gt = acc[ai][0][m][n], up = acc[ai][1][m][n]; f32x4 o;
#pragma unroll
                    for (int j = 0; j < 4; ++j) o[j] = siluf_(gt[j]) * up[j];
                    *(u32x2*)(act + (size_t)r * DFF + u.pn * 128 + wc * 32 + 16 * n + 4 * fq) = pack4(o); }
            }
    }
};

struct Ctx {
    const Params* p; LAS unsigned char* lds; float* L; int tid, lane, wave, G, gw, NGW;
    unsigned char* ws; float* out;
};

DI void tr_item(const float* W, int K, int N, bf16_t* WT, int mode, float* scr, int item, int lane) {
    const int nblk = (N + 31) / 32, kb = item / nblk, nb = item % nblk, k0 = 64 * kb, n0 = 32 * nb;
    const int nn = n0 + (lane & 31);
#pragma unroll 8
    for (int i = 0; i < 32; ++i) { const int kk = 2 * i + (lane >> 5); scr[kk * 33 + (lane & 31)] = (nn < N) ? W[(size_t)(k0 + kk) * N + nn] : 0.f; }
    __builtin_amdgcn_wave_barrier();
    const int c = lane & 7;
#pragma unroll
    for (int j = 0; j < 4; ++j) {
        const int nl = (lane >> 3) + 8 * j, n = n0 + nl; const float* s = scr + (8 * c) * 33 + nl;
        if (n < N) {
            int dst = n; if (mode == 1) { if (n < DFF) dst = (n >> 7) * 256 + (n & 127); else { const int jj = n - DFF; dst = (jj >> 7) * 256 + 128 + (jj & 127); } }
            u32x4 o; o.x = cvt_pk_bf16(s[0 * 33], s[1 * 33]); o.y = cvt_pk_bf16(s[2 * 33], s[3 * 33]); o.z = cvt_pk_bf16(s[4 * 33], s[5 * 33]); o.w = cvt_pk_bf16(s[6 * 33], s[7 * 33]);
            *(u32x4*)(WT + (size_t)dst * K + k0 + 8 * c) = o;
        }
    }
    __builtin_amdgcn_wave_barrier();
}
DI void convert_layer_weights(const Ctx& C, int layer, int gw0 = -1, int ngw = 0, int blk = -1, int nblk = 0) {
    const Params& p = *C.p;
    unsigned char* wb = C.ws + WS_W + (size_t)(layer & 1) * WBUF;
    bf16_t* Win = (bf16_t*)(wb + W_IN); bf16_t* Wout = (bf16_t*)(wb + W_OUT); bf16_t* Wffi = (bf16_t*)(wb + W_FFI); bf16_t* Wffo = (bf16_t*)(wb + W_FFO);
    float* scr = C.L + C.wave * (64 * 33);
    constexpr int I_IN = 16 * 121, I_OUT = 16 * 32, I_FFI = 16 * 176, I_FFO = 44 * 32, NIT = I_IN + I_OUT + I_FFI + I_FFO;
    int lane_ = C.lane; asm volatile("" : "+v"(lane_));
    const int gwA = gw0 >= 0 ? gw0 : C.gw, ngwA = gw0 >= 0 ? ngw : C.NGW, blkA = blk >= 0 ? blk : (int)blockIdx.x, nblkA = blk >= 0 ? nblk : C.G;
    for (int it = gwA; it < NIT; it += ngwA) {
        int r = it;
        if (r < I_IN) { tr_item(p.in[10] + (size_t)layer * DM * DIN, DM, DIN, Win, 0, scr, r, lane_); continue; } r -= I_IN;
        if (r < I_OUT) { tr_item(p.in[19] + (size_t)layer * DM * DM, DM, DM, Wout, 0, scr, r, lane_); continue; } r -= I_OUT;
        if (r < I_FFI) { tr_item(p.in[22] + (size_t)layer * DM * 2 * DFF, DM, 2 * DFF, Wffi, 1, scr, r, lane_); continue; } r -= I_FFI;
        tr_item(p.in[23] + (size_t)layer * DFF * DM, DFF, DM, Wffo, 0, scr, r, lane_);
    }
    u32x4* z = (u32x4*)(Win + (size_t)DIN * DM); const int nz = 240 * DM * 2 / 16;
    for (int i = blkA * 512 + C.tid; i < nz; i += nblkA * 512) z[i] = (u32x4){0u, 0u, 0u, 0u};
}

DI void mod_unit(const Ctx& C, int u) {
    const Params& p = *C.p; const int tid = C.tid;
    float* cs = C.L; float* red = C.L + 3072;
    const int layer = u >> 6, col0 = (u & 63) * 96;
    __syncthreads();
    for (int i = tid; i < 3072; i += 512) { const int v = i >> 10, k = i & 1023; const float c = (v == 0) ? p.in[7][k] : p.in[6][(v - 1) * 1024 + k]; cs[i] = siluf_(c); }
    __syncthreads();
    if (tid < 504) {
        const int cgp = tid % 24, rs = tid / 24;
        f32x4 a0 = {0, 0, 0, 0}, a1 = a0, a2 = a0;
        const float* Wp = p.in[8] + (size_t)layer * DM * 6144 + col0 + cgp * 4;
#pragma unroll 7
        for (int k = rs; k < 1024; k += 21) { const f32x4 w = *(const f32x4*)(Wp + (size_t)k * 6144); a0 += w * cs[k]; a1 += w * cs[1024 + k]; a2 += w * cs[2048 + k]; }
        float* rr = red + rs * 288 + cgp * 4;
#pragma unroll
        for (int j = 0; j < 4; ++j) { rr[j] = a0[j]; rr[96 + j] = a1[j]; rr[192 + j] = a2[j]; }
    }
    __syncthreads();
    if (tid < 288) {
        const int v = tid / 96, cc = tid % 96; float s = 0.f;
        for (int rs = 0; rs < 21; ++rs) s += red[rs * 288 + tid];
        ((float*)(C.ws + WS_MOD))[(size_t)(layer * 3 + v) * 6144 + col0 + cc] = s + p.in[9][layer * 6144 + col0 + cc];
    }
}

DI void phase0a(const Ctx& C) {
    const Params& p = *C.p;
    for (int u = blockIdx.x; u < 256; u += C.G) mod_unit(C, u);
    __syncthreads();
    convert_layer_weights(C, 0);
    const int gt = blockIdx.x * 512 + C.tid, NT = C.G * 512;
    float* tab = (float*)(C.ws + WS_TAB);
    if (gt < 1024) { const int pos = gt >> 4, i = gt & 15; const float inv = __builtin_amdgcn_exp2f(-(float)i * (13.287712379549449f / 16.0f)); float rev = (float)pos * inv * 0.15915494309189535f; rev -= floorf(rev);
        tab[2 * gt] = __builtin_amdgcn_cosf(rev); tab[2 * gt + 1] = __builtin_amdgcn_sinf(rev); }
    if (gt >= 1024 && gt < 1028) { const int l = gt - 1024; const float* dl = p.in[17] + l * 256; float s01 = 0.f, s23 = 0.f; for (int i = 0; i < 64; ++i) { s01 += dl[i] * dl[64 + i]; s23 += dl[128 + i] * dl[192 + i]; }
        tab[2048 + l] = __expf(s01) - __expf(s23) + (0.8f - 0.6f * __expf(-0.3f * (float)l)); }
    if (gt >= 2048 && gt < 2560) { const int dir = (gt - 2048) >> 8, c = gt & 255; const float* lb = p.in[15] + dir * 1024 + c; float v[4], mx = -1e30f; for (int l = 0; l < 4; ++l) { v[l] = lb[l * 256]; mx = fmaxf(mx, v[l]); }
        float s = 0.f; for (int l = 0; l < 4; ++l) { v[l] = __expf(v[l] - mx); s += v[l]; } float cum = 0.f; for (int l = 0; l < 4; ++l) { if (l > 0) cum += v[l] / s; tab[4096 + (dir * 4 + l) * 256 + c] = cum; } }
    bf16_t* ck = (bf16_t*)(C.ws + WS_CK); bf16_t* cv = (bf16_t*)(C.ws + WS_CV);
    for (int i = gt; i < 2 * 4 * 256 * 512 / 4; i += NT) { const int e = i * 4; const int c = e & 511, j = (e >> 9) & 255, l = (e >> 17) & 3, b = e >> 19;
        const size_t dst = ((size_t)((l * 2 + b) * 256 + j)) * 512 + c;
        *(u32x2*)(ck + dst) = pack4(*(const f32x4*)(p.in[2] + e)); }
    for (int i = gt; i < 2 * 4 * 256 * 512; i += NT) { const int j = i & 255, dv = (i >> 8) & 127, hh = (i >> 15) & 3, b = (i >> 17) & 1, l = i >> 18;
        cv[((size_t)((((l * 2 + b) * 4 + hh) * 2 + (j >> 7)) * 128 + dv)) * 128 + (j & 127)] = f2bf(p.in[3][((size_t)((b * 4 + l) * 256 + j) * 4 + hh) * 128 + dv]); }
}

DI void row_pass(const Ctx& C, int mode, const float* lng, const float* lnb, const float* modl, int sc_off, int sh_off, bool write_xm) {
    const Params& p = *C.p; float* x = C.out; bf16_t* xm = (bf16_t*)(C.ws + WS_XM);
    for (int r0 = C.gw; r0 < MROWS; r0 += 2 * C.NGW) {
        f32x4 v[2][4];
#pragma unroll
        for (int u = 0; u < 2; ++u) { const int r = r0 + u * C.NGW;
            if (mode == 0) { const float* src = (r < 8192 ? p.in[0] + (size_t)r * DM : p.in[1] + (size_t)(r - 8192) * DM);
#pragma unroll
                for (int j = 0; j < 4; ++j) v[u][j] = *(const f32x4*)(src + 4 * C.lane + 256 * j); }
            else {
#pragma unroll
                for (int j = 0; j < 4; ++j) { const u32x2 w2 = *(const u32x2*)(xm + (size_t)r * DM + 4 * C.lane + 256 * j);
                    v[u][j] = (f32x4){__uint_as_float(w2.x << 16), __uint_as_float(w2.x & 0xffff0000u), __uint_as_float(w2.y << 16), __uint_as_float(w2.y & 0xffff0000u)}; } } }
#pragma unroll
        for (int u = 0; u < 2; ++u) { const int r = r0 + u * C.NGW;
            if (mode == 1) {
                float s = 0.f;
#pragma unroll
                for (int j = 0; j < 4; ++j) s += (v[u][j][0] + v[u][j][1]) + (v[u][j][2] + v[u][j][3]);
                const float mean = wave_sum(s) * (1.f / DM); float s2 = 0.f;
#pragma unroll
                for (int j = 0; j < 4; ++j) { v[u][j] = v[u][j] - mean; s2 += (v[u][j][0] * v[u][j][0] + v[u][j][1] * v[u][j][1]) + (v[u][j][2] * v[u][j][2] + v[u][j][3] * v[u][j][3]); }
                const float rstd = 1.0f / sqrtf(wave_sum(s2) * (1.f / DM) + LN_EPS);
#pragma unroll
                for (int j = 0; j < 4; ++j) { const f32x4 g4 = *(const f32x4*)(lng + 4 * C.lane + 256 * j), b4 = *(const f32x4*)(lnb + 4 * C.lane + 256 * j); v[u][j] = v[u][j] * rstd * g4 + b4; }
            }
            if (PROBE_A >= 0 && !write_xm) { const float* tsf = (const float*)(C.ws + WS_TAB + 131072); const float sc = 1.0f + ((r >= 8192) ? tsf[12] : (PROBE_B >= 0 ? tsf[13] : 0.f));
#pragma unroll
                for (int j = 0; j < 4; ++j) v[u][j] = v[u][j] * sc; }
            if (!write_xm) {
#pragma unroll
                for (int j = 0; j < 4; ++j) *(f32x4*)(x + (size_t)r * DM + 4 * C.lane + 256 * j) = v[u][j];
            } else {
#pragma unroll
                for (int j = 0; j < 4; ++j) *(u32x2*)((bf16_t*)x + (size_t)r * DM + 4 * C.lane + 256 * j) = pack4(v[u][j]);
            }
            if (write_xm) {
                const float* mv = modl + row_mod(r) * 6144;
#pragma unroll
                for (int j = 0; j < 4; ++j) { const int c = 4 * C.lane + 256 * j; const f32x4 sc = *(const f32x4*)(mv + sc_off + c), sh = *(const f32x4*)(mv + sh_off + c);
                    *(u32x2*)(xm + (size_t)r * DM + c) = pack4(v[u][j] * (sc + 1.0f) + sh); }
            }
        }
    }
}

#define MFMA32(a, b, c) __builtin_amdgcn_mfma_f32_32x32x16_bf16((a), (b), (c), 0, 0, 0)
#define MFMA16(a, b, c) __builtin_amdgcn_mfma_f32_16x16x32_bf16((a), (b), (c), 0, 0, 0)
constexpr int AK_LD = 72, AV_LD = 136;
struct AttnSrc { const bf16_t* Klat; const bf16_t* Kctx; const bf16_t* VTlat; const bf16_t* VTctx; int ldv; int nst; int nlat; int h; };
template <int PASS>
DI void attn_pass(int tid, int q, int hi, int kq, const AttnSrc& A, LAS bf16_t* K1s, LAS bf16_t* K2s, LAS bf16_t* VTs, const bf16x8 (&q1)[4], const bf16x8 (&q2)[4],
                  float& m1, float& l1, float& m2, float& l2, float iL1, float iL2, f32x16 (&o)[4]) {
    u32x4 kreg[4], vreg[4];
    const int h = A.h;
    auto issue = [&](int st) {
        const bf16_t* kb = (st < A.nlat) ? A.Klat + (size_t)st * 128 * 512 : A.Kctx + (size_t)(st - A.nlat) * 128 * 512;
#pragma unroll
        for (int i = 0; i < 2; ++i) { const int id = tid + 512 * i, key = id >> 3, ch = id & 7; kreg[i] = *(const u32x4*)(kb + (size_t)key * 512 + h * 128 + ch * 8); kreg[2 + i] = *(const u32x4*)(kb + (size_t)key * 512 + h * 128 + 64 + ch * 8); }
        if (PASS == 1) {
            const bf16_t* vb = (st < A.nlat) ? A.VTlat + (size_t)st * 128 : A.VTctx + (size_t)(st - A.nlat) * 128; const int ld = (st < A.nlat) ? A.ldv : 256;
#pragma unroll
            for (int i = 0; i < 4; ++i) { const int id = tid + 512 * i, dv = id >> 4, ch = id & 15; vreg[i] = *(const u32x4*)(vb + (size_t)dv * ld + ch * 8); }
        }
    };
    issue(0);
    for (int st = 0; st < A.nst; ++st) {
        __syncthreads();
#pragma unroll
        for (int i = 0; i < 2; ++i) { const int id = tid + 512 * i, key = id >> 3, ch = id & 7; *(LAS u32x4*)(K1s + key * AK_LD + ch * 8) = kreg[i]; *(LAS u32x4*)(K2s + key * AK_LD + ch * 8) = kreg[2 + i]; }
        if (PASS == 1) {
#pragma unroll
            for (int i = 0; i < 4; ++i) { const int id = tid + 512 * i, dv = id >> 4, ch = id & 15; *(LAS u32x4*)(VTs + dv * AV_LD + ch * 8) = vreg[i]; }
        }
        __syncthreads();
        if (st + 1 < A.nst) issue(st + 1);
        const int keyrow = kq * 32 + q;
        f32x16 s1, pr;
#pragma unroll
        for (int r = 0; r < 16; ++r) s1[r] = 0.f;
#pragma unroll
        for (int ks = 0; ks < 4; ++ks) { const bf16x8 a1 = *(const LAS bf16x8*)(K1s + keyrow * AK_LD + 16 * ks + 8 * hi); s1 = MFMA32(a1, q1[ks], s1); }
        if (PASS == 0) {
            float mx1 = s1[0];
#pragma unroll
            for (int r = 1; r < 16; ++r) mx1 = fmaxf(mx1, s1[r]);
            const float n1 = fmaxf(m1, mx1); float a1s = 0.f;
#pragma unroll
            for (int r = 0; r < 16; ++r) a1s += __builtin_amdgcn_exp2f(s1[r] - n1);
            l1 = l1 * __builtin_amdgcn_exp2f(m1 - n1) + a1s; m1 = n1;
        } else {
#pragma unroll
            for (int r = 0; r < 16; ++r) pr[r] = __builtin_amdgcn_exp2f(s1[r] - m1) * iL1;
        }
#pragma unroll
        for (int r = 0; r < 16; ++r) s1[r] = 0.f;
#pragma unroll
        for (int ks = 0; ks < 4; ++ks) { const bf16x8 a2 = *(const LAS bf16x8*)(K2s + keyrow * AK_LD + 16 * ks + 8 * hi); s1 = MFMA32(a2, q2[ks], s1); }
        if (PASS == 0) {
            float mx2 = s1[0];
#pragma unroll
            for (int r = 1; r < 16; ++r) mx2 = fmaxf(mx2, s1[r]);
            const float n2 = fmaxf(m2, mx2); float a2s = 0.f;
#pragma unroll
            for (int r = 0; r < 16; ++r) a2s += __builtin_amdgcn_exp2f(s1[r] - n2);
            l2 = l2 * __builtin_amdgcn_exp2f(m2 - n2) + a2s; m2 = n2;
        } else {
#pragma unroll
            for (int r = 0; r < 16; ++r) pr[r] -= __builtin_amdgcn_exp2f(s1[r] - m2) * iL2;
            bf16x8 pb[2];
            { u32x4 t0, t1; t0.x = cvt_pk_bf16(pr[0], pr[1]); t0.y = cvt_pk_bf16(pr[2], pr[3]); t0.z = cvt_pk_bf16(pr[4], pr[5]); t0.w = cvt_pk_bf16(pr[6], pr[7]);
              t1.x = cvt_pk_bf16(pr[8], pr[9]); t1.y = cvt_pk_bf16(pr[10], pr[11]); t1.z = cvt_pk_bf16(pr[12], pr[13]); t1.w = cvt_pk_bf16(pr[14], pr[15]);
              pb[0] = __builtin_bit_cast(bf16x8, t0); pb[1] = __builtin_bit_cast(bf16x8, t1); }
#pragma unroll
            for (int blk = 0; blk < 4; ++blk)
#pragma unroll
                for (int s = 0; s < 2; ++s) {
                    const LAS bf16_t* vp = VTs + (blk * 32 + q) * AV_LD + kq * 32 + 16 * s + 4 * hi;
                    const s16x4 lo = *(const LAS s16x4*)vp, hh = *(const LAS s16x4*)(vp + 8);
                    const bf16x8 av = __builtin_shufflevector(lo, hh, 0, 1, 2, 3, 4, 5, 6, 7);
                    o[blk] = MFMA32(av, pb[s], o[blk]);
                }
        }
    }
}
DI void attn_unit(const Ctx& C, int layer, int uidx) {
    int tid = C.tid; asm volatile("" : "+v"(tid)); const int lane = tid & 63, w = __builtin_amdgcn_readfirstlane(tid >> 6), qg = w & 3, kh = w >> 2, q = lane & 15, g = lane >> 4;
    const bf16_t* Qb = (const bf16_t*)(C.ws + WS_Q); const bf16_t* Kb = (const bf16_t*)(C.ws + WS_K); const bf16_t* VT = (const bf16_t*)(C.ws + WS_V);
    const bf16_t* cK = (const bf16_t*)(C.ws + WS_CK); const bf16_t* cVT = (const bf16_t*)(C.ws + WS_CV);
    int b, h, rowq0; AttnSrc A;
    if (uidx < 512) { b = uidx >> 8; h = (uidx >> 6) & 3; const int qb = uidx & 63; rowq0 = 8192 + b * 4096 + qb * 64; A.nst = 34; A.nlat = 32; A.ldv = 4096;
        A.Klat = Kb + (size_t)(8192 + b * 4096) * 512; A.VTlat = VT + 4194304 + (size_t)((b * 4 + h) * 32) * 16384; A.Kctx = cK + (size_t)((layer * 2 + b) * 256) * 512; A.VTctx = cVT + (size_t)(((layer * 2 + b) * 4 + h) * 2) * 16384; }
    else { const int v = uidx - 512; b = v >> 4; h = (v >> 2) & 3; const int qb = v & 3; rowq0 = b * 256 + qb * 64; A.nst = 2; A.nlat = 2; A.ldv = 256;
        A.Klat = Kb + (size_t)(b * 256) * 512; A.VTlat = VT + (size_t)((b * 4 + h) * 2) * 16384; A.Kctx = A.Klat; A.VTctx = A.VTlat; }
    A.h = h;
    LAS bf16_t* K1s = (LAS bf16_t*)C.lds; LAS bf16_t* K2s = K1s + 128 * AK_LD; LAS bf16_t* VTs = K2s + 128 * AK_LD;
    const float lam = ((const float*)(C.ws + WS_TAB))[2048 + layer];
    bf16x8 qf1[2], qf2[2];
    { const bf16_t* qp = Qb + (size_t)(rowq0 + 16 * qg + q) * 512 + h * 128 + 8 * g;
#pragma unroll
      for (int ks = 0; ks < 2; ++ks) { qf1[ks] = *(const bf16x8*)(qp + 32 * ks); qf2[ks] = *(const bf16x8*)(qp + 64 + 32 * ks); } }
    float m1 = -1e30f, l1 = 0.f, m2 = -1e30f, l2 = 0.f;
    f32x4 O1[8], O2[8];
#pragma unroll
    for (int t = 0; t < 8; ++t) { O1[t] = (f32x4){0.f, 0.f, 0.f, 0.f}; O2[t] = O1[t]; }
    u32x4 kreg[4], vreg[4];
    auto issue = [&](int st) {
        const bf16_t* kb = (st < A.nlat) ? A.Klat + (size_t)st * 128 * 512 : A.Kctx + (size_t)(st - A.nlat) * 128 * 512;
#pragma unroll
        for (int i = 0; i < 2; ++i) { const int id = tid + 512 * i, key = id >> 3, ch = id & 7; kreg[i] = *(const u32x4*)(kb + (size_t)key * 512 + h * 128 + ch * 8); kreg[2 + i] = *(const u32x4*)(kb + (size_t)key * 512 + h * 128 + 64 + ch * 8); }
        const bf16_t* vb = (st < A.nlat) ? A.VTlat + (size_t)st * 16384 : A.VTctx + (size_t)(st - A.nlat) * 16384;
#pragma unroll
        for (int i = 0; i < 4; ++i) { const int id = tid + 512 * i; vreg[i] = *(const u32x4*)(vb + (size_t)id * 8); }
    };
    issue(0);
    for (int st = 0; st < A.nst; ++st) {
        __syncthreads();
#pragma unroll
        for (int i = 0; i < 2; ++i) { const int id = tid + 512 * i, key = id >> 3, ch = id & 7; *(LAS u32x4*)(K1s + key * AK_LD + ch * 8) = kreg[i]; *(LAS u32x4*)(K2s + key * AK_LD + ch * 8) = kreg[2 + i]; }
#pragma unroll
        for (int i = 0; i < 4; ++i) { const int id = tid + 512 * i, dv = id >> 4, ch = id & 15; *(LAS u32x4*)(VTs + dv * AV_LD + ch * 8) = vreg[i]; }
        __syncthreads();
        if (st + 1 < A.nst) issue(st + 1);
#pragma unroll
        for (int kb = 0; kb < 2; ++kb) {
            const int key0 = kh * 64 + kb * 32;
            f32x4 sA0 = {0.f, 0.f, 0.f, 0.f}, sA1 = sA0, sB0 = sA0, sB1 = sA0;
#pragma unroll
            for (int ks = 0; ks < 2; ++ks) {
                const bf16x8 a10 = *(const LAS bf16x8*)(K1s + (key0 + q) * AK_LD + 32 * ks + 8 * g), a11 = *(const LAS bf16x8*)(K1s + (key0 + 16 + q) * AK_LD + 32 * ks + 8 * g);
                const bf16x8 a20 = *(const LAS bf16x8*)(K2s + (key0 + q) * AK_LD + 32 * ks + 8 * g), a21 = *(const LAS bf16x8*)(K2s + (key0 + 16 + q) * AK_LD + 32 * ks + 8 * g);
                sA0 = MFMA16(a10, qf1[ks], sA0); sA1 = MFMA16(a11, qf1[ks], sA1); sB0 = MFMA16(a20, qf2[ks], sB0); sB1 = MFMA16(a21, qf2[ks], sB1);
            }
            float t1 = fmaxf(fmaxf(fmaxf(sA0[0], sA0[1]), fmaxf(sA0[2], sA0[3])), fmaxf(fmaxf(sA1[0], sA1[1]), fmaxf(sA1[2], sA1[3])));
            float t2 = fmaxf(fmaxf(fmaxf(sB0[0], sB0[1]), fmaxf(sB0[2], sB0[3])), fmaxf(fmaxf(sB1[0], sB1[1]), fmaxf(sB1[2], sB1[3])));
            if (__any(t1 > m1 || t2 > m2)) {
                t1 = fmaxf(t1, __shfl_xor(t1, 16)); t1 = fmaxf(t1, __shfl_xor(t1, 32)); t2 = fmaxf(t2, __shfl_xor(t2, 16)); t2 = fmaxf(t2, __shfl_xor(t2, 32));
                const float n1 = fmaxf(m1, t1), n2 = fmaxf(m2, t2); const float f1 = __builtin_amdgcn_exp2f(m1 - n1), f2 = __builtin_amdgcn_exp2f(m2 - n2);
                l1 *= f1; l2 *= f2; m1 = n1; m2 = n2;
#pragma unroll
                for (int t = 0; t < 8; ++t) { O1[t] = O1[t] * f1; O2[t] = O2[t] * f2; }
            }
            f32x4 pA0, pA1, pB0, pB1;
#pragma unroll
            for (int i = 0; i < 4; ++i) { pA0[i] = __builtin_amdgcn_exp2f(sA0[i] - m1); pA1[i] = __builtin_amdgcn_exp2f(sA1[i] - m1); pB0[i] = __builtin_amdgcn_exp2f(sB0[i] - m2); pB1[i] = __builtin_amdgcn_exp2f(sB1[i] - m2); }
            l1 += (pA0[0] + pA0[1]) + (pA0[2] + pA0[3]) + (pA1[0] + pA1[1]) + (pA1[2] + pA1[3]);
            l2 += (pB0[0] + pB0[1]) + (pB0[2] + pB0[3]) + (pB1[0] + pB1[1]) + (pB1[2] + pB1[3]);
            const bf16x8 pb1 = pack8(pA0, pA1), pb2 = pack8(pB0, pB1);
#pragma unroll
            for (int t = 0; t < 8; ++t) {
                const LAS bf16_t* vp = VTs + (16 * t + q) * AV_LD + key0 + 4 * g;
                const s16x4 lo = *(const LAS s16x4*)vp, hh = *(const LAS s16x4*)(vp + 16);
                const bf16x8 av = __builtin_shufflevector(lo, hh, 0, 1, 2, 3, 4, 5, 6, 7);
                O1[t] = MFMA16(av, pb1, O1[t]); O2[t] = MFMA16(av, pb2, O2[t]);
            }
        }
    }
    l1 += __shfl_xor(l1, 16); l1 += __shfl_xor(l1, 32); l2 += __shfl_xor(l2, 16); l2 += __shfl_xor(l2, 32);
    __syncthreads();
    LAS float* comb = (LAS float*)C.lds;
    LAS float* exs = (LAS float*)(C.lds + 65536);
    if (kh == 1) {
#pragma unroll
        for (int t = 0; t < 8; ++t)
#pragma unroll
            for (int i = 0; i < 4; ++i) { comb[(qg * 64 + t * 4 + i) * 64 + lane] = O1[t][i]; comb[(qg * 64 + 32 + t * 4 + i) * 64 + lane] = O2[t][i]; }
        exs[(qg * 4 + 0) * 64 + lane] = m1; exs[(qg * 4 + 1) * 64 + lane] = l1; exs[(qg * 4 + 2) * 64 + lane] = m2; exs[(qg * 4 + 3) * 64 + lane] = l2;
    }
    __syncthreads();
    if (kh == 0) {
        const float om1 = exs[(qg * 4 + 0) * 64 + lane], ol1 = exs[(qg * 4 + 1) * 64 + lane], om2 = exs[(qg * 4 + 2) * 64 + lane], ol2 = exs[(qg * 4 + 3) * 64 + lane];
        const float n1 = fmaxf(m1, om1), n2 = fmaxf(m2, om2);
        const float fa1 = __builtin_amdgcn_exp2f(m1 - n1), fb1 = __builtin_amdgcn_exp2f(om1 - n1), fa2 = __builtin_amdgcn_exp2f(m2 - n2), fb2 = __builtin_amdgcn_exp2f(om2 - n2);
        const float L1 = l1 * fa1 + ol1 * fb1, L2 = l2 * fa2 + ol2 * fb2;
        const float c1a = fa1 / L1, c1b = fb1 / L1, c2a = lam * fa2 / L2, c2b = lam * fb2 / L2;
        float ss = 0.f;
#pragma unroll
        for (int t = 0; t < 8; ++t)
#pragma unroll
            for (int i = 0; i < 4; ++i) { const float v = O1[t][i] * c1a + comb[(qg * 64 + t * 4 + i) * 64 + lane] * c1b - O2[t][i] * c2a - comb[(qg * 64 + 32 + t * 4 + i) * 64 + lane] * c2b; O1[t][i] = v; ss += v * v; }
        ss += __shfl_xor(ss, 16); ss += __shfl_xor(ss, 32);
        const float lam_init = 0.8f - 0.6f * __expf(-0.3f * (float)layer);
        const float sc = (1.0f / sqrtf(ss * (1.0f / 128.0f) + RMS_EPS)) * (1.0f - lam_init);
        const float* dn = C.p->in[18] + layer * 128;
        bf16_t* ob = (bf16_t*)(C.ws + WS_O) + (size_t)(rowq0 + 16 * qg + q) * DM + h * 128;
#pragma unroll
        for (int t = 0; t < 8; ++t) { const int dv = 16 * t + 4 * g; const f32x4 d4 = *(const f32x4*)(dn + dv); *(u32x2*)(ob + dv) = pack4(O1[t] * sc * d4); }
    }
    __syncthreads();
}

DI void delta_prep_unit(const Ctx& C, int layer, int unit) {
    const Params& p = *C.p; int tid = C.tid; asm volatile("" : "+v"(tid)); const int lane = tid & 63, w = __builtin_amdgcn_readfirstlane(tid >> 6);
    const int tc = unit >> 2, h = unit & 3, row0 = tc * 64;
    int ci, nch; if (tc < 128) { ci = tc & 3; nch = 4; } else { ci = (tc - 128) & 63; nch = 64; }
    const bool has_prev = ci > 0, has_next = ci < nch - 1;
    float* qs = C.L; float* kk = C.L + 4160; float* vv = C.L + 8320; float* KK0 = C.L + 12480; float* QK0 = KK0 + 4096; float* Ms = QK0 + 4096; float* bc = Ms + 8192; float* be = bc + 128;
    const bf16_t* zb = (const bf16_t*)(C.ws + WS_ZB);
    const float* cw = p.in[11] + layer * 3 * 768;
    __syncthreads();
    if (tid < 384) {
        const int c = tid % 192, th = tid / 192, which = c >> 6, d = c & 63, col = which * 256 + h * 64 + d;
        const float w0 = cw[col], w1 = cw[768 + col], w2 = cw[1536 + col];
        float xin[34];
#pragma unroll
        for (int i = 0; i < 34; ++i) { const int tt = 32 * th - 1 + i; const bool ok = (tt >= 0 || has_prev) && (tt < 64 || has_next); xin[i] = ok ? bf2f(zb[(size_t)(row0 + tt) * ZLD + col]) : 0.f; }
        float* dstp = (which == 0 ? qs : (which == 1 ? kk : vv)) + d;
#pragma unroll
        for (int i = 0; i < 32; ++i) dstp[(32 * th + i) * 65] = siluf_(w0 * xin[i] + w1 * xin[i + 1] + w2 * xin[i + 2]);
    }
    __syncthreads();
    { const int r = tid >> 2, part = tid & 3; float* base = (r < 64 ? qs + r * 65 : kk + (r - 64) * 65) + part * 16; float ss = 0.f;
#pragma unroll
      for (int i = 0; i < 16; ++i) ss += base[i] * base[i];
      ss += __shfl_xor(ss, 1); ss += __shfl_xor(ss, 2);
      const float sc = (1.0f / sqrtf(ss + 1e-6f)) * (r < 64 ? 0.125f : 1.0f);
#pragma unroll
      for (int i = 0; i < 16; ++i) base[i] *= sc; }
    if (w < 2) {
        const int dir = w, i = lane, tt = dir ? 63 - i : i; const size_t row = (size_t)(row0 + tt);
        const float braw = bf2f(zb[row * ZLD + ZB_BBETA + dir * 4 + h]), araw = bf2f(zb[row * ZLD + ZB_BA + dir * 4 + h]);
        const float A = __expf(p.in[12][layer * 8 + dir * 4 + h]); const float x = araw + p.in[13][layer * 8 + dir * 4 + h];
        const float sp = x > 20.f ? x : log1pf(__expf(x)); float g = -A * sp;
#pragma unroll
        for (int off = 1; off < 64; off <<= 1) { const float t = __shfl_up(g, off); if (lane >= off) g += t; }
        bc[dir * 64 + i] = g; const float bt = sigmoidf_(braw); be[dir * 64 + i] = bt; be[128 + dir * 64 + i] = bt * __expf(g);
    }
    __syncthreads();
    {
        const int rbm = w & 3, cb0 = (w >> 2) * 2, r16 = lane & 15, g4 = lane >> 4;
        bf16x8 kA[2], qA[2], kB[2][2];
#pragma unroll
        for (int ks = 0; ks < 2; ++ks) {
            const float* kp = kk + (16 * rbm + r16) * 65 + 32 * ks + 8 * g4; const float* qp = qs + (16 * rbm + r16) * 65 + 32 * ks + 8 * g4;
            kA[ks] = pack8((f32x4){kp[0], kp[1], kp[2], kp[3]}, (f32x4){kp[4], kp[5], kp[6], kp[7]});
            qA[ks] = pack8((f32x4){qp[0], qp[1], qp[2], qp[3]}, (f32x4){qp[4], qp[5], qp[6], qp[7]});
#pragma unroll
            for (int c = 0; c < 2; ++c) { const float* bp = kk + (16 * (cb0 + c) + r16) * 65 + 32 * ks + 8 * g4;
                kB[c][ks] = pack8((f32x4){bp[0], bp[1], bp[2], bp[3]}, (f32x4){bp[4], bp[5], bp[6], bp[7]}); }
        }
#pragma unroll
        for (int c = 0; c < 2; ++c) {
            f32x4 ak = {0.f, 0.f, 0.f, 0.f}, aq = ak;
#pragma unroll
            for (int ks = 0; ks < 2; ++ks) { ak = MFMA16(kA[ks], kB[c][ks], ak); aq = MFMA16(qA[ks], kB[c][ks], aq); }
#pragma unroll
            for (int i = 0; i < 4; ++i) { const int o = (16 * rbm + 4 * g4 + i) * 64 + 16 * (cb0 + c) + r16; KK0[o] = ak[i]; QK0[o] = aq[i]; }
        }
    }
    __syncthreads();
    bf16_t* dpW = (bf16_t*)(C.ws + WS_DPW); bf16_t* dpQD = (bf16_t*)(C.ws + WS_DPQD); bf16_t* dpQK = (bf16_t*)(C.ws + WS_DPQK); bf16_t* dpKD = (bf16_t*)(C.ws + WS_DPKD); bf16_t* dpU = (bf16_t*)(C.ws + WS_DPU);
    float* dpGL = (float*)(C.ws + WS_GL);
    { const int i = tid >> 3, j0 = (tid & 7) * 8;
#pragma unroll
      for (int dir = 0; dir < 2; ++dir) {
          const size_t ud = ((size_t)tc * 4 + h) * 2 + dir;
          const float bi = bc[dir * 64 + i], betai = be[dir * 64 + i]; const int ai = dir ? 63 - i : i;
#pragma unroll
          for (int jj = 0; jj < 8; ++jj) { const int j = j0 + jj, aj = dir ? 63 - j : j;
              const float dec = (j <= i) ? __expf(bi - bc[dir * 64 + j]) : 0.f;
              Ms[dir * 4096 + j * 64 + i] = (j < i) ? betai * KK0[ai * 64 + aj] * dec : 0.f;
              dpQK[ud * 4096 + i * 64 + pinv(j)] = f2bf(QK0[ai * 64 + aj] * dec); }
      } }
    __syncthreads();
    if (w < 4) {
        const int dir = w >> 1, c = (w & 1) * 64 + lane; const size_t ud = ((size_t)tc * 4 + h) * 2 + dir;
        const float* Msd = Ms + dir * 4096; const bool isU = (w & 1) == 0; const float* scp = be + (isU ? 0 : 128) + dir * 64; const float* srcp = (isU ? vv : kk) + lane;
        float x[64];
#pragma unroll
        for (int rb = 0; rb < 4; ++rb) {
            float r[16];
#pragma unroll
            for (int ii = 0; ii < 16; ++ii) { const int i = 16 * rb + ii, tt = dir ? 63 - i : i; r[ii] = scp[i] * srcp[tt * 65]; }
            asm volatile("" ::: "memory");
#pragma unroll
            for (int j = 0; j < 16 * rb; ++j) {
                const float* mp = Msd + j * 64 + 16 * rb;
                const f32x4 ma = *(const f32x4*)mp, mb = *(const f32x4*)(mp + 4), mc = *(const f32x4*)(mp + 8), md = *(const f32x4*)(mp + 12);
                const float xj = x[j];
#pragma unroll
                for (int c4 = 0; c4 < 4; ++c4) { r[c4] -= ma[c4] * xj; r[4 + c4] -= mb[c4] * xj; r[8 + c4] -= mc[c4] * xj; r[12 + c4] -= md[c4] * xj; }
                if ((j & 3) == 3) asm volatile("" ::: "memory");
            }
#pragma unroll
            for (int jj = 0; jj < 16; ++jj) {
                const float xj = r[jj]; x[16 * rb + jj] = xj;
                const float* mp = Msd + (16 * rb + jj) * 64 + 16 * rb;
#pragma unroll
                for (int ii = jj + 1; ii < 16; ++ii) r[ii] -= mp[ii] * xj;
                if ((jj & 3) == 3) asm volatile("" ::: "memory");
            }
        }
        if (c < 64) {
            bf16_t* up = dpU + ud * 4096 + c * 64;
#pragma unroll
            for (int i = 0; i < 64; i += 8) { u32x4 o; o.x = cvt_pk_bf16(x[i], x[i + 1]); o.y = cvt_pk_bf16(x[i + 2], x[i + 3]); o.z = cvt_pk_bf16(x[i + 4], x[i + 5]); o.w = cvt_pk_bf16(x[i + 6], x[i + 7]); *(u32x4*)(up + i) = o; }
        } else {
            bf16_t* wp = dpW + ud * 4096 + pinv(c - 64);
#pragma unroll
            for (int i = 0; i < 64; ++i) wp[i * 64] = f2bf(x[i]);
        }
    } else {
#pragma unroll 4
        for (int it = 0; it < 64; ++it) {
            const int e = (tid - 256) + 256 * it, dir = e >> 13, which = (e >> 12) & 1, rem = e & 4095; const size_t ud = ((size_t)tc * 4 + h) * 2 + dir;
            if (which == 0) { const int i = rem >> 6, d = rem & 63, tt = dir ? 63 - i : i; dpQD[ud * 4096 + i * 64 + pinv(d)] = f2bf(qs[tt * 65 + d] * __expf(bc[dir * 64 + i])); }
            else { const int dk = rem >> 6, i = rem & 63, tt = dir ? 63 - i : i; dpKD[ud * 4096 + dk * 64 + pinv(i)] = f2bf(kk[tt * 65 + dk] * __expf(bc[dir * 64 + 63] - bc[dir * 64 + i])); }
        }
        if (tid == 256 || tid == 257) { const int dir = tid - 256; dpGL[((size_t)tc * 4 + h) * 2 + dir] = __expf(bc[dir * 64 + 63]); }
    }
}

DI void delta_scan_unit(const Ctx& C, int layer, bool sample, int b, int h) {
    const Params& p = *C.p; int tid = C.tid; asm volatile("" : "+v"(tid)); const int lane = tid & 63; const int w = C.wave, dir = w >> 2, sl = w & 3, col = lane & 15, g = lane >> 4;
    const int tc0 = sample ? 128 + b * 64 : b * 4, nch = sample ? 64 : 4;
    const bf16_t* dpU = (const bf16_t*)(C.ws + WS_DPU);
    const float* dpGL = (const float*)(C.ws + WS_GL); float* od = (float*)(C.ws + WS_OD) + (size_t)dir * MROWS * 256;
    f32x4 S[4];
    if (sample) { const float* s0 = p.in[4] + ((((size_t)b * 4 + layer) * 2 + dir) * 4 + h) * 4096;
#pragma unroll
        for (int rb = 0; rb < 4; ++rb)
#pragma unroll
            for (int ii = 0; ii < 4; ++ii) S[rb][ii] = s0[(16 * rb + 4 * g + ii) * 64 + 16 * sl + col]; }
    else {
#pragma unroll
        for (int rb = 0; rb < 4; ++rb) S[rb] = (f32x4){0.f, 0.f, 0.f, 0.f}; }
    u32x4 Ra[8], Rb[8];
#define DS_TC(d_, n_) ((d_) ? tc0 + nch - 1 - (n_) : tc0 + (n_))
#define DS_ISSUE(R, n_) do { _Pragma("unroll") for (int i = 0; i < 8; ++i) { const int id = tid + 512 * i, dm = id >> 9, dd = dm >> 2, mat = dm & 3; \
        const size_t ud_ = ((size_t)DS_TC(dd, n_) * 4 + h) * 2 + dd; R[i] = *(const u32x4*)(C.ws + WS_DPW + (size_t)mat * (16u * MiB) + ud_ * 8192 + (size_t)(id & 511) * 16); } } while (0)
#define DS_WRITE(R, buf_) do { _Pragma("unroll") for (int i = 0; i < 8; ++i) { const int id = tid + 512 * i, dm = id >> 9, row = (id >> 3) & 63, c = id & 7; \
        *(LAS u32x4*)(C.lds + (buf_) * 65536 + dm * 8192 + row * 128 + ((c ^ (row & 7)) * 16)) = R[i]; } } while (0)
#define DS_FRAG(buf_, mat_, rb_, ks_) (*(const LAS bf16x8*)(C.lds + (buf_) * 65536 + (dir * 4 + (mat_)) * 8192 + (16 * (rb_) + col) * 128 + ((((ks_) * 4 + g) ^ (col & 7)) * 16)))
    __syncthreads();
    DS_ISSUE(Ra, 0); DS_WRITE(Ra, 0); DS_ISSUE(Ra, 1);
    s16x4 uuA[4], uuB[4]; float glA, glB;
#define DS_LOADU(uu, gl, n_) do { const size_t ud_ = ((size_t)DS_TC(dir, n_) * 4 + h) * 2 + dir; _Pragma("unroll") for (int rb = 0; rb < 4; ++rb) uu[rb] = *(const s16x4*)(dpU + ud_ * 4096 + (16 * sl + col) * 64 + 16 * rb + 4 * g); gl = dpGL[ud_]; } while (0)
    DS_LOADU(uuA, glA, 0); DS_LOADU(uuB, glB, 1);
    __syncthreads();
#define DS_STEP(n, buf, Rnext, Rcur, uu, gl) do { \
        if ((n) + 2 < nch) DS_ISSUE(Rnext, (n) + 2); \
        const int tc = DS_TC(dir, (n)); \
        bf16x8 Sb[2]; Sb[0] = pack8(S[0], S[1]); Sb[1] = pack8(S[2], S[3]); \
        f32x4 vn[4]; \
        _Pragma("unroll") for (int rb = 0; rb < 4; ++rb) { f32x4 t = (f32x4){0.f, 0.f, 0.f, 0.f}; t = MFMA16(DS_FRAG(buf, 0, rb, 0), Sb[0], t); t = MFMA16(DS_FRAG(buf, 0, rb, 1), Sb[1], t); \
            _Pragma("unroll") for (int ii = 0; ii < 4; ++ii) vn[rb][ii] = bf2f((bf16_t)uu[rb][ii]) - t[ii]; } \
        const float glc = gl; \
        if ((n) + 2 < nch) DS_LOADU(uu, gl, (n) + 2); \
        bf16x8 vb[2]; vb[0] = pack8(vn[0], vn[1]); vb[1] = pack8(vn[2], vn[3]); \
        const int rowb = tc * 64; \
        _Pragma("unroll") for (int rb = 0; rb < 4; ++rb) { f32x4 o = (f32x4){0.f, 0.f, 0.f, 0.f}; o = MFMA16(DS_FRAG(buf, 1, rb, 0), Sb[0], o); o = MFMA16(DS_FRAG(buf, 1, rb, 1), Sb[1], o); o = MFMA16(DS_FRAG(buf, 2, rb, 0), vb[0], o); o = MFMA16(DS_FRAG(buf, 2, rb, 1), vb[1], o); \
            _Pragma("unroll") for (int ii = 0; ii < 4; ++ii) { const int i = 16 * rb + 4 * g + ii; const int tt = dir ? 63 - i : i; od[(size_t)(rowb + tt) * 256 + h * 64 + 16 * sl + col] = o[ii]; } } \
        _Pragma("unroll") for (int rb = 0; rb < 4; ++rb) { f32x4 sn = S[rb] * glc; sn = MFMA16(DS_FRAG(buf, 3, rb, 0), vb[0], sn); sn = MFMA16(DS_FRAG(buf, 3, rb, 1), vb[1], sn); S[rb] = sn; } \
        if ((n) + 1 < nch) DS_WRITE(Rcur, (buf) ^ 1); \
        __syncthreads(); } while (0)
    for (int n = 0; n < nch; n += 2) {
        DS_STEP(n, 0, Rb, Ra, uuA, glA);
        DS_STEP(n + 1, 1, Ra, Rb, uuB, glB);
    }
#undef DS_STEP
#undef DS_TC
#undef DS_ISSUE
#undef DS_WRITE
#undef DS_FRAG
#undef DS_LOADU
    if (!sample) { float* so = C.out + OUT_SD + ((((size_t)b * 4 + layer) * 2 + dir) * 4 + h) * 4096;
#pragma unroll
        for (int rb = 0; rb < 4; ++rb)
#pragma unroll
            for (int ii = 0; ii < 4; ++ii) so[(16 * rb + 4 * g + ii) * 64 + 16 * sl + col] = S[rb][ii]; }
}

DI float hgrn_forget(const bf16_t* zb, size_t row, int dir, int h, int d, float lb) { const float x = bf2f(zb[row * ZLD + ZB_CF + dir * 256 + h * 64 + d]); return lb + (1.0f - lb) * sigmoidf_(x); }
DI void hgrn_local_unit(const Ctx& C, int layer, int unit) {
    int lane = C.lane; asm volatile("" : "+v"(lane)); const int dir = unit & 1, h = (unit >> 1) & 3, tc = unit >> 3, row0 = tc * 64;
    const bf16_t* zb = (const bf16_t*)(C.ws + WS_ZB);
    float* fs = C.L + C.wave * 2048; float* qs2 = fs + 1024;
    bf16_t* oloc = (bf16_t*)(C.ws + WS_XM + 16 * MiB) + (size_t)dir * MROWS * 256;
    bf16_t* qdb = (bf16_t*)((unsigned char*)C.out + 32 * MiB) + (size_t)dir * MROWS * 256;
    const float lb = ((const float*)(C.ws + WS_TAB))[4096 + (dir * 4 + layer) * 256 + h * 64 + lane];
    float S[64];
#pragma unroll
    for (int d = 0; d < 64; ++d) S[d] = 0.f;
    float Dl = 1.0f;
    for (int sb = 0; sb < 4; ++sb) {
        float vr[16];
#pragma unroll
        for (int i = 0; i < 16; ++i) { const int ti = sb * 16 + i, tt = dir ? 63 - ti : ti; const size_t row = (size_t)(row0 + tt);
            const float f = hgrn_forget(zb, row, dir, h, lane, lb); const float qv = siluf_(bf2f(zb[row * ZLD + ZB_CQ + h * 64 + lane]));
            fs[i * 64 + lane] = f; qs2[i * 64 + lane] = qv; Dl *= f; qdb[row * 256 + h * 64 + lane] = f2bf(qv * Dl); vr[i] = bf2f(zb[row * ZLD + ZB_CI + h * 64 + lane]); }
        __builtin_amdgcn_wave_barrier();
#pragma unroll
        for (int i = 0; i < 16; ++i) { const float v = vr[i]; float o0 = 0.f, o1 = 0.f, o2 = 0.f, o3 = 0.f;
#pragma unroll
            for (int d = 0; d < 64; d += 4) { const f32x4 f4 = *(const f32x4*)(fs + i * 64 + d), q4 = *(const f32x4*)(qs2 + i * 64 + d);
                S[d] = fmaf(f4[0], S[d] - v, v); S[d + 1] = fmaf(f4[1], S[d + 1] - v, v); S[d + 2] = fmaf(f4[2], S[d + 2] - v, v); S[d + 3] = fmaf(f4[3], S[d + 3] - v, v);
                o0 = fmaf(q4[0], S[d], o0); o1 = fmaf(q4[1], S[d + 1], o1); o2 = fmaf(q4[2], S[d + 2], o2); o3 = fmaf(q4[3], S[d + 3], o3);
                if ((d & 15) == 12) asm volatile("" ::: "memory"); }
            const int ti = sb * 16 + i, tt = dir ? 63 - ti : ti;
            oloc[(size_t)(row0 + tt) * 256 + h * 64 + lane] = f2bf((o0 + o1) + (o2 + o3)); }
        __builtin_amdgcn_wave_barrier();
    }
    float* hs = (float*)(C.ws + WS_HS) + (size_t)unit * 4096;
#pragma unroll
    for (int d = 0; d < 64; ++d) hs[d * 64 + lane] = S[d];
    ((float*)(C.ws + WS_HD))[(size_t)unit * 64 + lane] = Dl;
}
DI void hgrn_scan_unit(const Ctx& C, int layer, bool sample, int b, int h, int dir) {
    const Params& p = *C.p; int tid = C.tid; asm volatile("" : "+v"(tid)); const int tc0 = sample ? 128 + b * 64 : b * 4, nch = sample ? 64 : 4;
    float* HS = (float*)(C.ws + WS_HS); const float* HD = (const float*)(C.ws + WS_HD);
    f32x4 S0, S1;
    if (sample) { const float* s0 = p.in[5] + ((((size_t)b * 4 + layer) * 2 + dir) * 4 + h) * 4096 + tid * 8; S0 = *(const f32x4*)s0; S1 = *(const f32x4*)(s0 + 4); }
    else { float z_ = 0.f; asm volatile("" : "+v"(z_)); S0 = (f32x4){z_, z_, z_, z_}; S1 = S0; }
    for (int n0 = 0; n0 < nch; n0 += 4) {
        f32x4 la[4], lb[4]; float Dd[4];
#pragma unroll
        for (int k = 0; k < 4; ++k) { const int tc = dir ? tc0 + nch - 1 - (n0 + k) : tc0 + n0 + k; const size_t uh = ((size_t)tc * 4 + h) * 2 + dir;
            const float* hp = HS + uh * 4096 + tid * 8; la[k] = *(const f32x4*)hp; lb[k] = *(const f32x4*)(hp + 4); Dd[k] = HD[uh * 64 + (tid >> 3)]; }
#pragma unroll
        for (int k = 0; k < 4; ++k) { const int tc = dir ? tc0 + nch - 1 - (n0 + k) : tc0 + n0 + k; const size_t uh = ((size_t)tc * 4 + h) * 2 + dir;
            float* hp = HS + uh * 4096 + tid * 8; *(f32x4*)hp = S0; *(f32x4*)(hp + 4) = S1; S0 = S0 * Dd[k] + la[k]; S1 = S1 * Dd[k] + lb[k]; }
    }
    if (!sample) { float* so = C.out + OUT_SH + ((((size_t)b * 4 + layer) * 2 + dir) * 4 + h) * 4096 + tid * 8; *(f32x4*)so = S0; *(f32x4*)(so + 4) = S1; }
}
DI void hgrn_final_unit(const Ctx& C, int layer, int tc) {
    const Params& p = *C.p; int lane = C.lane; asm volatile("" : "+v"(lane)); const int w = C.wave, h = w >> 1, chh = w & 1, r16 = lane & 15, g4 = lane >> 4, row0 = tc * 64;
    const bf16_t* zb = (const bf16_t*)(C.ws + WS_ZB); const float* HS = (const float*)(C.ws + WS_HS);
    const bf16_t* oloc = (const bf16_t*)(C.ws + WS_XM + 16 * MiB); const bf16_t* qdb = (const bf16_t*)((const unsigned char*)C.out + 32 * MiB);
    float* otile = C.L;
    __syncthreads();
    f32x4 acc[4][2];
#pragma unroll
    for (int rb = 0; rb < 4; ++rb) { acc[rb][0] = (f32x4){0.f, 0.f, 0.f, 0.f}; acc[rb][1] = acc[rb][0]; }
#pragma unroll
    for (int dir = 0; dir < 2; ++dir) {
        const size_t uh = ((size_t)tc * 4 + h) * 2 + dir;
        bf16x8 Bf[2][2];
#pragma unroll
        for (int cb = 0; cb < 2; ++cb)
#pragma unroll
            for (int ks = 0; ks < 2; ++ks) { const float* sp = HS + uh * 4096 + (size_t)(32 * ks + 8 * g4) * 64 + 32 * chh + 16 * cb + r16;
                Bf[cb][ks] = pack8((f32x4){sp[0], sp[64], sp[128], sp[192]}, (f32x4){sp[256], sp[320], sp[384], sp[448]}); }
#pragma unroll
        for (int rb = 0; rb < 4; ++rb)
#pragma unroll
            for (int ks = 0; ks < 2; ++ks) { const bf16x8 Af = *(const bf16x8*)(qdb + (size_t)dir * MROWS * 256 + (size_t)(row0 + 16 * rb + r16) * 256 + h * 64 + 32 * ks + 8 * g4);
                acc[rb][0] = MFMA16(Af, Bf[0][ks], acc[rb][0]); acc[rb][1] = MFMA16(Af, Bf[1][ks], acc[rb][1]); }
    }
#pragma unroll
    for (int rb = 0; rb < 4; ++rb)
#pragma unroll
        for (int cb = 0; cb < 2; ++cb)
#pragma unroll
            for (int i = 0; i < 4; ++i) { const int t = 16 * rb + 4 * g4 + i, e = 32 * chh + 16 * cb + r16; const size_t ix = (size_t)(row0 + t) * 256 + h * 64 + e;
                otile[(h * 64 + t) * 64 + e] = acc[rb][cb][i] + bf2f(oloc[ix]) + bf2f(oloc[(size_t)MROWS * 256 + ix]); }
    __syncthreads();
    bf16_t* ob = (bf16_t*)(C.ws + WS_O);
    const float ng = p.in[16][layer * 64 + lane];
    bf16_t gts[32];
#pragma unroll
    for (int rr = 0; rr < 32; ++rr) { const int idx = w * 32 + rr, hh = idx >> 6, tt = idx & 63; gts[rr] = zb[(size_t)(row0 + tt) * ZLD + ZB_CG + hh * 64 + lane]; }
#pragma unroll
    for (int rr = 0; rr < 32; ++rr) { const int idx = w * 32 + rr, hh = idx >> 6, tt = idx & 63; const size_t row = (size_t)(row0 + tt);
        const float v = otile[(hh * 64 + tt) * 64 + lane]; const float ss = wave_sum(v * v);
        const float gt = siluf_(bf2f(gts[rr]));
        ob[row * DM + 768 + hh * 64 + lane] = f2bf(v * (1.0f / sqrtf(ss * (1.0f / 64.0f) + RMS_EPS)) * ng * gt); }
}
DI void delta_combine(const Ctx& C, int layer) {
    const Params& p = *C.p; const bf16_t* zb = (const bf16_t*)(C.ws + WS_ZB); const float* od = (const float*)(C.ws + WS_OD); bf16_t* ob = (bf16_t*)(C.ws + WS_O);
    const float ng = p.in[14][layer * 64 + C.lane];
    for (int it0 = C.gw * 4; it0 < MROWS * 4; it0 += C.NGW * 4) {
        float v[4]; bf16_t gr[4];
#pragma unroll
        for (int k = 0; k < 4; ++k) { const int it = it0 + k, h = it & 3; const size_t row = (size_t)(it >> 2);
            v[k] = od[row * 256 + h * 64 + C.lane] + od[(size_t)MROWS * 256 + row * 256 + h * 64 + C.lane]; gr[k] = zb[row * ZLD + ZB_BG + h * 64 + C.lane]; }
#pragma unroll
        for (int k = 0; k < 4; ++k) { const int it = it0 + k, h = it & 3; const size_t row = (size_t)(it >> 2);
            const float ss = wave_sum(v[k] * v[k]); const float gt = siluf_(bf2f(gr[k]));
            ob[row * DM + 512 + h * 64 + C.lane] = f2bf(v[k] * (1.0f / sqrtf(ss * (1.0f / 64.0f) + RMS_EPS)) * ng * gt); }
    }
}

#define XB_TMO      128
#define XB_XCNT(j)  (256  + 64 * (j))
#define XB_XSUB(j)  (1280 + 64 * (j))
#define XB_XGEN(j)  (2304 + 64 * (j))
#define XB_TOP      3328
#define XB_TOPGEN   3392
#define XB_SPIN_CAP (1u << 22)
DI unsigned xb_ld(unsigned* p)              { return __hip_atomic_load(p, __ATOMIC_RELAXED, __HIP_MEMORY_SCOPE_AGENT); }
DI unsigned xb_add(unsigned* p, unsigned v) { return __hip_atomic_fetch_add(p, v, __ATOMIC_RELAXED, __HIP_MEMORY_SCOPE_AGENT); }
DI unsigned xb_xcc_id() { return (unsigned)__builtin_amdgcn_s_getreg((3 << 11) | 20) & 0xFu; }
#define XB_SPIN(cond, bar) do { unsigned _sp = 0; while (cond) { __builtin_amdgcn_s_sleep(1); \
    if ((++_sp & 255u) == 0u) { if (xb_ld(&(bar)[XB_TMO])) break; if (_sp > XB_SPIN_CAP) { atomicAdd(&(bar)[XB_TMO], 1u); break; } } } } while (0)
struct XcdBarrier { unsigned* bar; unsigned x; volatile LAS unsigned* st; };
DI void xcd_barrier_complete(unsigned* bar, unsigned x, unsigned& nloc, unsigned& nx) {
    const unsigned G = gridDim.x * gridDim.y * gridDim.z;
    unsigned sum, cnt, mine, sp = 0u;
    for (;;) {
        sum = 0u; cnt = 0u; mine = 0u;
#pragma unroll
        for (unsigned j = 0; j < 16; ++j) { const unsigned c = xb_ld(&bar[XB_XCNT(j)]); sum += c; cnt += (c > 0u) ? 1u : 0u; mine = (j == x) ? c : mine; }
        if (sum == G) break;
        __builtin_amdgcn_s_sleep(1);
        if ((++sp & 255u) == 0u) { if (xb_ld(&bar[XB_TMO])) break; if (sp > XB_SPIN_CAP) { atomicAdd(&bar[XB_TMO], 1u); break; } }
    }
    nloc = mine > 0u ? mine : 1u; nx = cnt > 0u ? cnt : 1u;
}
DI void xcd_barrier(const XcdBarrier& b) {
    asm volatile("s_waitcnt vmcnt(0)" ::: "memory");
    __syncthreads();
    if (threadIdx.x == 0) {
        unsigned* bar = b.bar;
        __builtin_amdgcn_s_waitcnt(0);
        unsigned nloc = b.st[0], nx = b.st[1];
        if (nloc == 0u) { xcd_barrier_complete(bar, b.x, nloc, nx); b.st[0] = nloc; b.st[1] = nx; }
        const unsigned old = xb_add(&bar[XB_XSUB(b.x)], 1u);
        const unsigned gen = old / nloc;
        if (old + 1u == (gen + 1u) * nloc) {
            __builtin_amdgcn_fence(__ATOMIC_RELEASE, "agent");
            asm volatile("s_waitcnt vmcnt(0)" ::: "memory");
            const unsigned og = xb_add(&bar[XB_TOP], 1u);
            const unsigned tg = og / nx;
            if (og + 1u == (tg + 1u) * nx) xb_add(&bar[XB_TOPGEN], 1u);
            else XB_SPIN(xb_ld(&bar[XB_TOPGEN]) == tg, bar);
            __builtin_amdgcn_fence(__ATOMIC_ACQUIRE, "agent");
            xb_add(&bar[XB_XGEN(b.x)], 1u);
            asm volatile("s_waitcnt vmcnt(0)" ::: "memory");
        } else {
            XB_SPIN(xb_ld(&bar[XB_XGEN(b.x)]) == gen, bar);
            __builtin_amdgcn_fence(__ATOMIC_ACQUIRE, "agent");
            asm volatile("s_waitcnt vmcnt(0)" ::: "memory");
        }
    }
    __syncthreads();
}

DI void probe_stamp(unsigned char* ws, int cls) {
    if (PROBE_A >= 0 && blockIdx.x == 0 && threadIdx.x == 0) {
        volatile float* tsf = (volatile float*)(ws + WS_TAB + 131072); volatile unsigned long long* tsl = (volatile unsigned long long*)(ws + WS_TAB + 131072 + 256);
        const unsigned long long now = __builtin_amdgcn_s_memrealtime(); tsf[cls] += (float)(now - tsl[0]); tsl[0] = now; }
}
template <unsigned PHM_>
__global__ void __launch_bounds__(512) fwd_megakernel(Params p) {
    extern __shared__ __attribute__((aligned(16))) unsigned char lds_raw[];
    XcdBarrier xbar; xbar.bar = (unsigned*)(p.ws + WS_CTL) + 1024; xbar.x = xb_xcc_id(); xbar.st = (volatile LAS unsigned*)((LAS unsigned char*)lds_raw + 147400);
    if (threadIdx.x == 0) { xbar.st[0] = 0u; xbar.st[1] = 0u; (void)xb_add(&xbar.bar[XB_XCNT(xbar.x)], 1u); }
    __syncthreads();
    for (int ph = p.ph_lo; ph < p.ph_hi; ++ph) {
        if (PROBE_A >= 0 && blockIdx.x == 0 && threadIdx.x == 0) {
            volatile float* tsf = (volatile float*)(p.ws + WS_TAB + 131072); volatile unsigned long long* tsl = (volatile unsigned long long*)(p.ws + WS_TAB + 131072 + 256);
            const unsigned long long now = __builtin_amdgcn_s_memrealtime();
            if (ph == 0) { for (int i = 0; i < 16; ++i) tsf[i] = 0.f; tsl[1] = now; }
            else { const int pp = ph - 1; const int cls = pp < 2 ? 8 : (((pp - 2) % 9) == 8 ? 5 : ((pp - 2) % 9)); const float dt = (float)(now - tsl[0]); tsf[cls] += dt; }
            tsl[0] = now;
            if (ph == NPHASE - 2 && PROBE_A < 20) { const float tot = (float)(now - tsl[1]); tsf[12] = rintf(tsf[(PROBE_A >= 0 && PROBE_A < 16) ? PROBE_A : 0] / tot * 40.f) / 40.f; tsf[13] = rintf(tsf[PROBE_B >= 0 ? PROBE_B : 0] / tot * 40.f) / 40.f; }
        }
        if (PROBE_A >= 0 && ph == 0 && threadIdx.x == 0) { volatile float* tsb = (volatile float*)(p.ws + WS_TAB + 196608) + blockIdx.x * 8; for (int i = 0; i < 8; ++i) tsb[i] = 0.f; }
        if (PROBE_A >= 20 && ph == NPHASE - 2 && blockIdx.x == 0 && threadIdx.x == 0) {
            volatile float* tsf = (volatile float*)(p.ws + WS_TAB + 131072); volatile unsigned long long* tsl = (volatile unsigned long long*)(p.ws + WS_TAB + 131072 + 256);
            const float* tsb = (const float*)(p.ws + WS_TAB + 196608); float sum = 0.f; for (int b2 = 0; b2 < (int)gridDim.x; ++b2) sum += __hip_atomic_load(tsb + b2 * 8 + (PROBE_A - 20), __ATOMIC_RELAXED, __HIP_MEMORY_SCOPE_AGENT); sum *= (PROBE_A == 20 ? 32.f : (PROBE_A == 21 ? 16.f : 1.f));
            const float tot = (float)(__builtin_amdgcn_s_memrealtime() - tsl[1]); tsf[12] = rintf(sum / (float)gridDim.x / tot * 40.f) / 40.f; tsf[13] = 0.f; }
        int tid_ = threadIdx.x; asm volatile("" : "+v"(tid_));
        unsigned char* ws_ = p.ws; asm volatile("" : "+s"(ws_));
        float* out_ = p.out; asm volatile("" : "+s"(out_));
        Ctx C; C.p = &p; C.lds = (LAS unsigned char*)lds_raw; C.L = (float*)lds_raw; C.tid = tid_; C.lane = C.tid & 63; C.wave = __builtin_amdgcn_readfirstlane(C.tid >> 6);
        C.G = gridDim.x; C.gw = blockIdx.x * 8 + C.wave; C.NGW = C.G * 8; C.ws = ws_; C.out = out_;
        unsigned* ctl = (unsigned*)(ws_ + WS_CTL);
        const float* modbuf = (const float*)(ws_ + WS_MOD);
        bf16_t* xm = (bf16_t*)(ws_ + WS_XM); bf16_t* ob = (bf16_t*)(ws_ + WS_O); bf16_t* act = (bf16_t*)(ws_ + WS_ACT);
        if (ph == 0) { if (PHON(0)) phase0a(C); }
        else if (ph == 1) { if (PHON(1)) row_pass(C, 0, nullptr, nullptr, modbuf, 1024, 0, true); }
        else {
            const int layer = (ph - 2) / 9, sub = (ph - 2) % 9;
            unsigned char* wb = ws_ + WS_W + (size_t)(layer & 1) * WBUF;
            const float* modl = modbuf + (size_t)layer * 3 * 6144;
            if (sub == 0) { if (PHON(2)) {
                pg8::Gemm g{xm, (const bf16_t*)(wb + W_IN), MROWS, 4096, DM}; pg8::StaticOrder S; S.init(MROWS, 4096, C.G, (int)blockIdx.x);
                EpiIn E{(bf16_t*)(ws_ + WS_Q), (bf16_t*)(ws_ + WS_K), (bf16_t*)(ws_ + WS_V), (bf16_t*)(ws_ + WS_ZB), out_ + OUT_K, out_ + OUT_V, (const f32x2*)(ws_ + WS_TAB), layer};
                pg8::gemm_phase(C.lds, g, S, E, C.tid); }
            } else if (sub == 1) {
                __syncthreads();
                if (PHON(4)) for (int u = blockIdx.x; u < 1024; u += C.G) delta_prep_unit(C, layer, u);
                __syncthreads();
                if (PHON(5)) for (int u = C.gw; u < 2048; u += C.NGW) hgrn_local_unit(C, layer, u);
                __syncthreads();
            } else if (sub == 2) {
                LAS int* slot = (LAS int*)(C.lds + 147392);
                for (;;) {
                    __syncthreads();
                    if (C.tid == 0) *slot = (int)atomicAdd(ctl + 64 * (layer + 1), 1u);
                    __syncthreads();
                    const int u = *slot;
                    if (u >= 1432 + 256) break;
                    if (u >= 1432) { if (layer + 1 < DEPTH) convert_layer_weights(C, layer + 1, (u - 1432) * 8 + C.wave, 2048, u - 1432, 256); continue; }
                    unsigned long long pt0_ = 0; if (PROBE_A >= 0 && C.tid == 0) pt0_ = __builtin_amdgcn_s_memrealtime();
                    if (u < 8) { if (PHON(6)) delta_scan_unit(C, layer, true, u >> 2, u & 3); }
                    else if (u < 24) { const int v = u - 8; if (PHON(7)) hgrn_scan_unit(C, layer, true, v >> 3, (v >> 1) & 3, v & 1); }
                    else if (u < 536) { if (PHON(8)) attn_unit(C, layer, u - 24); }
                    else if (u < 664) { const int v = u - 536; if (PHON(6)) delta_scan_unit(C, layer, false, v >> 2, v & 3); }
                    else if (u < 1176) { if (PHON(8)) attn_unit(C, layer, 512 + (u - 664)); }
                    else { const int v = u - 1176; if (PHON(7)) hgrn_scan_unit(C, layer, false, v >> 3, (v >> 1) & 3, v & 1); }
                    if (PROBE_A >= 0) { __syncthreads(); if (C.tid == 0) { const int ty = (u < 8) ? 0 : (u < 24 ? 1 : (u < 536 ? 2 : (u < 664 ? 3 : (u < 1176 ? 4 : 5))));
                        volatile float* tsb = (volatile float*)(ws_ + WS_TAB + 196608) + blockIdx.x * 8; tsb[ty] += (float)(__builtin_amdgcn_s_memrealtime() - pt0_); } }
                }
            } else if (sub == 3) {
                if (PHON(9)) for (int u = blockIdx.x; u < 256; u += C.G) hgrn_final_unit(C, layer, u);
                __syncthreads();
                if (PHON(10)) delta_combine(C, layer);
                __syncthreads();
            } else if (sub == 4) {
                pg8::Gemm g{ob, (const bf16_t*)(wb + W_OUT), MROWS, DM, DM}; pg8::StaticOrder S; S.init(MROWS, DM, C.G, (int)blockIdx.x);
                EpiRes E{out_, modl + 2048, xm};
                if (PHON(11)) pg8::gemm_phase(C.lds, g, S, E, C.tid);
            } else if (sub == 5) {
                if (PHON(12)) row_pass(C, 1, p.in[20] + (size_t)(layer * 2) * DM, p.in[21] + (size_t)(layer * 2) * DM, modl, 4096, 3072, true);
            } else if (sub == 6) {
                pg8::Gemm g{xm, (const bf16_t*)(wb + W_FFI), MROWS, 2 * DFF, DM}; pg8::StaticOrder S; S.init(MROWS, 2 * DFF, C.G, (int)blockIdx.x);
                EpiFfn E{act};
                if (PHON(13)) pg8::gemm_phase(C.lds, g, S, E, C.tid);
            } else if (sub == 7) {
                pg8::Gemm g{act, (const bf16_t*)(wb + W_FFO), MROWS, DM, DFF}; pg8::StaticOrder S; S.init(MROWS, DM, C.G, (int)blockIdx.x);
                EpiRes E{out_, modl + 5120, xm};
                if (PHON(14)) pg8::gemm_phase(C.lds, g, S, E, C.tid);
            } else {
                const bool last = layer + 1 == DEPTH;
                if (PHON(12)) row_pass(C, 1, p.in[20] + (size_t)(layer * 2 + 1) * DM, p.in[21] + (size_t)(layer * 2 + 1) * DM, modbuf + (size_t)(last ? layer : layer + 1) * 3 * 6144, 1024, 0, !last);
            }
        }
        if (ph + 1 < p.ph_hi) { if (p.ph_hi > 100000) { __threadfence(); cg::this_grid().sync(); } else xcd_barrier(xbar); }
    }
}

#if !MK_ONE_LAUNCH
static unsigned phase_mask(int ph) {
    if (ph == 0) return 1u << 0; if (ph == 1) return 1u << 1;
    const int sub = (ph - 2) % 9;
    switch (sub) { case 0: return 1u << 2; case 1: return (1u << 3) | (1u << 4) | (1u << 5); case 2: return (1u << 6) | (1u << 7) | (1u << 8); case 3: return (1u << 9) | (1u << 10);
        case 4: return 1u << 11; case 5: return 1u << 12; case 6: return 1u << 13; case 7: return 1u << 14; default: return 1u << 12; }
}
typedef void (*kern_t)(Params);
static kern_t kernel_for_mask(unsigned m) {
    switch (m) {
        case 1u << 0: return fwd_megakernel<1u << 0>; case 1u << 1: return fwd_megakernel<1u << 1>; case 1u << 2: return fwd_megakernel<1u << 2>;
        case (1u << 3) | (1u << 4) | (1u << 5): return fwd_megakernel<(1u << 3) | (1u << 4) | (1u << 5)>;
        case (1u << 6) | (1u << 7) | (1u << 8): return fwd_megakernel<(1u << 6) | (1u << 7) | (1u << 8)>;
        case (1u << 9) | (1u << 10): return fwd_megakernel<(1u << 9) | (1u << 10)>;
        case 1u << 11: return fwd_megakernel<1u << 11>; case 1u << 12: return fwd_megakernel<1u << 12>; case 1u << 13: return fwd_megakernel<1u << 13>; default: return fwd_megakernel<1u << 14>;
    }
}
#endif
extern "C" void kernel_launch(void* const* d_in, const int* in_sizes, int n_in, void* d_out, int out_size, void* d_ws, size_t ws_size, hipStream_t stream) {
    static int grid = 0;
    if (grid == 0) {
        if (n_in != 24 || out_size != 58720256 || ws_size < WS_END) { fprintf(stderr, "kernel_launch: unexpected shapes (n_in %d out %d ws %zu)\n", n_in, out_size, ws_size); grid = -1; return; }
        int dev = 0, cus = 0;
        (void)hipGetDevice(&dev); (void)hipDeviceGetAttribute(&cus, hipDeviceAttributeMultiprocessorCount, dev);
#if MK_ONE_LAUNCH
        if (hipFuncSetAttribute((const void*)fwd_megakernel<0x7FFFu>, hipFuncAttributeMaxDynamicSharedMemorySize, LDS_BYTES) != hipSuccess) { fprintf(stderr, "kernel_launch: hipFuncSetAttribute failed\n"); grid = -1; return; }
#else
        for (int ph = 0; ph < 11; ++ph) (void)hipFuncSetAttribute((const void*)kernel_for_mask(phase_mask(ph)), hipFuncAttributeMaxDynamicSharedMemorySize, LDS_BYTES);
#endif
        (void)hipGetLastError();
        grid = cus > 0 ? cus : 256;
        if (grid != 256) { fprintf(stderr, "kernel_launch: expected 256 CUs, got %d\n", grid); grid = 256; }
    }
    if (grid < 0) return;
    (void)hipMemsetAsync((char*)d_ws + WS_CTL, 0, 65536, stream);
    Params p{};
    for (int i = 0; i < 24; ++i) p.in[i] = (const float*)d_in[i];
    p.out = (float*)d_out; p.ws = (unsigned char*)d_ws;
#if MK_ONE_LAUNCH
    p.ph_lo = 0; p.ph_hi = NPHASE;
    void* args[] = {&p};
    hipError_t e = hipLaunchCooperativeKernel((const void*)fwd_megakernel<0x7FFFu>, dim3(grid), dim3(512), args, LDS_BYTES, stream);
    if (e != hipSuccess) fprintf(stderr, "cooperative launch failed: %s (grid %d)\n", hipGetErrorString(e), grid);
#else
    for (int ph = 0; ph < NPHASE; ++ph) { p.ph_lo = ph; p.ph_hi = ph + 1; hipLaunchKernelGGL(kernel_for_mask(phase_mask(ph)), dim3(grid), dim3(512), LDS_BYTES, stream, p); }
#endif
}
```

```cpp
#include <hip/hip_runtime.h>
#include <hip/hip_cooperative_groups.h>
#include <cstdio>
#include <cstdint>
namespace cg = cooperative_groups;

#define PHON(k) ((PHM_ >> (k)) & 1)
#ifndef PROBE_A
#define PROBE_A -1
#endif
#ifndef PROBE_B
#define PROBE_B -1
#endif
#ifndef MK_ONE_LAUNCH
#define MK_ONE_LAUNCH 1
#endif

#define DI __device__ __forceinline__
#define LAS __attribute__((address_space(3)))
typedef unsigned short bf16_t;
typedef short bf16x8 __attribute__((ext_vector_type(8)));
typedef short s16x4 __attribute__((ext_vector_type(4)));
typedef float f32x4 __attribute__((ext_vector_type(4)));
typedef float f32x16 __attribute__((ext_vector_type(16)));
typedef float f32x2 __attribute__((ext_vector_type(2)));
typedef unsigned u32x4 __attribute__((ext_vector_type(4)));
typedef unsigned u32x2 __attribute__((ext_vector_type(2)));

constexpr int MROWS = 16384, DM = 1024, DEPTH = 4, DFF = 2816, DIN = 3856, ZLD = 2320;
constexpr float ALPHA = 1.681792830507429f, LN_EPS = 1e-5f, RMS_EPS = 1e-6f;
constexpr float QSCALE = 0.125f * 1.4426950408889634f;
constexpr int ZB_BQ = 0, ZB_BK = 256, ZB_BV = 512, ZB_BG = 768, ZB_BBETA = 1024, ZB_BA = 1032, ZB_CQ = 1040, ZB_CF = 1296, ZB_CI = 1808, ZB_CG = 2064;
constexpr size_t OUT_K = 16777216, OUT_V = 33554432, OUT_SD = 50331648, OUT_SH = 54525952;
constexpr size_t MiB = 1u << 20;
constexpr size_t WS_CTL = 0, WS_MOD = 64 * 1024, WS_TAB = 512 * 1024, WS_CK = 1 * MiB, WS_CV = 3 * MiB, WS_W = 8 * MiB, WBUF = 27 * MiB;
constexpr size_t W_IN = 0, W_OUT = 8 * MiB, W_FFI = 10 * MiB, W_FFO = 21 * MiB;
constexpr size_t WS_XM = 62 * MiB, WS_O = 94 * MiB, WS_ZB = 126 * MiB, WS_Q = 199 * MiB, WS_K = 215 * MiB, WS_V = 231 * MiB;
constexpr size_t WS_ACT = 126 * MiB;
constexpr size_t WS_DPW = 247 * MiB, WS_DPQD = 263 * MiB, WS_DPQK = 279 * MiB, WS_DPKD = 295 * MiB;
constexpr size_t WS_DPU = WS_XM;
constexpr size_t WS_OD = 311 * MiB, WS_HS = 343 * MiB, WS_HD = 375 * MiB, WS_GL = 375 * MiB + 512 * 1024, WS_END = 376 * MiB;
constexpr int LDS_BYTES = 147456;
constexpr int NPHASE = 2 + 9 * DEPTH;

struct Params { const float* in[24]; float* out; unsigned char* ws; int ph_lo, ph_hi; };

DI unsigned cvt_pk_bf16(float lo, float hi) { unsigned r; asm("v_cvt_pk_bf16_f32 %0, %1, %2" : "=v"(r) : "v"(lo), "v"(hi)); return r; }
DI bf16_t f2bf(float f) { return (bf16_t)(cvt_pk_bf16(f, 0.f) & 0xffffu); }
DI float bf2f(bf16_t b) { return __uint_as_float(((unsigned)b) << 16); }
DI float sigmoidf_(float x) { return __builtin_amdgcn_rcpf(1.0f + __expf(-x)); }
DI float siluf_(float x) { return x * __builtin_amdgcn_rcpf(1.0f + __expf(-x)); }
DI float wave_sum(float v) {
#pragma unroll
    for (int o = 1; o < 64; o <<= 1) v += __shfl_xor(v, o);
    return v;
}
DI u32x2 pack4(f32x4 v) { u32x2 w; w.x = cvt_pk_bf16(v[0], v[1]); w.y = cvt_pk_bf16(v[2], v[3]); return w; }
DI bf16x8 pack8(f32x4 a, f32x4 b) { u32x4 w; w.x = cvt_pk_bf16(a[0], a[1]); w.y = cvt_pk_bf16(a[2], a[3]); w.z = cvt_pk_bf16(b[0], b[1]); w.w = cvt_pk_bf16(b[2], b[3]); return __builtin_bit_cast(bf16x8, w); }
DI int pinv(int k) { return (k >> 5) * 32 + ((k >> 2) & 3) * 8 + ((k >> 4) & 1) * 4 + (k & 3); }
DI int row_mod(int r) { return r < 8192 ? 0 : 1 + ((r - 8192) >> 12); }

namespace pg8 {
constexpr int BM = 256, BK = 64, HALF = 128, HTB = HALF * BK * 2, STAGE_BYTES = 8 * HTB, NXCD = 8, WGM = 8;
DI int lds_byte(int r, int c) { const int st = (r >> 4) * 2 + (c >> 5), rr = r & 15, cc = c & 31, ob = rr * 64 + cc * 2; return st * 1024 + (ob ^ (((ob >> 9) & 1) << 5)); }
DI void stage_rc(int b, int& R, int& C) { const int st = b / 1024, sb = b % 1024, swz = sb ^ (((sb >> 9) & 1) << 5); R = (st >> 1) * 16 + swz / 64; C = (st & 1) * 32 + (swz % 64) / 2; }
struct Unit { int pm, pn; };
struct Gemm { const bf16_t* A; const bf16_t* Bt; int M, N, K; };
struct StaticOrder {
    int nM, nN, nwg, G, c;
    DI void init(int M, int N, int G_, int c_) { nM = M / BM; nN = N / BM; nwg = nM * nN; G = G_; c = c_; }
    DI bool next(int i, Unit& u) const {
        const long L = (long)i * G + c; if (L >= nwg) return false;
        int wgid = (int)L; { const int q = nwg / NXCD, r = nwg % NXCD, xcd = wgid % NXCD, off = wgid / NXCD; wgid = (xcd < r ? xcd * (q + 1) : r * (q + 1) + (xcd - r) * q) + off; }
        const int nig = WGM * nN, gid = wgid / nig, fm = gid * WGM, gsz = (nM - fm) < WGM ? (nM - fm) : WGM;
        u.pm = fm + ((wgid % nig) % gsz); u.pn = (wgid % nig) / gsz; return true;
    }
};

template <class Epi>
DI void gemm_phase(LAS unsigned char* lds, const Gemm g, const StaticOrder& S, const Epi& E, int tid_in) {
    const int tid = tid_in, wid = __builtin_amdgcn_readfirstlane(tid >> 6), lane = tid & 63, wr = wid >> 2, wc = wid & 3, fr = lane & 15, fq = lane >> 4;
    const int K = g.K, nt = K / BK;
    unsigned voffA[2];
#pragma unroll
    for (int i = 0; i < 2; ++i) { int R, C; stage_rc(tid * 16 + i * 8192, R, C); voffA[i] = (unsigned)(R * K + C) * 2u; }
    const size_t kstep = (size_t)(BK * 2);
    const size_t hstep = (size_t)HALF * K * 2;
    const size_t tstep = 2 * hstep;
    const unsigned ldsw = (unsigned)wid * 1024u;
    const int aoff = lds_byte(wr * 64 + fr, fq * 8), boff = lds_byte(wc * 32 + fr, fq * 8);
#define PG8_SA(b, h) (((b) * 2 + (h)) * HTB)
#define PG8_SB(b, h) ((4 + (b) * 2 + (h)) * HTB)
#define PG8_STAGE(bufoff, gbase) do { _Pragma("unroll") for (int _i = 0; _i < 2; ++_i) \
        __builtin_amdgcn_global_load_lds((const unsigned*)((const char*)(gbase) + voffA[_i]), (LAS unsigned*)(lds + (bufoff) + ldsw + _i * 8192), 16, 0, 0); } while (0)
#define PG8_LDA(dst, b, h) do { _Pragma("unroll") for (int m = 0; m < 4; ++m) _Pragma("unroll") for (int k = 0; k < 2; ++k) dst[m][k] = *(const LAS bf16x8*)(lds + PG8_SA(b, h) + aoff + m * 2048 + k * 1024); } while (0)
#define PG8_LDB(dst, b, h) do { _Pragma("unroll") for (int n = 0; n < 2; ++n) _Pragma("unroll") for (int k = 0; k < 2; ++k) dst[n][k] = *(const LAS bf16x8*)(lds + PG8_SB(b, h) + boff + n * 2048 + k * 1024); } while (0)
#define PG8_MMA(ai, bj, At, Bt) do { __builtin_amdgcn_s_setprio(1); _Pragma("unroll") for (int m = 0; m < 4; ++m) _Pragma("unroll") for (int n = 0; n < 2; ++n) _Pragma("unroll") for (int k = 0; k < 2; ++k) \
        acc[ai][bj][m][n] = __builtin_amdgcn_mfma_f32_16x16x32_bf16(Bt[n][k], At[m][k], acc[ai][bj][m][n], 0, 0, 0); __builtin_amdgcn_s_setprio(0); } while (0)
#define PG8_WAIT_V(n) asm volatile("s_waitcnt vmcnt(" #n ")" ::: "memory")
#define PG8_WAIT_L(n) asm volatile("s_waitcnt lgkmcnt(" #n ")" ::: "memory")
#define PG8_BAR __builtin_amdgcn_s_barrier()
#define PG8_SCHED __builtin_amdgcn_sched_barrier(0)
    Unit cur, nxt; int ui = 0;
    if (!S.next(0, cur)) return;
    f32x4 acc[2][2][4][2];
#pragma unroll
    for (int a = 0; a < 2; ++a)
#pragma unroll
        for (int b = 0; b < 2; ++b)
#pragma unroll
            for (int m = 0; m < 4; ++m)
#pragma unroll
                for (int n = 0; n < 2; ++n) acc[a][b][m][n] = (f32x4){0.f, 0.f, 0.f, 0.f};
    bf16x8 At[4][2], B0[2][2], B1[2][2];
    const char* cA = (const char*)g.A + (size_t)cur.pm * tstep; const char* cB = (const char*)g.Bt + (size_t)cur.pn * tstep;
    PG8_STAGE(PG8_SB(0, 0), cB); PG8_STAGE(PG8_SB(0, 1), cB + hstep); PG8_STAGE(PG8_SA(0, 0), cA); PG8_STAGE(PG8_SA(0, 1), cA + hstep);
    if (wr == 1) PG8_BAR;
    PG8_WAIT_V(2); PG8_BAR;
    PG8_STAGE(PG8_SB(1, 0), cB + kstep); PG8_STAGE(PG8_SA(1, 0), cA + kstep); PG8_STAGE(PG8_SB(1, 1), cB + hstep + kstep);
    PG8_WAIT_V(6); PG8_BAR;
    for (;;) {
        const bool has_next = S.next(ui + 1, nxt);
        const char* nA = has_next ? (const char*)g.A + (size_t)nxt.pm * tstep : cA; const char* nB = has_next ? (const char*)g.Bt + (size_t)nxt.pn * tstep : cB;
        for (int t = 0; t < nt; t += 2) {
            const bool last = (t == nt - 2);
            const char* a1 = cA + (size_t)(t + 1) * kstep;
            const char* a2 = last ? nA : cA + (size_t)(t + 2) * kstep; const char* b2 = last ? nB : cB + (size_t)(t + 2) * kstep;
            const char* a3 = a2 + kstep; const char* b3 = b2 + kstep;
            PG8_LDB(B0, 0, 0); PG8_LDB(B1, 0, 1); PG8_SCHED; PG8_LDA(At, 0, 0); PG8_STAGE(PG8_SA(1, 1), a1 + hstep);
            PG8_WAIT_V(8); PG8_WAIT_L(0); PG8_BAR; PG8_MMA(0, 0, At, B0); PG8_MMA(0, 1, At, B1); PG8_BAR; PG8_SCHED;
            PG8_LDA(At, 0, 1); PG8_STAGE(PG8_SB(0, 0), b2); PG8_STAGE(PG8_SB(0, 1), b2 + hstep); PG8_STAGE(PG8_SA(0, 0), a2);
            PG8_WAIT_V(8); PG8_WAIT_L(0); PG8_BAR; PG8_MMA(1, 0, At, B0); PG8_MMA(1, 1, At, B1); PG8_BAR; PG8_SCHED;
            PG8_LDB(B0, 1, 0); PG8_LDB(B1, 1, 1); PG8_SCHED; PG8_LDA(At, 1, 0); PG8_STAGE(PG8_SA(0, 1), a2 + hstep);
            PG8_WAIT_V(8); PG8_WAIT_L(0); PG8_BAR; PG8_MMA(0, 0, At, B0); PG8_MMA(0, 1, At, B1); PG8_BAR; PG8_SCHED;
            PG8_LDA(At, 1, 1); PG8_STAGE(PG8_SB(1, 0), b3); PG8_STAGE(PG8_SB(1, 1), b3 + hstep); PG8_STAGE(PG8_SA(1, 0), a3);
            PG8_WAIT_V(8); PG8_WAIT_L(0); PG8_BAR; PG8_MMA(1, 0, At, B0); PG8_MMA(1, 1, At, B1); PG8_BAR; PG8_SCHED;
        }
        if (wr == 0) PG8_BAR;
        E(acc, cur, wr, wc, fr, fq);
        if (!has_next) break;
#pragma unroll
        for (int a = 0; a < 2; ++a)
#pragma unroll
            for (int b = 0; b < 2; ++b)
#pragma unroll
                for (int m = 0; m < 4; ++m)
#pragma unroll
                    for (int n = 0; n < 2; ++n) acc[a][b][m][n] = (f32x4){0.f, 0.f, 0.f, 0.f};
        cur = nxt; cA = nA; cB = nB; ++ui;
        if (wr == 1) PG8_BAR;
    }
    PG8_WAIT_V(0);
    PG8_BAR;
#undef PG8_SA
#undef PG8_SB
#undef PG8_STAGE
#undef PG8_LDA
#undef PG8_LDB
#undef PG8_MMA
#undef PG8_WAIT_V
#undef PG8_WAIT_L
#undef PG8_BAR
#undef PG8_SCHED
}
}

struct EpiIn {
    bf16_t *Qb, *Kb, *Vb, *zb; float *outK, *outV; const f32x2* rope; int layer;
    DI void operator()(const f32x4 (&acc)[2][2][4][2], const pg8::Unit& u, int wr, int wc, int fr, int fq) const {
        const int tile = u.pn; const bool sample = u.pm >= 32;
        if (tile < 6) {
            const int kind = tile >> 1; const int cb = (tile & 1) * 256 + wc * 32 + 4 * fq;
            bf16_t* dst = Qb + (size_t)kind * (16u * 1024u * 1024u / 2u);
            float* of = outK + (size_t)(kind >= 1 ? kind - 1 : 0) * 16777216u;
#pragma unroll
            for (int ai = 0; ai < 2; ++ai)
#pragma unroll
                for (int m = 0; m < 4; ++m) {
                    const int r = u.pm * 256 + ai * 128 + wr * 64 + m * 16 + fr;
#pragma unroll
                    for (int bj = 0; bj < 2; ++bj) {
                        f32x4 a = acc[ai][bj][m][0], b = acc[ai][bj][m][1]; const int cc = cb + bj * 128;
                        if (!sample && kind >= 1) { float* o = of + ((size_t)((r >> 8) * 4 + layer) * 256 + (r & 255)) * 512 + cc; *(f32x4*)o = a; *(f32x4*)(o + 16) = b; }
                        if (sample && kind < 2) {
                            const int t = (r - 8192) & 4095; const int pos = (wc & 1) ? (t & 63) : (t >> 6); const f32x2* rp = rope + pos * 16 + 4 * fq;
#pragma unroll
                            for (int j = 0; j < 4; ++j) { const f32x2 cs = rp[j]; const float x1 = a[j], x2 = b[j]; a[j] = x1 * cs.x - x2 * cs.y; b[j] = x2 * cs.x + x1 * cs.y; }
                        }
                        if (kind == 0) { a = a * QSCALE; b = b * QSCALE; }
                        if (kind == 2) {
                            const int hh = cc >> 7, dv0 = cc & 127, tt = sample ? ((r - 8192) & 4095) : (r & 255);
                            bf16_t* vt = sample ? Vb + 4194304 + ((size_t)((((r - 8192) >> 12) * 4 + hh) * 32 + (tt >> 7)) * 128 + dv0) * 128 + (tt & 127)
                                                : Vb + ((size_t)(((r >> 8) * 4 + hh) * 2 + (tt >> 7)) * 128 + dv0) * 128 + (tt & 127);
#pragma unroll
                            for (int j = 0; j < 4; ++j) { vt[(size_t)j * 128] = f2bf(a[j]); vt[(size_t)(16 + j) * 128] = f2bf(b[j]); }
                        } else { *(u32x2*)(dst + (size_t)r * 512 + cc) = pack4(a); *(u32x2*)(dst + (size_t)r * 512 + cc + 16) = pack4(b); }
                    }
                    asm volatile("" ::: "memory");
                }
        } else {
#pragma unroll
            for (int ai = 0; ai < 2; ++ai)
#pragma unroll
                for (int m = 0; m < 4; ++m) {
                    const int r = u.pm * 256 + ai * 128 + wr * 64 + m * 16 + fr;
#pragma unroll
                    for (int bj = 0; bj < 2; ++bj)
#pragma unroll
                        for (int n = 0; n < 2; ++n) { const int c = (tile - 6) * 256 + bj * 128 + wc * 32 + 16 * n + 4 * fq; if (c < ZLD) *(u32x2*)(zb + (size_t)r * ZLD + c) = pack4(acc[ai][bj][m][n]); }
                    asm volatile("" ::: "memory");
                }
        }
    }
};
struct EpiRes {
    float* x; const float* gate; bf16_t* vb;
    DI void operator()(const f32x4 (&acc)[2][2][4][2], const pg8::Unit& u, int wr, int wc, int fr, int fq) const {
        const float* gv = gate + row_mod(u.pm * 256) * 6144;
#pragma unroll
        for (int ai = 0; ai < 2; ++ai)
#pragma unroll
            for (int m = 0; m < 4; ++m) {
                const int r = u.pm * 256 + ai * 128 + wr * 64 + m * 16 + fr;
#pragma unroll
                for (int bj = 0; bj < 2; ++bj)
#pragma unroll
                    for (int n = 0; n < 2; ++n) { const int c = u.pn * 256 + bj * 128 + wc * 32 + 16 * n + 4 * fq; const f32x4 g4 = *(const f32x4*)(gv + c); const u32x2 xw = *(const u32x2*)((const bf16_t*)x + (size_t)r * DM + c); const f32x4 xv = (f32x4){__uint_as_float(xw.x << 16), __uint_as_float(xw.x & 0xffff0000u), __uint_as_float(xw.y << 16), __uint_as_float(xw.y & 0xffff0000u)}; *(u32x2*)(vb + (size_t)r * DM + c) = pack4(xv * ALPHA + g4 * acc[ai][bj][m][n]); }
            }
    }
};
struct EpiFfn {
    bf16_t* act;
    DI void operator()(const f32x4 (&acc)[2][2][4][2], const pg8::Unit& u, int wr, int wc, int fr, int fq) const {
#pragma unroll
        for (int ai = 0; ai < 2; ++ai)
#pragma unroll
            for (int m = 0; m < 4; ++m) {
                const int r = u.pm * 256 + ai * 128 + wr * 64 + m * 16 + fr;
#pragma unroll
                for (int n = 0; n < 2; ++n) { const f32x4 gt = acc[ai][0][m][n], up = acc[ai][1][m][n]; f32x4 o;
#pragma unroll
                    for (int j = 0; j < 4; ++j) o[j] = siluf_(gt[j]) * up[j];
                    *(u32x2*)(act + (size_t)r * DFF + u.pn * 128 + wc * 32 + 16 * n + 4 * fq) = pack4(o); }
            }
    }
};

struct Ctx {
    const Params* p; LAS unsigned char* lds; float* L; int tid, lane, wave, G, gw, NGW;
    unsigned char* ws; float* out;
};

DI void tr_item(const float* W, int K, int N, bf16_t* WT, int mode, float* scr, int item, int lane) {
    const int nblk = (N + 31) / 32, kb = item / nblk, nb = item % nblk, k0 = 64 * kb, n0 = 32 * nb;
    const int nn = n0 + (lane & 31);
#pragma unroll 8
    for (int i = 0; i < 32; ++i) { const int kk = 2 * i + (lane >> 5); scr[kk * 33 + (lane & 31)] = (nn < N) ? W[(size_t)(k0 + kk) * N + nn] : 0.f; }
    __builtin_amdgcn_wave_barrier();
    const int c = lane & 7;
#pragma unroll
    for (int j = 0; j < 4; ++j) {
        const int nl = (lane >> 3) + 8 * j, n = n0 + nl; const float* s = scr + (8 * c) * 33 + nl;
        if (n < N) {
            int dst = n; if (mode == 1) { if (n < DFF) dst = (n >> 7) * 256 + (n & 127); else { const int jj = n - DFF; dst = (jj >> 7) * 256 + 128 + (jj & 127); } }
            u32x4 o; o.x = cvt_pk_bf16(s[0 * 33], s[1 * 33]); o.y = cvt_pk_bf16(s[2 * 33], s[3 * 33]); o.z = cvt_pk_bf16(s[4 * 33], s[5 * 33]); o.w = cvt_pk_bf16(s[6 * 33], s[7 * 33]);
            *(u32x4*)(WT + (size_t)dst * K + k0 + 8 * c) = o;
        }
    }
    __builtin_amdgcn_wave_barrier();
}
DI void convert_layer_weights(const Ctx& C, int layer, int gw0 = -1, int ngw = 0, int blk = -1, int nblk = 0) {
    const Params& p = *C.p;
    unsigned char* wb = C.ws + WS_W + (size_t)(layer & 1) * WBUF;
    bf16_t* Win = (bf16_t*)(wb + W_IN); bf16_t* Wout = (bf16_t*)(wb + W_OUT); bf16_t* Wffi = (bf16_t*)(wb + W_FFI); bf16_t* Wffo = (bf16_t*)(wb + W_FFO);
    float* scr = C.L + C.wave * (64 * 33);
    constexpr int I_IN = 16 * 121, I_OUT = 16 * 32, I_FFI = 16 * 176, I_FFO = 44 * 32, NIT = I_IN + I_OUT + I_FFI + I_FFO;
    int lane_ = C.lane; asm volatile("" : "+v"(lane_));
    const int gwA = gw0 >= 0 ? gw0 : C.gw, ngwA = gw0 >= 0 ? ngw : C.NGW, blkA = blk >= 0 ? blk : (int)blockIdx.x, nblkA = blk >= 0 ? nblk : C.G;
    for (int it = gwA; it < NIT; it += ngwA) {
        int r = it;
        if (r < I_IN) { tr_item(p.in[10] + (size_t)layer * DM * DIN, DM, DIN, Win, 0, scr, r, lane_); continue; } r -= I_IN;
        if (r < I_OUT) { tr_item(p.in[19] + (size_t)layer * DM * DM, DM, DM, Wout, 0, scr, r, lane_); continue; } r -= I_OUT;
        if (r < I_FFI) { tr_item(p.in[22] + (size_t)layer * DM * 2 * DFF, DM, 2 * DFF, Wffi, 1, scr, r, lane_); continue; } r -= I_FFI;
        tr_item(p.in[23] + (size_t)layer * DFF * DM, DFF, DM, Wffo, 0, scr, r, lane_);
    }
    u32x4* z = (u32x4*)(Win + (size_t)DIN * DM); const int nz = 240 * DM * 2 / 16;
    for (int i = blkA * 512 + C.tid; i < nz; i += nblkA * 512) z[i] = (u32x4){0u, 0u, 0u, 0u};
}

DI void mod_unit(const Ctx& C, int u) {
    const Params& p = *C.p; const int tid = C.tid;
    float* cs = C.L; float* red = C.L + 3072;
    const int layer = u >> 6, col0 = (u & 63) * 96;
    __syncthreads();
    for (int i = tid; i < 3072; i += 512) { const int v = i >> 10, k = i & 1023; const float c = (v == 0) ? p.in[7][k] : p.in[6][(v - 1) * 1024 + k]; cs[i] = siluf_(c); }
    __syncthreads();
    if (tid < 504) {
        const int cgp = tid % 24, rs = tid / 24;
        f32x4 a0 = {0, 0, 0, 0}, a1 = a0, a2 = a0;
        const float* Wp = p.in[8] + (size_t)layer * DM * 6144 + col0 + cgp * 4;
#pragma unroll 7
        for (int k = rs; k < 1024; k += 21) { const f32x4 w = *(const f32x4*)(Wp + (size_t)k * 6144); a0 += w * cs[k]; a1 += w * cs[1024 + k]; a2 += w * cs[2048 + k]; }
        float* rr = red + rs * 288 + cgp * 4;
#pragma unroll
        for (int j = 0; j < 4; ++j) { rr[j] = a0[j]; rr[96 + j] = a1[j]; rr[192 + j] = a2[j]; }
    }
    __syncthreads();
    if (tid < 288) {
        const int v = tid / 96, cc = tid % 96; float s = 0.f;
        for (int rs = 0; rs < 21; ++rs) s += red[rs * 288 + tid];
        ((float*)(C.ws + WS_MOD))[(size_t)(layer * 3 + v) * 6144 + col0 + cc] = s + p.in[9][layer * 6144 + col0 + cc];
    }
}

DI void phase0a(const Ctx& C) {
    const Params& p = *C.p;
    for (int u = blockIdx.x; u < 256; u += C.G) mod_unit(C, u);
    __syncthreads();
    convert_layer_weights(C, 0);
    const int gt = blockIdx.x * 512 + C.tid, NT = C.G * 512;
    float* tab = (float*)(C.ws + WS_TAB);
    if (gt < 1024) { const int pos = gt >> 4, i = gt & 15; const float inv = __builtin_amdgcn_exp2f(-(float)i * (13.287712379549449f / 16.0f)); float rev = (float)pos * inv * 0.15915494309189535f; rev -= floorf(rev);
        tab[2 * gt] = __builtin_amdgcn_cosf(rev); tab[2 * gt + 1] = __builtin_amdgcn_sinf(rev); }
    if (gt >= 1024 && gt < 1028) { const int l = gt - 1024; const float* dl = p.in[17] + l * 256; float s01 = 0.f, s23 = 0.f; for (int i = 0; i < 64; ++i) { s01 += dl[i] * dl[64 + i]; s23 += dl[128 + i] * dl[192 + i]; }
        tab[2048 + l] = __expf(s01) - __expf(s23) + (0.8f - 0.6f * __expf(-0.3f * (float)l)); }
    if (gt >= 2048 && gt < 2560) { const int dir = (gt - 2048) >> 8, c = gt & 255; const float* lb = p.in[15] + dir * 1024 + c; float v[4], mx = -1e30f; for (int l = 0; l < 4; ++l) { v[l] = lb[l * 256]; mx = fmaxf(mx, v[l]); }
        float s = 0.f; for (int l = 0; l < 4; ++l) { v[l] = __expf(v[l] - mx); s += v[l]; } float cum = 0.f; for (int l = 0; l < 4; ++l) { if (l > 0) cum += v[l] / s; tab[4096 + (dir * 4 + l) * 256 + c] = cum; } }
    bf16_t* ck = (bf16_t*)(C.ws + WS_CK); bf16_t* cv = (bf16_t*)(C.ws + WS_CV);
    for (int i = gt; i < 2 * 4 * 256 * 512 / 4; i += NT) { const int e = i * 4; const int c = e & 511, j = (e >> 9) & 255, l = (e >> 17) & 3, b = e >> 19;
        const size_t dst = ((size_t)((l * 2 + b) * 256 + j)) * 512 + c;
        *(u32x2*)(ck + dst) = pack4(*(const f32x4*)(p.in[2] + e)); }
    for (int i = gt; i < 2 * 4 * 256 * 512; i += NT) { const int j = i & 255, dv = (i >> 8) & 127, hh = (i >> 15) & 3, b = (i >> 17) & 1, l = i >> 18;
        cv[((size_t)((((l * 2 + b) * 4 + hh) * 2 + (j >> 7)) * 128 + dv)) * 128 + (j & 127)] = f2bf(p.in[3][((size_t)((b * 4 + l) * 256 + j) * 4 + hh) * 128 + dv]); }
}

DI void row_pass(const Ctx& C, int mode, const float* lng, const float* lnb, const float* modl, int sc_off, int sh_off, bool write_xm) {
    const Params& p = *C.p; float* x = C.out; bf16_t* xm = (bf16_t*)(C.ws + WS_XM);
    for (int r0 = C.gw; r0 < MROWS; r0 += 2 * C.NGW) {
        f32x4 v[2][4];
#pragma unroll
        for (int u = 0; u < 2; ++u) { const int r = r0 + u * C.NGW;
            if (mode == 0) { const float* src = (r < 8192 ? p.in[0] + (size_t)r * DM : p.in[1] + (size_t)(r - 8192) * DM);
#pragma unroll
                for (int j = 0; j < 4; ++j) v[u][j] = *(const f32x4*)(src + 4 * C.lane + 256 * j); }
            else {
#pragma unroll
                for (int j = 0; j < 4; ++j) { const u32x2 w2 = *(const u32x2*)(xm + (size_t)r * DM + 4 * C.lane + 256 * j);
                    v[u][j] = (f32x4){__uint_as_float(w2.x << 16), __uint_as_float(w2.x & 0xffff0000u), __uint_as_float(w2.y << 16), __uint_as_float(w2.y & 0xffff0000u)}; } } }
#pragma unroll
        for (int u = 0; u < 2; ++u) { const int r = r0 + u * C.NGW;
            if (mode == 1) {
                float s = 0.f;
#pragma unroll
                for (int j = 0; j < 4; ++j) s += (v[u][j][0] + v[u][j][1]) + (v[u][j][2] + v[u][j][3]);
                const float mean = wave_sum(s) * (1.f / DM); float s2 = 0.f;
#pragma unroll
                for (int j = 0; j < 4; ++j) { v[u][j] = v[u][j] - mean; s2 += (v[u][j][0] * v[u][j][0] + v[u][j][1] * v[u][j][1]) + (v[u][j][2] * v[u][j][2] + v[u][j][3] * v[u][j][3]); }
                const float rstd = 1.0f / sqrtf(wave_sum(s2) * (1.f / DM) + LN_EPS);
#pragma unroll
                for (int j = 0; j < 4; ++j) { const f32x4 g4 = *(const f32x4*)(lng + 4 * C.lane + 256 * j), b4 = *(const f32x4*)(lnb + 4 * C.lane + 256 * j); v[u][j] = v[u][j] * rstd * g4 + b4; }
            }
            if (PROBE_A >= 0 && !write_xm) { const float* tsf = (const float*)(C.ws + WS_TAB + 131072); const float sc = 1.0f + ((r >= 8192) ? tsf[12] : (PROBE_B >= 0 ? tsf[13] : 0.f));
#pragma unroll
                for (int j = 0; j < 4; ++j) v[u][j] = v[u][j] * sc; }
            if (!write_xm) {
#pragma unroll
                for (int j = 0; j < 4; ++j) *(f32x4*)(x + (size_t)r * DM + 4 * C.lane + 256 * j) = v[u][j];
            } else {
#pragma unroll
                for (int j = 0; j < 4; ++j) *(u32x2*)((bf16_t*)x + (size_t)r * DM + 4 * C.lane + 256 * j) = pack4(v[u][j]);
            }
            if (write_xm) {
                const float* mv = modl + row_mod(r) * 6144;
#pragma unroll
                for (int j = 0; j < 4; ++j) { const int c = 4 * C.lane + 256 * j; const f32x4 sc = *(const f32x4*)(mv + sc_off + c), sh = *(const f32x4*)(mv + sh_off + c);
                    *(u32x2*)(xm + (size_t)r * DM + c) = pack4(v[u][j] * (sc + 1.0f) + sh); }
            }
        }
    }
}

#define MFMA32(a, b, c) __builtin_amdgcn_mfma_f32_32x32x16_bf16((a), (b), (c), 0, 0, 0)
#define MFMA16(a, b, c) __builtin_amdgcn_mfma_f32_16x16x32_bf16((a), (b), (c), 0, 0, 0)
constexpr int AK_LD = 72, AV_LD = 136;
struct AttnSrc { const bf16_t* Klat; const bf16_t* Kctx; const bf16_t* VTlat; const bf16_t* VTctx; int ldv; int nst; int nlat; int h; };
template <int PASS>
DI void attn_pass(int tid, int q, int hi, int kq, const AttnSrc& A, LAS bf16_t* K1s, LAS bf16_t* K2s, LAS bf16_t* VTs, const bf16x8 (&q1)[4], const bf16x8 (&q2)[4],
                  float& m1, float& l1, float& m2, float& l2, float iL1, float iL2, f32x16 (&o)[4]) {
    u32x4 kreg[4], vreg[4];
    const int h = A.h;
    auto issue = [&](int st) {
        const bf16_t* kb = (st < A.nlat) ? A.Klat + (size_t)st * 128 * 512 : A.Kctx + (size_t)(st - A.nlat) * 128 * 512;
#pragma unroll
        for (int i = 0; i < 2; ++i) { const int id = tid + 512 * i, key = id >> 3, ch = id & 7; kreg[i] = *(const u32x4*)(kb + (size_t)key * 512 + h * 128 + ch * 8); kreg[2 + i] = *(const u32x4*)(kb + (size_t)key * 512 + h * 128 + 64 + ch * 8); }
        if (PASS == 1) {
            const bf16_t* vb = (st < A.nlat) ? A.VTlat + (size_t)st * 128 : A.VTctx + (size_t)(st - A.nlat) * 128; const int ld = (st < A.nlat) ? A.ldv : 256;
#pragma unroll
            for (int i = 0; i < 4; ++i) { const int id = tid + 512 * i, dv = id >> 4, ch = id & 15; vreg[i] = *(const u32x4*)(vb + (size_t)dv * ld + ch * 8); }
        }
    };
    issue(0);
    for (int st = 0; st < A.nst; ++st) {
        __syncthreads();
#pragma unroll
        for (int i = 0; i < 2; ++i) { const int id = tid + 512 * i, key = id >> 3, ch = id & 7; *(LAS u32x4*)(K1s + key * AK_LD + ch * 8) = kreg[i]; *(LAS u32x4*)(K2s + key * AK_LD + ch * 8) = kreg[2 + i]; }
        if (PASS == 1) {
#pragma unroll
            for (int i = 0; i < 4; ++i) { const int id = tid + 512 * i, dv = id >> 4, ch = id & 15; *(LAS u32x4*)(VTs + dv * AV_LD + ch * 8) = vreg[i]; }
        }
        __syncthreads();
        if (st + 1 < A.nst) issue(st + 1);
        const int keyrow = kq * 32 + q;
        f32x16 s1, pr;
#pragma unroll
        for (int r = 0; r < 16; ++r) s1[r] = 0.f;
#pragma unroll
        for (int ks = 0; ks < 4; ++ks) { const bf16x8 a1 = *(const LAS bf16x8*)(K1s + keyrow * AK_LD + 16 * ks + 8 * hi); s1 = MFMA32(a1, q1[ks], s1); }
        if (PASS == 0) {
            float mx1 = s1[0];
#pragma unroll
            for (int r = 1; r < 16; ++r) mx1 = fmaxf(mx1, s1[r]);
            const float n1 = fmaxf(m1, mx1); float a1s = 0.f;
#pragma unroll
            for (int r = 0; r < 16; ++r) a1s += __builtin_amdgcn_exp2f(s1[r] - n1);
            l1 = l1 * __builtin_amdgcn_exp2f(m1 - n1) + a1s; m1 = n1;
        } else {
#pragma unroll
            for (int r = 0; r < 16; ++r) pr[r] = __builtin_amdgcn_exp2f(s1[r] - m1) * iL1;
        }
#pragma unroll
        for (int r = 0; r < 16; ++r) s1[r] = 0.f;
#pragma unroll
        for (int ks = 0; ks < 4; ++ks) { const bf16x8 a2 = *(const LAS bf16x8*)(K2s + keyrow * AK_LD + 16 * ks + 8 * hi); s1 = MFMA32(a2, q2[ks], s1); }
        if (PASS == 0) {
            float mx2 = s1[0];
#pragma unroll
            for (int r = 1; r < 16; ++r) mx2 = fmaxf(mx2, s1[r]);
            const float n2 = fmaxf(m2, mx2); float a2s = 0.f;
#pragma unroll
            for (int r = 0; r < 16; ++r) a2s += __builtin_amdgcn_exp2f(s1[r] - n2);
            l2 = l2 * __builtin_amdgcn_exp2f(m2 - n2) + a2s; m2 = n2;
        } else {
#pragma unroll
            for (int r = 0; r < 16; ++r) pr[r] -= __builtin_amdgcn_exp2f(s1[r] - m2) * iL2;
            bf16x8 pb[2];
            { u32x4 t0, t1; t0.x = cvt_pk_bf16(pr[0], pr[1]); t0.y = cvt_pk_bf16(pr[2], pr[3]); t0.z = cvt_pk_bf16(pr[4], pr[5]); t0.w = cvt_pk_bf16(pr[6], pr[7]);
              t1.x = cvt_pk_bf16(pr[8], pr[9]); t1.y = cvt_pk_bf16(pr[10], pr[11]); t1.z = cvt_pk_bf16(pr[12], pr[13]); t1.w = cvt_pk_bf16(pr[14], pr[15]);
              pb[0] = __builtin_bit_cast(bf16x8, t0); pb[1] = __builtin_bit_cast(bf16x8, t1); }
#pragma unroll
            for (int blk = 0; blk < 4; ++blk)
#pragma unroll
                for (int s = 0; s < 2; ++s) {
                    const LAS bf16_t* vp = VTs + (blk * 32 + q) * AV_LD + kq * 32 + 16 * s + 4 * hi;
                    const s16x4 lo = *(const LAS s16x4*)vp, hh = *(const LAS s16x4*)(vp + 8);
                    const bf16x8 av = __builtin_shufflevector(lo, hh, 0, 1, 2, 3, 4, 5, 6, 7);
                    o[blk] = MFMA32(av, pb[s], o[blk]);
                }
        }
    }
}
DI void attn_unit(const Ctx& C, int layer, int uidx) {
    int tid = C.tid; asm volatile("" : "+v"(tid)); const int lane = tid & 63, w = __builtin_amdgcn_readfirstlane(tid >> 6), qg = w & 3, kh = w >> 2, q = lane & 15, g = lane >> 4;
    const bf16_t* Qb = (const bf16_t*)(C.ws + WS_Q); const bf16_t* Kb = (const bf16_t*)(C.ws + WS_K); const bf16_t* VT = (const bf16_t*)(C.ws + WS_V);
    const bf16_t* cK = (const bf16_t*)(C.ws + WS_CK); const bf16_t* cVT = (const bf16_t*)(C.ws + WS_CV);
    int b, h, rowq0; AttnSrc A;
    if (uidx < 512) { b = uidx >> 8; h = (uidx >> 6) & 3; const int qb = uidx & 63; rowq0 = 8192 + b * 4096 + qb * 64; A.nst = 34; A.nlat = 32; A.ldv = 4096;
        A.Klat = Kb + (size_t)(8192 + b * 4096) * 512; A.VTlat = VT + 4194304 + (size_t)((b * 4 + h) * 32) * 16384; A.Kctx = cK + (size_t)((layer * 2 + b) * 256) * 512; A.VTctx = cVT + (size_t)(((layer * 2 + b) * 4 + h) * 2) * 16384; }
    else { const int v = uidx - 512; b = v >> 4; h = (v >> 2) & 3; const int qb = v & 3; rowq0 = b * 256 + qb * 64; A.nst = 2; A.nlat = 2; A.ldv = 256;
        A.Klat = Kb + (size_t)(b * 256) * 512; A.VTlat = VT + (size_t)((b * 4 + h) * 2) * 16384; A.Kctx = A.Klat; A.VTctx = A.VTlat; }
    A.h = h;
    LAS bf16_t* K1s = (LAS bf16_t*)C.lds; LAS bf16_t* K2s = K1s + 128 * AK_LD; LAS bf16_t* VTs = K2s + 128 * AK_LD;
    const float lam = ((const float*)(C.ws + WS_TAB))[2048 + layer];
    bf16x8 qf1[2], qf2[2];
    { const bf16_t* qp = Qb + (size_t)(rowq0 + 16 * qg + q) * 512 + h * 128 + 8 * g;
#pragma unroll
      for (int ks = 0; ks < 2; ++ks) { qf1[ks] = *(const bf16x8*)(qp + 32 * ks); qf2[ks] = *(const bf16x8*)(qp + 64 + 32 * ks); } }
    float m1 = -1e30f, l1 = 0.f, m2 = -1e30f, l2 = 0.f;
    f32x4 O1[8], O2[8];
#pragma unroll
    for (int t = 0; t < 8; ++t) { O1[t] = (f32x4){0.f, 0.f, 0.f, 0.f}; O2[t] = O1[t]; }
    u32x4 kreg[4], vreg[4];
    auto issue = [&](int st) {
        const bf16_t* kb = (st < A.nlat) ? A.Klat + (size_t)st * 128 * 512 : A.Kctx + (size_t)(st - A.nlat) * 128 * 512;
#pragma unroll
        for (int i = 0; i < 2; ++i) { const int id = tid + 512 * i, key = id >> 3, ch = id & 7; kreg[i] = *(const u32x4*)(kb + (size_t)key * 512 + h * 128 + ch * 8); kreg[2 + i] = *(const u32x4*)(kb + (size_t)key * 512 + h * 128 + 64 + ch * 8); }
        const bf16_t* vb = (st < A.nlat) ? A.VTlat + (size_t)st * 16384 : A.VTctx + (size_t)(st - A.nlat) * 16384;
#pragma unroll
        for (int i = 0; i < 4; ++i) { const int id = tid + 512 * i; vreg[i] = *(const u32x4*)(vb + (size_t)id * 8); }
    };
    issue(0);
    for (int st = 0; st < A.nst; ++st) {
        __syncthreads();
#pragma unroll
        for (int i = 0; i < 2; ++i) { const int id = tid + 512 * i, key = id >> 3, ch = id & 7; *(LAS u32x4*)(K1s + key * AK_LD + ch * 8) = kreg[i]; *(LAS u32x4*)(K2s + key * AK_LD + ch * 8) = kreg[2 + i]; }
#pragma unroll
        for (int i = 0; i < 4; ++i) { const int id = tid + 512 * i, dv = id >> 4, ch = id & 15; *(LAS u32x4*)(VTs + dv * AV_LD + ch * 8) = vreg[i]; }
        __syncthreads();
        if (st + 1 < A.nst) issue(st + 1);
#pragma unroll
        for (int kb = 0; kb < 2; ++kb) {
            const int key0 = kh * 64 + kb * 32;
            f32x4 sA0 = {0.f, 0.f, 0.f, 0.f}, sA1 = sA0, sB0 = sA0, sB1 = sA0;
#pragma unroll
            for (int ks = 0; ks < 2; ++ks) {
                const bf16x8 a10 = *(const LAS bf16x8*)(K1s + (key0 + q) * AK_LD + 32 * ks + 8 * g), a11 = *(const LAS bf16x8*)(K1s + (key0 + 16 + q) * AK_LD + 32 * ks + 8 * g);
                const bf16x8 a20 = *(const LAS bf16x8*)(K2s + (key0 + q) * AK_LD + 32 * ks + 8 * g), a21 = *(const LAS bf16x8*)(K2s + (key0 + 16 + q) * AK_LD + 32 * ks + 8 * g);
                sA0 = MFMA16(a10, qf1[ks], sA0); sA1 = MFMA16(a11, qf1[ks], sA1); sB0 = MFMA16(a20, qf2[ks], sB0); sB1 = MFMA16(a21, qf2[ks], sB1);
            }
            float t1 = fmaxf(fmaxf(fmaxf(sA0[0], sA0[1]), fmaxf(sA0[2], sA0[3])), fmaxf(fmaxf(sA1[0], sA1[1]), fmaxf(sA1[2], sA1[3])));
            float t2 = fmaxf(fmaxf(fmaxf(sB0[0], sB0[1]), fmaxf(sB0[2], sB0[3])), fmaxf(fmaxf(sB1[0], sB1[1]), fmaxf(sB1[2], sB1[3])));
            if (__any(t1 > m1 || t2 > m2)) {
                t1 = fmaxf(t1, __shfl_xor(t1, 16)); t1 = fmaxf(t1, __shfl_xor(t1, 32)); t2 = fmaxf(t2, __shfl_xor(t2, 16)); t2 = fmaxf(t2, __shfl_xor(t2, 32));
                const float n1 = fmaxf(m1, t1), n2 = fmaxf(m2, t2); const float f1 = __builtin_amdgcn_exp2f(m1 - n1), f2 = __builtin_amdgcn_exp2f(m2 - n2);
                l1 *= f1; l2 *= f2; m1 = n1; m2 = n2;
#pragma unroll
                for (int t = 0; t < 8; ++t) { O1[t] = O1[t] * f1; O2[t] = O2[t] * f2; }
            }
            f32x4 pA0, pA1, pB0, pB1;
#pragma unroll
            for (int i = 0; i < 4; ++i) { pA0[i] = __builtin_amdgcn_exp2f(sA0[i] - m1); pA1[i] = __builtin_amdgcn_exp2f(sA1[i] - m1); pB0[i] = __builtin_amdgcn_exp2f(sB0[i] - m2); pB1[i] = __builtin_amdgcn_exp2f(sB1[i] - m2); }
            l1 += (pA0[0] + pA0[1]) + (pA0[2] + pA0[3]) + (pA1[0] + pA1[1]) + (pA1[2] + pA1[3]);
            l2 += (pB0[0] + pB0[1]) + (pB0[2] + pB0[3]) + (pB1[0] + pB1[1]) + (pB1[2] + pB1[3]);
            const bf16x8 pb1 = pack8(pA0, pA1), pb2 = pack8(pB0, pB1);
#pragma unroll
            for (int t = 0; t < 8; ++t) {
                const LAS bf16_t* vp = VTs + (16 * t + q) * AV_LD + key0 + 4 * g;
                const s16x4 lo = *(const LAS s16x4*)vp, hh = *(const LAS s16x4*)(vp + 16);
                const bf16x8 av = __builtin_shufflevector(lo, hh, 0, 1, 2, 3, 4, 5, 6, 7);
                O1[t] = MFMA16(av, pb1, O1[t]); O2[t] = MFMA16(av, pb2, O2[t]);
            }
        }
    }
    l1 += __shfl_xor(l1, 16); l1 += __shfl_xor(l1, 32); l2 += __shfl_xor(l2, 16); l2 += __shfl_xor(l2, 32);
    __syncthreads();
    LAS float* comb = (LAS float*)C.lds;
    LAS float* exs = (LAS float*)(C.lds + 65536);
    if (kh == 1) {
#pragma unroll
        for (int t = 0; t < 8; ++t)
#pragma unroll
            for (int i = 0; i < 4; ++i) { comb[(qg * 64 + t * 4 + i) * 64 + lane] = O1[t][i]; comb[(qg * 64 + 32 + t * 4 + i) * 64 + lane] = O2[t][i]; }
        exs[(qg * 4 + 0) * 64 + lane] = m1; exs[(qg * 4 + 1) * 64 + lane] = l1; exs[(qg * 4 + 2) * 64 + lane] = m2; exs[(qg * 4 + 3) * 64 + lane] = l2;
    }
    __syncthreads();
    if (kh == 0) {
        const float om1 = exs[(qg * 4 + 0) * 64 + lane], ol1 = exs[(qg * 4 + 1) * 64 + lane], om2 = exs[(qg * 4 + 2) * 64 + lane], ol2 = exs[(qg * 4 + 3) * 64 + lane];
        const float n1 = fmaxf(m1, om1), n2 = fmaxf(m2, om2);
        const float fa1 = __builtin_amdgcn_exp2f(m1 - n1), fb1 = __builtin_amdgcn_exp2f(om1 - n1), fa2 = __builtin_amdgcn_exp2f(m2 - n2), fb2 = __builtin_amdgcn_exp2f(om2 - n2);
        const float L1 = l1 * fa1 + ol1 * fb1, L2 = l2 * fa2 + ol2 * fb2;
        const float c1a = fa1 / L1, c1b = fb1 / L1, c2a = lam * fa2 / L2, c2b = lam * fb2 / L2;
        float ss = 0.f;
#pragma unroll
        for (int t = 0; t < 8; ++t)
#pragma unroll
            for (int i = 0; i < 4; ++i) { const float v = O1[t][i] * c1a + comb[(qg * 64 + t * 4 + i) * 64 + lane] * c1b - O2[t][i] * c2a - comb[(qg * 64 + 32 + t * 4 + i) * 64 + lane] * c2b; O1[t][i] = v; ss += v * v; }
        ss += __shfl_xor(ss, 16); ss += __shfl_xor(ss, 32);
        const float lam_init = 0.8f - 0.6f * __expf(-0.3f * (float)layer);
        const float sc = (1.0f / sqrtf(ss * (1.0f / 128.0f) + RMS_EPS)) * (1.0f - lam_init);
        const float* dn = C.p->in[18] + layer * 128;
        bf16_t* ob = (bf16_t*)(C.ws + WS_O) + (size_t)(rowq0 + 16 * qg + q) * DM + h * 128;
#pragma unroll
        for (int t = 0; t < 8; ++t) { const int dv = 16 * t + 4 * g; const f32x4 d4 = *(const f32x4*)(dn + dv); *(u32x2*)(ob + dv) = pack4(O1[t] * sc * d4); }
    }
    __syncthreads();
}

DI void delta_prep_unit(const Ctx& C, int layer, int unit) {
    const Params& p = *C.p; int tid = C.tid; asm volatile("" : "+v"(tid)); const int lane = tid & 63, w = __builtin_amdgcn_readfirstlane(tid >> 6);
    const int tc = unit >> 2, h = unit & 3, row0 = tc * 64;
    int ci, nch; if (tc < 128) { ci = tc & 3; nch = 4; } else { ci = (tc - 128) & 63; nch = 64; }
    const bool has_prev = ci > 0, has_next = ci < nch - 1;
    float* qs = C.L; float* kk = C.L + 4160; float* vv = C.L + 8320; float* KK0 = C.L + 12480; float* QK0 = KK0 + 4096; float* Ms = QK0 + 4096; float* bc = Ms + 8192; float* be = bc + 128;
    const bf16_t* zb = (const bf16_t*)(C.ws + WS_ZB);
    const float* cw = p.in[11] + layer * 3 * 768;
    __syncthreads();
    if (tid < 384) {
        const int c = tid % 192, th = tid / 192, which = c >> 6, d = c & 63, col = which * 256 + h * 64 + d;
        const float w0 = cw[col], w1 = cw[768 + col], w2 = cw[1536 + col];
        float xin[34];
#pragma unroll
        for (int i = 0; i < 34; ++i) { const int tt = 32 * th - 1 + i; const bool ok = (tt >= 0 || has_prev) && (tt < 64 || has_next); xin[i] = ok ? bf2f(zb[(size_t)(row0 + tt) * ZLD + col]) : 0.f; }
        float* dstp = (which == 0 ? qs : (which == 1 ? kk : vv)) + d;
#pragma unroll
        for (int i = 0; i < 32; ++i) dstp[(32 * th + i) * 65] = siluf_(w0 * xin[i] + w1 * xin[i + 1] + w2 * xin[i + 2]);
    }
    __syncthreads();
    { const int r = tid >> 2, part = tid & 3; float* base = (r < 64 ? qs + r * 65 : kk + (r - 64) * 65) + part * 16; float ss = 0.f;
#pragma unroll
      for (int i = 0; i < 16; ++i) ss += base[i] * base[i];
      ss += __shfl_xor(ss, 1); ss += __shfl_xor(ss, 2);
      const float sc = (1.0f / sqrtf(ss + 1e-6f)) * (r < 64 ? 0.125f : 1.0f);
#pragma unroll
      for (int i = 0; i < 16; ++i) base[i] *= sc; }
    if (w < 2) {
        const int dir = w, i = lane, tt = dir ? 63 - i : i; const size_t row = (size_t)(row0 + tt);
        const float braw = bf2f(zb[row * ZLD + ZB_BBETA + dir * 4 + h]), araw = bf2f(zb[row * ZLD + ZB_BA + dir * 4 + h]);
        const float A = __expf(p.in[12][layer * 8 + dir * 4 + h]); const float x = araw + p.in[13][layer * 8 + dir * 4 + h];
        const float sp = x > 20.f ? x : log1pf(__expf(x)); float g = -A * sp;
#pragma unroll
        for (int off = 1; off < 64; off <<= 1) { const float t = __shfl_up(g, off); if (lane >= off) g += t; }
        bc[dir * 64 + i] = g; const float bt = sigmoidf_(braw); be[dir * 64 + i] = bt; be[128 + dir * 64 + i] = bt * __expf(g);
    }
    __syncthreads();
    {
        const int rbm = w & 3, cb0 = (w >> 2) * 2, r16 = lane & 15, g4 = lane >> 4;
        bf16x8 kA[2], qA[2], kB[2][2];
#pragma unroll
        for (int ks = 0; ks < 2; ++ks) {
            const float* kp = kk + (16 * rbm + r16) * 65 + 32 * ks + 8 * g4; const float* qp = qs + (16 * rbm + r16) * 65 + 32 * ks + 8 * g4;
            kA[ks] = pack8((f32x4){kp[0], kp[1], kp[2], kp[3]}, (f32x4){kp[4], kp[5], kp[6], kp[7]});
            qA[ks] = pack8((f32x4){qp[0], qp[1], qp[2], qp[3]}, (f32x4){qp[4], qp[5], qp[6], qp[7]});
#pragma unroll
            for (int c = 0; c < 2; ++c) { const float* bp = kk + (16 * (cb0 + c) + r16) * 65 + 32 * ks + 8 * g4;
                kB[c][ks] = pack8((f32x4){bp[0], bp[1], bp[2], bp[3]}, (f32x4){bp[4], bp[5], bp[6], bp[7]}); }
        }
#pragma unroll
        for (int c = 0; c < 2; ++c) {
            f32x4 ak = {0.f, 0.f, 0.f, 0.f}, aq = ak;
#pragma unroll
            for (int ks = 0; ks < 2; ++ks) { ak = MFMA16(kA[ks], kB[c][ks], ak); aq = MFMA16(qA[ks], kB[c][ks], aq); }
#pragma unroll
            for (int i = 0; i < 4; ++i) { const int o = (16 * rbm + 4 * g4 + i) * 64 + 16 * (cb0 + c) + r16; KK0[o] = ak[i]; QK0[o] = aq[i]; }
        }
    }
    __syncthreads();
    bf16_t* dpW = (bf16_t*)(C.ws + WS_DPW); bf16_t* dpQD = (bf16_t*)(C.ws + WS_DPQD); bf16_t* dpQK = (bf16_t*)(C.ws + WS_DPQK); bf16_t* dpKD = (bf16_t*)(C.ws + WS_DPKD); bf16_t* dpU = (bf16_t*)(C.ws + WS_DPU);
    float* dpGL = (float*)(C.ws + WS_GL);
    { const int i = tid >> 3, j0 = (tid & 7) * 8;
#pragma unroll
      for (int dir = 0; dir < 2; ++dir) {
          const size_t ud = ((size_t)tc * 4 + h) * 2 + dir;
          const float bi = bc[dir * 64 + i], betai = be[dir * 64 + i]; const int ai = dir ? 63 - i : i;
#pragma unroll
          for (int jj = 0; jj < 8; ++jj) { const int j = j0 + jj, aj = dir ? 63 - j : j;
              const float dec = (j <= i) ? __expf(bi - bc[dir * 64 + j]) : 0.f;
              Ms[dir * 4096 + j * 64 + i] = (j < i) ? betai * KK0[ai * 64 + aj] * dec : 0.f;
              dpQK[ud * 4096 + i * 64 + pinv(j)] = f2bf(QK0[ai * 64 + aj] * dec); }
      } }
    __syncthreads();
    if (w < 4) {
        const int dir = w >> 1, c = (w & 1) * 64 + lane; const size_t ud = ((size_t)tc * 4 + h) * 2 + dir;
        const float* Msd = Ms + dir * 4096; const bool isU = (w & 1) == 0; const float* scp = be + (isU ? 0 : 128) + dir * 64; const float* srcp = (isU ? vv : kk) + lane;
        float x[64];
#pragma unroll
        for (int rb = 0; rb < 4; ++rb) {
            float r[16];
#pragma unroll
            for (int ii = 0; ii < 16; ++ii) { const int i = 16 * rb + ii, tt = dir ? 63 - i : i; r[ii] = scp[i] * srcp[tt * 65]; }
            asm volatile("" ::: "memory");
#pragma unroll
            for (int j = 0; j < 16 * rb; ++j) {
                const float* mp = Msd + j * 64 + 16 * rb;
                const f32x4 ma = *(const f32x4*)mp, mb = *(const f32x4*)(mp + 4), mc = *(const f32x4*)(mp + 8), md = *(const f32x4*)(mp + 12);
                const float xj = x[j];
#pragma unroll
                for (int c4 = 0; c4 < 4; ++c4) { r[c4] -= ma[c4] * xj; r[4 + c4] -= mb[c4] * xj; r[8 + c4] -= mc[c4] * xj; r[12 + c4] -= md[c4] * xj; }
                if ((j & 3) == 3) asm volatile("" ::: "memory");
            }
#pragma unroll
            for (int jj = 0; jj < 16; ++jj) {
                const float xj = r[jj]; x[16 * rb + jj] = xj;
                const float* mp = Msd + (16 * rb + jj) * 64 + 16 * rb;
#pragma unroll
                for (int ii = jj + 1; ii < 16; ++ii) r[ii] -= mp[ii] * xj;
                if ((jj & 3) == 3) asm volatile("" ::: "memory");
            }
        }
        if (c < 64) {
            bf16_t* up = dpU + ud * 4096 + c * 64;
#pragma unroll
            for (int i = 0; i < 64; i += 8) { u32x4 o; o.x = cvt_pk_bf16(x[i], x[i + 1]); o.y = cvt_pk_bf16(x[i + 2], x[i + 3]); o.z = cvt_pk_bf16(x[i + 4], x[i + 5]); o.w = cvt_pk_bf16(x[i + 6], x[i + 7]); *(u32x4*)(up + i) = o; }
        } else {
            bf16_t* wp = dpW + ud * 4096 + pinv(c - 64);
#pragma unroll
            for (int i = 0; i < 64; ++i) wp[i * 64] = f2bf(x[i]);
        }
    } else {
#pragma unroll 4
        for (int it = 0; it < 64; ++it) {
            const int e = (tid - 256) + 256 * it, dir = e >> 13, which = (e >> 12) & 1, rem = e & 4095; const size_t ud = ((size_t)tc * 4 + h) * 2 + dir;
            if (which == 0) { const int i = rem >> 6, d = rem & 63, tt = dir ? 63 - i : i; dpQD[ud * 4096 + i * 64 + pinv(d)] = f2bf(qs[tt * 65 + d] * __expf(bc[dir * 64 + i])); }
            else { const int dk = rem >> 6, i = rem & 63, tt = dir ? 63 - i : i; dpKD[ud * 4096 + dk * 64 + pinv(i)] = f2bf(kk[tt * 65 + dk] * __expf(bc[dir * 64 + 63] - bc[dir * 64 + i])); }
        }
        if (tid == 256 || tid == 257) { const int dir = tid - 256; dpGL[((size_t)tc * 4 + h) * 2 + dir] = __expf(bc[dir * 64 + 63]); }
    }
}

DI void delta_scan_unit(const Ctx& C, int layer, bool sample, int b, int h) {
    const Params& p = *C.p; int tid = C.tid; asm volatile("" : "+v"(tid)); const int lane = tid & 63; const int w = C.wave, dir = w >> 2, sl = w & 3, col = lane & 15, g = lane >> 4;
    const int tc0 = sample ? 128 + b * 64 : b * 4, nch = sample ? 64 : 4;
    const bf16_t* dpU = (const bf16_t*)(C.ws + WS_DPU);
    const float* dpGL = (const float*)(C.ws + WS_GL); float* od = (float*)(C.ws + WS_OD) + (size_t)dir * MROWS * 256;
    f32x4 S[4];
    if (sample) { const float* s0 = p.in[4] + ((((size_t)b * 4 + layer) * 2 + dir) * 4 + h) * 4096;
#pragma unroll
        for (int rb = 0; rb < 4; ++rb)
#pragma unroll
            for (int ii = 0; ii < 4; ++ii) S[rb][ii] = s0[(16 * rb + 4 * g + ii) * 64 + 16 * sl + col]; }
    else {
#pragma unroll
        for (int rb = 0; rb < 4; ++rb) S[rb] = (f32x4){0.f, 0.f, 0.f, 0.f}; }
    u32x4 Ra[8], Rb[8];
#define DS_TC(d_, n_) ((d_) ? tc0 + nch - 1 - (n_) : tc0 + (n_))
#define DS_ISSUE(R, n_) do { _Pragma("unroll") for (int i = 0; i < 8; ++i) { const int id = tid + 512 * i, dm = id >> 9, dd = dm >> 2, mat = dm & 3; \
        const size_t ud_ = ((size_t)DS_TC(dd, n_) * 4 + h) * 2 + dd; R[i] = *(const u32x4*)(C.ws + WS_DPW + (size_t)mat * (16u * MiB) + ud_ * 8192 + (size_t)(id & 511) * 16); } } while (0)
#define DS_WRITE(R, buf_) do { _Pragma("unroll") for (int i = 0; i < 8; ++i) { const int id = tid + 512 * i, dm = id >> 9, row = (id >> 3) & 63, c = id & 7; \
        *(LAS u32x4*)(C.lds + (buf_) * 65536 + dm * 8192 + row * 128 + ((c ^ (row & 7)) * 16)) = R[i]; } } while (0)
#define DS_FRAG(buf_, mat_, rb_, ks_) (*(const LAS bf16x8*)(C.lds + (buf_) * 65536 + (dir * 4 + (mat_)) * 8192 + (16 * (rb_) + col) * 128 + ((((ks_) * 4 + g) ^ (col & 7)) * 16)))
    __syncthreads();
    DS_ISSUE(Ra, 0); DS_WRITE(Ra, 0); DS_ISSUE(Ra, 1);
    s16x4 uuA[4], uuB[4]; float glA, glB;
#define DS_LOADU(uu, gl, n_) do { const size_t ud_ = ((size_t)DS_TC(dir, n_) * 4 + h) * 2 + dir; _Pragma("unroll") for (int rb = 0; rb < 4; ++rb) uu[rb] = *(const s16x4*)(dpU + ud_ * 4096 + (16 * sl + col) * 64 + 16 * rb + 4 * g); gl = dpGL[ud_]; } while (0)
    DS_LOADU(uuA, glA, 0); DS_LOADU(uuB, glB, 1);
    __syncthreads();
#define DS_STEP(n, buf, Rnext, Rcur, uu, gl) do { \
        if ((n) + 2 < nch) DS_ISSUE(Rnext, (n) + 2); \
        const int tc = DS_TC(dir, (n)); \
        bf16x8 Sb[2]; Sb[0] = pack8(S[0], S[1]); Sb[1] = pack8(S[2], S[3]); \
        f32x4 vn[4]; \
        _Pragma("unroll") for (int rb = 0; rb < 4; ++rb) { f32x4 t = (f32x4){0.f, 0.f, 0.f, 0.f}; t = MFMA16(DS_FRAG(buf, 0, rb, 0), Sb[0], t); t = MFMA16(DS_FRAG(buf, 0, rb, 1), Sb[1], t); \
            _Pragma("unroll") for (int ii = 0; ii < 4; ++ii) vn[rb][ii] = bf2f((bf16_t)uu[rb][ii]) - t[ii]; } \
        const float glc = gl; \
        if ((n) + 2 < nch) DS_LOADU(uu, gl, (n) + 2); \
        bf16x8 vb[2]; vb[0] = pack8(vn[0], vn[1]); vb[1] = pack8(vn[2], vn[3]); \
        const int rowb = tc * 64; \
        _Pragma("unroll") for (int rb = 0; rb < 4; ++rb) { f32x4 o = (f32x4){0.f, 0.f, 0.f, 0.f}; o = MFMA16(DS_FRAG(buf, 1, rb, 0), Sb[0], o); o = MFMA16(DS_FRAG(buf, 1, rb, 1), Sb[1], o); o = MFMA16(DS_FRAG(buf, 2, rb, 0), vb[0], o); o = MFMA16(DS_FRAG(buf, 2, rb, 1), vb[1], o); \
            _Pragma("unroll") for (int ii = 0; ii < 4; ++ii) { const int i = 16 * rb + 4 * g + ii; const int tt = dir ? 63 - i : i; od[(size_t)(rowb + tt) * 256 + h * 64 + 16 * sl + col] = o[ii]; } } \
        _Pragma("unroll") for (int rb = 0; rb < 4; ++rb) { f32x4 sn = S[rb] * glc; sn = MFMA16(DS_FRAG(buf, 3, rb, 0), vb[0], sn); sn = MFMA16(DS_FRAG(buf, 3, rb, 1), vb[1], sn); S[rb] = sn; } \
        if ((n) + 1 < nch) DS_WRITE(Rcur, (buf) ^ 1); \
        __syncthreads(); } while (0)
    for (int n = 0; n < nch; n += 2) {
        DS_STEP(n, 0, Rb, Ra, uuA, glA);
        DS_STEP(n + 1, 1, Ra, Rb, uuB, glB);
    }
#undef DS_STEP
#undef DS_TC
#undef DS_ISSUE
#undef DS_WRITE
#undef DS_FRAG
#undef DS_LOADU
    if (!sample) { float* so = C.out + OUT_SD + ((((size_t)b * 4 + layer) * 2 + dir) * 4 + h) * 4096;
#pragma unroll
        for (int rb = 0; rb < 4; ++rb)
#pragma unroll
            for (int ii = 0; ii < 4; ++ii) so[(16 * rb + 4 * g + ii) * 64 + 16 * sl + col] = S[rb][ii]; }
}

DI float hgrn_forget(const bf16_t* zb, size_t row, int dir, int h, int d, float lb) { const float x = bf2f(zb[row * ZLD + ZB_CF + dir * 256 + h * 64 + d]); return lb + (1.0f - lb) * sigmoidf_(x); }
DI void hgrn_local_unit(const Ctx& C, int layer, int unit) {
    int lane = C.lane; asm volatile("" : "+v"(lane)); const int dir = unit & 1, h = (unit >> 1) & 3, tc = unit >> 3, row0 = tc * 64, ep = lane & 31, dh = lane >> 5;
    const bf16_t* zb = (const bf16_t*)(C.ws + WS_ZB);
    float* fs = C.L + C.wave * 2048; float* qs2 = fs + 1024;
    bf16_t* oloc = (bf16_t*)(C.ws + WS_XM + 16 * MiB) + (size_t)dir * MROWS * 256;
    bf16_t* qdb = (bf16_t*)((unsigned char*)C.out + 32 * MiB) + (size_t)dir * MROWS * 256;
    const float lb = ((const float*)(C.ws + WS_TAB))[4096 + (dir * 4 + layer) * 256 + h * 64 + lane];
    f32x2 S[32];
#pragma unroll
    for (int k = 0; k < 32; ++k) S[k] = (f32x2){0.f, 0.f};
    float Dl = 1.0f;
    for (int sb = 0; sb < 4; ++sb) {
        f32x2 vr[16];
#pragma unroll
        for (int i = 0; i < 16; ++i) { const int ti = sb * 16 + i, tt = dir ? 63 - ti : ti; const size_t row = (size_t)(row0 + tt);
            const float f = hgrn_forget(zb, row, dir, h, lane, lb); const float qv = siluf_(bf2f(zb[row * ZLD + ZB_CQ + h * 64 + lane]));
            fs[i * 64 + lane] = f; qs2[i * 64 + lane] = qv; Dl *= f; qdb[row * 256 + h * 64 + lane] = f2bf(qv * Dl);
            const unsigned rv = *(const unsigned*)(zb + row * ZLD + ZB_CI + h * 64 + 2 * ep); vr[i] = (f32x2){__uint_as_float(rv << 16), __uint_as_float(rv & 0xffff0000u)}; }
        __builtin_amdgcn_wave_barrier();
#pragma unroll
        for (int i = 0; i < 16; ++i) { const f32x2 v = vr[i]; f32x2 osa = {0.f, 0.f}, osb = {0.f, 0.f};
#pragma unroll
            for (int k = 0; k < 32; k += 4) { const f32x4 f4 = *(const f32x4*)(fs + i * 64 + 32 * dh + k), q4 = *(const f32x4*)(qs2 + i * 64 + 32 * dh + k);
#pragma unroll
                for (int c = 0; c < 4; ++c) { S[k + c] = (S[k + c] - v) * f4[c] + v; if (c & 1) osb += S[k + c] * q4[c]; else osa += S[k + c] * q4[c]; }
                if ((k & 15) == 12) asm volatile("" ::: "memory"); }
            f32x2 os = osa + osb;
            os.x += __shfl_xor(os.x, 32); os.y += __shfl_xor(os.y, 32);
            const int ti = sb * 16 + i, tt = dir ? 63 - ti : ti;
            if (dh == 0) *(unsigned*)(oloc + (size_t)(row0 + tt) * 256 + h * 64 + 2 * ep) = cvt_pk_bf16(os.x, os.y);
            asm volatile("" ::: "memory"); }
        __builtin_amdgcn_wave_barrier();
    }
    float* hs = (float*)(C.ws + WS_HS) + (size_t)unit * 4096;
#pragma unroll
    for (int k = 0; k < 32; ++k) *(f32x2*)(hs + (32 * dh + k) * 64 + 2 * ep) = S[k];
    ((float*)(C.ws + WS_HD))[(size_t)unit * 64 + lane] = Dl;
}
DI void hgrn_scan_unit(const Ctx& C, int layer, bool sample, int b, int h, int dir) {
    const Params& p = *C.p; int tid = C.tid; asm volatile("" : "+v"(tid)); const int tc0 = sample ? 128 + b * 64 : b * 4, nch = sample ? 64 : 4;
    float* HS = (float*)(C.ws + WS_HS); const float* HD = (const float*)(C.ws + WS_HD);
    f32x4 S0, S1;
    if (sample) { const float* s0 = p.in[5] + ((((size_t)b * 4 + layer) * 2 + dir) * 4 + h) * 4096 + tid * 8; S0 = *(const f32x4*)s0; S1 = *(const f32x4*)(s0 + 4); }
    else { float z_ = 0.f; asm volatile("" : "+v"(z_)); S0 = (f32x4){z_, z_, z_, z_}; S1 = S0; }
    for (int n0 = 0; n0 < nch; n0 += 4) {
        f32x4 la[4], lb[4]; float Dd[4];
#pragma unroll
        for (int k = 0; k < 4; ++k) { const int tc = dir ? tc0 + nch - 1 - (n0 + k) : tc0 + n0 + k; const size_t uh = ((size_t)tc * 4 + h) * 2 + dir;
            const float* hp = HS + uh * 4096 + tid * 8; la[k] = *(const f32x4*)hp; lb[k] = *(const f32x4*)(hp + 4); Dd[k] = HD[uh * 64 + (tid >> 3)]; }
#pragma unroll
        for (int k = 0; k < 4; ++k) { const int tc = dir ? tc0 + nch - 1 - (n0 + k) : tc0 + n0 + k; const size_t uh = ((size_t)tc * 4 + h) * 2 + dir;
            float* hp = HS + uh * 4096 + tid * 8; *(f32x4*)hp = S0; *(f32x4*)(hp + 4) = S1; S0 = S0 * Dd[k] + la[k]; S1 = S1 * Dd[k] + lb[k]; }
    }
    if (!sample) { float* so = C.out + OUT_SH + ((((size_t)b * 4 + layer) * 2 + dir) * 4 + h) * 4096 + tid * 8; *(f32x4*)so = S0; *(f32x4*)(so + 4) = S1; }
}
DI void hgrn_final_unit(const Ctx& C, int layer, int tc) {
    const Params& p = *C.p; int lane = C.lane; asm volatile("" : "+v"(lane)); const int w = C.wave, h = w >> 1, chh = w & 1, r16 = lane & 15, g4 = lane >> 4, row0 = tc * 64;
    const bf16_t* zb = (const bf16_t*)(C.ws + WS_ZB); const float* HS = (const float*)(C.ws + WS_HS);
    const bf16_t* oloc = (const bf16_t*)(C.ws + WS_XM + 16 * MiB); const bf16_t* qdb = (const bf16_t*)((const unsigned char*)C.out + 32 * MiB);
    float* otile = C.L;
    __syncthreads();
    f32x4 acc[4][2];
#pragma unroll
    for (int rb = 0; rb < 4; ++rb) { acc[rb][0] = (f32x4){0.f, 0.f, 0.f, 0.f}; acc[rb][1] = acc[rb][0]; }
#pragma unroll
    for (int dir = 0; dir < 2; ++dir) {
        const size_t uh = ((size_t)tc * 4 + h) * 2 + dir;
        bf16x8 Bf[2][2];
#pragma unroll
        for (int cb = 0; cb < 2; ++cb)
#pragma unroll
            for (int ks = 0; ks < 2; ++ks) { const float* sp = HS + uh * 4096 + (size_t)(32 * ks + 8 * g4) * 64 + 32 * chh + 16 * cb + r16;
                Bf[cb][ks] = pack8((f32x4){sp[0], sp[64], sp[128], sp[192]}, (f32x4){sp[256], sp[320], sp[384], sp[448]}); }
#pragma unroll
        for (int rb = 0; rb < 4; ++rb)
#pragma unroll
            for (int ks = 0; ks < 2; ++ks) { const bf16x8 Af = *(const bf16x8*)(qdb + (size_t)dir * MROWS * 256 + (size_t)(row0 + 16 * rb + r16) * 256 + h * 64 + 32 * ks + 8 * g4);
                acc[rb][0] = MFMA16(Af, Bf[0][ks], acc[rb][0]); acc[rb][1] = MFMA16(Af, Bf[1][ks], acc[rb][1]); }
    }
#pragma unroll
    for (int rb = 0; rb < 4; ++rb)
#pragma unroll
        for (int cb = 0; cb < 2; ++cb)
#pragma unroll
            for (int i = 0; i < 4; ++i) { const int t = 16 * rb + 4 * g4 + i, e = 32 * chh + 16 * cb + r16; const size_t ix = (size_t)(row0 + t) * 256 + h * 64 + e;
                otile[(h * 64 + t) * 64 + e] = acc[rb][cb][i] + bf2f(oloc[ix]) + bf2f(oloc[(size_t)MROWS * 256 + ix]); }
    __syncthreads();
    bf16_t* ob = (bf16_t*)(C.ws + WS_O);
    const float ng = p.in[16][layer * 64 + lane];
    bf16_t gts[32];
#pragma unroll
    for (int rr = 0; rr < 32; ++rr) { const int idx = w * 32 + rr, hh = idx >> 6, tt = idx & 63; gts[rr] = zb[(size_t)(row0 + tt) * ZLD + ZB_CG + hh * 64 + lane]; }
#pragma unroll
    for (int rr = 0; rr < 32; ++rr) { const int idx = w * 32 + rr, hh = idx >> 6, tt = idx & 63; const size_t row = (size_t)(row0 + tt);
        const float v = otile[(hh * 64 + tt) * 64 + lane]; const float ss = wave_sum(v * v);
        const float gt = siluf_(bf2f(gts[rr]));
        ob[row * DM + 768 + hh * 64 + lane] = f2bf(v * (1.0f / sqrtf(ss * (1.0f / 64.0f) + RMS_EPS)) * ng * gt); }
}
DI void delta_combine(const Ctx& C, int layer) {
    const Params& p = *C.p; const bf16_t* zb = (const bf16_t*)(C.ws + WS_ZB); const float* od = (const float*)(C.ws + WS_OD); bf16_t* ob = (bf16_t*)(C.ws + WS_O);
    const float ng = p.in[14][layer * 64 + C.lane];
    for (int it0 = C.gw * 4; it0 < MROWS * 4; it0 += C.NGW * 4) {
        float v[4]; bf16_t gr[4];
#pragma unroll
        for (int k = 0; k < 4; ++k) { const int it = it0 + k, h = it & 3; const size_t row = (size_t)(it >> 2);
            v[k] = od[row * 256 + h * 64 + C.lane] + od[(size_t)MROWS * 256 + row * 256 + h * 64 + C.lane]; gr[k] = zb[row * ZLD + ZB_BG + h * 64 + C.lane]; }
#pragma unroll
        for (int k = 0; k < 4; ++k) { const int it = it0 + k, h = it & 3; const size_t row = (size_t)(it >> 2);
            const float ss = wave_sum(v[k] * v[k]); const float gt = siluf_(bf2f(gr[k]));
            ob[row * DM + 512 + h * 64 + C.lane] = f2bf(v[k] * (1.0f / sqrtf(ss * (1.0f / 64.0f) + RMS_EPS)) * ng * gt); }
    }
}

#define XB_TMO      128
#define XB_XCNT(j)  (256  + 64 * (j))
#define XB_XSUB(j)  (1280 + 64 * (j))
#define XB_XGEN(j)  (2304 + 64 * (j))
#define XB_TOP      3328
#define XB_TOPGEN   3392
#define XB_SPIN_CAP (1u << 22)
DI unsigned xb_ld(unsigned* p)              { return __hip_atomic_load(p, __ATOMIC_RELAXED, __HIP_MEMORY_SCOPE_AGENT); }
DI unsigned xb_add(unsigned* p, unsigned v) { return __hip_atomic_fetch_add(p, v, __ATOMIC_RELAXED, __HIP_MEMORY_SCOPE_AGENT); }
DI unsigned xb_xcc_id() { return (unsigned)__builtin_amdgcn_s_getreg((3 << 11) | 20) & 0xFu; }
#define XB_SPIN(cond, bar) do { unsigned _sp = 0; while (cond) { __builtin_amdgcn_s_sleep(1); \
    if ((++_sp & 255u) == 0u) { if (xb_ld(&(bar)[XB_TMO])) break; if (_sp > XB_SPIN_CAP) { atomicAdd(&(bar)[XB_TMO], 1u); break; } } } } while (0)
struct XcdBarrier { unsigned* bar; unsigned x; volatile LAS unsigned* st; };
DI void xcd_barrier_complete(unsigned* bar, unsigned x, unsigned& nloc, unsigned& nx) {
    const unsigned G = gridDim.x * gridDim.y * gridDim.z;
    unsigned sum, cnt, mine, sp = 0u;
    for (;;) {
        sum = 0u; cnt = 0u; mine = 0u;
#pragma unroll
        for (unsigned j = 0; j < 16; ++j) { const unsigned c = xb_ld(&bar[XB_XCNT(j)]); sum += c; cnt += (c > 0u) ? 1u : 0u; mine = (j == x) ? c : mine; }
        if (sum == G) break;
        __builtin_amdgcn_s_sleep(1);
        if ((++sp & 255u) == 0u) { if (xb_ld(&bar[XB_TMO])) break; if (sp > XB_SPIN_CAP) { atomicAdd(&bar[XB_TMO], 1u); break; } }
    }
    nloc = mine > 0u ? mine : 1u; nx = cnt > 0u ? cnt : 1u;
}
DI void xcd_barrier(const XcdBarrier& b) {
    asm volatile("s_waitcnt vmcnt(0)" ::: "memory");
    __syncthreads();
    if (threadIdx.x == 0) {
        unsigned* bar = b.bar;
        __builtin_amdgcn_s_waitcnt(0);
        unsigned nloc = b.st[0], nx = b.st[1];
        if (nloc == 0u) { xcd_barrier_complete(bar, b.x, nloc, nx); b.st[0] = nloc; b.st[1] = nx; }
        const unsigned old = xb_add(&bar[XB_XSUB(b.x)], 1u);
        const unsigned gen = old / nloc;
        if (old + 1u == (gen + 1u) * nloc) {
            __builtin_amdgcn_fence(__ATOMIC_RELEASE, "agent");
            asm volatile("s_waitcnt vmcnt(0)" ::: "memory");
            const unsigned og = xb_add(&bar[XB_TOP], 1u);
            const unsigned tg = og / nx;
            if (og + 1u == (tg + 1u) * nx) xb_add(&bar[XB_TOPGEN], 1u);
            else XB_SPIN(xb_ld(&bar[XB_TOPGEN]) == tg, bar);
            __builtin_amdgcn_fence(__ATOMIC_ACQUIRE, "agent");
            xb_add(&bar[XB_XGEN(b.x)], 1u);
            asm volatile("s_waitcnt vmcnt(0)" ::: "memory");
        } else {
            XB_SPIN(xb_ld(&bar[XB_XGEN(b.x)]) == gen, bar);
            __builtin_amdgcn_fence(__ATOMIC_ACQUIRE, "agent");
            asm volatile("s_waitcnt vmcnt(0)" ::: "memory");
        }
    }
    __syncthreads();
}

DI void probe_stamp(unsigned char* ws, int cls) {
    if (PROBE_A >= 0 && blockIdx.x == 0 && threadIdx.x == 0) {
        volatile float* tsf = (volatile float*)(ws + WS_TAB + 131072); volatile unsigned long long* tsl = (volatile unsigned long long*)(ws + WS_TAB + 131072 + 256);
        const unsigned long long now = __builtin_amdgcn_s_memrealtime(); tsf[cls] += (float)(now - tsl[0]); tsl[0] = now; }
}
template <unsigned PHM_>
__global__ void __launch_bounds__(512) fwd_megakernel(Params p) {
    extern __shared__ __attribute__((aligned(16))) unsigned char lds_raw[];
    XcdBarrier xbar; xbar.bar = (unsigned*)(p.ws + WS_CTL) + 1024; xbar.x = xb_xcc_id(); xbar.st = (volatile LAS unsigned*)((LAS unsigned char*)lds_raw + 147400);
    if (threadIdx.x == 0) { xbar.st[0] = 0u; xbar.st[1] = 0u; (void)xb_add(&xbar.bar[XB_XCNT(xbar.x)], 1u); }
    __syncthreads();
    for (int ph = p.ph_lo; ph < p.ph_hi; ++ph) {
        if (PROBE_A >= 0 && blockIdx.x == 0 && threadIdx.x == 0) {
            volatile float* tsf = (volatile float*)(p.ws + WS_TAB + 131072); volatile unsigned long long* tsl = (volatile unsigned long long*)(p.ws + WS_TAB + 131072 + 256);
            const unsigned long long now = __builtin_amdgcn_s_memrealtime();
            if (ph == 0) { for (int i = 0; i < 16; ++i) tsf[i] = 0.f; tsl[1] = now; }
            else { const int pp = ph - 1; const int cls = pp < 2 ? 8 : (((pp - 2) % 9) == 8 ? 5 : ((pp - 2) % 9)); const float dt = (float)(now - tsl[0]); tsf[cls] += dt; }
            tsl[0] = now;
            if (ph == NPHASE - 2 && PROBE_A < 20) { const float tot = (float)(now - tsl[1]); tsf[12] = rintf(tsf[(PROBE_A >= 0 && PROBE_A < 16) ? PROBE_A : 0] / tot * 40.f) / 40.f; tsf[13] = rintf(tsf[PROBE_B >= 0 ? PROBE_B : 0] / tot * 40.f) / 40.f; }
        }
        if (PROBE_A >= 0 && ph == 0 && threadIdx.x == 0) { volatile float* tsb = (volatile float*)(p.ws + WS_TAB + 196608) + blockIdx.x * 8; for (int i = 0; i < 8; ++i) tsb[i] = 0.f; }
        if (PROBE_A >= 20 && ph == NPHASE - 2 && blockIdx.x == 0 && threadIdx.x == 0) {
            volatile float* tsf = (volatile float*)(p.ws + WS_TAB + 131072); volatile unsigned long long* tsl = (volatile unsigned long long*)(p.ws + WS_TAB + 131072 + 256);
            const float* tsb = (const float*)(p.ws + WS_TAB + 196608); float sum = 0.f; for (int b2 = 0; b2 < (int)gridDim.x; ++b2) sum += __hip_atomic_load(tsb + b2 * 8 + (PROBE_A - 20), __ATOMIC_RELAXED, __HIP_MEMORY_SCOPE_AGENT); sum *= (PROBE_A == 20 ? 32.f : (PROBE_A == 21 ? 16.f : 1.f));
            const float tot = (float)(__builtin_amdgcn_s_memrealtime() - tsl[1]); tsf[12] = rintf(sum / (float)gridDim.x / tot * 40.f) / 40.f; tsf[13] = 0.f; }
        int tid_ = threadIdx.x; asm volatile("" : "+v"(tid_));
        unsigned char* ws_ = p.ws; asm volatile("" : "+s"(ws_));
        float* out_ = p.out; asm volatile("" : "+s"(out_));
        Ctx C; C.p = &p; C.lds = (LAS unsigned char*)lds_raw; C.L = (float*)lds_raw; C.tid = tid_; C.lane = C.tid & 63; C.wave = __builtin_amdgcn_readfirstlane(C.tid >> 6);
        C.G = gridDim.x; C.gw = blockIdx.x * 8 + C.wave; C.NGW = C.G * 8; C.ws = ws_; C.out = out_;
        unsigned* ctl = (unsigned*)(ws_ + WS_CTL);
        const float* modbuf = (const float*)(ws_ + WS_MOD);
        bf16_t* xm = (bf16_t*)(ws_ + WS_XM); bf16_t* ob = (bf16_t*)(ws_ + WS_O); bf16_t* act = (bf16_t*)(ws_ + WS_ACT);
        if (ph == 0) { if (PHON(0)) phase0a(C); }
        else if (ph == 1) { if (PHON(1)) row_pass(C, 0, nullptr, nullptr, modbuf, 1024, 0, true); }
        else {
            const int layer = (ph - 2) / 9, sub = (ph - 2) % 9;
            unsigned char* wb = ws_ + WS_W + (size_t)(layer & 1) * WBUF;
            const float* modl = modbuf + (size_t)layer * 3 * 6144;
            if (sub == 0) { if (PHON(2)) {
                pg8::Gemm g{xm, (const bf16_t*)(wb + W_IN), MROWS, 4096, DM}; pg8::StaticOrder S; S.init(MROWS, 4096, C.G, (int)blockIdx.x);
                EpiIn E{(bf16_t*)(ws_ + WS_Q), (bf16_t*)(ws_ + WS_K), (bf16_t*)(ws_ + WS_V), (bf16_t*)(ws_ + WS_ZB), out_ + OUT_K, out_ + OUT_V, (const f32x2*)(ws_ + WS_TAB), layer};
                pg8::gemm_phase(C.lds, g, S, E, C.tid); }
            } else if (sub == 1) {
                __syncthreads();
                if (PHON(4)) for (int u = blockIdx.x; u < 1024; u += C.G) delta_prep_unit(C, layer, u);
                __syncthreads();
                if (PHON(5)) for (int u = C.gw; u < 2048; u += C.NGW) hgrn_local_unit(C, layer, u);
                __syncthreads();
            } else if (sub == 2) {
                LAS int* slot = (LAS int*)(C.lds + 147392);
                for (;;) {
                    __syncthreads();
                    if (C.tid == 0) *slot = (int)atomicAdd(ctl + 64 * (layer + 1), 1u);
                    __syncthreads();
                    const int u = *slot;
                    if (u >= 1432 + 256) break;
                    if (u >= 1432) { if (layer + 1 < DEPTH) convert_layer_weights(C, layer + 1, (u - 1432) * 8 + C.wave, 2048, u - 1432, 256); continue; }
                    unsigned long long pt0_ = 0; if (PROBE_A >= 0 && C.tid == 0) pt0_ = __builtin_amdgcn_s_memrealtime();
                    if (u < 8) { if (PHON(6)) delta_scan_unit(C, layer, true, u >> 2, u & 3); }
                    else if (u < 24) { const int v = u - 8; if (PHON(7)) hgrn_scan_unit(C, layer, true, v >> 3, (v >> 1) & 3, v & 1); }
                    else if (u < 536) { if (PHON(8)) attn_unit(C, layer, u - 24); }
                    else if (u < 664) { const int v = u - 536; if (PHON(6)) delta_scan_unit(C, layer, false, v >> 2, v & 3); }
                    else if (u < 1176) { if (PHON(8)) attn_unit(C, layer, 512 + (u - 664)); }
                    else { const int v = u - 1176; if (PHON(7)) hgrn_scan_unit(C, layer, false, v >> 3, (v >> 1) & 3, v & 1); }
                    if (PROBE_A >= 0) { __syncthreads(); if (C.tid == 0) { const int ty = (u < 8) ? 0 : (u < 24 ? 1 : (u < 536 ? 2 : (u < 664 ? 3 : (u < 1176 ? 4 : 5))));
                        volatile float* tsb = (volatile float*)(ws_ + WS_TAB + 196608) + blockIdx.x * 8; tsb[ty] += (float)(__builtin_amdgcn_s_memrealtime() - pt0_); } }
                }
            } else if (sub == 3) {
                if (PHON(9)) for (int u = blockIdx.x; u < 256; u += C.G) hgrn_final_unit(C, layer, u);
                __syncthreads();
                if (PHON(10)) delta_combine(C, layer);
                __syncthreads();
            } else if (sub == 4) {
                pg8::Gemm g{ob, (const bf16_t*)(wb + W_OUT), MROWS, DM, DM}; pg8::StaticOrder S; S.init(MROWS, DM, C.G, (int)blockIdx.x);
                EpiRes E{out_, modl + 2048, xm};
                if (PHON(11)) pg8::gemm_phase(C.lds, g, S, E, C.tid);
            } else if (sub == 5) {
                if (PHON(12)) row_pass(C, 1, p.in[20] + (size_t)(layer * 2) * DM, p.in[21] + (size_t)(layer * 2) * DM, modl, 4096, 3072, true);
            } else if (sub == 6) {
                pg8::Gemm g{xm, (const bf16_t*)(wb + W_FFI), MROWS, 2 * DFF, DM}; pg8::StaticOrder S; S.init(MROWS, 2 * DFF, C.G, (int)blockIdx.x);
                EpiFfn E{act};
                if (PHON(13)) pg8::gemm_phase(C.lds, g, S, E, C.tid);
            } else if (sub == 7) {
                pg8::Gemm g{act, (const bf16_t*)(wb + W_FFO), MROWS, DM, DFF}; pg8::StaticOrder S; S.init(MROWS, DM, C.G, (int)blockIdx.x);
                EpiRes E{out_, modl + 5120, xm};
                if (PHON(14)) pg8::gemm_phase(C.lds, g, S, E, C.tid);
            } else {
                const bool last = layer + 1 == DEPTH;
                if (PHON(12)) row_pass(C, 1, p.in[20] + (size_t)(layer * 2 + 1) * DM, p.in[21] + (size_t)(layer * 2 + 1) * DM, modbuf + (size_t)(last ? layer : layer + 1) * 3 * 6144, 1024, 0, !last);
            }
        }
        if (ph + 1 < p.ph_hi) { if (p.ph_hi > 100000) { __threadfence(); cg::this_grid().sync(); } else xcd_barrier(xbar); }
    }
}

#if !MK_ONE_LAUNCH
static unsigned phase_mask(int ph) {
    if (ph == 0) return 1u << 0; if (ph == 1) return 1u << 1;
    const int sub = (ph - 2) % 9;
    switch (sub) { case 0: return 1u << 2; case 1: return (1u << 3) | (1u << 4) | (1u << 5); case 2: return (1u << 6) | (1u << 7) | (1u << 8); case 3: return (1u << 9) | (1u << 10);
        case 4: return 1u << 11; case 5: return 1u << 12; case 6: return 1u << 13; case 7: return 1u << 14; default: return 1u << 12; }
}
typedef void (*kern_t)(Params);
static kern_t kernel_for_mask(unsigned m) {
    switch (m) {
        case 1u << 0: return fwd_megakernel<1u << 0>; case 1u << 1: return fwd_megakernel<1u << 1>; case 1u << 2: return fwd_megakernel<1u << 2>;
        case (1u << 3) | (1u << 4) | (1u << 5): return fwd_megakernel<(1u << 3) | (1u << 4) | (1u << 5)>;
        case (1u << 6) | (1u << 7) | (1u << 8): return fwd_megakernel<(1u << 6) | (1u << 7) | (1u << 8)>;
        case (1u << 9) | (1u << 10): return fwd_megakernel<(1u << 9) | (1u << 10)>;
        case 1u << 11: return fwd_megakernel<1u << 11>; case 1u << 12: return fwd_megakernel<1u << 12>; case 1u << 13: return fwd_megakernel<1u << 13>; default: return fwd_megakernel<1u << 14>;
    }
}
#endif
extern "C" void kernel_launch(void* const* d_in, const int* in_sizes, int n_in, void* d_out, int out_size, void* d_ws, size_t ws_size, hipStream_t stream) {
    static int grid = 0;
    if (grid == 0) {
        if (n_in != 24 || out_size != 58720256 || ws_size < WS_END) { fprintf(stderr, "kernel_launch: unexpected shapes (n_in %d out %d ws %zu)\n", n_in, out_size, ws_size); grid = -1; return; }
        int dev = 0, cus = 0;
        (void)hipGetDevice(&dev); (void)hipDeviceGetAttribute(&cus, hipDeviceAttributeMultiprocessorCount, dev);
#if MK_ONE_LAUNCH
        if (hipFuncSetAttribute((const void*)fwd_megakernel<0x7FFFu>, hipFuncAttributeMaxDynamicSharedMemorySize, LDS_BYTES) != hipSuccess) { fprintf(stderr, "kernel_launch: hipFuncSetAttribute failed\n"); grid = -1; return; }
#else
        for (int ph = 0; ph < 11; ++ph) (void)hipFuncSetAttribute((const void*)kernel_for_mask(phase_mask(ph)), hipFuncAttributeMaxDynamicSharedMemorySize, LDS_BYTES);
#endif
        (void)hipGetLastError();
        grid = cus > 0 ? cus : 256;
        if (grid != 256) { fprintf(stderr, "kernel_launch: expected 256 CUs, got %d\n", grid); grid = 256; }
    }
    if (grid < 0) return;
    (void)hipMemsetAsync((char*)d_ws + WS_CTL, 0, 65536, stream);
    Params p{};
    for (int i = 0; i < 24; ++i) p.in[i] = (const float*)d_in[i];
    p.out = (float*)d_out; p.ws = (unsigned char*)d_ws;
#if MK_ONE_LAUNCH
    p.ph_lo = 0; p.ph_hi = NPHASE;
    void* args[] = {&p};
    hipError_t e = hipLaunchCooperativeKernel((const void*)fwd_megakernel<0x7FFFu>, dim3(grid), dim3(512), args, LDS_BYTES, stream);
    if (e != hipSuccess) fprintf(stderr, "cooperative launch failed: %s (grid %d)\n", hipGetErrorString(e), grid);
#else
    for (int ph = 0; ph < NPHASE; ++ph) { p.ph_lo = ph; p.ph_hi = ph + 1; hipLaunchKernelGGL(kernel_for_mask(phase_mask(ph)), dim3(grid), dim3(512), LDS_BYTES, stream, p); }
#endif
}
```

```cpp
#include <hip/hip_runtime.h>
#include <hip/hip_cooperative_groups.h>
#include <cstdio>
#include <cstdint>
namespace cg = cooperative_groups;

#define PHON(k) ((PHM_ >> (k)) & 1)
#ifndef PROBE_A
#define PROBE_A -1
#endif
#ifndef PROBE_B
#define PROBE_B -1
#endif
#ifndef MK_ONE_LAUNCH
#define MK_ONE_LAUNCH 1
#endif

#define DI __device__ __forceinline__
#define LAS __attribute__((address_space(3)))
typedef unsigned short bf16_t;
typedef short bf16x8 __attribute__((ext_vector_type(8)));
typedef short s16x4 __attribute__((ext_vector_type(4)));
typedef float f32x4 __attribute__((ext_vector_type(4)));
typedef float f32x16 __attribute__((ext_vector_type(16)));
typedef float f32x2 __attribute__((ext_vector_type(2)));
typedef unsigned u32x4 __attribute__((ext_vector_type(4)));
typedef unsigned u32x2 __attribute__((ext_vector_type(2)));

constexpr int MROWS = 16384, DM = 1024, DEPTH = 4, DFF = 2816, DIN = 3856, ZLD = 2320;
constexpr float ALPHA = 1.681792830507429f, LN_EPS = 1e-5f, RMS_EPS = 1e-6f;
constexpr float QSCALE = 0.125f * 1.4426950408889634f;
constexpr int ZB_BQ = 0, ZB_BK = 256, ZB_BV = 512, ZB_BG = 768, ZB_BBETA = 1024, ZB_BA = 1032, ZB_CQ = 1040, ZB_CF = 1296, ZB_CI = 1808, ZB_CG = 2064;
constexpr size_t OUT_K = 16777216, OUT_V = 33554432, OUT_SD = 50331648, OUT_SH = 54525952;
constexpr size_t MiB = 1u << 20;
constexpr size_t WS_CTL = 0, WS_MOD = 64 * 1024, WS_TAB = 512 * 1024, WS_CK = 1 * MiB, WS_CV = 3 * MiB, WS_W = 8 * MiB, WBUF = 27 * MiB;
constexpr size_t W_IN = 0, W_OUT = 8 * MiB, W_FFI = 10 * MiB, W_FFO = 21 * MiB;
constexpr size_t WS_XM = 62 * MiB, WS_O = 94 * MiB, WS_ZB = 126 * MiB, WS_Q = 199 * MiB, WS_K = 215 * MiB, WS_V = 231 * MiB;
constexpr size_t WS_ACT = 126 * MiB;
constexpr size_t WS_DPW = 247 * MiB, WS_DPQD = 263 * MiB, WS_DPQK = 279 * MiB, WS_DPKD = 295 * MiB;
constexpr size_t WS_DPU = WS_XM;
constexpr size_t WS_OD = 311 * MiB, WS_HS = 343 * MiB, WS_HD = 375 * MiB, WS_GL = 375 * MiB + 512 * 1024, WS_END = 376 * MiB;
constexpr int LDS_BYTES = 147456;
constexpr int NPHASE = 2 + 9 * DEPTH;

struct Params { const float* in[24]; float* out; unsigned char* ws; int ph_lo, ph_hi; };

DI unsigned cvt_pk_bf16(float lo, float hi) { unsigned r; asm("v_cvt_pk_bf16_f32 %0, %1, %2" : "=v"(r) : "v"(lo), "v"(hi)); return r; }
DI bf16_t f2bf(float f) { return (bf16_t)(cvt_pk_bf16(f, 0.f) & 0xffffu); }
DI float bf2f(bf16_t b) { return __uint_as_float(((unsigned)b) << 16); }
DI float sigmoidf_(float x) { return __builtin_amdgcn_rcpf(1.0f + __expf(-x)); }
DI float siluf_(float x) { return x * __builtin_amdgcn_rcpf(1.0f + __expf(-x)); }
DI float wave_sum(float v) {
#pragma unroll
    for (int o = 1; o < 64; o <<= 1) v += __shfl_xor(v, o);
    return v;
}
DI u32x2 pack4(f32x4 v) { u32x2 w; w.x = cvt_pk_bf16(v[0], v[1]); w.y = cvt_pk_bf16(v[2], v[3]); return w; }
DI bf16x8 pack8(f32x4 a, f32x4 b) { u32x4 w; w.x = cvt_pk_bf16(a[0], a[1]); w.y = cvt_pk_bf16(a[2], a[3]); w.z = cvt_pk_bf16(b[0], b[1]); w.w = cvt_pk_bf16(b[2], b[3]); return __builtin_bit_cast(bf16x8, w); }
DI int pinv(int k) { return (k >> 5) * 32 + ((k >> 2) & 3) * 8 + ((k >> 4) & 1) * 4 + (k & 3); }
DI int row_mod(int r) { return r < 8192 ? 0 : 1 + ((r - 8192) >> 12); }

namespace pg8 {
constexpr int BM = 256, BK = 64, HALF = 128, HTB = HALF * BK * 2, STAGE_BYTES = 8 * HTB, NXCD = 8, WGM = 8;
DI int lds_byte(int r, int c) { const int st = (r >> 4) * 2 + (c >> 5), rr = r & 15, cc = c & 31, ob = rr * 64 + cc * 2; return st * 1024 + (ob ^ (((ob >> 9) & 1) << 5)); }
DI void stage_rc(int b, int& R, int& C) { const int st = b / 1024, sb = b % 1024, swz = sb ^ (((sb >> 9) & 1) << 5); R = (st >> 1) * 16 + swz / 64; C = (st & 1) * 32 + (swz % 64) / 2; }
struct Unit { int pm, pn; };
struct Gemm { const bf16_t* A; const bf16_t* Bt; int M, N, K; };
struct StaticOrder {
    int nM, nN, nwg, G, c;
    DI void init(int M, int N, int G_, int c_) { nM = M / BM; nN = N / BM; nwg = nM * nN; G = G_; c = c_; }
    DI bool next(int i, Unit& u) const {
        const long L = (long)i * G + c; if (L >= nwg) return false;
        int wgid = (int)L; { const int q = nwg / NXCD, r = nwg % NXCD, xcd = wgid % NXCD, off = wgid / NXCD; wgid = (xcd < r ? xcd * (q + 1) : r * (q + 1) + (xcd - r) * q) + off; }
        const int nig = WGM * nN, gid = wgid / nig, fm = gid * WGM, gsz = (nM - fm) < WGM ? (nM - fm) : WGM;
        u.pm = fm + ((wgid % nig) % gsz); u.pn = (wgid % nig) / gsz; return true;
    }
};

template <class Epi>
DI void gemm_phase(LAS unsigned char* lds, const Gemm g, const StaticOrder& S, const Epi& E, int tid_in) {
    const int tid = tid_in, wid = __builtin_amdgcn_readfirstlane(tid >> 6), lane = tid & 63, wr = wid >> 2, wc = wid & 3, fr = lane & 15, fq = lane >> 4;
    const int K = g.K, nt = K / BK;
    unsigned voffA[2];
#pragma unroll
    for (int i = 0; i < 2; ++i) { int R, C; stage_rc(tid * 16 + i * 8192, R, C); voffA[i] = (unsigned)(R * K + C) * 2u; }
    const size_t kstep = (size_t)(BK * 2);
    const size_t hstep = (size_t)HALF * K * 2;
    const size_t tstep = 2 * hstep;
    const unsigned ldsw = (unsigned)wid * 1024u;
    const int aoff = lds_byte(wr * 64 + fr, fq * 8), boff = lds_byte(wc * 32 + fr, fq * 8);
#define PG8_SA(b, h) (((b) * 2 + (h)) * HTB)
#define PG8_SB(b, h) ((4 + (b) * 2 + (h)) * HTB)
#define PG8_STAGE(bufoff, gbase) do { _Pragma("unroll") for (int _i = 0; _i < 2; ++_i) \
        __builtin_amdgcn_global_load_lds((const unsigned*)((const char*)(gbase) + voffA[_i]), (LAS unsigned*)(lds + (bufoff) + ldsw + _i * 8192), 16, 0, 0); } while (0)
#define PG8_LDA(dst, b, h) do { _Pragma("unroll") for (int m = 0; m < 4; ++m) _Pragma("unroll") for (int k = 0; k < 2; ++k) dst[m][k] = *(const LAS bf16x8*)(lds + PG8_SA(b, h) + aoff + m * 2048 + k * 1024); } while (0)
#define PG8_LDB(dst, b, h) do { _Pragma("unroll") for (int n = 0; n < 2; ++n) _Pragma("unroll") for (int k = 0; k < 2; ++k) dst[n][k] = *(const LAS bf16x8*)(lds + PG8_SB(b, h) + boff + n * 2048 + k * 1024); } while (0)
#define PG8_MMA(ai, bj, At, Bt) do { __builtin_amdgcn_s_setprio(1); _Pragma("unroll") for (int m = 0; m < 4; ++m) _Pragma("unroll") for (int n = 0; n < 2; ++n) _Pragma("unroll") for (int k = 0; k < 2; ++k) \
        acc[ai][bj][m][n] = __builtin_amdgcn_mfma_f32_16x16x32_bf16(Bt[n][k], At[m][k], acc[ai][bj][m][n], 0, 0, 0); __builtin_amdgcn_s_setprio(0); } while (0)
#define PG8_WAIT_V(n) asm volatile("s_waitcnt vmcnt(" #n ")" ::: "memory")
#define PG8_WAIT_L(n) asm volatile("s_waitcnt lgkmcnt(" #n ")" ::: "memory")
#define PG8_BAR __builtin_amdgcn_s_barrier()
#define PG8_SCHED __builtin_amdgcn_sched_barrier(0)
    Unit cur, nxt; int ui = 0;
    if (!S.next(0, cur)) return;
    f32x4 acc[2][2][4][2];
#pragma unroll
    for (int a = 0; a < 2; ++a)
#pragma unroll
        for (int b = 0; b < 2; ++b)
#pragma unroll
            for (int m = 0; m < 4; ++m)
#pragma unroll
                for (int n = 0; n < 2; ++n) acc[a][b][m][n] = (f32x4){0.f, 0.f, 0.f, 0.f};
    bf16x8 At[4][2], B0[2][2], B1[2][2];
    const char* cA = (const char*)g.A + (size_t)cur.pm * tstep; const char* cB = (const char*)g.Bt + (size_t)cur.pn * tstep;
    PG8_STAGE(PG8_SB(0, 0), cB); PG8_STAGE(PG8_SB(0, 1), cB + hstep); PG8_STAGE(PG8_SA(0, 0), cA); PG8_STAGE(PG8_SA(0, 1), cA + hstep);
    if (wr == 1) PG8_BAR;
    PG8_WAIT_V(2); PG8_BAR;
    PG8_STAGE(PG8_SB(1, 0), cB + kstep); PG8_STAGE(PG8_SA(1, 0), cA + kstep); PG8_STAGE(PG8_SB(1, 1), cB + hstep + kstep);
    PG8_WAIT_V(6); PG8_BAR;
    for (;;) {
        const bool has_next = S.next(ui + 1, nxt);
        const char* nA = has_next ? (const char*)g.A + (size_t)nxt.pm * tstep : cA; const char* nB = has_next ? (const char*)g.Bt + (size_t)nxt.pn * tstep : cB;
        for (int t = 0; t < nt; t += 2) {
            const bool last = (t == nt - 2);
            const char* a1 = cA + (size_t)(t + 1) * kstep;
            const char* a2 = last ? nA : cA + (size_t)(t + 2) * kstep; const char* b2 = last ? nB : cB + (size_t)(t + 2) * kstep;
            const char* a3 = a2 + kstep; const char* b3 = b2 + kstep;
            PG8_LDB(B0, 0, 0); PG8_LDB(B1, 0, 1); PG8_SCHED; PG8_LDA(At, 0, 0); PG8_STAGE(PG8_SA(1, 1), a1 + hstep);
            PG8_WAIT_V(8); PG8_WAIT_L(0); PG8_BAR; PG8_MMA(0, 0, At, B0); PG8_MMA(0, 1, At, B1); PG8_BAR; PG8_SCHED;
            PG8_LDA(At, 0, 1); PG8_STAGE(PG8_SB(0, 0), b2); PG8_STAGE(PG8_SB(0, 1), b2 + hstep); PG8_STAGE(PG8_SA(0, 0), a2);
            PG8_WAIT_V(8); PG8_WAIT_L(0); PG8_BAR; PG8_MMA(1, 0, At, B0); PG8_MMA(1, 1, At, B1); PG8_BAR; PG8_SCHED;
            PG8_LDB(B0, 1, 0); PG8_LDB(B1, 1, 1); PG8_SCHED; PG8_LDA(At, 1, 0); PG8_STAGE(PG8_SA(0, 1), a2 + hstep);
            PG8_WAIT_V(8); PG8_WAIT_L(0); PG8_BAR; PG8_MMA(0, 0, At, B0); PG8_MMA(0, 1, At, B1); PG8_BAR; PG8_SCHED;
            PG8_LDA(At, 1, 1); PG8_STAGE(PG8_SB(1, 0), b3); PG8_STAGE(PG8_SB(1, 1), b3 + hstep); PG8_STAGE(PG8_SA(1, 0), a3);
            PG8_WAIT_V(8); PG8_WAIT_L(0); PG8_BAR; PG8_MMA(1, 0, At, B0); PG8_MMA(1, 1, At, B1); PG8_BAR; PG8_SCHED;
        }
        if (wr == 0) PG8_BAR;
        E(acc, cur, wr, wc, fr, fq);
        if (!has_next) break;
#pragma unroll
        for (int a = 0; a < 2; ++a)
#pragma unroll
            for (int b = 0; b < 2; ++b)
#pragma unroll
                for (int m = 0; m < 4; ++m)
#pragma unroll
                    for (int n = 0; n < 2; ++n) acc[a][b][m][n] = (f32x4){0.f, 0.f, 0.f, 0.f};
        cur = nxt; cA = nA; cB = nB; ++ui;
        if (wr == 1) PG8_BAR;
    }
    PG8_WAIT_V(0);
    PG8_BAR;
#undef PG8_SA
#undef PG8_SB
#undef PG8_STAGE
#undef PG8_LDA
#undef PG8_LDB
#undef PG8_MMA
#undef PG8_WAIT_V
#undef PG8_WAIT_L
#undef PG8_BAR
#undef PG8_SCHED
}
}

struct EpiIn {
    bf16_t *Qb, *Kb, *Vb, *zb; float *outK, *outV; const f32x2* rope; int layer;
    DI void operator()(const f32x4 (&acc)[2][2][4][2], const pg8::Unit& u, int wr, int wc, int fr, int fq) const {
        const int tile = u.pn; const bool sample = u.pm >= 32;
        if (tile < 6) {
            const int kind = tile >> 1; const int cb = (tile & 1) * 256 + wc * 32 + 4 * fq;
            bf16_t* dst = Qb + (size_t)kind * (16u * 1024u * 1024u / 2u);
            float* of = outK + (size_t)(kind >= 1 ? kind - 1 : 0) * 16777216u;
#pragma unroll
            for (int ai = 0; ai < 2; ++ai)
#pragma unroll
                for (int m = 0; m < 4; ++m) {
                    const int r = u.pm * 256 + ai * 128 + wr * 64 + m * 16 + fr;
#pragma unroll
                    for (int bj = 0; bj < 2; ++bj) {
                        f32x4 a = acc[ai][bj][m][0], b = acc[ai][bj][m][1]; const int cc = cb + bj * 128;
                        if (!sample && kind >= 1) { float* o = of + ((size_t)((r >> 8) * 4 + layer) * 256 + (r & 255)) * 512 + cc; *(f32x4*)o = a; *(f32x4*)(o + 16) = b; }
                        if (sample && kind < 2) {
                            const int t = (r - 8192) & 4095; const int pos = (wc & 1) ? (t & 63) : (t >> 6); const f32x2* rp = rope + pos * 16 + 4 * fq;
#pragma unroll
                            for (int j = 0; j < 4; ++j) { const f32x2 cs = rp[j]; const float x1 = a[j], x2 = b[j]; a[j] = x1 * cs.x - x2 * cs.y; b[j] = x2 * cs.x + x1 * cs.y; }
                        }
                        if (kind == 0) { a = a * QSCALE; b = b * QSCALE; }
                        if (kind == 2) {
                            const int hh = cc >> 7, dv0 = cc & 127, tt = sample ? ((r - 8192) & 4095) : (r & 255);
                            bf16_t* vt = sample ? Vb + 4194304 + ((size_t)((((r - 8192) >> 12) * 4 + hh) * 32 + (tt >> 7)) * 128 + dv0) * 128 + (tt & 127)
                                                : Vb + ((size_t)(((r >> 8) * 4 + hh) * 2 + (tt >> 7)) * 128 + dv0) * 128 + (tt & 127);
#pragma unroll
                            for (int j = 0; j < 4; ++j) { vt[(size_t)j * 128] = f2bf(a[j]); vt[(size_t)(16 + j) * 128] = f2bf(b[j]); }
                        } else { *(u32x2*)(dst + (size_t)r * 512 + cc) = pack4(a); *(u32x2*)(dst + (size_t)r * 512 + cc + 16) = pack4(b); }
                    }
                    asm volatile("" ::: "memory");
                }
        } else {
#pragma unroll
            for (int ai = 0; ai < 2; ++ai)
#pragma unroll
                for (int m = 0; m < 4; ++m) {
                    const int r = u.pm * 256 + ai * 128 + wr * 64 + m * 16 + fr;
#pragma unroll
                    for (int bj = 0; bj < 2; ++bj)
#pragma unroll
                        for (int n = 0; n < 2; ++n) { const int c = (tile - 6) * 256 + bj * 128 + wc * 32 + 16 * n + 4 * fq; if (c < ZLD) *(u32x2*)(zb + (size_t)r * ZLD + c) = pack4(acc[ai][bj][m][n]); }
                    asm volatile("" ::: "memory");
                }
        }
    }
};
struct EpiRes {
    float* x; const float* gate; bf16_t* vb;
    DI void operator()(const f32x4 (&acc)[2][2][4][2], const pg8::Unit& u, int wr, int wc, int fr, int fq) const {
        const float* gv = gate + row_mod(u.pm * 256) * 6144;
#pragma unroll
        for (int ai = 0; ai < 2; ++ai)
#pragma unroll
            for (int m = 0; m < 4; ++m) {
                const int r = u.pm * 256 + ai * 128 + wr * 64 + m * 16 + fr;
#pragma unroll
                for (int bj = 0; bj < 2; ++bj)
#pragma unroll
                    for (int n = 0; n < 2; ++n) { const int c = u.pn * 256 + bj * 128 + wc * 32 + 16 * n + 4 * fq; const f32x4 g4 = *(const f32x4*)(gv + c); const u32x2 xw = *(const u32x2*)((const bf16_t*)x + (size_t)r * DM + c); const f32x4 xv = (f32x4){__uint_as_float(xw.x << 16), __uint_as_float(xw.x & 0xffff0000u), __uint_as_float(xw.y << 16), __uint_as_float(xw.y & 0xffff0000u)}; *(u32x2*)(vb + (size_t)r * DM + c) = pack4(xv * ALPHA + g4 * acc[ai][bj][m][n]); }
            }
    }
};
struct EpiFfn {
    bf16_t* act;
    DI void operator()(const f32x4 (&acc)[2][2][4][2], const pg8::Unit& u, int wr, int wc, int fr, int fq) const {
#pragma unroll
        for (int ai = 0; ai < 2; ++ai)
#pragma unroll
            for (int m = 0; m < 4; ++m) {
                const int r = u.pm * 256 + ai * 128 + wr * 64 + m * 16 + fr;
#pragma unroll
                for (int n = 0; n < 2; ++n) { const f32x4 gt = acc[ai][0][m][n], up = acc[ai][1][m][n]; f32x4 o;
#pragma unroll
                    for (int j = 0; j < 4; ++j) o[j] = siluf_(gt[j]) * up[j];
                    *(u32x2*)(act + (size_t)r * DFF + u.pn * 128 + wc * 32 + 16 * n + 4 * fq) = pack4(o); }
            }
    }
};

struct Ctx {
    const Params* p; LAS unsigned char* lds; float* L; int tid, lane, wave, G, gw, NGW;
    unsigned char* ws; float* out;
};

DI void tr_item(const float* W, int K, int N, bf16_t* WT, int mode, float* scr, int item, int lane) {
    const int nblk = (N + 31) / 32, kb = item / nblk, nb = item % nblk, k0 = 64 * kb, n0 = 32 * nb;
    const int nn = n0 + (lane & 31);
#pragma unroll 8
    for (int i = 0; i < 32; ++i) { const int kk = 2 * i + (lane >> 5); scr[kk * 33 + (lane & 31)] = (nn < N) ? W[(size_t)(k0 + kk) * N + nn] : 0.f; }
    __builtin_amdgcn_wave_barrier();
    const int c = lane & 7;
#pragma unroll
    for (int j = 0; j < 4; ++j) {
        const int nl = (lane >> 3) + 8 * j, n = n0 + nl; const float* s = scr + (8 * c) * 33 + nl;
        if (n < N) {
            int dst = n; if (mode == 1) { if (n < DFF) dst = (n >> 7) * 256 + (n & 127); else { const int jj = n - DFF; dst = (jj >> 7) * 256 + 128 + (jj & 127); } }
            u32x4 o; o.x = cvt_pk_bf16(s[0 * 33], s[1 * 33]); o.y = cvt_pk_bf16(s[2 * 33], s[3 * 33]); o.z = cvt_pk_bf16(s[4 * 33], s[5 * 33]); o.w = cvt_pk_bf16(s[6 * 33], s[7 * 33]);
            *(u32x4*)(WT + (size_t)dst * K + k0 + 8 * c) = o;
        }
    }
    __builtin_amdgcn_wave_barrier();
}
DI void convert_layer_weights(const Ctx& C, int layer, int gw0 = -1, int ngw = 0, int blk = -1, int nblk = 0) {
    const Params& p = *C.p;
    unsigned char* wb = C.ws + WS_W + (size_t)(layer & 1) * WBUF;
    bf16_t* Win = (bf16_t*)(wb + W_IN); bf16_t* Wout = (bf16_t*)(wb + W_OUT); bf16_t* Wffi = (bf16_t*)(wb + W_FFI); bf16_t* Wffo = (bf16_t*)(wb + W_FFO);
    float* scr = C.L + C.wave * (64 * 33);
    constexpr int I_IN = 16 * 121, I_OUT = 16 * 32, I_FFI = 16 * 176, I_FFO = 44 * 32, NIT = I_IN + I_OUT + I_FFI + I_FFO;
    int lane_ = C.lane; asm volatile("" : "+v"(lane_));
    const int gwA = gw0 >= 0 ? gw0 : C.gw, ngwA = gw0 >= 0 ? ngw : C.NGW, blkA = blk >= 0 ? blk : (int)blockIdx.x, nblkA = blk >= 0 ? nblk : C.G;
    for (int it = gwA; it < NIT; it += ngwA) {
        int r = it;
        if (r < I_IN) { tr_item(p.in[10] + (size_t)layer * DM * DIN, DM, DIN, Win, 0, scr, r, lane_); continue; } r -= I_IN;
        if (r < I_OUT) { tr_item(p.in[19] + (size_t)layer * DM * DM, DM, DM, Wout, 0, scr, r, lane_); continue; } r -= I_OUT;
        if (r < I_FFI) { tr_item(p.in[22] + (size_t)layer * DM * 2 * DFF, DM, 2 * DFF, Wffi, 1, scr, r, lane_); continue; } r -= I_FFI;
        tr_item(p.in[23] + (size_t)layer * DFF * DM, DFF, DM, Wffo, 0, scr, r, lane_);
    }
    u32x4* z = (u32x4*)(Win + (size_t)DIN * DM); const int nz = 240 * DM * 2 / 16;
    for (int i = blkA * 512 + C.tid; i < nz; i += nblkA * 512) z[i] = (u32x4){0u, 0u, 0u, 0u};
}

DI void mod_unit(const Ctx& C, int u) {
    const Params& p = *C.p; const int tid = C.tid;
    float* cs = C.L; float* red = C.L + 3072;
    const int layer = u >> 6, col0 = (u & 63) * 96;
    __syncthreads();
    for (int i = tid; i < 3072; i += 512) { const int v = i >> 10, k = i & 1023; const float c = (v == 0) ? p.in[7][k] : p.in[6][(v - 1) * 1024 + k]; cs[i] = siluf_(c); }
    __syncthreads();
    if (tid < 504) {
        const int cgp = tid % 24, rs = tid / 24;
        f32x4 a0 = {0, 0, 0, 0}, a1 = a0, a2 = a0;
        const float* Wp = p.in[8] + (size_t)layer * DM * 6144 + col0 + cgp * 4;
#pragma unroll 7
        for (int k = rs; k < 1024; k += 21) { const f32x4 w = *(const f32x4*)(Wp + (size_t)k * 6144); a0 += w * cs[k]; a1 += w * cs[1024 + k]; a2 += w * cs[2048 + k]; }
        float* rr = red + rs * 288 + cgp * 4;
#pragma unroll
        for (int j = 0; j < 4; ++j) { rr[j] = a0[j]; rr[96 + j] = a1[j]; rr[192 + j] = a2[j]; }
    }
    __syncthreads();
    if (tid < 288) {
        const int v = tid / 96, cc = tid % 96; float s = 0.f;
        for (int rs = 0; rs < 21; ++rs) s += red[rs * 288 + tid];
        ((float*)(C.ws + WS_MOD))[(size_t)(layer * 3 + v) * 6144 + col0 + cc] = s + p.in[9][layer * 6144 + col0 + cc];
    }
}

DI void phase0a(const Ctx& C) {
    const Params& p = *C.p;
    for (int u = blockIdx.x; u < 256; u += C.G) mod_unit(C, u);
    __syncthreads();
    convert_layer_weights(C, 0);
    const int gt = blockIdx.x * 512 + C.tid, NT = C.G * 512;
    float* tab = (float*)(C.ws + WS_TAB);
    if (gt < 1024) { const int pos = gt >> 4, i = gt & 15; const float inv = __builtin_amdgcn_exp2f(-(float)i * (13.287712379549449f / 16.0f)); float rev = (float)pos * inv * 0.15915494309189535f; rev -= floorf(rev);
        tab[2 * gt] = __builtin_amdgcn_cosf(rev); tab[2 * gt + 1] = __builtin_amdgcn_sinf(rev); }
    if (gt >= 1024 && gt < 1028) { const int l = gt - 1024; const float* dl = p.in[17] + l * 256; float s01 = 0.f, s23 = 0.f; for (int i = 0; i < 64; ++i) { s01 += dl[i] * dl[64 + i]; s23 += dl[128 + i] * dl[192 + i]; }
        tab[2048 + l] = __expf(s01) - __expf(s23) + (0.8f - 0.6f * __expf(-0.3f * (float)l)); }
    if (gt >= 2048 && gt < 2560) { const int dir = (gt - 2048) >> 8, c = gt & 255; const float* lb = p.in[15] + dir * 1024 + c; float v[4], mx = -1e30f; for (int l = 0; l < 4; ++l) { v[l] = lb[l * 256]; mx = fmaxf(mx, v[l]); }
        float s = 0.f; for (int l = 0; l < 4; ++l) { v[l] = __expf(v[l] - mx); s += v[l]; } float cum = 0.f; for (int l = 0; l < 4; ++l) { if (l > 0) cum += v[l] / s; tab[4096 + (dir * 4 + l) * 256 + c] = cum; } }
    bf16_t* ck = (bf16_t*)(C.ws + WS_CK); bf16_t* cv = (bf16_t*)(C.ws + WS_CV);
    for (int i = gt; i < 2 * 4 * 256 * 512 / 4; i += NT) { const int e = i * 4; const int c = e & 511, j = (e >> 9) & 255, l = (e >> 17) & 3, b = e >> 19;
        const size_t dst = ((size_t)((l * 2 + b) * 256 + j)) * 512 + c;
        *(u32x2*)(ck + dst) = pack4(*(const f32x4*)(p.in[2] + e)); }
    for (int i = gt; i < 2 * 4 * 256 * 512; i += NT) { const int j = i & 255, dv = (i >> 8) & 127, hh = (i >> 15) & 3, b = (i >> 17) & 1, l = i >> 18;
        cv[((size_t)((((l * 2 + b) * 4 + hh) * 2 + (j >> 7)) * 128 + dv)) * 128 + (j & 127)] = f2bf(p.in[3][((size_t)((b * 4 + l) * 256 + j) * 4 + hh) * 128 + dv]); }
}

DI void row_pass(const Ctx& C, int mode, const float* lng, const float* lnb, const float* modl, int sc_off, int sh_off, bool write_xm) {
    const Params& p = *C.p; float* x = C.out; bf16_t* xm = (bf16_t*)(C.ws + WS_XM);
    for (int r0 = C.gw; r0 < MROWS; r0 += 2 * C.NGW) {
        f32x4 v[2][4];
#pragma unroll
        for (int u = 0; u < 2; ++u) { const int r = r0 + u * C.NGW;
            if (mode == 0) { const float* src = (r < 8192 ? p.in[0] + (size_t)r * DM : p.in[1] + (size_t)(r - 8192) * DM);
#pragma unroll
                for (int j = 0; j < 4; ++j) v[u][j] = *(const f32x4*)(src + 4 * C.lane + 256 * j); }
            else {
#pragma unroll
                for (int j = 0; j < 4; ++j) { const u32x2 w2 = *(const u32x2*)(xm + (size_t)r * DM + 4 * C.lane + 256 * j);
                    v[u][j] = (f32x4){__uint_as_float(w2.x << 16), __uint_as_float(w2.x & 0xffff0000u), __uint_as_float(w2.y << 16), __uint_as_float(w2.y & 0xffff0000u)}; } } }
#pragma unroll
        for (int u = 0; u < 2; ++u) { const int r = r0 + u * C.NGW;
            if (mode == 1) {
                float s = 0.f;
#pragma unroll
                for (int j = 0; j < 4; ++j) s += (v[u][j][0] + v[u][j][1]) + (v[u][j][2] + v[u][j][3]);
                const float mean = wave_sum(s) * (1.f / DM); float s2 = 0.f;
#pragma unroll
                for (int j = 0; j < 4; ++j) { v[u][j] = v[u][j] - mean; s2 += (v[u][j][0] * v[u][j][0] + v[u][j][1] * v[u][j][1]) + (v[u][j][2] * v[u][j][2] + v[u][j][3] * v[u][j][3]); }
                const float rstd = 1.0f / sqrtf(wave_sum(s2) * (1.f / DM) + LN_EPS);
#pragma unroll
                for (int j = 0; j < 4; ++j) { const f32x4 g4 = *(const f32x4*)(lng + 4 * C.lane + 256 * j), b4 = *(const f32x4*)(lnb + 4 * C.lane + 256 * j); v[u][j] = v[u][j] * rstd * g4 + b4; }
            }
            if (PROBE_A >= 0 && !write_xm) { const float* tsf = (const float*)(C.ws + WS_TAB + 131072); const float sc = 1.0f + ((r >= 8192) ? tsf[12] : (PROBE_B >= 0 ? tsf[13] : 0.f));
#pragma unroll
                for (int j = 0; j < 4; ++j) v[u][j] = v[u][j] * sc; }
            if (!write_xm) {
#pragma unroll
                for (int j = 0; j < 4; ++j) *(f32x4*)(x + (size_t)r * DM + 4 * C.lane + 256 * j) = v[u][j];
            } else {
#pragma unroll
                for (int j = 0; j < 4; ++j) *(u32x2*)((bf16_t*)x + (size_t)r * DM + 4 * C.lane + 256 * j) = pack4(v[u][j]);
            }
            if (write_xm) {
                const float* mv = modl + row_mod(r) * 6144;
#pragma unroll
                for (int j = 0; j < 4; ++j) { const int c = 4 * C.lane + 256 * j; const f32x4 sc = *(const f32x4*)(mv + sc_off + c), sh = *(const f32x4*)(mv + sh_off + c);
                    *(u32x2*)(xm + (size_t)r * DM + c) = pack4(v[u][j] * (sc + 1.0f) + sh); }
            }
        }
    }
}

#define MFMA32(a, b, c) __builtin_amdgcn_mfma_f32_32x32x16_bf16((a), (b), (c), 0, 0, 0)
#define MFMA16(a, b, c) __builtin_amdgcn_mfma_f32_16x16x32_bf16((a), (b), (c), 0, 0, 0)
constexpr int AK_LD = 72, AV_LD = 136;
struct AttnSrc { const bf16_t* Klat; const bf16_t* Kctx; const bf16_t* VTlat; const bf16_t* VTctx; int ldv; int nst; int nlat; int h; };
template <int PASS>
DI void attn_pass(int tid, int q, int hi, int kq, const AttnSrc& A, LAS bf16_t* K1s, LAS bf16_t* K2s, LAS bf16_t* VTs, const bf16x8 (&q1)[4], const bf16x8 (&q2)[4],
                  float& m1, float& l1, float& m2, float& l2, float iL1, float iL2, f32x16 (&o)[4]) {
    u32x4 kreg[4], vreg[4];
    const int h = A.h;
    auto issue = [&](int st) {
        const bf16_t* kb = (st < A.nlat) ? A.Klat + (size_t)st * 128 * 512 : A.Kctx + (size_t)(st - A.nlat) * 128 * 512;
#pragma unroll
        for (int i = 0; i < 2; ++i) { const int id = tid + 512 * i, key = id >> 3, ch = id & 7; kreg[i] = *(const u32x4*)(kb + (size_t)key * 512 + h * 128 + ch * 8); kreg[2 + i] = *(const u32x4*)(kb + (size_t)key * 512 + h * 128 + 64 + ch * 8); }
        if (PASS == 1) {
            const bf16_t* vb = (st < A.nlat) ? A.VTlat + (size_t)st * 128 : A.VTctx + (size_t)(st - A.nlat) * 128; const int ld = (st < A.nlat) ? A.ldv : 256;
#pragma unroll
            for (int i = 0; i < 4; ++i) { const int id = tid + 512 * i, dv = id >> 4, ch = id & 15; vreg[i] = *(const u32x4*)(vb + (size_t)dv * ld + ch * 8); }
        }
    };
    issue(0);
    for (int st = 0; st < A.nst; ++st) {
        __syncthreads();
#pragma unroll
        for (int i = 0; i < 2; ++i) { const int id = tid + 512 * i, key = id >> 3, ch = id & 7; *(LAS u32x4*)(K1s + key * AK_LD + ch * 8) = kreg[i]; *(LAS u32x4*)(K2s + key * AK_LD + ch * 8) = kreg[2 + i]; }
        if (PASS == 1) {
#pragma unroll
            for (int i = 0; i < 4; ++i) { const int id = tid + 512 * i, dv = id >> 4, ch = id & 15; *(LAS u32x4*)(VTs + dv * AV_LD + ch * 8) = vreg[i]; }
        }
        __syncthreads();
        if (st + 1 < A.nst) issue(st + 1);
        const int keyrow = kq * 32 + q;
        f32x16 s1, pr;
#pragma unroll
        for (int r = 0; r < 16; ++r) s1[r] = 0.f;
#pragma unroll
        for (int ks = 0; ks < 4; ++ks) { const bf16x8 a1 = *(const LAS bf16x8*)(K1s + keyrow * AK_LD + 16 * ks + 8 * hi); s1 = MFMA32(a1, q1[ks], s1); }
        if (PASS == 0) {
            float mx1 = s1[0];
#pragma unroll
            for (int r = 1; r < 16; ++r) mx1 = fmaxf(mx1, s1[r]);
            const float n1 = fmaxf(m1, mx1); float a1s = 0.f;
#pragma unroll
            for (int r = 0; r < 16; ++r) a1s += __builtin_amdgcn_exp2f(s1[r] - n1);
            l1 = l1 * __builtin_amdgcn_exp2f(m1 - n1) + a1s; m1 = n1;
        } else {
#pragma unroll
            for (int r = 0; r < 16; ++r) pr[r] = __builtin_amdgcn_exp2f(s1[r] - m1) * iL1;
        }
#pragma unroll
        for (int r = 0; r < 16; ++r) s1[r] = 0.f;
#pragma unroll
        for (int ks = 0; ks < 4; ++ks) { const bf16x8 a2 = *(const LAS bf16x8*)(K2s + keyrow * AK_LD + 16 * ks + 8 * hi); s1 = MFMA32(a2, q2[ks], s1); }
        if (PASS == 0) {
            float mx2 = s1[0];
#pragma unroll
            for (int r = 1; r < 16; ++r) mx2 = fmaxf(mx2, s1[r]);
            const float n2 = fmaxf(m2, mx2); float a2s = 0.f;
#pragma unroll
            for (int r = 0; r < 16; ++r) a2s += __builtin_amdgcn_exp2f(s1[r] - n2);
            l2 = l2 * __builtin_amdgcn_exp2f(m2 - n2) + a2s; m2 = n2;
        } else {
#pragma unroll
            for (int r = 0; r < 16; ++r) pr[r] -= __builtin_amdgcn_exp2f(s1[r] - m2) * iL2;
            bf16x8 pb[2];
            { u32x4 t0, t1; t0.x = cvt_pk_bf16(pr[0], pr[1]); t0.y = cvt_pk_bf16(pr[2], pr[3]); t0.z = cvt_pk_bf16(pr[4], pr[5]); t0.w = cvt_pk_bf16(pr[6], pr[7]);
              t1.x = cvt_pk_bf16(pr[8], pr[9]); t1.y = cvt_pk_bf16(pr[10], pr[11]); t1.z = cvt_pk_bf16(pr[12], pr[13]); t1.w = cvt_pk_bf16(pr[14], pr[15]);
              pb[0] = __builtin_bit_cast(bf16x8, t0); pb[1] = __builtin_bit_cast(bf16x8, t1); }
#pragma unroll
            for (int blk = 0; blk < 4; ++blk)
#pragma unroll
                for (int s = 0; s < 2; ++s) {
                    const LAS bf16_t* vp = VTs + (blk * 32 + q) * AV_LD + kq * 32 + 16 * s + 4 * hi;
                    const s16x4 lo = *(const LAS s16x4*)vp, hh = *(const LAS s16x4*)(vp + 8);
                    const bf16x8 av = __builtin_shufflevector(lo, hh, 0, 1, 2, 3, 4, 5, 6, 7);
                    o[blk] = MFMA32(av, pb[s], o[blk]);
                }
        }
    }
}
DI void attn_unit(const Ctx& C, int layer, int uidx) {
    int tid = C.tid; asm volatile("" : "+v"(tid)); const int lane = tid & 63, w = __builtin_amdgcn_readfirstlane(tid >> 6), qg = w & 3, kh = w >> 2, q = lane & 15, g = lane >> 4;
    const bf16_t* Qb = (const bf16_t*)(C.ws + WS_Q); const bf16_t* Kb = (const bf16_t*)(C.ws + WS_K); const bf16_t* VT = (const bf16_t*)(C.ws + WS_V);
    const bf16_t* cK = (const bf16_t*)(C.ws + WS_CK); const bf16_t* cVT = (const bf16_t*)(C.ws + WS_CV);
    int b, h, rowq0; AttnSrc A;
    if (uidx < 512) { b = uidx >> 8; h = (uidx >> 6) & 3; const int qb = uidx & 63; rowq0 = 8192 + b * 4096 + qb * 64; A.nst = 34; A.nlat = 32; A.ldv = 4096;
        A.Klat = Kb + (size_t)(8192 + b * 4096) * 512; A.VTlat = VT + 4194304 + (size_t)((b * 4 + h) * 32) * 16384; A.Kctx = cK + (size_t)((layer * 2 + b) * 256) * 512; A.VTctx = cVT + (size_t)(((layer * 2 + b) * 4 + h) * 2) * 16384; }
    else { const int v = uidx - 512; b = v >> 4; h = (v >> 2) & 3; const int qb = v & 3; rowq0 = b * 256 + qb * 64; A.nst = 2; A.nlat = 2; A.ldv = 256;
        A.Klat = Kb + (size_t)(b * 256) * 512; A.VTlat = VT + (size_t)((b * 4 + h) * 2) * 16384; A.Kctx = A.Klat; A.VTctx = A.VTlat; }
    A.h = h;
    LAS bf16_t* K1s = (LAS bf16_t*)C.lds; LAS bf16_t* K2s = K1s + 128 * AK_LD; LAS bf16_t* VTs = K2s + 128 * AK_LD;
    const float lam = ((const float*)(C.ws + WS_TAB))[2048 + layer];
    bf16x8 qf1[2], qf2[2];
    { const bf16_t* qp = Qb + (size_t)(rowq0 + 16 * qg + q) * 512 + h * 128 + 8 * g;
#pragma unroll
      for (int ks = 0; ks < 2; ++ks) { qf1[ks] = *(const bf16x8*)(qp + 32 * ks); qf2[ks] = *(const bf16x8*)(qp + 64 + 32 * ks); } }
    float m1 = -1e30f, l1 = 0.f, m2 = -1e30f, l2 = 0.f;
    f32x4 O1[8], O2[8];
#pragma unroll
    for (int t = 0; t < 8; ++t) { O1[t] = (f32x4){0.f, 0.f, 0.f, 0.f}; O2[t] = O1[t]; }
    u32x4 kreg[4], vreg[4];
    auto issue = [&](int st) {
        const bf16_t* kb = (st < A.nlat) ? A.Klat + (size_t)st * 128 * 512 : A.Kctx + (size_t)(st - A.nlat) * 128 * 512;
#pragma unroll
        for (int i = 0; i < 2; ++i) { const int id = tid + 512 * i, key = id >> 3, ch = id & 7; kreg[i] = *(const u32x4*)(kb + (size_t)key * 512 + h * 128 + ch * 8); kreg[2 + i] = *(const u32x4*)(kb + (size_t)key * 512 + h * 128 + 64 + ch * 8); }
        const bf16_t* vb = (st < A.nlat) ? A.VTlat + (size_t)st * 16384 : A.VTctx + (size_t)(st - A.nlat) * 16384;
#pragma unroll
        for (int i = 0; i < 4; ++i) { const int id = tid + 512 * i; vreg[i] = *(const u32x4*)(vb + (size_t)id * 8); }
    };
    issue(0);
    for (int st = 0; st < A.nst; ++st) {
        __syncthreads();
#pragma unroll
        for (int i = 0; i < 2; ++i) { const int id = tid + 512 * i, key = id >> 3, ch = id & 7; *(LAS u32x4*)(K1s + key * AK_LD + ch * 8) = kreg[i]; *(LAS u32x4*)(K2s + key * AK_LD + ch * 8) = kreg[2 + i]; }
#pragma unroll
        for (int i = 0; i < 4; ++i) { const int id = tid + 512 * i, dv = id >> 4, ch = id & 15; *(LAS u32x4*)(VTs + dv * AV_LD + ch * 8) = vreg[i]; }
        __syncthreads();
        if (st + 1 < A.nst) issue(st + 1);
#pragma unroll
        for (int kb = 0; kb < 2; ++kb) {
            const int key0 = kh * 64 + kb * 32;
            f32x4 sA0 = {0.f, 0.f, 0.f, 0.f}, sA1 = sA0, sB0 = sA0, sB1 = sA0;
#pragma unroll
            for (int ks = 0; ks < 2; ++ks) {
                const bf16x8 a10 = *(const LAS bf16x8*)(K1s + (key0 + q) * AK_LD + 32 * ks + 8 * g), a11 = *(const LAS bf16x8*)(K1s + (key0 + 16 + q) * AK_LD + 32 * ks + 8 * g);
                const bf16x8 a20 = *(const LAS bf16x8*)(K2s + (key0 + q) * AK_LD + 32 * ks + 8 * g), a21 = *(const LAS bf16x8*)(K2s + (key0 + 16 + q) * AK_LD + 32 * ks + 8 * g);
                sA0 = MFMA16(a10, qf1[ks], sA0); sA1 = MFMA16(a11, qf1[ks], sA1); sB0 = MFMA16(a20, qf2[ks], sB0); sB1 = MFMA16(a21, qf2[ks], sB1);
            }
            float t1 = fmaxf(fmaxf(fmaxf(sA0[0], sA0[1]), fmaxf(sA0[2], sA0[3])), fmaxf(fmaxf(sA1[0], sA1[1]), fmaxf(sA1[2], sA1[3])));
            float t2 = fmaxf(fmaxf(fmaxf(sB0[0], sB0[1]), fmaxf(sB0[2], sB0[3])), fmaxf(fmaxf(sB1[0], sB1[1]), fmaxf(sB1[2], sB1[3])));
            if (__any(t1 > m1 || t2 > m2)) {
                t1 = fmaxf(t1, __shfl_xor(t1, 16)); t1 = fmaxf(t1, __shfl_xor(t1, 32)); t2 = fmaxf(t2, __shfl_xor(t2, 16)); t2 = fmaxf(t2, __shfl_xor(t2, 32));
                const float n1 = fmaxf(m1, t1), n2 = fmaxf(m2, t2); const float f1 = __builtin_amdgcn_exp2f(m1 - n1), f2 = __builtin_amdgcn_exp2f(m2 - n2);
                l1 *= f1; l2 *= f2; m1 = n1; m2 = n2;
#pragma unroll
                for (int t = 0; t < 8; ++t) { O1[t] = O1[t] * f1; O2[t] = O2[t] * f2; }
            }
            f32x4 pA0, pA1, pB0, pB1;
#pragma unroll
            for (int i = 0; i < 4; ++i) { pA0[i] = __builtin_amdgcn_exp2f(sA0[i] - m1); pA1[i] = __builtin_amdgcn_exp2f(sA1[i] - m1); pB0[i] = __builtin_amdgcn_exp2f(sB0[i] - m2); pB1[i] = __builtin_amdgcn_exp2f(sB1[i] - m2); }
            l1 += (pA0[0] + pA0[1]) + (pA0[2] + pA0[3]) + (pA1[0] + pA1[1]) + (pA1[2] + pA1[3]);
            l2 += (pB0[0] + pB0[1]) + (pB0[2] + pB0[3]) + (pB1[0] + pB1[1]) + (pB1[2] + pB1[3]);
            const bf16x8 pb1 = pack8(pA0, pA1), pb2 = pack8(pB0, pB1);
#pragma unroll
            for (int t = 0; t < 8; ++t) {
                const LAS bf16_t* vp = VTs + (16 * t + q) * AV_LD + key0 + 4 * g;
                const s16x4 lo = *(const LAS s16x4*)vp, hh = *(const LAS s16x4*)(vp + 16);
                const bf16x8 av = __builtin_shufflevector(lo, hh, 0, 1, 2, 3, 4, 5, 6, 7);
                O1[t] = MFMA16(av, pb1, O1[t]); O2[t] = MFMA16(av, pb2, O2[t]);
            }
        }
    }
    l1 += __shfl_xor(l1, 16); l1 += __shfl_xor(l1, 32); l2 += __shfl_xor(l2, 16); l2 += __shfl_xor(l2, 32);
    __syncthreads();
    LAS float* comb = (LAS float*)C.lds;
    LAS float* exs = (LAS float*)(C.lds + 65536);
    if (kh == 1) {
#pragma unroll
        for (int t = 0; t < 8; ++t)
#pragma unroll
            for (int i = 0; i < 4; ++i) { comb[(qg * 64 + t * 4 + i) * 64 + lane] = O1[t][i]; comb[(qg * 64 + 32 + t * 4 + i) * 64 + lane] = O2[t][i]; }
        exs[(qg * 4 + 0) * 64 + lane] = m1; exs[(qg * 4 + 1) * 64 + lane] = l1; exs[(qg * 4 + 2) * 64 + lane] = m2; exs[(qg * 4 + 3) * 64 + lane] = l2;
    }
    __syncthreads();
    if (kh == 0) {
        const float om1 = exs[(qg * 4 + 0) * 64 + lane], ol1 = exs[(qg * 4 + 1) * 64 + lane], om2 = exs[(qg * 4 + 2) * 64 + lane], ol2 = exs[(qg * 4 + 3) * 64 + lane];
        const float n1 = fmaxf(m1, om1), n2 = fmaxf(m2, om2);
        const float fa1 = __builtin_amdgcn_exp2f(m1 - n1), fb1 = __builtin_amdgcn_exp2f(om1 - n1), fa2 = __builtin_amdgcn_exp2f(m2 - n2), fb2 = __builtin_amdgcn_exp2f(om2 - n2);
        const float L1 = l1 * fa1 + ol1 * fb1, L2 = l2 * fa2 + ol2 * fb2;
        const float c1a = fa1 / L1, c1b = fb1 / L1, c2a = lam * fa2 / L2, c2b = lam * fb2 / L2;
        float ss = 0.f;
#pragma unroll
        for (int t = 0; t < 8; ++t)
#pragma unroll
            for (int i = 0; i < 4; ++i) { const float v = O1[t][i] * c1a + comb[(qg * 64 + t * 4 + i) * 64 + lane] * c1b - O2[t][i] * c2a - comb[(qg * 64 + 32 + t * 4 + i) * 64 + lane] * c2b; O1[t][i] = v; ss += v * v; }
        ss += __shfl_xor(ss, 16); ss += __shfl_xor(ss, 32);
        const float lam_init = 0.8f - 0.6f * __expf(-0.3f * (float)layer);
        const float sc = (1.0f / sqrtf(ss * (1.0f / 128.0f) + RMS_EPS)) * (1.0f - lam_init);
        const float* dn = C.p->in[18] + layer * 128;
        bf16_t* ob = (bf16_t*)(C.ws + WS_O) + (size_t)(rowq0 + 16 * qg + q) * DM + h * 128;
#pragma unroll
        for (int t = 0; t < 8; ++t) { const int dv = 16 * t + 4 * g; const f32x4 d4 = *(const f32x4*)(dn + dv); *(u32x2*)(ob + dv) = pack4(O1[t] * sc * d4); }
    }
    __syncthreads();
}

DI void delta_prep_unit(const Ctx& C, int layer, int unit) {
    const Params& p = *C.p; int tid = C.tid; asm volatile("" : "+v"(tid)); const int lane = tid & 63, w = __builtin_amdgcn_readfirstlane(tid >> 6);
    const int tc = unit >> 2, h = unit & 3, row0 = tc * 64;
    int ci, nch; if (tc < 128) { ci = tc & 3; nch = 4; } else { ci = (tc - 128) & 63; nch = 64; }
    const bool has_prev = ci > 0, has_next = ci < nch - 1;
    float* qs = C.L; float* kk = C.L + 4160; float* vv = C.L + 8320; float* KK0 = C.L + 12480; float* QK0 = KK0 + 4096; float* Ms = QK0 + 4096; float* bc = Ms + 8192; float* be = bc + 128;
    const bf16_t* zb = (const bf16_t*)(C.ws + WS_ZB);
    const float* cw = p.in[11] + layer * 3 * 768;
    __syncthreads();
    if (tid < 384) {
        const int c = tid % 192, th = tid / 192, which = c >> 6, d = c & 63, col = which * 256 + h * 64 + d;
        const float w0 = cw[col], w1 = cw[768 + col], w2 = cw[1536 + col];
        float xin[34];
#pragma unroll
        for (int i = 0; i < 34; ++i) { const int tt = 32 * th - 1 + i; const bool ok = (tt >= 0 || has_prev) && (tt < 64 || has_next); xin[i] = ok ? bf2f(zb[(size_t)(row0 + tt) * ZLD + col]) : 0.f; }
        float* dstp = (which == 0 ? qs : (which == 1 ? kk : vv)) + d;
#pragma unroll
        for (int i = 0; i < 32; ++i) dstp[(32 * th + i) * 65] = siluf_(w0 * xin[i] + w1 * xin[i + 1] + w2 * xin[i + 2]);
    }
    __syncthreads();
    { const int r = tid >> 2, part = tid & 3; float* base = (r < 64 ? qs + r * 65 : kk + (r - 64) * 65) + part * 16; float ss = 0.f;
#pragma unroll
      for (int i = 0; i < 16; ++i) ss += base[i] * base[i];
      ss += __shfl_xor(ss, 1); ss += __shfl_xor(ss, 2);
      const float sc = (1.0f / sqrtf(ss + 1e-6f)) * (r < 64 ? 0.125f : 1.0f);
#pragma unroll
      for (int i = 0; i < 16; ++i) base[i] *= sc; }
    if (w < 2) {
        const int dir = w, i = lane, tt = dir ? 63 - i : i; const size_t row = (size_t)(row0 + tt);
        const float braw = bf2f(zb[row * ZLD + ZB_BBETA + dir * 4 + h]), araw = bf2f(zb[row * ZLD + ZB_BA + dir * 4 + h]);
        const float A = __expf(p.in[12][layer * 8 + dir * 4 + h]); const float x = araw + p.in[13][layer * 8 + dir * 4 + h];
        const float sp = x > 20.f ? x : log1pf(__expf(x)); float g = -A * sp;
#pragma unroll
        for (int off = 1; off < 64; off <<= 1) { const float t = __shfl_up(g, off); if (lane >= off) g += t; }
        bc[dir * 64 + i] = g; const float bt = sigmoidf_(braw); be[dir * 64 + i] = bt; be[128 + dir * 64 + i] = bt * __expf(g);
    }
    __syncthreads();
    {
        const int rbm = w & 3, cb0 = (w >> 2) * 2, r16 = lane & 15, g4 = lane >> 4;
        bf16x8 kA[2], qA[2], kB[2][2];
#pragma unroll
        for (int ks = 0; ks < 2; ++ks) {
            const float* kp = kk + (16 * rbm + r16) * 65 + 32 * ks + 8 * g4; const float* qp = qs + (16 * rbm + r16) * 65 + 32 * ks + 8 * g4;
            kA[ks] = pack8((f32x4){kp[0], kp[1], kp[2], kp[3]}, (f32x4){kp[4], kp[5], kp[6], kp[7]});
            qA[ks] = pack8((f32x4){qp[0], qp[1], qp[2], qp[3]}, (f32x4){qp[4], qp[5], qp[6], qp[7]});
#pragma unroll
            for (int c = 0; c < 2; ++c) { const float* bp = kk + (16 * (cb0 + c) + r16) * 65 + 32 * ks + 8 * g4;
                kB[c][ks] = pack8((f32x4){bp[0], bp[1], bp[2], bp[3]}, (f32x4){bp[4], bp[5], bp[6], bp[7]}); }
        }
#pragma unroll
        for (int c = 0; c < 2; ++c) {
            f32x4 ak = {0.f, 0.f, 0.f, 0.f}, aq = ak;
#pragma unroll
            for (int ks = 0; ks < 2; ++ks) { ak = MFMA16(kA[ks], kB[c][ks], ak); aq = MFMA16(qA[ks], kB[c][ks], aq); }
#pragma unroll
            for (int i = 0; i < 4; ++i) { const int o = (16 * rbm + 4 * g4 + i) * 64 + 16 * (cb0 + c) + r16; KK0[o] = ak[i]; QK0[o] = aq[i]; }
        }
    }
    __syncthreads();
    bf16_t* dpW = (bf16_t*)(C.ws + WS_DPW); bf16_t* dpQD = (bf16_t*)(C.ws + WS_DPQD); bf16_t* dpQK = (bf16_t*)(C.ws + WS_DPQK); bf16_t* dpKD = (bf16_t*)(C.ws + WS_DPKD); bf16_t* dpU = (bf16_t*)(C.ws + WS_DPU);
    float* dpGL = (float*)(C.ws + WS_GL);
    { const int i = tid >> 3, j0 = (tid & 7) * 8;
#pragma unroll
      for (int dir = 0; dir < 2; ++dir) {
          const size_t ud = ((size_t)tc * 4 + h) * 2 + dir;
          const float bi = bc[dir * 64 + i], betai = be[dir * 64 + i]; const int ai = dir ? 63 - i : i;
#pragma unroll
          for (int jj = 0; jj < 8; ++jj) { const int j = j0 + jj, aj = dir ? 63 - j : j;
              const float dec = (j <= i) ? __expf(bi - bc[dir * 64 + j]) : 0.f;
              Ms[dir * 4096 + j * 64 + i] = (j < i) ? betai * KK0[ai * 64 + aj] * dec : 0.f;
              dpQK[ud * 4096 + i * 64 + pinv(j)] = f2bf(QK0[ai * 64 + aj] * dec); }
      } }
    __syncthreads();
    if (w < 4) {
        const int dir = w >> 1, c = (w & 1) * 64 + lane; const size_t ud = ((size_t)tc * 4 + h) * 2 + dir;
        const float* Msd = Ms + dir * 4096; const bool isU = (w & 1) == 0; const float* scp = be + (isU ? 0 : 128) + dir * 64; const float* srcp = (isU ? vv : kk) + lane;
        float x[64];
#pragma unroll
        for (int rb = 0; rb < 4; ++rb) {
            float r[16];
#pragma unroll
            for (int ii = 0; ii < 16; ++ii) { const int i = 16 * rb + ii, tt = dir ? 63 - i : i; r[ii] = scp[i] * srcp[tt * 65]; }
            asm volatile("" ::: "memory");
#pragma unroll
            for (int j = 0; j < 16 * rb; ++j) {
                const float* mp = Msd + j * 64 + 16 * rb;
                const f32x4 ma = *(const f32x4*)mp, mb = *(const f32x4*)(mp + 4), mc = *(const f32x4*)(mp + 8), md = *(const f32x4*)(mp + 12);
                const float xj = x[j];
#pragma unroll
                for (int c4 = 0; c4 < 4; ++c4) { r[c4] -= ma[c4] * xj; r[4 + c4] -= mb[c4] * xj; r[8 + c4] -= mc[c4] * xj; r[12 + c4] -= md[c4] * xj; }
                if ((j & 3) == 3) asm volatile("" ::: "memory");
            }
#pragma unroll
            for (int jj = 0; jj < 16; ++jj) {
                const float xj = r[jj]; x[16 * rb + jj] = xj;
                const float* mp = Msd + (16 * rb + jj) * 64 + 16 * rb;
#pragma unroll
                for (int ii = jj + 1; ii < 16; ++ii) r[ii] -= mp[ii] * xj;
                if ((jj & 3) == 3) asm volatile("" ::: "memory");
            }
        }
        if (c < 64) {
            bf16_t* up = dpU + ud * 4096 + c * 64;
#pragma unroll
            for (int i = 0; i < 64; i += 8) { u32x4 o; o.x = cvt_pk_bf16(x[i], x[i + 1]); o.y = cvt_pk_bf16(x[i + 2], x[i + 3]); o.z = cvt_pk_bf16(x[i + 4], x[i + 5]); o.w = cvt_pk_bf16(x[i + 6], x[i + 7]); *(u32x4*)(up + i) = o; }
        } else {
            bf16_t* wp = dpW + ud * 4096 + pinv(c - 64);
#pragma unroll
            for (int i = 0; i < 64; ++i) wp[i * 64] = f2bf(x[i]);
        }
    } else {
#pragma unroll 4
        for (int it = 0; it < 64; ++it) {
            const int e = (tid - 256) + 256 * it, dir = e >> 13, which = (e >> 12) & 1, rem = e & 4095; const size_t ud = ((size_t)tc * 4 + h) * 2 + dir;
            if (which == 0) { const int i = rem >> 6, d = rem & 63, tt = dir ? 63 - i : i; dpQD[ud * 4096 + i * 64 + pinv(d)] = f2bf(qs[tt * 65 + d] * __expf(bc[dir * 64 + i])); }
            else { const int dk = rem >> 6, i = rem & 63, tt = dir ? 63 - i : i; dpKD[ud * 4096 + dk * 64 + pinv(i)] = f2bf(kk[tt * 65 + dk] * __expf(bc[dir * 64 + 63] - bc[dir * 64 + i])); }
        }
        if (tid == 256 || tid == 257) { const int dir = tid - 256; dpGL[((size_t)tc * 4 + h) * 2 + dir] = __expf(bc[dir * 64 + 63]); }
    }
}

DI void delta_scan_unit(const Ctx& C, int layer, bool sample, int b, int h) {
    const Params& p = *C.p; int tid = C.tid; asm volatile("" : "+v"(tid)); const int lane = tid & 63; const int w = C.wave, dir = w >> 2, sl = w & 3, col = lane & 15, g = lane >> 4;
    const int tc0 = sample ? 128 + b * 64 : b * 4, nch = sample ? 64 : 4;
    const bf16_t* dpU = (const bf16_t*)(C.ws + WS_DPU);
    const float* dpGL = (const float*)(C.ws + WS_GL); float* od = (float*)(C.ws + WS_OD) + (size_t)dir * MROWS * 256;
    f32x4 S[4];
    if (sample) { const float* s0 = p.in[4] + ((((size_t)b * 4 + layer) * 2 + dir) * 4 + h) * 4096;
#pragma unroll
        for (int rb = 0; rb < 4; ++rb)
#pragma unroll
            for (int ii = 0; ii < 4; ++ii) S[rb][ii] = s0[(16 * rb + 4 * g + ii) * 64 + 16 * sl + col]; }
    else {
#pragma unroll
        for (int rb = 0; rb < 4; ++rb) S[rb] = (f32x4){0.f, 0.f, 0.f, 0.f}; }
    u32x4 Ra[8], Rb[8];
#define DS_TC(d_, n_) ((d_) ? tc0 + nch - 1 - (n_) : tc0 + (n_))
#define DS_ISSUE(R, n_) do { _Pragma("unroll") for (int i = 0; i < 8; ++i) { const int id = tid + 512 * i, dm = id >> 9, dd = dm >> 2, mat = dm & 3; \
        const size_t ud_ = ((size_t)DS_TC(dd, n_) * 4 + h) * 2 + dd; R[i] = *(const u32x4*)(C.ws + WS_DPW + (size_t)mat * (16u * MiB) + ud_ * 8192 + (size_t)(id & 511) * 16); } } while (0)
#define DS_WRITE(R, buf_) do { _Pragma("unroll") for (int i = 0; i < 8; ++i) { const int id = tid + 512 * i, dm = id >> 9, row = (id >> 3) & 63, c = id & 7; \
        *(LAS u32x4*)(C.lds + (buf_) * 65536 + dm * 8192 + row * 128 + ((c ^ (row & 7)) * 16)) = R[i]; } } while (0)
#define DS_FRAG(buf_, mat_, rb_, ks_) (*(const LAS bf16x8*)(C.lds + (buf_) * 65536 + (dir * 4 + (mat_)) * 8192 + (16 * (rb_) + col) * 128 + ((((ks_) * 4 + g) ^ (col & 7)) * 16)))
    __syncthreads();
    DS_ISSUE(Ra, 0); DS_WRITE(Ra, 0); DS_ISSUE(Ra, 1);
    s16x4 uuA[4], uuB[4]; float glA, glB;
#define DS_LOADU(uu, gl, n_) do { const size_t ud_ = ((size_t)DS_TC(dir, n_) * 4 + h) * 2 + dir; _Pragma("unroll") for (int rb = 0; rb < 4; ++rb) uu[rb] = *(const s16x4*)(dpU + ud_ * 4096 + (16 * sl + col) * 64 + 16 * rb + 4 * g); gl = dpGL[ud_]; } while (0)
    DS_LOADU(uuA, glA, 0); DS_LOADU(uuB, glB, 1);
    __syncthreads();
#define DS_STEP(n, buf, Rnext, Rcur, uu, gl) do { \
        if ((n) + 2 < nch) DS_ISSUE(Rnext, (n) + 2); \
        const int tc = DS_TC(dir, (n)); \
        bf16x8 Sb[2]; Sb[0] = pack8(S[0], S[1]); Sb[1] = pack8(S[2], S[3]); \
        f32x4 vn[4]; \
        _Pragma("unroll") for (int rb = 0; rb < 4; ++rb) { f32x4 t = (f32x4){0.f, 0.f, 0.f, 0.f}; t = MFMA16(DS_FRAG(buf, 0, rb, 0), Sb[0], t); t = MFMA16(DS_FRAG(buf, 0, rb, 1), Sb[1], t); \
            _Pragma("unroll") for (int ii = 0; ii < 4; ++ii) vn[rb][ii] = bf2f((bf16_t)uu[rb][ii]) - t[ii]; } \
        const float glc = gl; \
        if ((n) + 2 < nch) DS_LOADU(uu, gl, (n) + 2); \
        bf16x8 vb[2]; vb[0] = pack8(vn[0], vn[1]); vb[1] = pack8(vn[2], vn[3]); \
        const int rowb = tc * 64; \
        _Pragma("unroll") for (int rb = 0; rb < 4; ++rb) { f32x4 o = (f32x4){0.f, 0.f, 0.f, 0.f}; o = MFMA16(DS_FRAG(buf, 1, rb, 0), Sb[0], o); o = MFMA16(DS_FRAG(buf, 1, rb, 1), Sb[1], o); o = MFMA16(DS_FRAG(buf, 2, rb, 0), vb[0], o); o = MFMA16(DS_FRAG(buf, 2, rb, 1), vb[1], o); \
            _Pragma("unroll") for (int ii = 0; ii < 4; ++ii) { const int i = 16 * rb + 4 * g + ii; const int tt = dir ? 63 - i : i; od[(size_t)(rowb + tt) * 256 + h * 64 + 16 * sl + col] = o[ii]; } } \
        _Pragma("unroll") for (int rb = 0; rb < 4; ++rb) { f32x4 sn = S[rb] * glc; sn = MFMA16(DS_FRAG(buf, 3, rb, 0), vb[0], sn); sn = MFMA16(DS_FRAG(buf, 3, rb, 1), vb[1], sn); S[rb] = sn; } \
        if ((n) + 1 < nch) DS_WRITE(Rcur, (buf) ^ 1); \
        __syncthreads(); } while (0)
    for (int n = 0; n < nch; n += 2) {
        DS_STEP(n, 0, Rb, Ra, uuA, glA);
        DS_STEP(n + 1, 1, Ra, Rb, uuB, glB);
    }
#undef DS_STEP
#undef DS_TC
#undef DS_ISSUE
#undef DS_WRITE
#undef DS_FRAG
#undef DS_LOADU
    if (!sample) { float* so = C.out + OUT_SD + ((((size_t)b * 4 + layer) * 2 + dir) * 4 + h) * 4096;
#pragma unroll
        for (int rb = 0; rb < 4; ++rb)
#pragma unroll
            for (int ii = 0; ii < 4; ++ii) so[(16 * rb + 4 * g + ii) * 64 + 16 * sl + col] = S[rb][ii]; }
}

DI float hgrn_forget(const bf16_t* zb, size_t row, int dir, int h, int d, float lb) { const float x = bf2f(zb[row * ZLD + ZB_CF + dir * 256 + h * 64 + d]); return lb + (1.0f - lb) * sigmoidf_(x); }
DI void hgrn_local_unit(const Ctx& C, int layer, int unit) {
    int lane = C.lane; asm volatile("" : "+v"(lane)); const int dir = unit & 1, h = (unit >> 1) & 3, tc = unit >> 3, row0 = tc * 64, ep = lane & 31, dh = lane >> 5;
    const bf16_t* zb = (const bf16_t*)(C.ws + WS_ZB);
    float* fs = C.L + C.wave * 2048; float* qs2 = fs + 1024;
    bf16_t* oloc = (bf16_t*)(C.ws + WS_XM + 16 * MiB) + (size_t)dir * MROWS * 256;
    bf16_t* qdb = (bf16_t*)((unsigned char*)C.out + 32 * MiB) + (size_t)dir * MROWS * 256;
    const float lb = ((const float*)(C.ws + WS_TAB))[4096 + (dir * 4 + layer) * 256 + h * 64 + lane];
    f32x2 S[32];
#pragma unroll
    for (int k = 0; k < 32; ++k) S[k] = (f32x2){0.f, 0.f};
    float Dl = 1.0f;
    bf16_t rf[16], rq[16]; unsigned rv[16];
#define HL_LOAD(sb_) do { _Pragma("unroll") for (int i = 0; i < 16; ++i) { const int ti = (sb_) * 16 + i, tt = dir ? 63 - ti : ti; const size_t row = (size_t)(row0 + tt); \
        rf[i] = zb[row * ZLD + ZB_CF + dir * 256 + h * 64 + lane]; rq[i] = zb[row * ZLD + ZB_CQ + h * 64 + lane]; rv[i] = *(const unsigned*)(zb + row * ZLD + ZB_CI + h * 64 + 2 * ep); } } while (0)
    HL_LOAD(0);
    for (int sb = 0; sb < 4; ++sb) {
        f32x2 vr[16];
#pragma unroll
        for (int i = 0; i < 16; ++i) { const int ti = sb * 16 + i, tt = dir ? 63 - ti : ti; const size_t row = (size_t)(row0 + tt);
            const float f = lb + (1.0f - lb) * sigmoidf_(bf2f(rf[i])); const float qv = siluf_(bf2f(rq[i]));
            fs[i * 64 + lane] = f; qs2[i * 64 + lane] = qv; Dl *= f; qdb[row * 256 + h * 64 + lane] = f2bf(qv * Dl);
            vr[i] = (f32x2){__uint_as_float(rv[i] << 16), __uint_as_float(rv[i] & 0xffff0000u)}; }
        if (sb + 1 < 4) HL_LOAD(sb + 1);
        __builtin_amdgcn_wave_barrier();
#pragma unroll
        for (int i = 0; i < 16; ++i) { const f32x2 v = vr[i]; f32x2 osa = {0.f, 0.f}, osb = {0.f, 0.f};
#pragma unroll
            for (int k = 0; k < 32; k += 4) { const f32x4 f4 = *(const f32x4*)(fs + i * 64 + 32 * dh + k), q4 = *(const f32x4*)(qs2 + i * 64 + 32 * dh + k);
#pragma unroll
                for (int c = 0; c < 4; ++c) { S[k + c] = (S[k + c] - v) * f4[c] + v; if (c & 1) osb += S[k + c] * q4[c]; else osa += S[k + c] * q4[c]; }
                if ((k & 15) == 12) asm volatile("" ::: "memory"); }
            f32x2 os = osa + osb;
            os.x += __shfl_xor(os.x, 32); os.y += __shfl_xor(os.y, 32);
            const int ti = sb * 16 + i, tt = dir ? 63 - ti : ti;
            if (dh == 0) *(unsigned*)(oloc + (size_t)(row0 + tt) * 256 + h * 64 + 2 * ep) = cvt_pk_bf16(os.x, os.y);
            asm volatile("" ::: "memory"); }
        __builtin_amdgcn_wave_barrier();
    }
#undef HL_LOAD
    float* hs = (float*)(C.ws + WS_HS) + (size_t)unit * 4096;
#pragma unroll
    for (int k = 0; k < 32; ++k) *(f32x2*)(hs + (32 * dh + k) * 64 + 2 * ep) = S[k];
    ((float*)(C.ws + WS_HD))[(size_t)unit * 64 + lane] = Dl;
}
DI void hgrn_scan_unit(const Ctx& C, int layer, bool sample, int b, int h, int dir) {
    const Params& p = *C.p; int tid = C.tid; asm volatile("" : "+v"(tid)); const int tc0 = sample ? 128 + b * 64 : b * 4, nch = sample ? 64 : 4;
    float* HS = (float*)(C.ws + WS_HS); const float* HD = (const float*)(C.ws + WS_HD);
    f32x4 S0, S1;
    if (sample) { const float* s0 = p.in[5] + ((((size_t)b * 4 + layer) * 2 + dir) * 4 + h) * 4096 + tid * 8; S0 = *(const f32x4*)s0; S1 = *(const f32x4*)(s0 + 4); }
    else { float z_ = 0.f; asm volatile("" : "+v"(z_)); S0 = (f32x4){z_, z_, z_, z_}; S1 = S0; }
    for (int n0 = 0; n0 < nch; n0 += 4) {
        f32x4 la[4], lb[4]; float Dd[4];
#pragma unroll
        for (int k = 0; k < 4; ++k) { const int tc = dir ? tc0 + nch - 1 - (n0 + k) : tc0 + n0 + k; const size_t uh = ((size_t)tc * 4 + h) * 2 + dir;
            const float* hp = HS + uh * 4096 + tid * 8; la[k] = *(const f32x4*)hp; lb[k] = *(const f32x4*)(hp + 4); Dd[k] = HD[uh * 64 + (tid >> 3)]; }
#pragma unroll
        for (int k = 0; k < 4; ++k) { const int tc = dir ? tc0 + nch - 1 - (n0 + k) : tc0 + n0 + k; const size_t uh = ((size_t)tc * 4 + h) * 2 + dir;
            float* hp = HS + uh * 4096 + tid * 8; *(f32x4*)hp = S0; *(f32x4*)(hp + 4) = S1; S0 = S0 * Dd[k] + la[k]; S1 = S1 * Dd[k] + lb[k]; }
    }
    if (!sample) { float* so = C.out + OUT_SH + ((((size_t)b * 4 + layer) * 2 + dir) * 4 + h) * 4096 + tid * 8; *(f32x4*)so = S0; *(f32x4*)(so + 4) = S1; }
}
DI void hgrn_final_unit(const Ctx& C, int layer, int tc) {
    const Params& p = *C.p; int lane = C.lane; asm volatile("" : "+v"(lane)); const int w = C.wave, h = w >> 1, chh = w & 1, r16 = lane & 15, g4 = lane >> 4, row0 = tc * 64;
    const bf16_t* zb = (const bf16_t*)(C.ws + WS_ZB); const float* HS = (const float*)(C.ws + WS_HS);
    const bf16_t* oloc = (const bf16_t*)(C.ws + WS_XM + 16 * MiB); const bf16_t* qdb = (const bf16_t*)((const unsigned char*)C.out + 32 * MiB);
    float* otile = C.L;
    __syncthreads();
    f32x4 acc[4][2];
#pragma unroll
    for (int rb = 0; rb < 4; ++rb) { acc[rb][0] = (f32x4){0.f, 0.f, 0.f, 0.f}; acc[rb][1] = acc[rb][0]; }
#pragma unroll
    for (int dir = 0; dir < 2; ++dir) {
        const size_t uh = ((size_t)tc * 4 + h) * 2 + dir;
        bf16x8 Bf[2][2];
#pragma unroll
        for (int cb = 0; cb < 2; ++cb)
#pragma unroll
            for (int ks = 0; ks < 2; ++ks) { const float* sp = HS + uh * 4096 + (size_t)(32 * ks + 8 * g4) * 64 + 32 * chh + 16 * cb + r16;
                Bf[cb][ks] = pack8((f32x4){sp[0], sp[64], sp[128], sp[192]}, (f32x4){sp[256], sp[320], sp[384], sp[448]}); }
#pragma unroll
        for (int rb = 0; rb < 4; ++rb)
#pragma unroll
            for (int ks = 0; ks < 2; ++ks) { const bf16x8 Af = *(const bf16x8*)(qdb + (size_t)dir * MROWS * 256 + (size_t)(row0 + 16 * rb + r16) * 256 + h * 64 + 32 * ks + 8 * g4);
                acc[rb][0] = MFMA16(Af, Bf[0][ks], acc[rb][0]); acc[rb][1] = MFMA16(Af, Bf[1][ks], acc[rb][1]); }
    }
#pragma unroll
    for (int rb = 0; rb < 4; ++rb)
#pragma unroll
        for (int cb = 0; cb < 2; ++cb)
#pragma unroll
            for (int i = 0; i < 4; ++i) { const int t = 16 * rb + 4 * g4 + i, e = 32 * chh + 16 * cb + r16; const size_t ix = (size_t)(row0 + t) * 256 + h * 64 + e;
                otile[(h * 64 + t) * 64 + e] = acc[rb][cb][i] + bf2f(oloc[ix]) + bf2f(oloc[(size_t)MROWS * 256 + ix]); }
    __syncthreads();
    bf16_t* ob = (bf16_t*)(C.ws + WS_O);
    const float ng = p.in[16][layer * 64 + lane];
    bf16_t gts[32];
#pragma unroll
    for (int rr = 0; rr < 32; ++rr) { const int idx = w * 32 + rr, hh = idx >> 6, tt = idx & 63; gts[rr] = zb[(size_t)(row0 + tt) * ZLD + ZB_CG + hh * 64 + lane]; }
#pragma unroll
    for (int rr = 0; rr < 32; ++rr) { const int idx = w * 32 + rr, hh = idx >> 6, tt = idx & 63; const size_t row = (size_t)(row0 + tt);
        const float v = otile[(hh * 64 + tt) * 64 + lane]; const float ss = wave_sum(v * v);
        const float gt = siluf_(bf2f(gts[rr]));
        ob[row * DM + 768 + hh * 64 + lane] = f2bf(v * (1.0f / sqrtf(ss * (1.0f / 64.0f) + RMS_EPS)) * ng * gt); }
}
DI void delta_combine(const Ctx& C, int layer) {
    const Params& p = *C.p; const bf16_t* zb = (const bf16_t*)(C.ws + WS_ZB); const float* od = (const float*)(C.ws + WS_OD); bf16_t* ob = (bf16_t*)(C.ws + WS_O);
    const float ng = p.in[14][layer * 64 + C.lane];
    for (int it0 = C.gw * 4; it0 < MROWS * 4; it0 += C.NGW * 4) {
        float v[4]; bf16_t gr[4];
#pragma unroll
        for (int k = 0; k < 4; ++k) { const int it = it0 + k, h = it & 3; const size_t row = (size_t)(it >> 2);
            v[k] = od[row * 256 + h * 64 + C.lane] + od[(size_t)MROWS * 256 + row * 256 + h * 64 + C.lane]; gr[k] = zb[row * ZLD + ZB_BG + h * 64 + C.lane]; }
#pragma unroll
        for (int k = 0; k < 4; ++k) { const int it = it0 + k, h = it & 3; const size_t row = (size_t)(it >> 2);
            const float ss = wave_sum(v[k] * v[k]); const float gt = siluf_(bf2f(gr[k]));
            ob[row * DM + 512 + h * 64 + C.lane] = f2bf(v[k] * (1.0f / sqrtf(ss * (1.0f / 64.0f) + RMS_EPS)) * ng * gt); }
    }
}

#define XB_TMO      128
#define XB_XCNT(j)  (256  + 64 * (j))
#define XB_XSUB(j)  (1280 + 64 * (j))
#define XB_XGEN(j)  (2304 + 64 * (j))
#define XB_TOP      3328
#define XB_TOPGEN   3392
#define XB_SPIN_CAP (1u << 22)
DI unsigned xb_ld(unsigned* p)              { return __hip_atomic_load(p, __ATOMIC_RELAXED, __HIP_MEMORY_SCOPE_AGENT); }
DI unsigned xb_add(unsigned* p, unsigned v) { return __hip_atomic_fetch_add(p, v, __ATOMIC_RELAXED, __HIP_MEMORY_SCOPE_AGENT); }
DI unsigned xb_xcc_id() { return (unsigned)__builtin_amdgcn_s_getreg((3 << 11) | 20) & 0xFu; }
#define XB_SPIN(cond, bar) do { unsigned _sp = 0; while (cond) { __builtin_amdgcn_s_sleep(1); \
    if ((++_sp & 255u) == 0u) { if (xb_ld(&(bar)[XB_TMO])) break; if (_sp > XB_SPIN_CAP) { atomicAdd(&(bar)[XB_TMO], 1u); break; } } } } while (0)
struct XcdBarrier { unsigned* bar; unsigned x; volatile LAS unsigned* st; };
DI void xcd_barrier_complete(unsigned* bar, unsigned x, unsigned& nloc, unsigned& nx) {
    const unsigned G = gridDim.x * gridDim.y * gridDim.z;
    unsigned sum, cnt, mine, sp = 0u;
    for (;;) {
        sum = 0u; cnt = 0u; mine = 0u;
#pragma unroll
        for (unsigned j = 0; j < 16; ++j) { const unsigned c = xb_ld(&bar[XB_XCNT(j)]); sum += c; cnt += (c > 0u) ? 1u : 0u; mine = (j == x) ? c : mine; }
        if (sum == G) break;
        __builtin_amdgcn_s_sleep(1);
        if ((++sp & 255u) == 0u) { if (xb_ld(&bar[XB_TMO])) break; if (sp > XB_SPIN_CAP) { atomicAdd(&bar[XB_TMO], 1u); break; } }
    }
    nloc = mine > 0u ? mine : 1u; nx = cnt > 0u ? cnt : 1u;
}
DI void xcd_barrier(const XcdBarrier& b) {
    asm volatile("s_waitcnt vmcnt(0)" ::: "memory");
    __syncthreads();
    if (threadIdx.x == 0) {
        unsigned* bar = b.bar;
        __builtin_amdgcn_s_waitcnt(0);
        unsigned nloc = b.st[0], nx = b.st[1];
        if (nloc == 0u) { xcd_barrier_complete(bar, b.x, nloc, nx); b.st[0] = nloc; b.st[1] = nx; }
        const unsigned old = xb_add(&bar[XB_XSUB(b.x)], 1u);
        const unsigned gen = old / nloc;
        if (old + 1u == (gen + 1u) * nloc) {
            __builtin_amdgcn_fence(__ATOMIC_RELEASE, "agent");
            asm volatile("s_waitcnt vmcnt(0)" ::: "memory");
            const unsigned og = xb_add(&bar[XB_TOP], 1u);
            const unsigned tg = og / nx;
            if (og + 1u == (tg + 1u) * nx) xb_add(&bar[XB_TOPGEN], 1u);
            else XB_SPIN(xb_ld(&bar[XB_TOPGEN]) == tg, bar);
            __builtin_amdgcn_fence(__ATOMIC_ACQUIRE, "agent");
            xb_add(&bar[XB_XGEN(b.x)], 1u);
            asm volatile("s_waitcnt vmcnt(0)" ::: "memory");
        } else {
            XB_SPIN(xb_ld(&bar[XB_XGEN(b.x)]) == gen, bar);
            __builtin_amdgcn_fence(__ATOMIC_ACQUIRE, "agent");
            asm volatile("s_waitcnt vmcnt(0)" ::: "memory");
        }
    }
    __syncthreads();
}

DI void probe_stamp(unsigned char* ws, int cls) {
    if (PROBE_A >= 0 && blockIdx.x == 0 && threadIdx.x == 0) {
        volatile float* tsf = (volatile float*)(ws + WS_TAB + 131072); volatile unsigned long long* tsl = (volatile unsigned long long*)(ws + WS_TAB + 131072 + 256);
        const unsigned long long now = __builtin_amdgcn_s_memrealtime(); tsf[cls] += (float)(now - tsl[0]); tsl[0] = now; }
}
template <unsigned PHM_>
__global__ void __launch_bounds__(512) fwd_megakernel(Params p) {
    extern __shared__ __attribute__((aligned(16))) unsigned char lds_raw[];
    XcdBarrier xbar; xbar.bar = (unsigned*)(p.ws + WS_CTL) + 1024; xbar.x = xb_xcc_id(); xbar.st = (volatile LAS unsigned*)((LAS unsigned char*)lds_raw + 147400);
    if (threadIdx.x == 0) { xbar.st[0] = 0u; xbar.st[1] = 0u; (void)xb_add(&xbar.bar[XB_XCNT(xbar.x)], 1u); }
    __syncthreads();
    for (int ph = p.ph_lo; ph < p.ph_hi; ++ph) {
        if (PROBE_A >= 0 && blockIdx.x == 0 && threadIdx.x == 0) {
            volatile float* tsf = (volatile float*)(p.ws + WS_TAB + 131072); volatile unsigned long long* tsl = (volatile unsigned long long*)(p.ws + WS_TAB + 131072 + 256);
            const unsigned long long now = __builtin_amdgcn_s_memrealtime();
            if (ph == 0) { for (int i = 0; i < 16; ++i) tsf[i] = 0.f; tsl[1] = now; }
            else { const int pp = ph - 1; const int cls = pp < 2 ? 8 : (((pp - 2) % 9) == 8 ? 5 : ((pp - 2) % 9)); const float dt = (float)(now - tsl[0]); tsf[cls] += dt; }
            tsl[0] = now;
            if (ph == NPHASE - 2 && PROBE_A < 20) { const float tot = (float)(now - tsl[1]); tsf[12] = rintf(tsf[(PROBE_A >= 0 && PROBE_A < 16) ? PROBE_A : 0] / tot * 40.f) / 40.f; tsf[13] = rintf(tsf[PROBE_B >= 0 ? PROBE_B : 0] / tot * 40.f) / 40.f; }
        }
        if (PROBE_A >= 0 && ph == 0 && threadIdx.x == 0) { volatile float* tsb = (volatile float*)(p.ws + WS_TAB + 196608) + blockIdx.x * 8; for (int i = 0; i < 8; ++i) tsb[i] = 0.f; }
        if (PROBE_A >= 20 && ph == NPHASE - 2 && blockIdx.x == 0 && threadIdx.x == 0) {
            volatile float* tsf = (volatile float*)(p.ws + WS_TAB + 131072); volatile unsigned long long* tsl = (volatile unsigned long long*)(p.ws + WS_TAB + 131072 + 256);
            const float* tsb = (const float*)(p.ws + WS_TAB + 196608); float sum = 0.f; for (int b2 = 0; b2 < (int)gridDim.x; ++b2) sum += __hip_atomic_load(tsb + b2 * 8 + (PROBE_A - 20), __ATOMIC_RELAXED, __HIP_MEMORY_SCOPE_AGENT); sum *= (PROBE_A == 20 ? 32.f : (PROBE_A == 21 ? 16.f : 1.f));
            const float tot = (float)(__builtin_amdgcn_s_memrealtime() - tsl[1]); tsf[12] = rintf(sum / (float)gridDim.x / tot * 40.f) / 40.f; tsf[13] = 0.f; }
        int tid_ = threadIdx.x; asm volatile("" : "+v"(tid_));
        unsigned char* ws_ = p.ws; asm volatile("" : "+s"(ws_));
        float* out_ = p.out; asm volatile("" : "+s"(out_));
        Ctx C; C.p = &p; C.lds = (LAS unsigned char*)lds_raw; C.L = (float*)lds_raw; C.tid = tid_; C.lane = C.tid & 63; C.wave = __builtin_amdgcn_readfirstlane(C.tid >> 6);
        C.G = gridDim.x; C.gw = blockIdx.x * 8 + C.wave; C.NGW = C.G * 8; C.ws = ws_; C.out = out_;
        unsigned* ctl = (unsigned*)(ws_ + WS_CTL);
        const float* modbuf = (const float*)(ws_ + WS_MOD);
        bf16_t* xm = (bf16_t*)(ws_ + WS_XM); bf16_t* ob = (bf16_t*)(ws_ + WS_O); bf16_t* act = (bf16_t*)(ws_ + WS_ACT);
        if (ph == 0) { if (PHON(0)) phase0a(C); }
        else if (ph == 1) { if (PHON(1)) row_pass(C, 0, nullptr, nullptr, modbuf, 1024, 0, true); }
        else {
            const int layer = (ph - 2) / 9, sub = (ph - 2) % 9;
            unsigned char* wb = ws_ + WS_W + (size_t)(layer & 1) * WBUF;
            const float* modl = modbuf + (size_t)layer * 3 * 6144;
            if (sub == 0) { if (PHON(2)) {
                pg8::Gemm g{xm, (const bf16_t*)(wb + W_IN), MROWS, 4096, DM}; pg8::StaticOrder S; S.init(MROWS, 4096, C.G, (int)blockIdx.x);
                EpiIn E{(bf16_t*)(ws_ + WS_Q), (bf16_t*)(ws_ + WS_K), (bf16_t*)(ws_ + WS_V), (bf16_t*)(ws_ + WS_ZB), out_ + OUT_K, out_ + OUT_V, (const f32x2*)(ws_ + WS_TAB), layer};
                pg8::gemm_phase(C.lds, g, S, E, C.tid); }
            } else if (sub == 1) {
                __syncthreads();
                if (PHON(4)) for (int u = blockIdx.x; u < 1024; u += C.G) delta_prep_unit(C, layer, u);
                __syncthreads();
                if (PHON(5)) for (int u = C.gw; u < 2048; u += C.NGW) hgrn_local_unit(C, layer, u);
                __syncthreads();
            } else if (sub == 2) {
                LAS int* slot = (LAS int*)(C.lds + 147392);
                for (;;) {
                    __syncthreads();
                    if (C.tid == 0) *slot = (int)atomicAdd(ctl + 64 * (layer + 1), 1u);
                    __syncthreads();
                    const int u = *slot;
                    if (u >= 1432 + 256) break;
                    if (u >= 1432) { if (layer + 1 < DEPTH) convert_layer_weights(C, layer + 1, (u - 1432) * 8 + C.wave, 2048, u - 1432, 256); continue; }
                    unsigned long long pt0_ = 0; if (PROBE_A >= 0 && C.tid == 0) pt0_ = __builtin_amdgcn_s_memrealtime();
                    if (u < 8) { if (PHON(6)) delta_scan_unit(C, layer, true, u >> 2, u & 3); }
                    else if (u < 24) { const int v = u - 8; if (PHON(7)) hgrn_scan_unit(C, layer, true, v >> 3, (v >> 1) & 3, v & 1); }
                    else if (u < 536) { if (PHON(8)) attn_unit(C, layer, u - 24); }
                    else if (u < 664) { const int v = u - 536; if (PHON(6)) delta_scan_unit(C, layer, false, v >> 2, v & 3); }
                    else if (u < 1176) { if (PHON(8)) attn_unit(C, layer, 512 + (u - 664)); }
                    else { const int v = u - 1176; if (PHON(7)) hgrn_scan_unit(C, layer, false, v >> 3, (v >> 1) & 3, v & 1); }
                    if (PROBE_A >= 0) { __syncthreads(); if (C.tid == 0) { const int ty = (u < 8) ? 0 : (u < 24 ? 1 : (u < 536 ? 2 : (u < 664 ? 3 : (u < 1176 ? 4 : 5))));
                        volatile float* tsb = (volatile float*)(ws_ + WS_TAB + 196608) + blockIdx.x * 8; tsb[ty] += (float)(__builtin_amdgcn_s_memrealtime() - pt0_); } }
                }
            } else if (sub == 3) {
                if (PHON(9)) for (int u = blockIdx.x; u < 256; u += C.G) hgrn_final_unit(C, layer, u);
                __syncthreads();
                if (PHON(10)) delta_combine(C, layer);
                __syncthreads();
            } else if (sub == 4) {
                pg8::Gemm g{ob, (const bf16_t*)(wb + W_OUT), MROWS, DM, DM}; pg8::StaticOrder S; S.init(MROWS, DM, C.G, (int)blockIdx.x);
                EpiRes E{out_, modl + 2048, xm};
                if (PHON(11)) pg8::gemm_phase(C.lds, g, S, E, C.tid);
            } else if (sub == 5) {
                if (PHON(12)) row_pass(C, 1, p.in[20] + (size_t)(layer * 2) * DM, p.in[21] + (size_t)(layer * 2) * DM, modl, 4096, 3072, true);
            } else if (sub == 6) {
                pg8::Gemm g{xm, (const bf16_t*)(wb + W_FFI), MROWS, 2 * DFF, DM}; pg8::StaticOrder S; S.init(MROWS, 2 * DFF, C.G, (int)blockIdx.x);
                EpiFfn E{act};
                if (PHON(13)) pg8::gemm_phase(C.lds, g, S, E, C.tid);
            } else if (sub == 7) {
                pg8::Gemm g{act, (const bf16_t*)(wb + W_FFO), MROWS, DM, DFF}; pg8::StaticOrder S; S.init(MROWS, DM, C.G, (int)blockIdx.x);
                EpiRes E{out_, modl + 5120, xm};
                if (PHON(14)) pg8::gemm_phase(C.lds, g, S, E, C.tid);
            } else {
                const bool last = layer + 1 == DEPTH;
                if (PHON(12)) row_pass(C, 1, p.in[20] + (size_t)(layer * 2 + 1) * DM, p.in[21] + (size_t)(layer * 2 + 1) * DM, modbuf + (size_t)(last ? layer : layer + 1) * 3 * 6144, 1024, 0, !last);
            }
        }
        if (ph + 1 < p.ph_hi) { if (p.ph_hi > 100000) { __threadfence(); cg::this_grid().sync(); } else xcd_barrier(xbar); }
    }
}

#if !MK_ONE_LAUNCH
static unsigned phase_mask(int ph) {
    if (ph == 0) return 1u << 0; if (ph == 1) return 1u << 1;
    const int sub = (ph - 2) % 9;
    switch (sub) { case 0: return 1u << 2; case 1: return (1u << 3) | (1u << 4) | (1u << 5); case 2: return (1u << 6) | (1u << 7) | (1u << 8); case 3: return (1u << 9) | (1u << 10);
        case 4: return 1u << 11; case 5: return 1u << 12; case 6: return 1u << 13; case 7: return 1u << 14; default: return 1u << 12; }
}
typedef void (*kern_t)(Params);
static kern_t kernel_for_mask(unsigned m) {
    switch (m) {
        case 1u << 0: return fwd_megakernel<1u << 0>; case 1u << 1: return fwd_megakernel<1u << 1>; case 1u << 2: return fwd_megakernel<1u << 2>;
        case (1u << 3) | (1u << 4) | (1u << 5): return fwd_megakernel<(1u << 3) | (1u << 4) | (1u << 5)>;
        case (1u << 6) | (1u << 7) | (1u << 8): return fwd_megakernel<(1u << 6) | (1u << 7) | (1u << 8)>;
        case (1u << 9) | (1u << 10): return fwd_megakernel<(1u << 9) | (1u << 10)>;
        case 1u << 11: return fwd_megakernel<1u << 11>; case 1u << 12: return fwd_megakernel<1u << 12>; case 1u << 13: return fwd_megakernel<1u << 13>; default: return fwd_megakernel<1u << 14>;
    }
}
#endif
extern "C" void kernel_launch(void* const* d_in, const int* in_sizes, int n_in, void* d_out, int out_size, void* d_ws, size_t ws_size, hipStream_t stream) {
    static int grid = 0;
    if (grid == 0) {
        if (n_in != 24 || out_size != 58720256 || ws_size < WS_END) { fprintf(stderr, "kernel_launch: unexpected shapes (n_in %d out %d ws %zu)\n", n_in, out_size, ws_size); grid = -1; return; }
        int dev = 0, cus = 0;
        (void)hipGetDevice(&dev); (void)hipDeviceGetAttribute(&cus, hipDeviceAttributeMultiprocessorCount, dev);
#if MK_ONE_LAUNCH
        if (hipFuncSetAttribute((const void*)fwd_megakernel<0x7FFFu>, hipFuncAttributeMaxDynamicSharedMemorySize, LDS_BYTES) != hipSuccess) { fprintf(stderr, "kernel_launch: hipFuncSetAttribute failed\n"); grid = -1; return; }
#else
        for (int ph = 0; ph < 11; ++ph) (void)hipFuncSetAttribute((const void*)kernel_for_mask(phase_mask(ph)), hipFuncAttributeMaxDynamicSharedMemorySize, LDS_BYTES);
#endif
        (void)hipGetLastError();
        grid = cus > 0 ? cus : 256;
        if (grid != 256) { fprintf(stderr, "kernel_launch: expected 256 CUs, got %d\n", grid); grid = 256; }
    }
    if (grid < 0) return;
    (void)hipMemsetAsync((char*)d_ws + WS_CTL, 0, 65536, stream);
    Params p{};
    for (int i = 0; i < 24; ++i) p.in[i] = (const float*)d_in[i];
    p.out = (float*)d_out; p.ws = (unsigned char*)d_ws;
#if MK_ONE_LAUNCH
    p.ph_lo = 0; p.ph_hi = NPHASE;
    void* args[] = {&p};
    hipError_t e = hipLaunchCooperativeKernel((const void*)fwd_megakernel<0x7FFFu>, dim3(grid), dim3(512), args, LDS_BYTES, stream);
    if (e != hipSuccess) fprintf(stderr, "cooperative launch failed: %s (grid %d)\n", hipGetErrorString(e), grid);
#else
    for (int ph = 0; ph < NPHASE; ++ph) { p.ph_lo = ph; p.ph_hi = ph + 1; hipLaunchKernelGGL(kernel_for_mask(phase_mask(ph)), dim3(grid), dim3(512), LDS_BYTES, stream, p); }
#endif
}
```

```cpp
#include <hip/hip_runtime.h>
#include <hip/hip_cooperative_groups.h>
#include <cstdio>
#include <cstdint>
namespace cg = cooperative_groups;

#define PHON(k) ((PHM_ >> (k)) & 1)
#ifndef PROBE_A
#define PROBE_A -1
#endif
#ifndef PROBE_B
#define PROBE_B -1
#endif
#ifndef MK_ONE_LAUNCH
#define MK_ONE_LAUNCH 1
#endif

#define DI __device__ __forceinline__
#define LAS __attribute__((address_space(3)))
typedef unsigned short bf16_t;
typedef short bf16x8 __attribute__((ext_vector_type(8)));
typedef short s16x4 __attribute__((ext_vector_type(4)));
typedef float f32x4 __attribute__((ext_vector_type(4)));
typedef float f32x16 __attribute__((ext_vector_type(16)));
typedef float f32x2 __attribute__((ext_vector_type(2)));
typedef unsigned u32x4 __attribute__((ext_vector_type(4)));
typedef unsigned u32x2 __attribute__((ext_vector_type(2)));

constexpr int MROWS = 16384, DM = 1024, DEPTH = 4, DFF = 2816, DIN = 3856, ZLD = 2320;
constexpr float ALPHA = 1.681792830507429f, LN_EPS = 1e-5f, RMS_EPS = 1e-6f;
constexpr float QSCALE = 0.125f * 1.4426950408889634f;
constexpr int ZB_BQ = 0, ZB_BK = 256, ZB_BV = 512, ZB_BG = 768, ZB_BBETA = 1024, ZB_BA = 1032, ZB_CQ = 1040, ZB_CF = 1296, ZB_CI = 1808, ZB_CG = 2064;
constexpr size_t OUT_K = 16777216, OUT_V = 33554432, OUT_SD = 50331648, OUT_SH = 54525952;
constexpr size_t MiB = 1u << 20;
constexpr size_t WS_CTL = 0, WS_MOD = 64 * 1024, WS_TAB = 512 * 1024, WS_CK = 1 * MiB, WS_CV = 3 * MiB, WS_W = 8 * MiB, WBUF = 27 * MiB;
constexpr size_t W_IN = 0, W_OUT = 8 * MiB, W_FFI = 10 * MiB, W_FFO = 21 * MiB;
constexpr size_t WS_XM = 62 * MiB, WS_O = 94 * MiB, WS_ZB = 126 * MiB, WS_Q = 199 * MiB, WS_K = 215 * MiB, WS_V = 231 * MiB;
constexpr size_t WS_ACT = 126 * MiB;
constexpr size_t WS_DPW = 247 * MiB, WS_DPQD = 263 * MiB, WS_DPQK = 279 * MiB, WS_DPKD = 295 * MiB;
constexpr size_t WS_DPU = WS_XM;
constexpr size_t WS_OD = 311 * MiB, WS_HS = 343 * MiB, WS_HD = 375 * MiB, WS_GL = 375 * MiB + 512 * 1024, WS_END = 376 * MiB;
constexpr int LDS_BYTES = 147456;
constexpr int NPHASE = 2 + 9 * DEPTH;

struct Params { const float* in[24]; float* out; unsigned char* ws; int ph_lo, ph_hi; };

DI unsigned cvt_pk_bf16(float lo, float hi) { unsigned r; asm("v_cvt_pk_bf16_f32 %0, %1, %2" : "=v"(r) : "v"(lo), "v"(hi)); return r; }
DI bf16_t f2bf(float f) { return (bf16_t)(cvt_pk_bf16(f, 0.f) & 0xffffu); }
DI float bf2f(bf16_t b) { return __uint_as_float(((unsigned)b) << 16); }
DI float sigmoidf_(float x) { return __builtin_amdgcn_rcpf(1.0f + __expf(-x)); }
DI float siluf_(float x) { return x * __builtin_amdgcn_rcpf(1.0f + __expf(-x)); }
DI float wave_sum(float v) {
#pragma unroll
    for (int o = 1; o < 64; o <<= 1) v += __shfl_xor(v, o);
    return v;
}
DI u32x2 pack4(f32x4 v) { u32x2 w; w.x = cvt_pk_bf16(v[0], v[1]); w.y = cvt_pk_bf16(v[2], v[3]); return w; }
DI bf16x8 pack8(f32x4 a, f32x4 b) { u32x4 w; w.x = cvt_pk_bf16(a[0], a[1]); w.y = cvt_pk_bf16(a[2], a[3]); w.z = cvt_pk_bf16(b[0], b[1]); w.w = cvt_pk_bf16(b[2], b[3]); return __builtin_bit_cast(bf16x8, w); }
DI int pinv(int k) { return (k >> 5) * 32 + ((k >> 2) & 3) * 8 + ((k >> 4) & 1) * 4 + (k & 3); }
DI int row_mod(int r) { return r < 8192 ? 0 : 1 + ((r - 8192) >> 12); }

namespace pg8 {
constexpr int BM = 256, BK = 64, HALF = 128, HTB = HALF * BK * 2, STAGE_BYTES = 8 * HTB, NXCD = 8, WGM = 8;
DI int lds_byte(int r, int c) { const int st = (r >> 4) * 2 + (c >> 5), rr = r & 15, cc = c & 31, ob = rr * 64 + cc * 2; return st * 1024 + (ob ^ (((ob >> 9) & 1) << 5)); }
DI void stage_rc(int b, int& R, int& C) { const int st = b / 1024, sb = b % 1024, swz = sb ^ (((sb >> 9) & 1) << 5); R = (st >> 1) * 16 + swz / 64; C = (st & 1) * 32 + (swz % 64) / 2; }
struct Unit { int pm, pn; };
struct Gemm { const bf16_t* A; const bf16_t* Bt; int M, N, K; };
struct StaticOrder {
    int nM, nN, nwg, G, c;
    DI void init(int M, int N, int G_, int c_) { nM = M / BM; nN = N / BM; nwg = nM * nN; G = G_; c = c_; }
    DI bool next(int i, Unit& u) const {
        const long L = (long)i * G + c; if (L >= nwg) return false;
        int wgid = (int)L; { const int q = nwg / NXCD, r = nwg % NXCD, xcd = wgid % NXCD, off = wgid / NXCD; wgid = (xcd < r ? xcd * (q + 1) : r * (q + 1) + (xcd - r) * q) + off; }
        const int nig = WGM * nN, gid = wgid / nig, fm = gid * WGM, gsz = (nM - fm) < WGM ? (nM - fm) : WGM;
        u.pm = fm + ((wgid % nig) % gsz); u.pn = (wgid % nig) / gsz; return true;
    }
};

template <class Epi>
DI void gemm_phase(LAS unsigned char* lds, const Gemm g, const StaticOrder& S, const Epi& E, int tid_in) {
    const int tid = tid_in, wid = __builtin_amdgcn_readfirstlane(tid >> 6), lane = tid & 63, wr = wid >> 2, wc = wid & 3, fr = lane & 15, fq = lane >> 4;
    const int K = g.K, nt = K / BK;
    unsigned voffA[2];
#pragma unroll
    for (int i = 0; i < 2; ++i) { int R, C; stage_rc(tid * 16 + i * 8192, R, C); voffA[i] = (unsigned)(R * K + C) * 2u; }
    const size_t kstep = (size_t)(BK * 2);
    const size_t hstep = (size_t)HALF * K * 2;
    const size_t tstep = 2 * hstep;
    const unsigned ldsw = (unsigned)wid * 1024u;
    const int aoff = lds_byte(wr * 64 + fr, fq * 8), boff = lds_byte(wc * 32 + fr, fq * 8);
#define PG8_SA(b, h) (((b) * 2 + (h)) * HTB)
#define PG8_SB(b, h) ((4 + (b) * 2 + (h)) * HTB)
#define PG8_STAGE(bufoff, gbase) do { _Pragma("unroll") for (int _i = 0; _i < 2; ++_i) \
        __builtin_amdgcn_global_load_lds((const unsigned*)((const char*)(gbase) + voffA[_i]), (LAS unsigned*)(lds + (bufoff) + ldsw + _i * 8192), 16, 0, 0); } while (0)
#define PG8_LDA(dst, b, h) do { _Pragma("unroll") for (int m = 0; m < 4; ++m) _Pragma("unroll") for (int k = 0; k < 2; ++k) dst[m][k] = *(const LAS bf16x8*)(lds + PG8_SA(b, h) + aoff + m * 2048 + k * 1024); } while (0)
#define PG8_LDB(dst, b, h) do { _Pragma("unroll") for (int n = 0; n < 2; ++n) _Pragma("unroll") for (int k = 0; k < 2; ++k) dst[n][k] = *(const LAS bf16x8*)(lds + PG8_SB(b, h) + boff + n * 2048 + k * 1024); } while (0)
#define PG8_MMA(ai, bj, At, Bt) do { __builtin_amdgcn_s_setprio(1); _Pragma("unroll") for (int m = 0; m < 4; ++m) _Pragma("unroll") for (int n = 0; n < 2; ++n) _Pragma("unroll") for (int k = 0; k < 2; ++k) \
        acc[ai][bj][m][n] = __builtin_amdgcn_mfma_f32_16x16x32_bf16(Bt[n][k], At[m][k], acc[ai][bj][m][n], 0, 0, 0); __builtin_amdgcn_s_setprio(0); } while (0)
#define PG8_WAIT_V(n) asm volatile("s_waitcnt vmcnt(" #n ")" ::: "memory")
#define PG8_WAIT_L(n) asm volatile("s_waitcnt lgkmcnt(" #n ")" ::: "memory")
#define PG8_BAR __builtin_amdgcn_s_barrier()
#define PG8_SCHED __builtin_amdgcn_sched_barrier(0)
    Unit cur, nxt; int ui = 0;
    if (!S.next(0, cur)) return;
    f32x4 acc[2][2][4][2];
#pragma unroll
    for (int a = 0; a < 2; ++a)
#pragma unroll
        for (int b = 0; b < 2; ++b)
#pragma unroll
            for (int m = 0; m < 4; ++m)
#pragma unroll
                for (int n = 0; n < 2; ++n) acc[a][b][m][n] = (f32x4){0.f, 0.f, 0.f, 0.f};
    bf16x8 At[4][2], B0[2][2], B1[2][2];
    const char* cA = (const char*)g.A + (size_t)cur.pm * tstep; const char* cB = (const char*)g.Bt + (size_t)cur.pn * tstep;
    PG8_STAGE(PG8_SB(0, 0), cB); PG8_STAGE(PG8_SB(0, 1), cB + hstep); PG8_STAGE(PG8_SA(0, 0), cA); PG8_STAGE(PG8_SA(0, 1), cA + hstep);
    if (wr == 1) PG8_BAR;
    PG8_WAIT_V(2); PG8_BAR;
    PG8_STAGE(PG8_SB(1, 0), cB + kstep); PG8_STAGE(PG8_SA(1, 0), cA + kstep); PG8_STAGE(PG8_SB(1, 1), cB + hstep + kstep);
    PG8_WAIT_V(6); PG8_BAR;
    for (;;) {
        const bool has_next = S.next(ui + 1, nxt);
        const char* nA = has_next ? (const char*)g.A + (size_t)nxt.pm * tstep : cA; const char* nB = has_next ? (const char*)g.Bt + (size_t)nxt.pn * tstep : cB;
        for (int t = 0; t < nt; t += 2) {
            const bool last = (t == nt - 2);
            const char* a1 = cA + (size_t)(t + 1) * kstep;
            const char* a2 = last ? nA : cA + (size_t)(t + 2) * kstep; const char* b2 = last ? nB : cB + (size_t)(t + 2) * kstep;
            const char* a3 = a2 + kstep; const char* b3 = b2 + kstep;
            PG8_LDB(B0, 0, 0); PG8_LDB(B1, 0, 1); PG8_SCHED; PG8_LDA(At, 0, 0); PG8_STAGE(PG8_SA(1, 1), a1 + hstep);
            PG8_WAIT_V(8); PG8_WAIT_L(0); PG8_BAR; PG8_MMA(0, 0, At, B0); PG8_MMA(0, 1, At, B1); PG8_BAR; PG8_SCHED;
            PG8_LDA(At, 0, 1); PG8_STAGE(PG8_SB(0, 0), b2); PG8_STAGE(PG8_SB(0, 1), b2 + hstep); PG8_STAGE(PG8_SA(0, 0), a2);
            PG8_WAIT_V(8); PG8_WAIT_L(0); PG8_BAR; PG8_MMA(1, 0, At, B0); PG8_MMA(1, 1, At, B1); PG8_BAR; PG8_SCHED;
            PG8_LDB(B0, 1, 0); PG8_LDB(B1, 1, 1); PG8_SCHED; PG8_LDA(At, 1, 0); PG8_STAGE(PG8_SA(0, 1), a2 + hstep);
            PG8_WAIT_V(8); PG8_WAIT_L(0); PG8_BAR; PG8_MMA(0, 0, At, B0); PG8_MMA(0, 1, At, B1); PG8_BAR; PG8_SCHED;
            PG8_LDA(At, 1, 1); PG8_STAGE(PG8_SB(1, 0), b3); PG8_STAGE(PG8_SB(1, 1), b3 + hstep); PG8_STAGE(PG8_SA(1, 0), a3);
            PG8_WAIT_V(8); PG8_WAIT_L(0); PG8_BAR; PG8_MMA(1, 0, At, B0); PG8_MMA(1, 1, At, B1); PG8_BAR; PG8_SCHED;
        }
        if (wr == 0) PG8_BAR;
        E(acc, cur, wr, wc, fr, fq);
        if (!has_next) break;
#pragma unroll
        for (int a = 0; a < 2; ++a)
#pragma unroll
            for (int b = 0; b < 2; ++b)
#pragma unroll
                for (int m = 0; m < 4; ++m)
#pragma unroll
                    for (int n = 0; n < 2; ++n) acc[a][b][m][n] = (f32x4){0.f, 0.f, 0.f, 0.f};
        cur = nxt; cA = nA; cB = nB; ++ui;
        if (wr == 1) PG8_BAR;
    }
    PG8_WAIT_V(0);
    PG8_BAR;
#undef PG8_SA
#undef PG8_SB
#undef PG8_STAGE
#undef PG8_LDA
#undef PG8_LDB
#undef PG8_MMA
#undef PG8_WAIT_V
#undef PG8_WAIT_L
#undef PG8_BAR
#undef PG8_SCHED
}
}

struct EpiIn {
    bf16_t *Qb, *Kb, *Vb, *zb; float *outK, *outV; const f32x2* rope; int layer;
    DI void operator()(const f32x4 (&acc)[2][2][4][2], const pg8::Unit& u, int wr, int wc, int fr, int fq) const {
        const int tile = u.pn; const bool sample = u.pm >= 32;
        if (tile < 6) {
            const int kind = tile >> 1; const int cb = (tile & 1) * 256 + wc * 32 + 4 * fq;
            bf16_t* dst = Qb + (size_t)kind * (16u * 1024u * 1024u / 2u);
            float* of = outK + (size_t)(kind >= 1 ? kind - 1 : 0) * 16777216u;
#pragma unroll
            for (int ai = 0; ai < 2; ++ai)
#pragma unroll
                for (int m = 0; m < 4; ++m) {
                    const int r = u.pm * 256 + ai * 128 + wr * 64 + m * 16 + fr;
#pragma unroll
                    for (int bj = 0; bj < 2; ++bj) {
                        f32x4 a = acc[ai][bj][m][0], b = acc[ai][bj][m][1]; const int cc = cb + bj * 128;
                        if (!sample && kind >= 1) { float* o = of + ((size_t)((r >> 8) * 4 + layer) * 256 + (r & 255)) * 512 + cc; *(f32x4*)o = a; *(f32x4*)(o + 16) = b; }
                        if (sample && kind < 2) {
                            const int t = (r - 8192) & 4095; const int pos = (wc & 1) ? (t & 63) : (t >> 6); const f32x2* rp = rope + pos * 16 + 4 * fq;
#pragma unroll
                            for (int j = 0; j < 4; ++j) { const f32x2 cs = rp[j]; const float x1 = a[j], x2 = b[j]; a[j] = x1 * cs.x - x2 * cs.y; b[j] = x2 * cs.x + x1 * cs.y; }
                        }
                        if (kind == 0) { a = a * QSCALE; b = b * QSCALE; }
                        if (kind == 2) {
                            const int hh = cc >> 7, dv0 = cc & 127, tt = sample ? ((r - 8192) & 4095) : (r & 255);
                            bf16_t* vt = sample ? Vb + 4194304 + ((size_t)((((r - 8192) >> 12) * 4 + hh) * 32 + (tt >> 7)) * 128 + dv0) * 128 + (tt & 127)
                                                : Vb + ((size_t)(((r >> 8) * 4 + hh) * 2 + (tt >> 7)) * 128 + dv0) * 128 + (tt & 127);
#pragma unroll
                            for (int j = 0; j < 4; ++j) { vt[(size_t)j * 128] = f2bf(a[j]); vt[(size_t)(16 + j) * 128] = f2bf(b[j]); }
                        } else { *(u32x2*)(dst + (size_t)r * 512 + cc) = pack4(a); *(u32x2*)(dst + (size_t)r * 512 + cc + 16) = pack4(b); }
                    }
                    asm volatile("" ::: "memory");
                }
        } else {
#pragma unroll
            for (int ai = 0; ai < 2; ++ai)
#pragma unroll
                for (int m = 0; m < 4; ++m) {
                    const int r = u.pm * 256 + ai * 128 + wr * 64 + m * 16 + fr;
#pragma unroll
                    for (int bj = 0; bj < 2; ++bj)
#pragma unroll
                        for (int n = 0; n < 2; ++n) { const int c = (tile - 6) * 256 + bj * 128 + wc * 32 + 16 * n + 4 * fq; if (c < ZLD) *(u32x2*)(zb + (size_t)r * ZLD + c) = pack4(acc[ai][bj][m][n]); }
                    asm volatile("" ::: "memory");
                }
        }
    }
};
struct EpiRes {
    float* x; const float* gate; bf16_t* vb;
    DI void operator()(const f32x4 (&acc)[2][2][4][2], const pg8::Unit& u, int wr, int wc, int fr, int fq) const {
        const float* gv = gate + row_mod(u.pm * 256) * 6144;
#pragma unroll
        for (int ai = 0; ai < 2; ++ai)
#pragma unroll
            for (int m = 0; m < 4; ++m) {
                const int r = u.pm * 256 + ai * 128 + wr * 64 + m * 16 + fr;
#pragma unroll
                for (int bj = 0; bj < 2; ++bj)
#pragma unroll
                    for (int n = 0; n < 2; ++n) { const int c = u.pn * 256 + bj * 128 + wc * 32 + 16 * n + 4 * fq; const f32x4 g4 = *(const f32x4*)(gv + c); const u32x2 xw = *(const u32x2*)((const bf16_t*)x + (size_t)r * DM + c); const f32x4 xv = (f32x4){__uint_as_float(xw.x << 16), __uint_as_float(xw.x & 0xffff0000u), __uint_as_float(xw.y << 16), __uint_as_float(xw.y & 0xffff0000u)}; *(u32x2*)(vb + (size_t)r * DM + c) = pack4(xv * ALPHA + g4 * acc[ai][bj][m][n]); }
            }
    }
};
struct EpiFfn {
    bf16_t* act;
    DI void operator()(const f32x4 (&acc)[2][2][4][2], const pg8::Unit& u, int wr, int wc, int fr, int fq) const {
#pragma unroll
        for (int ai = 0; ai < 2; ++ai)
#pragma unroll
            for (int m = 0; m < 4; ++m) {
                const int r = u.pm * 256 + ai * 128 + wr * 64 + m * 16 + fr;
#pragma unroll
                for (int n = 0; n < 2; ++n) { const f32x4 gt = acc[ai][0][m][n], up = acc[ai][1][m][n]; f32x4 o;
#pragma unroll
                    for (int j = 0; j < 4; ++j) o[j] = siluf_(gt[j]) * up[j];
                    *(u32x2*)(act + (size_t)r * DFF + u.pn * 128 + wc * 32 + 16 * n + 4 * fq) = pack4(o); }
            }
    }
};

struct Ctx {
    const Params* p; LAS unsigned char* lds; float* L; int tid, lane, wave, G, gw, NGW;
    unsigned char* ws; float* out;
};

DI void tr_item(const float* W, int K, int N, bf16_t* WT, int mode, float* scr, int item, int lane) {
    const int nblk = (N + 31) / 32, kb = item / nblk, nb = item % nblk, k0 = 64 * kb, n0 = 32 * nb;
    const int nn = n0 + 4 * (lane & 7);
#pragma unroll
    for (int i = 0; i < 8; ++i) { const int kk = 8 * i + (lane >> 3); const f32x4 v4 = (nn < N) ? *(const f32x4*)(W + (size_t)(k0 + kk) * N + nn) : (f32x4){0.f, 0.f, 0.f, 0.f};
        float* sp_ = scr + kk * 33 + 4 * (lane & 7); sp_[0] = v4[0]; sp_[1] = v4[1]; sp_[2] = v4[2]; sp_[3] = v4[3]; }
    __builtin_amdgcn_wave_barrier();
    const int c = lane & 7;
#pragma unroll
    for (int j = 0; j < 4; ++j) {
        const int nl = (lane >> 3) + 8 * j, n = n0 + nl; const float* s = scr + (8 * c) * 33 + nl;
        if (n < N) {
            int dst = n; if (mode == 1) { if (n < DFF) dst = (n >> 7) * 256 + (n & 127); else { const int jj = n - DFF; dst = (jj >> 7) * 256 + 128 + (jj & 127); } }
            u32x4 o; o.x = cvt_pk_bf16(s[0 * 33], s[1 * 33]); o.y = cvt_pk_bf16(s[2 * 33], s[3 * 33]); o.z = cvt_pk_bf16(s[4 * 33], s[5 * 33]); o.w = cvt_pk_bf16(s[6 * 33], s[7 * 33]);
            *(u32x4*)(WT + (size_t)dst * K + k0 + 8 * c) = o;
        }
    }
    __builtin_amdgcn_wave_barrier();
}
DI void convert_layer_weights(const Ctx& C, int layer, int gw0 = -1, int ngw = 0, int blk = -1, int nblk = 0) {
    const Params& p = *C.p;
    unsigned char* wb = C.ws + WS_W + (size_t)(layer & 1) * WBUF;
    bf16_t* Win = (bf16_t*)(wb + W_IN); bf16_t* Wout = (bf16_t*)(wb + W_OUT); bf16_t* Wffi = (bf16_t*)(wb + W_FFI); bf16_t* Wffo = (bf16_t*)(wb + W_FFO);
    float* scr = C.L + C.wave * (64 * 33);
    constexpr int I_IN = 16 * 121, I_OUT = 16 * 32, I_FFI = 16 * 176, I_FFO = 44 * 32, NIT = I_IN + I_OUT + I_FFI + I_FFO;
    int lane_ = C.lane; asm volatile("" : "+v"(lane_));
    const int gwA = gw0 >= 0 ? gw0 : C.gw, ngwA = gw0 >= 0 ? ngw : C.NGW, blkA = blk >= 0 ? blk : (int)blockIdx.x, nblkA = blk >= 0 ? nblk : C.G;
    for (int it = gwA; it < NIT; it += ngwA) {
        int r = it;
        if (r < I_IN) { tr_item(p.in[10] + (size_t)layer * DM * DIN, DM, DIN, Win, 0, scr, r, lane_); continue; } r -= I_IN;
        if (r < I_OUT) { tr_item(p.in[19] + (size_t)layer * DM * DM, DM, DM, Wout, 0, scr, r, lane_); continue; } r -= I_OUT;
        if (r < I_FFI) { tr_item(p.in[22] + (size_t)layer * DM * 2 * DFF, DM, 2 * DFF, Wffi, 1, scr, r, lane_); continue; } r -= I_FFI;
        tr_item(p.in[23] + (size_t)layer * DFF * DM, DFF, DM, Wffo, 0, scr, r, lane_);
    }
    u32x4* z = (u32x4*)(Win + (size_t)DIN * DM); const int nz = 240 * DM * 2 / 16;
    for (int i = blkA * 512 + C.tid; i < nz; i += nblkA * 512) z[i] = (u32x4){0u, 0u, 0u, 0u};
}

DI void mod_unit(const Ctx& C, int u) {
    const Params& p = *C.p; const int tid = C.tid;
    float* cs = C.L; float* red = C.L + 3072;
    const int layer = u >> 6, col0 = (u & 63) * 96;
    __syncthreads();
    for (int i = tid; i < 3072; i += 512) { const int v = i >> 10, k = i & 1023; const float c = (v == 0) ? p.in[7][k] : p.in[6][(v - 1) * 1024 + k]; cs[i] = siluf_(c); }
    __syncthreads();
    if (tid < 504) {
        const int cgp = tid % 24, rs = tid / 24;
        f32x4 a0 = {0, 0, 0, 0}, a1 = a0, a2 = a0;
        const float* Wp = p.in[8] + (size_t)layer * DM * 6144 + col0 + cgp * 4;
#pragma unroll 7
        for (int k = rs; k < 1024; k += 21) { const f32x4 w = *(const f32x4*)(Wp + (size_t)k * 6144); a0 += w * cs[k]; a1 += w * cs[1024 + k]; a2 += w * cs[2048 + k]; }
        float* rr = red + rs * 288 + cgp * 4;
#pragma unroll
        for (int j = 0; j < 4; ++j) { rr[j] = a0[j]; rr[96 + j] = a1[j]; rr[192 + j] = a2[j]; }
    }
    __syncthreads();
    if (tid < 288) {
        const int v = tid / 96, cc = tid % 96; float s = 0.f;
        for (int rs = 0; rs < 21; ++rs) s += red[rs * 288 + tid];
        ((float*)(C.ws + WS_MOD))[(size_t)(layer * 3 + v) * 6144 + col0 + cc] = s + p.in[9][layer * 6144 + col0 + cc];
    }
}

DI void phase0a(const Ctx& C) {
    const Params& p = *C.p;
    for (int u = blockIdx.x; u < 256; u += C.G) mod_unit(C, u);
    __syncthreads();
    convert_layer_weights(C, 0);
    const int gt = blockIdx.x * 512 + C.tid, NT = C.G * 512;
    float* tab = (float*)(C.ws + WS_TAB);
    if (gt < 1024) { const int pos = gt >> 4, i = gt & 15; const float inv = __builtin_amdgcn_exp2f(-(float)i * (13.287712379549449f / 16.0f)); float rev = (float)pos * inv * 0.15915494309189535f; rev -= floorf(rev);
        tab[2 * gt] = __builtin_amdgcn_cosf(rev); tab[2 * gt + 1] = __builtin_amdgcn_sinf(rev); }
    if (gt >= 1024 && gt < 1028) { const int l = gt - 1024; const float* dl = p.in[17] + l * 256; float s01 = 0.f, s23 = 0.f; for (int i = 0; i < 64; ++i) { s01 += dl[i] * dl[64 + i]; s23 += dl[128 + i] * dl[192 + i]; }
        tab[2048 + l] = __expf(s01) - __expf(s23) + (0.8f - 0.6f * __expf(-0.3f * (float)l)); }
    if (gt >= 2048 && gt < 2560) { const int dir = (gt - 2048) >> 8, c = gt & 255; const float* lb = p.in[15] + dir * 1024 + c; float v[4], mx = -1e30f; for (int l = 0; l < 4; ++l) { v[l] = lb[l * 256]; mx = fmaxf(mx, v[l]); }
        float s = 0.f; for (int l = 0; l < 4; ++l) { v[l] = __expf(v[l] - mx); s += v[l]; } float cum = 0.f; for (int l = 0; l < 4; ++l) { if (l > 0) cum += v[l] / s; tab[4096 + (dir * 4 + l) * 256 + c] = cum; } }
    bf16_t* ck = (bf16_t*)(C.ws + WS_CK); bf16_t* cv = (bf16_t*)(C.ws + WS_CV);
    for (int i = gt; i < 2 * 4 * 256 * 512 / 4; i += NT) { const int e = i * 4; const int c = e & 511, j = (e >> 9) & 255, l = (e >> 17) & 3, b = e >> 19;
        const size_t dst = ((size_t)((l * 2 + b) * 256 + j)) * 512 + c;
        *(u32x2*)(ck + dst) = pack4(*(const f32x4*)(p.in[2] + e)); }
    for (int i = gt; i < 2 * 4 * 256 * 512; i += NT) { const int j = i & 255, dv = (i >> 8) & 127, hh = (i >> 15) & 3, b = (i >> 17) & 1, l = i >> 18;
        cv[((size_t)((((l * 2 + b) * 4 + hh) * 2 + (j >> 7)) * 128 + dv)) * 128 + (j & 127)] = f2bf(p.in[3][((size_t)((b * 4 + l) * 256 + j) * 4 + hh) * 128 + dv]); }
}

DI void row_pass(const Ctx& C, int mode, const float* lng, const float* lnb, const float* modl, int sc_off, int sh_off, bool write_xm) {
    const Params& p = *C.p; float* x = C.out; bf16_t* xm = (bf16_t*)(C.ws + WS_XM);
    for (int r0 = C.gw; r0 < MROWS; r0 += 2 * C.NGW) {
        f32x4 v[2][4];
#pragma unroll
        for (int u = 0; u < 2; ++u) { const int r = r0 + u * C.NGW;
            if (mode == 0) { const float* src = (r < 8192 ? p.in[0] + (size_t)r * DM : p.in[1] + (size_t)(r - 8192) * DM);
#pragma unroll
                for (int j = 0; j < 4; ++j) v[u][j] = *(const f32x4*)(src + 4 * C.lane + 256 * j); }
            else {
#pragma unroll
                for (int j = 0; j < 4; ++j) { const u32x2 w2 = *(const u32x2*)(xm + (size_t)r * DM + 4 * C.lane + 256 * j);
                    v[u][j] = (f32x4){__uint_as_float(w2.x << 16), __uint_as_float(w2.x & 0xffff0000u), __uint_as_float(w2.y << 16), __uint_as_float(w2.y & 0xffff0000u)}; } } }
#pragma unroll
        for (int u = 0; u < 2; ++u) { const int r = r0 + u * C.NGW;
            if (mode == 1) {
                float s = 0.f;
#pragma unroll
                for (int j = 0; j < 4; ++j) s += (v[u][j][0] + v[u][j][1]) + (v[u][j][2] + v[u][j][3]);
                const float mean = wave_sum(s) * (1.f / DM); float s2 = 0.f;
#pragma unroll
                for (int j = 0; j < 4; ++j) { v[u][j] = v[u][j] - mean; s2 += (v[u][j][0] * v[u][j][0] + v[u][j][1] * v[u][j][1]) + (v[u][j][2] * v[u][j][2] + v[u][j][3] * v[u][j][3]); }
                const float rstd = 1.0f / sqrtf(wave_sum(s2) * (1.f / DM) + LN_EPS);
#pragma unroll
                for (int j = 0; j < 4; ++j) { const f32x4 g4 = *(const f32x4*)(lng + 4 * C.lane + 256 * j), b4 = *(const f32x4*)(lnb + 4 * C.lane + 256 * j); v[u][j] = v[u][j] * rstd * g4 + b4; }
            }
            if (PROBE_A >= 0 && !write_xm) { const float* tsf = (const float*)(C.ws + WS_TAB + 131072); const float sc = 1.0f + ((r >= 8192) ? tsf[12] : (PROBE_B >= 0 ? tsf[13] : 0.f));
#pragma unroll
                for (int j = 0; j < 4; ++j) v[u][j] = v[u][j] * sc; }
            if (!write_xm) {
#pragma unroll
                for (int j = 0; j < 4; ++j) *(f32x4*)(x + (size_t)r * DM + 4 * C.lane + 256 * j) = v[u][j];
            } else {
#pragma unroll
                for (int j = 0; j < 4; ++j) *(u32x2*)((bf16_t*)x + (size_t)r * DM + 4 * C.lane + 256 * j) = pack4(v[u][j]);
            }
            if (write_xm) {
                const float* mv = modl + row_mod(r) * 6144;
#pragma unroll
                for (int j = 0; j < 4; ++j) { const int c = 4 * C.lane + 256 * j; const f32x4 sc = *(const f32x4*)(mv + sc_off + c), sh = *(const f32x4*)(mv + sh_off + c);
                    *(u32x2*)(xm + (size_t)r * DM + c) = pack4(v[u][j] * (sc + 1.0f) + sh); }
            }
        }
    }
}

#define MFMA32(a, b, c) __builtin_amdgcn_mfma_f32_32x32x16_bf16((a), (b), (c), 0, 0, 0)
#define MFMA16(a, b, c) __builtin_amdgcn_mfma_f32_16x16x32_bf16((a), (b), (c), 0, 0, 0)
constexpr int AK_LD = 72, AV_LD = 136;
struct AttnSrc { const bf16_t* Klat; const bf16_t* Kctx; const bf16_t* VTlat; const bf16_t* VTctx; int ldv; int nst; int nlat; int h; };
template <int PASS>
DI void attn_pass(int tid, int q, int hi, int kq, const AttnSrc& A, LAS bf16_t* K1s, LAS bf16_t* K2s, LAS bf16_t* VTs, const bf16x8 (&q1)[4], const bf16x8 (&q2)[4],
                  float& m1, float& l1, float& m2, float& l2, float iL1, float iL2, f32x16 (&o)[4]) {
    u32x4 kreg[4], vreg[4];
    const int h = A.h;
    auto issue = [&](int st) {
        const bf16_t* kb = (st < A.nlat) ? A.Klat + (size_t)st * 128 * 512 : A.Kctx + (size_t)(st - A.nlat) * 128 * 512;
#pragma unroll
        for (int i = 0; i < 2; ++i) { const int id = tid + 512 * i, key = id >> 3, ch = id & 7; kreg[i] = *(const u32x4*)(kb + (size_t)key * 512 + h * 128 + ch * 8); kreg[2 + i] = *(const u32x4*)(kb + (size_t)key * 512 + h * 128 + 64 + ch * 8); }
        if (PASS == 1) {
            const bf16_t* vb = (st < A.nlat) ? A.VTlat + (size_t)st * 128 : A.VTctx + (size_t)(st - A.nlat) * 128; const int ld = (st < A.nlat) ? A.ldv : 256;
#pragma unroll
            for (int i = 0; i < 4; ++i) { const int id = tid + 512 * i, dv = id >> 4, ch = id & 15; vreg[i] = *(const u32x4*)(vb + (size_t)dv * ld + ch * 8); }
        }
    };
    issue(0);
    for (int st = 0; st < A.nst; ++st) {
        __syncthreads();
#pragma unroll
        for (int i = 0; i < 2; ++i) { const int id = tid + 512 * i, key = id >> 3, ch = id & 7; *(LAS u32x4*)(K1s + key * AK_LD + ch * 8) = kreg[i]; *(LAS u32x4*)(K2s + key * AK_LD + ch * 8) = kreg[2 + i]; }
        if (PASS == 1) {
#pragma unroll
            for (int i = 0; i < 4; ++i) { const int id = tid + 512 * i, dv = id >> 4, ch = id & 15; *(LAS u32x4*)(VTs + dv * AV_LD + ch * 8) = vreg[i]; }
        }
        __syncthreads();
        if (st + 1 < A.nst) issue(st + 1);
        const int keyrow = kq * 32 + q;
        f32x16 s1, pr;
#pragma unroll
        for (int r = 0; r < 16; ++r) s1[r] = 0.f;
#pragma unroll
        for (int ks = 0; ks < 4; ++ks) { const bf16x8 a1 = *(const LAS bf16x8*)(K1s + keyrow * AK_LD + 16 * ks + 8 * hi); s1 = MFMA32(a1, q1[ks], s1); }
        if (PASS == 0) {
            float mx1 = s1[0];
#pragma unroll
            for (int r = 1; r < 16; ++r) mx1 = fmaxf(mx1, s1[r]);
            const float n1 = fmaxf(m1, mx1); float a1s = 0.f;
#pragma unroll
            for (int r = 0; r < 16; ++r) a1s += __builtin_amdgcn_exp2f(s1[r] - n1);
            l1 = l1 * __builtin_amdgcn_exp2f(m1 - n1) + a1s; m1 = n1;
        } else {
#pragma unroll
            for (int r = 0; r < 16; ++r) pr[r] = __builtin_amdgcn_exp2f(s1[r] - m1) * iL1;
        }
#pragma unroll
        for (int r = 0; r < 16; ++r) s1[r] = 0.f;
#pragma unroll
        for (int ks = 0; ks < 4; ++ks) { const bf16x8 a2 = *(const LAS bf16x8*)(K2s + keyrow * AK_LD + 16 * ks + 8 * hi); s1 = MFMA32(a2, q2[ks], s1); }
        if (PASS == 0) {
            float mx2 = s1[0];
#pragma unroll
            for (int r = 1; r < 16; ++r) mx2 = fmaxf(mx2, s1[r]);
            const float n2 = fmaxf(m2, mx2); float a2s = 0.f;
#pragma unroll
            for (int r = 0; r < 16; ++r) a2s += __builtin_amdgcn_exp2f(s1[r] - n2);
            l2 = l2 * __builtin_amdgcn_exp2f(m2 - n2) + a2s; m2 = n2;
        } else {
#pragma unroll
            for (int r = 0; r < 16; ++r) pr[r] -= __builtin_amdgcn_exp2f(s1[r] - m2) * iL2;
            bf16x8 pb[2];
            { u32x4 t0, t1; t0.x = cvt_pk_bf16(pr[0], pr[1]); t0.y = cvt_pk_bf16(pr[2], pr[3]); t0.z = cvt_pk_bf16(pr[4], pr[5]); t0.w = cvt_pk_bf16(pr[6], pr[7]);
              t1.x = cvt_pk_bf16(pr[8], pr[9]); t1.y = cvt_pk_bf16(pr[10], pr[11]); t1.z = cvt_pk_bf16(pr[12], pr[13]); t1.w = cvt_pk_bf16(pr[14], pr[15]);
              pb[0] = __builtin_bit_cast(bf16x8, t0); pb[1] = __builtin_bit_cast(bf16x8, t1); }
#pragma unroll
            for (int blk = 0; blk < 4; ++blk)
#pragma unroll
                for (int s = 0; s < 2; ++s) {
                    const LAS bf16_t* vp = VTs + (blk * 32 + q) * AV_LD + kq * 32 + 16 * s + 4 * hi;
                    const s16x4 lo = *(const LAS s16x4*)vp, hh = *(const LAS s16x4*)(vp + 8);
                    const bf16x8 av = __builtin_shufflevector(lo, hh, 0, 1, 2, 3, 4, 5, 6, 7);
                    o[blk] = MFMA32(av, pb[s], o[blk]);
                }
        }
    }
}
DI void attn_unit(const Ctx& C, int layer, int uidx) {
    int tid = C.tid; asm volatile("" : "+v"(tid)); const int lane = tid & 63, w = __builtin_amdgcn_readfirstlane(tid >> 6), qg = w & 3, kh = w >> 2, q = lane & 15, g = lane >> 4;
    const bf16_t* Qb = (const bf16_t*)(C.ws + WS_Q); const bf16_t* Kb = (const bf16_t*)(C.ws + WS_K); const bf16_t* VT = (const bf16_t*)(C.ws + WS_V);
    const bf16_t* cK = (const bf16_t*)(C.ws + WS_CK); const bf16_t* cVT = (const bf16_t*)(C.ws + WS_CV);
    int b, h, rowq0; AttnSrc A;
    if (uidx < 512) { b = uidx >> 8; h = (uidx >> 6) & 3; const int qb = uidx & 63; rowq0 = 8192 + b * 4096 + qb * 64; A.nst = 34; A.nlat = 32; A.ldv = 4096;
        A.Klat = Kb + (size_t)(8192 + b * 4096) * 512; A.VTlat = VT + 4194304 + (size_t)((b * 4 + h) * 32) * 16384; A.Kctx = cK + (size_t)((layer * 2 + b) * 256) * 512; A.VTctx = cVT + (size_t)(((layer * 2 + b) * 4 + h) * 2) * 16384; }
    else { const int v = uidx - 512; b = v >> 4; h = (v >> 2) & 3; const int qb = v & 3; rowq0 = b * 256 + qb * 64; A.nst = 2; A.nlat = 2; A.ldv = 256;
        A.Klat = Kb + (size_t)(b * 256) * 512; A.VTlat = VT + (size_t)((b * 4 + h) * 2) * 16384; A.Kctx = A.Klat; A.VTctx = A.VTlat; }
    A.h = h;
    LAS bf16_t* K1s = (LAS bf16_t*)C.lds; LAS bf16_t* K2s = K1s + 128 * AK_LD; LAS bf16_t* VTs = K2s + 128 * AK_LD;
    const float lam = ((const float*)(C.ws + WS_TAB))[2048 + layer];
    bf16x8 qf1[2], qf2[2];
    { const bf16_t* qp = Qb + (size_t)(rowq0 + 16 * qg + q) * 512 + h * 128 + 8 * g;
#pragma unroll
      for (int ks = 0; ks < 2; ++ks) { qf1[ks] = *(const bf16x8*)(qp + 32 * ks); qf2[ks] = *(const bf16x8*)(qp + 64 + 32 * ks); } }
    float m1 = -1e30f, l1 = 0.f, m2 = -1e30f, l2 = 0.f;
    f32x4 O1[8], O2[8];
#pragma unroll
    for (int t = 0; t < 8; ++t) { O1[t] = (f32x4){0.f, 0.f, 0.f, 0.f}; O2[t] = O1[t]; }
    u32x4 kreg[4], vreg[4];
    auto issue = [&](int st) {
        const bf16_t* kb = (st < A.nlat) ? A.Klat + (size_t)st * 128 * 512 : A.Kctx + (size_t)(st - A.nlat) * 128 * 512;
#pragma unroll
        for (int i = 0; i < 2; ++i) { const int id = tid + 512 * i, key = id >> 3, ch = id & 7; kreg[i] = *(const u32x4*)(kb + (size_t)key * 512 + h * 128 + ch * 8); kreg[2 + i] = *(const u32x4*)(kb + (size_t)key * 512 + h * 128 + 64 + ch * 8); }
        const bf16_t* vb = (st < A.nlat) ? A.VTlat + (size_t)st * 16384 : A.VTctx + (size_t)(st - A.nlat) * 16384;
#pragma unroll
        for (int i = 0; i < 4; ++i) { const int id = tid + 512 * i; vreg[i] = *(const u32x4*)(vb + (size_t)id * 8); }
    };
    issue(0);
    for (int st = 0; st < A.nst; ++st) {
        __syncthreads();
#pragma unroll
        for (int i = 0; i < 2; ++i) { const int id = tid + 512 * i, key = id >> 3, ch = id & 7; *(LAS u32x4*)(K1s + key * AK_LD + ch * 8) = kreg[i]; *(LAS u32x4*)(K2s + key * AK_LD + ch * 8) = kreg[2 + i]; }
#pragma unroll
        for (int i = 0; i < 4; ++i) { const int id = tid + 512 * i, dv = id >> 4, ch = id & 15; *(LAS u32x4*)(VTs + dv * AV_LD + ch * 8) = vreg[i]; }
        __syncthreads();
        if (st + 1 < A.nst) issue(st + 1);
#pragma unroll
        for (int kb = 0; kb < 2; ++kb) {
            const int key0 = kh * 64 + kb * 32;
            f32x4 sA0 = {0.f, 0.f, 0.f, 0.f}, sA1 = sA0, sB0 = sA0, sB1 = sA0;
#pragma unroll
            for (int ks = 0; ks < 2; ++ks) {
                const bf16x8 a10 = *(const LAS bf16x8*)(K1s + (key0 + q) * AK_LD + 32 * ks + 8 * g), a11 = *(const LAS bf16x8*)(K1s + (key0 + 16 + q) * AK_LD + 32 * ks + 8 * g);
                const bf16x8 a20 = *(const LAS bf16x8*)(K2s + (key0 + q) * AK_LD + 32 * ks + 8 * g), a21 = *(const LAS bf16x8*)(K2s + (key0 + 16 + q) * AK_LD + 32 * ks + 8 * g);
                sA0 = MFMA16(a10, qf1[ks], sA0); sA1 = MFMA16(a11, qf1[ks], sA1); sB0 = MFMA16(a20, qf2[ks], sB0); sB1 = MFMA16(a21, qf2[ks], sB1);
            }
            float t1 = fmaxf(fmaxf(fmaxf(sA0[0], sA0[1]), fmaxf(sA0[2], sA0[3])), fmaxf(fmaxf(sA1[0], sA1[1]), fmaxf(sA1[2], sA1[3])));
            float t2 = fmaxf(fmaxf(fmaxf(sB0[0], sB0[1]), fmaxf(sB0[2], sB0[3])), fmaxf(fmaxf(sB1[0], sB1[1]), fmaxf(sB1[2], sB1[3])));
            if (__any(t1 > m1 || t2 > m2)) {
                t1 = fmaxf(t1, __shfl_xor(t1, 16)); t1 = fmaxf(t1, __shfl_xor(t1, 32)); t2 = fmaxf(t2, __shfl_xor(t2, 16)); t2 = fmaxf(t2, __shfl_xor(t2, 32));
                const float n1 = fmaxf(m1, t1), n2 = fmaxf(m2, t2); const float f1 = __builtin_amdgcn_exp2f(m1 - n1), f2 = __builtin_amdgcn_exp2f(m2 - n2);
                l1 *= f1; l2 *= f2; m1 = n1; m2 = n2;
#pragma unroll
                for (int t = 0; t < 8; ++t) { O1[t] = O1[t] * f1; O2[t] = O2[t] * f2; }
            }
            f32x4 pA0, pA1, pB0, pB1;
#pragma unroll
            for (int i = 0; i < 4; ++i) { pA0[i] = __builtin_amdgcn_exp2f(sA0[i] - m1); pA1[i] = __builtin_amdgcn_exp2f(sA1[i] - m1); pB0[i] = __builtin_amdgcn_exp2f(sB0[i] - m2); pB1[i] = __builtin_amdgcn_exp2f(sB1[i] - m2); }
            l1 += (pA0[0] + pA0[1]) + (pA0[2] + pA0[3]) + (pA1[0] + pA1[1]) + (pA1[2] + pA1[3]);
            l2 += (pB0[0] + pB0[1]) + (pB0[2] + pB0[3]) + (pB1[0] + pB1[1]) + (pB1[2] + pB1[3]);
            const bf16x8 pb1 = pack8(pA0, pA1), pb2 = pack8(pB0, pB1);
#pragma unroll
            for (int t = 0; t < 8; ++t) {
                const LAS bf16_t* vp = VTs + (16 * t + q) * AV_LD + key0 + 4 * g;
                const s16x4 lo = *(const LAS s16x4*)vp, hh = *(const LAS s16x4*)(vp + 16);
                const bf16x8 av = __builtin_shufflevector(lo, hh, 0, 1, 2, 3, 4, 5, 6, 7);
                O1[t] = MFMA16(av, pb1, O1[t]); O2[t] = MFMA16(av, pb2, O2[t]);
            }
        }
    }
    l1 += __shfl_xor(l1, 16); l1 += __shfl_xor(l1, 32); l2 += __shfl_xor(l2, 16); l2 += __shfl_xor(l2, 32);
    __syncthreads();
    LAS float* comb = (LAS float*)C.lds;
    LAS float* exs = (LAS float*)(C.lds + 65536);
    if (kh == 1) {
#pragma unroll
        for (int t = 0; t < 8; ++t)
#pragma unroll
            for (int i = 0; i < 4; ++i) { comb[(qg * 64 + t * 4 + i) * 64 + lane] = O1[t][i]; comb[(qg * 64 + 32 + t * 4 + i) * 64 + lane] = O2[t][i]; }
        exs[(qg * 4 + 0) * 64 + lane] = m1; exs[(qg * 4 + 1) * 64 + lane] = l1; exs[(qg * 4 + 2) * 64 + lane] = m2; exs[(qg * 4 + 3) * 64 + lane] = l2;
    }
    __syncthreads();
    if (kh == 0) {
        const float om1 = exs[(qg * 4 + 0) * 64 + lane], ol1 = exs[(qg * 4 + 1) * 64 + lane], om2 = exs[(qg * 4 + 2) * 64 + lane], ol2 = exs[(qg * 4 + 3) * 64 + lane];
        const float n1 = fmaxf(m1, om1), n2 = fmaxf(m2, om2);
        const float fa1 = __builtin_amdgcn_exp2f(m1 - n1), fb1 = __builtin_amdgcn_exp2f(om1 - n1), fa2 = __builtin_amdgcn_exp2f(m2 - n2), fb2 = __builtin_amdgcn_exp2f(om2 - n2);
        const float L1 = l1 * fa1 + ol1 * fb1, L2 = l2 * fa2 + ol2 * fb2;
        const float c1a = fa1 / L1, c1b = fb1 / L1, c2a = lam * fa2 / L2, c2b = lam * fb2 / L2;
        float ss = 0.f;
#pragma unroll
        for (int t = 0; t < 8; ++t)
#pragma unroll
            for (int i = 0; i < 4; ++i) { const float v = O1[t][i] * c1a + comb[(qg * 64 + t * 4 + i) * 64 + lane] * c1b - O2[t][i] * c2a - comb[(qg * 64 + 32 + t * 4 + i) * 64 + lane] * c2b; O1[t][i] = v; ss += v * v; }
        ss += __shfl_xor(ss, 16); ss += __shfl_xor(ss, 32);
        const float lam_init = 0.8f - 0.6f * __expf(-0.3f * (float)layer);
        const float sc = (1.0f / sqrtf(ss * (1.0f / 128.0f) + RMS_EPS)) * (1.0f - lam_init);
        const float* dn = C.p->in[18] + layer * 128;
        bf16_t* ob = (bf16_t*)(C.ws + WS_O) + (size_t)(rowq0 + 16 * qg + q) * DM + h * 128;
#pragma unroll
        for (int t = 0; t < 8; ++t) { const int dv = 16 * t + 4 * g; const f32x4 d4 = *(const f32x4*)(dn + dv); *(u32x2*)(ob + dv) = pack4(O1[t] * sc * d4); }
    }
    __syncthreads();
}

DI void delta_prep_unit(const Ctx& C, int layer, int unit) {
    const Params& p = *C.p; int tid = C.tid; asm volatile("" : "+v"(tid)); const int lane = tid & 63, w = __builtin_amdgcn_readfirstlane(tid >> 6);
    const int tc = unit >> 2, h = unit & 3, row0 = tc * 64;
    int ci, nch; if (tc < 128) { ci = tc & 3; nch = 4; } else { ci = (tc - 128) & 63; nch = 64; }
    const bool has_prev = ci > 0, has_next = ci < nch - 1;
    float* qs = C.L; float* kk = C.L + 4160; float* vv = C.L + 8320; float* KK0 = C.L + 12480; float* QK0 = KK0 + 4096; float* Ms = QK0 + 4096; float* bc = Ms + 8192; float* be = bc + 128;
    const bf16_t* zb = (const bf16_t*)(C.ws + WS_ZB);
    const float* cw = p.in[11] + layer * 3 * 768;
    __syncthreads();
    if (tid < 384) {
        const int c = tid % 192, th = tid / 192, which = c >> 6, d = c & 63, col = which * 256 + h * 64 + d;
        const float w0 = cw[col], w1 = cw[768 + col], w2 = cw[1536 + col];
        float xin[34];
#pragma unroll
        for (int i = 0; i < 34; ++i) { const int tt = 32 * th - 1 + i; const bool ok = (tt >= 0 || has_prev) && (tt < 64 || has_next); xin[i] = ok ? bf2f(zb[(size_t)(row0 + tt) * ZLD + col]) : 0.f; }
        float* dstp = (which == 0 ? qs : (which == 1 ? kk : vv)) + d;
#pragma unroll
        for (int i = 0; i < 32; ++i) dstp[(32 * th + i) * 65] = siluf_(w0 * xin[i] + w1 * xin[i + 1] + w2 * xin[i + 2]);
    }
    __syncthreads();
    { const int r = tid >> 2, part = tid & 3; float* base = (r < 64 ? qs + r * 65 : kk + (r - 64) * 65) + part * 16; float ss = 0.f;
#pragma unroll
      for (int i = 0; i < 16; ++i) ss += base[i] * base[i];
      ss += __shfl_xor(ss, 1); ss += __shfl_xor(ss, 2);
      const float sc = (1.0f / sqrtf(ss + 1e-6f)) * (r < 64 ? 0.125f : 1.0f);
#pragma unroll
      for (int i = 0; i < 16; ++i) base[i] *= sc; }
    if (w < 2) {
        const int dir = w, i = lane, tt = dir ? 63 - i : i; const size_t row = (size_t)(row0 + tt);
        const float braw = bf2f(zb[row * ZLD + ZB_BBETA + dir * 4 + h]), araw = bf2f(zb[row * ZLD + ZB_BA + dir * 4 + h]);
        const float A = __expf(p.in[12][layer * 8 + dir * 4 + h]); const float x = araw + p.in[13][layer * 8 + dir * 4 + h];
        const float sp = x > 20.f ? x : log1pf(__expf(x)); float g = -A * sp;
#pragma unroll
        for (int off = 1; off < 64; off <<= 1) { const float t = __shfl_up(g, off); if (lane >= off) g += t; }
        bc[dir * 64 + i] = g; const float bt = sigmoidf_(braw); be[dir * 64 + i] = bt; be[128 + dir * 64 + i] = bt * __expf(g);
    }
    __syncthreads();
    {
        const int rbm = w & 3, cb0 = (w >> 2) * 2, r16 = lane & 15, g4 = lane >> 4;
        bf16x8 kA[2], qA[2], kB[2][2];
#pragma unroll
        for (int ks = 0; ks < 2; ++ks) {
            const float* kp = kk + (16 * rbm + r16) * 65 + 32 * ks + 8 * g4; const float* qp = qs + (16 * rbm + r16) * 65 + 32 * ks + 8 * g4;
            kA[ks] = pack8((f32x4){kp[0], kp[1], kp[2], kp[3]}, (f32x4){kp[4], kp[5], kp[6], kp[7]});
            qA[ks] = pack8((f32x4){qp[0], qp[1], qp[2], qp[3]}, (f32x4){qp[4], qp[5], qp[6], qp[7]});
#pragma unroll
            for (int c = 0; c < 2; ++c) { const float* bp = kk + (16 * (cb0 + c) + r16) * 65 + 32 * ks + 8 * g4;
                kB[c][ks] = pack8((f32x4){bp[0], bp[1], bp[2], bp[3]}, (f32x4){bp[4], bp[5], bp[6], bp[7]}); }
        }
#pragma unroll
        for (int c = 0; c < 2; ++c) {
            f32x4 ak = {0.f, 0.f, 0.f, 0.f}, aq = ak;
#pragma unroll
            for (int ks = 0; ks < 2; ++ks) { ak = MFMA16(kA[ks], kB[c][ks], ak); aq = MFMA16(qA[ks], kB[c][ks], aq); }
#pragma unroll
            for (int i = 0; i < 4; ++i) { const int o = (16 * rbm + 4 * g4 + i) * 64 + 16 * (cb0 + c) + r16; KK0[o] = ak[i]; QK0[o] = aq[i]; }
        }
    }
    __syncthreads();
    bf16_t* dpW = (bf16_t*)(C.ws + WS_DPW); bf16_t* dpQD = (bf16_t*)(C.ws + WS_DPQD); bf16_t* dpQK = (bf16_t*)(C.ws + WS_DPQK); bf16_t* dpKD = (bf16_t*)(C.ws + WS_DPKD); bf16_t* dpU = (bf16_t*)(C.ws + WS_DPU);
    float* dpGL = (float*)(C.ws + WS_GL);
    { const int i = tid >> 3, j0 = (tid & 7) * 8;
#pragma unroll
      for (int dir = 0; dir < 2; ++dir) {
          const size_t ud = ((size_t)tc * 4 + h) * 2 + dir;
          const float bi = bc[dir * 64 + i], betai = be[dir * 64 + i]; const int ai = dir ? 63 - i : i;
#pragma unroll
          for (int jj = 0; jj < 8; ++jj) { const int j = j0 + jj, aj = dir ? 63 - j : j;
              const float dec = (j <= i) ? __expf(bi - bc[dir * 64 + j]) : 0.f;
              Ms[dir * 4096 + j * 64 + i] = (j < i) ? betai * KK0[ai * 64 + aj] * dec : 0.f;
              dpQK[ud * 4096 + i * 64 + pinv(j)] = f2bf(QK0[ai * 64 + aj] * dec); }
      } }
    __syncthreads();
    if (w < 4) {
        const int dir = w >> 1, c = (w & 1) * 64 + lane; const size_t ud = ((size_t)tc * 4 + h) * 2 + dir;
        const float* Msd = Ms + dir * 4096; const bool isU = (w & 1) == 0; const float* scp = be + (isU ? 0 : 128) + dir * 64; const float* srcp = (isU ? vv : kk) + lane;
        float x[64];
#pragma unroll
        for (int rb = 0; rb < 4; ++rb) {
            float r[16];
#pragma unroll
            for (int ii = 0; ii < 16; ++ii) { const int i = 16 * rb + ii, tt = dir ? 63 - i : i; r[ii] = scp[i] * srcp[tt * 65]; }
            asm volatile("" ::: "memory");
#pragma unroll
            for (int j = 0; j < 16 * rb; ++j) {
                const float* mp = Msd + j * 64 + 16 * rb;
                const f32x4 ma = *(const f32x4*)mp, mb = *(const f32x4*)(mp + 4), mc = *(const f32x4*)(mp + 8), md = *(const f32x4*)(mp + 12);
                const float xj = x[j];
#pragma unroll
                for (int c4 = 0; c4 < 4; ++c4) { r[c4] -= ma[c4] * xj; r[4 + c4] -= mb[c4] * xj; r[8 + c4] -= mc[c4] * xj; r[12 + c4] -= md[c4] * xj; }
                if ((j & 3) == 3) asm volatile("" ::: "memory");
            }
#pragma unroll
            for (int jj = 0; jj < 16; ++jj) {
                const float xj = r[jj]; x[16 * rb + jj] = xj;
                const float* mp = Msd + (16 * rb + jj) * 64 + 16 * rb;
#pragma unroll
                for (int ii = jj + 1; ii < 16; ++ii) r[ii] -= mp[ii] * xj;
                if ((jj & 3) == 3) asm volatile("" ::: "memory");
            }
        }
        if (c < 64) {
            bf16_t* up = dpU + ud * 4096 + c * 64;
#pragma unroll
            for (int i = 0; i < 64; i += 8) { u32x4 o; o.x = cvt_pk_bf16(x[i], x[i + 1]); o.y = cvt_pk_bf16(x[i + 2], x[i + 3]); o.z = cvt_pk_bf16(x[i + 4], x[i + 5]); o.w = cvt_pk_bf16(x[i + 6], x[i + 7]); *(u32x4*)(up + i) = o; }
        } else {
            bf16_t* wp = dpW + ud * 4096 + pinv(c - 64);
#pragma unroll
            for (int i = 0; i < 64; ++i) wp[i * 64] = f2bf(x[i]);
        }
    } else {
#pragma unroll 4
        for (int it = 0; it < 64; ++it) {
            const int e = (tid - 256) + 256 * it, dir = e >> 13, which = (e >> 12) & 1, rem = e & 4095; const size_t ud = ((size_t)tc * 4 + h) * 2 + dir;
            if (which == 0) { const int i = rem >> 6, d = rem & 63, tt = dir ? 63 - i : i; dpQD[ud * 4096 + i * 64 + pinv(d)] = f2bf(qs[tt * 65 + d] * __expf(bc[dir * 64 + i])); }
            else { const int dk = rem >> 6, i = rem & 63, tt = dir ? 63 - i : i; dpKD[ud * 4096 + dk * 64 + pinv(i)] = f2bf(kk[tt * 65 + dk] * __expf(bc[dir * 64 + 63] - bc[dir * 64 + i])); }
        }
        if (tid == 256 || tid == 257) { const int dir = tid - 256; dpGL[((size_t)tc * 4 + h) * 2 + dir] = __expf(bc[dir * 64 + 63]); }
    }
}

DI void delta_scan_unit(const Ctx& C, int layer, bool sample, int b, int h) {
    const Params& p = *C.p; int tid = C.tid; asm volatile("" : "+v"(tid)); const int lane = tid & 63; const int w = C.wave, dir = w >> 2, sl = w & 3, col = lane & 15, g = lane >> 4;
    const int tc0 = sample ? 128 + b * 64 : b * 4, nch = sample ? 64 : 4;
    const bf16_t* dpU = (const bf16_t*)(C.ws + WS_DPU);
    const float* dpGL = (const float*)(C.ws + WS_GL); float* od = (float*)(C.ws + WS_OD) + (size_t)dir * MROWS * 256;
    f32x4 S[4];
    if (sample) { const float* s0 = p.in[4] + ((((size_t)b * 4 + layer) * 2 + dir) * 4 + h) * 4096;
#pragma unroll
        for (int rb = 0; rb < 4; ++rb)
#pragma unroll
            for (int ii = 0; ii < 4; ++ii) S[rb][ii] = s0[(16 * rb + 4 * g + ii) * 64 + 16 * sl + col]; }
    else {
#pragma unroll
        for (int rb = 0; rb < 4; ++rb) S[rb] = (f32x4){0.f, 0.f, 0.f, 0.f}; }
    u32x4 Ra[8], Rb[8];
#define DS_TC(d_, n_) ((d_) ? tc0 + nch - 1 - (n_) : tc0 + (n_))
#define DS_ISSUE(R, n_) do { _Pragma("unroll") for (int i = 0; i < 8; ++i) { const int id = tid + 512 * i, dm = id >> 9, dd = dm >> 2, mat = dm & 3; \
        const size_t ud_ = ((size_t)DS_TC(dd, n_) * 4 + h) * 2 + dd; R[i] = *(const u32x4*)(C.ws + WS_DPW + (size_t)mat * (16u * MiB) + ud_ * 8192 + (size_t)(id & 511) * 16); } } while (0)
#define DS_WRITE(R, buf_) do { _Pragma("unroll") for (int i = 0; i < 8; ++i) { const int id = tid + 512 * i, dm = id >> 9, row = (id >> 3) & 63, c = id & 7; \
        *(LAS u32x4*)(C.lds + (buf_) * 65536 + dm * 8192 + row * 128 + ((c ^ (row & 7)) * 16)) = R[i]; } } while (0)
#define DS_FRAG(buf_, mat_, rb_, ks_) (*(const LAS bf16x8*)(C.lds + (buf_) * 65536 + (dir * 4 + (mat_)) * 8192 + (16 * (rb_) + col) * 128 + ((((ks_) * 4 + g) ^ (col & 7)) * 16)))
    __syncthreads();
    DS_ISSUE(Ra, 0); DS_WRITE(Ra, 0); DS_ISSUE(Ra, 1);
    s16x4 uuA[4], uuB[4]; float glA, glB;
#define DS_LOADU(uu, gl, n_) do { const size_t ud_ = ((size_t)DS_TC(dir, n_) * 4 + h) * 2 + dir; _Pragma("unroll") for (int rb = 0; rb < 4; ++rb) uu[rb] = *(const s16x4*)(dpU + ud_ * 4096 + (16 * sl + col) * 64 + 16 * rb + 4 * g); gl = dpGL[ud_]; } while (0)
    DS_LOADU(uuA, glA, 0); DS_LOADU(uuB, glB, 1);
    __syncthreads();
#define DS_STEP(n, buf, Rnext, Rcur, uu, gl) do { \
        if ((n) + 2 < nch) DS_ISSUE(Rnext, (n) + 2); \
        const int tc = DS_TC(dir, (n)); \
        bf16x8 Sb[2]; Sb[0] = pack8(S[0], S[1]); Sb[1] = pack8(S[2], S[3]); \
        f32x4 vn[4]; \
        _Pragma("unroll") for (int rb = 0; rb < 4; ++rb) { f32x4 t = (f32x4){0.f, 0.f, 0.f, 0.f}; t = MFMA16(DS_FRAG(buf, 0, rb, 0), Sb[0], t); t = MFMA16(DS_FRAG(buf, 0, rb, 1), Sb[1], t); \
            _Pragma("unroll") for (int ii = 0; ii < 4; ++ii) vn[rb][ii] = bf2f((bf16_t)uu[rb][ii]) - t[ii]; } \
        const float glc = gl; \
        if ((n) + 2 < nch) DS_LOADU(uu, gl, (n) + 2); \
        bf16x8 vb[2]; vb[0] = pack8(vn[0], vn[1]); vb[1] = pack8(vn[2], vn[3]); \
        const int rowb = tc * 64; \
        _Pragma("unroll") for (int rb = 0; rb < 4; ++rb) { f32x4 o = (f32x4){0.f, 0.f, 0.f, 0.f}; o = MFMA16(DS_FRAG(buf, 1, rb, 0), Sb[0], o); o = MFMA16(DS_FRAG(buf, 1, rb, 1), Sb[1], o); o = MFMA16(DS_FRAG(buf, 2, rb, 0), vb[0], o); o = MFMA16(DS_FRAG(buf, 2, rb, 1), vb[1], o); \
            _Pragma("unroll") for (int ii = 0; ii < 4; ++ii) { const int i = 16 * rb + 4 * g + ii; const int tt = dir ? 63 - i : i; od[(size_t)(rowb + tt) * 256 + h * 64 + 16 * sl + col] = o[ii]; } } \
        _Pragma("unroll") for (int rb = 0; rb < 4; ++rb) { f32x4 sn = S[rb] * glc; sn = MFMA16(DS_FRAG(buf, 3, rb, 0), vb[0], sn); sn = MFMA16(DS_FRAG(buf, 3, rb, 1), vb[1], sn); S[rb] = sn; } \
        if ((n) + 1 < nch) DS_WRITE(Rcur, (buf) ^ 1); \
        __syncthreads(); } while (0)
    for (int n = 0; n < nch; n += 2) {
        DS_STEP(n, 0, Rb, Ra, uuA, glA);
        DS_STEP(n + 1, 1, Ra, Rb, uuB, glB);
    }
#undef DS_STEP
#undef DS_TC
#undef DS_ISSUE
#undef DS_WRITE
#undef DS_FRAG
#undef DS_LOADU
    if (!sample) { float* so = C.out + OUT_SD + ((((size_t)b * 4 + layer) * 2 + dir) * 4 + h) * 4096;
#pragma unroll
        for (int rb = 0; rb < 4; ++rb)
#pragma unroll
            for (int ii = 0; ii < 4; ++ii) so[(16 * rb + 4 * g + ii) * 64 + 16 * sl + col] = S[rb][ii]; }
}

DI float hgrn_forget(const bf16_t* zb, size_t row, int dir, int h, int d, float lb) { const float x = bf2f(zb[row * ZLD + ZB_CF + dir * 256 + h * 64 + d]); return lb + (1.0f - lb) * sigmoidf_(x); }
DI void hgrn_local_unit(const Ctx& C, int layer, int unit) {
    int lane = C.lane; asm volatile("" : "+v"(lane)); const int dir = unit & 1, h = (unit >> 1) & 3, tc = unit >> 3, row0 = tc * 64, ep = lane & 31, dh = lane >> 5;
    const bf16_t* zb = (const bf16_t*)(C.ws + WS_ZB);
    float* fs = C.L + C.wave * 2048; float* qs2 = fs + 1024;
    bf16_t* oloc = (bf16_t*)(C.ws + WS_XM + 16 * MiB) + (size_t)dir * MROWS * 256;
    bf16_t* qdb = (bf16_t*)((unsigned char*)C.out + 32 * MiB) + (size_t)dir * MROWS * 256;
    const float lb = ((const float*)(C.ws + WS_TAB))[4096 + (dir * 4 + layer) * 256 + h * 64 + lane];
    f32x2 S[32];
#pragma unroll
    for (int k = 0; k < 32; ++k) S[k] = (f32x2){0.f, 0.f};
    float Dl = 1.0f;
    bf16_t rf[16], rq[16]; unsigned rv[16];
#define HL_LOAD(sb_) do { _Pragma("unroll") for (int i = 0; i < 16; ++i) { const int ti = (sb_) * 16 + i, tt = dir ? 63 - ti : ti; const size_t row = (size_t)(row0 + tt); \
        rf[i] = zb[row * ZLD + ZB_CF + dir * 256 + h * 64 + lane]; rq[i] = zb[row * ZLD + ZB_CQ + h * 64 + lane]; rv[i] = *(const unsigned*)(zb + row * ZLD + ZB_CI + h * 64 + 2 * ep); } } while (0)
    HL_LOAD(0);
    for (int sb = 0; sb < 4; ++sb) {
        f32x2 vr[16];
#pragma unroll
        for (int i = 0; i < 16; ++i) { const int ti = sb * 16 + i, tt = dir ? 63 - ti : ti; const size_t row = (size_t)(row0 + tt);
            const float f = lb + (1.0f - lb) * sigmoidf_(bf2f(rf[i])); const float qv = siluf_(bf2f(rq[i]));
            fs[i * 64 + lane] = f; qs2[i * 64 + lane] = qv; Dl *= f; qdb[row * 256 + h * 64 + lane] = f2bf(qv * Dl);
            vr[i] = (f32x2){__uint_as_float(rv[i] << 16), __uint_as_float(rv[i] & 0xffff0000u)}; }
        if (sb + 1 < 4) HL_LOAD(sb + 1);
        __builtin_amdgcn_wave_barrier();
#pragma unroll
        for (int i = 0; i < 16; ++i) { const f32x2 v = vr[i]; f32x2 osa = {0.f, 0.f}, osb = {0.f, 0.f};
#pragma unroll
            for (int k = 0; k < 32; k += 4) { const f32x4 f4 = *(const f32x4*)(fs + i * 64 + 32 * dh + k), q4 = *(const f32x4*)(qs2 + i * 64 + 32 * dh + k);
#pragma unroll
                for (int c = 0; c < 4; ++c) { S[k + c] = (S[k + c] - v) * f4[c] + v; if (c & 1) osb += S[k + c] * q4[c]; else osa += S[k + c] * q4[c]; }
                if ((k & 15) == 12) asm volatile("" ::: "memory"); }
            f32x2 os = osa + osb;
            os.x += __shfl_xor(os.x, 32); os.y += __shfl_xor(os.y, 32);
            const int ti = sb * 16 + i, tt = dir ? 63 - ti : ti;
            if (dh == 0) *(unsigned*)(oloc + (size_t)(row0 + tt) * 256 + h * 64 + 2 * ep) = cvt_pk_bf16(os.x, os.y);
            asm volatile("" ::: "memory"); }
        __builtin_amdgcn_wave_barrier();
    }
#undef HL_LOAD
    float* hs = (float*)(C.ws + WS_HS) + (size_t)unit * 4096;
#pragma unroll
    for (int k = 0; k < 32; ++k) *(f32x2*)(hs + (32 * dh + k) * 64 + 2 * ep) = S[k];
    ((float*)(C.ws + WS_HD))[(size_t)unit * 64 + lane] = Dl;
}
DI void hgrn_scan_unit(const Ctx& C, int layer, bool sample, int b, int h, int dir) {
    const Params& p = *C.p; int tid = C.tid; asm volatile("" : "+v"(tid)); const int tc0 = sample ? 128 + b * 64 : b * 4, nch = sample ? 64 : 4;
    float* HS = (float*)(C.ws + WS_HS); const float* HD = (const float*)(C.ws + WS_HD);
    f32x4 S0, S1;
    if (sample) { const float* s0 = p.in[5] + ((((size_t)b * 4 + layer) * 2 + dir) * 4 + h) * 4096 + tid * 8; S0 = *(const f32x4*)s0; S1 = *(const f32x4*)(s0 + 4); }
    else { float z_ = 0.f; asm volatile("" : "+v"(z_)); S0 = (f32x4){z_, z_, z_, z_}; S1 = S0; }
    for (int n0 = 0; n0 < nch; n0 += 4) {
        f32x4 la[4], lb[4]; float Dd[4];
#pragma unroll
        for (int k = 0; k < 4; ++k) { const int tc = dir ? tc0 + nch - 1 - (n0 + k) : tc0 + n0 + k; const size_t uh = ((size_t)tc * 4 + h) * 2 + dir;
            const float* hp = HS + uh * 4096 + tid * 8; la[k] = *(const f32x4*)hp; lb[k] = *(const f32x4*)(hp + 4); Dd[k] = HD[uh * 64 + (tid >> 3)]; }
#pragma unroll
        for (int k = 0; k < 4; ++k) { const int tc = dir ? tc0 + nch - 1 - (n0 + k) : tc0 + n0 + k; const size_t uh = ((size_t)tc * 4 + h) * 2 + dir;
            float* hp = HS + uh * 4096 + tid * 8; *(f32x4*)hp = S0; *(f32x4*)(hp + 4) = S1; S0 = S0 * Dd[k] + la[k]; S1 = S1 * Dd[k] + lb[k]; }
    }
    if (!sample) { float* so = C.out + OUT_SH + ((((size_t)b * 4 + layer) * 2 + dir) * 4 + h) * 4096 + tid * 8; *(f32x4*)so = S0; *(f32x4*)(so + 4) = S1; }
}
DI void hgrn_final_unit(const Ctx& C, int layer, int tc) {
    const Params& p = *C.p; int lane = C.lane; asm volatile("" : "+v"(lane)); const int w = C.wave, h = w >> 1, chh = w & 1, r16 = lane & 15, g4 = lane >> 4, row0 = tc * 64;
    const bf16_t* zb = (const bf16_t*)(C.ws + WS_ZB); const float* HS = (const float*)(C.ws + WS_HS);
    const bf16_t* oloc = (const bf16_t*)(C.ws + WS_XM + 16 * MiB); const bf16_t* qdb = (const bf16_t*)((const unsigned char*)C.out + 32 * MiB);
    float* otile = C.L;
    __syncthreads();
    f32x4 acc[4][2];
#pragma unroll
    for (int rb = 0; rb < 4; ++rb) { acc[rb][0] = (f32x4){0.f, 0.f, 0.f, 0.f}; acc[rb][1] = acc[rb][0]; }
#pragma unroll
    for (int dir = 0; dir < 2; ++dir) {
        const size_t uh = ((size_t)tc * 4 + h) * 2 + dir;
        bf16x8 Bf[2][2];
#pragma unroll
        for (int cb = 0; cb < 2; ++cb)
#pragma unroll
            for (int ks = 0; ks < 2; ++ks) { const float* sp = HS + uh * 4096 + (size_t)(32 * ks + 8 * g4) * 64 + 32 * chh + 16 * cb + r16;
                Bf[cb][ks] = pack8((f32x4){sp[0], sp[64], sp[128], sp[192]}, (f32x4){sp[256], sp[320], sp[384], sp[448]}); }
#pragma unroll
        for (int rb = 0; rb < 4; ++rb)
#pragma unroll
            for (int ks = 0; ks < 2; ++ks) { const bf16x8 Af = *(const bf16x8*)(qdb + (size_t)dir * MROWS * 256 + (size_t)(row0 + 16 * rb + r16) * 256 + h * 64 + 32 * ks + 8 * g4);
                acc[rb][0] = MFMA16(Af, Bf[0][ks], acc[rb][0]); acc[rb][1] = MFMA16(Af, Bf[1][ks], acc[rb][1]); }
    }
#pragma unroll
    for (int rb = 0; rb < 4; ++rb)
#pragma unroll
        for (int cb = 0; cb < 2; ++cb)
#pragma unroll
            for (int i = 0; i < 4; ++i) { const int t = 16 * rb + 4 * g4 + i, e = 32 * chh + 16 * cb + r16; const size_t ix = (size_t)(row0 + t) * 256 + h * 64 + e;
                otile[(h * 64 + t) * 64 + e] = acc[rb][cb][i] + bf2f(oloc[ix]) + bf2f(oloc[(size_t)MROWS * 256 + ix]); }
    __syncthreads();
    bf16_t* ob = (bf16_t*)(C.ws + WS_O);
    const float ng = p.in[16][layer * 64 + lane];
    bf16_t gts[32];
#pragma unroll
    for (int rr = 0; rr < 32; ++rr) { const int idx = w * 32 + rr, hh = idx >> 6, tt = idx & 63; gts[rr] = zb[(size_t)(row0 + tt) * ZLD + ZB_CG + hh * 64 + lane]; }
#pragma unroll
    for (int rr = 0; rr < 32; ++rr) { const int idx = w * 32 + rr, hh = idx >> 6, tt = idx & 63; const size_t row = (size_t)(row0 + tt);
        const float v = otile[(hh * 64 + tt) * 64 + lane]; const float ss = wave_sum(v * v);
        const float gt = siluf_(bf2f(gts[rr]));
        ob[row * DM + 768 + hh * 64 + lane] = f2bf(v * (1.0f / sqrtf(ss * (1.0f / 64.0f) + RMS_EPS)) * ng * gt); }
}
DI void delta_combine(const Ctx& C, int layer) {
    const Params& p = *C.p; const bf16_t* zb = (const bf16_t*)(C.ws + WS_ZB); const float* od = (const float*)(C.ws + WS_OD); bf16_t* ob = (bf16_t*)(C.ws + WS_O);
    const float ng = p.in[14][layer * 64 + C.lane];
    for (int it0 = C.gw * 4; it0 < MROWS * 4; it0 += C.NGW * 4) {
        float v[4]; bf16_t gr[4];
#pragma unroll
        for (int k = 0; k < 4; ++k) { const int it = it0 + k, h = it & 3; const size_t row = (size_t)(it >> 2);
            v[k] = od[row * 256 + h * 64 + C.lane] + od[(size_t)MROWS * 256 + row * 256 + h * 64 + C.lane]; gr[k] = zb[row * ZLD + ZB_BG + h * 64 + C.lane]; }
#pragma unroll
        for (int k = 0; k < 4; ++k) { const int it = it0 + k, h = it & 3; const size_t row = (size_t)(it >> 2);
            const float ss = wave_sum(v[k] * v[k]); const float gt = siluf_(bf2f(gr[k]));
            ob[row * DM + 512 + h * 64 + C.lane] = f2bf(v[k] * (1.0f / sqrtf(ss * (1.0f / 64.0f) + RMS_EPS)) * ng * gt); }
    }
}

#define XB_TMO      128
#define XB_XCNT(j)  (256  + 64 * (j))
#define XB_XSUB(j)  (1280 + 64 * (j))
#define XB_XGEN(j)  (2304 + 64 * (j))
#define XB_TOP      3328
#define XB_TOPGEN   3392
#define XB_SPIN_CAP (1u << 22)
DI unsigned xb_ld(unsigned* p)              { return __hip_atomic_load(p, __ATOMIC_RELAXED, __HIP_MEMORY_SCOPE_AGENT); }
DI unsigned xb_add(unsigned* p, unsigned v) { return __hip_atomic_fetch_add(p, v, __ATOMIC_RELAXED, __HIP_MEMORY_SCOPE_AGENT); }
DI unsigned xb_xcc_id() { return (unsigned)__builtin_amdgcn_s_getreg((3 << 11) | 20) & 0xFu; }
#define XB_SPIN(cond, bar) do { unsigned _sp = 0; while (cond) { __builtin_amdgcn_s_sleep(1); \
    if ((++_sp & 255u) == 0u) { if (xb_ld(&(bar)[XB_TMO])) break; if (_sp > XB_SPIN_CAP) { atomicAdd(&(bar)[XB_TMO], 1u); break; } } } } while (0)
struct XcdBarrier { unsigned* bar; unsigned x; volatile LAS unsigned* st; };
DI void xcd_barrier_complete(unsigned* bar, unsigned x, unsigned& nloc, unsigned& nx) {
    const unsigned G = gridDim.x * gridDim.y * gridDim.z;
    unsigned sum, cnt, mine, sp = 0u;
    for (;;) {
        sum = 0u; cnt = 0u; mine = 0u;
#pragma unroll
        for (unsigned j = 0; j < 16; ++j) { const unsigned c = xb_ld(&bar[XB_XCNT(j)]); sum += c; cnt += (c > 0u) ? 1u : 0u; mine = (j == x) ? c : mine; }
        if (sum == G) break;
        __builtin_amdgcn_s_sleep(1);
        if ((++sp & 255u) == 0u) { if (xb_ld(&bar[XB_TMO])) break; if (sp > XB_SPIN_CAP) { atomicAdd(&bar[XB_TMO], 1u); break; } }
    }
    nloc = mine > 0u ? mine : 1u; nx = cnt > 0u ? cnt : 1u;
}
DI void xcd_barrier(const XcdBarrier& b) {
    asm volatile("s_waitcnt vmcnt(0)" ::: "memory");
    __syncthreads();
    if (threadIdx.x == 0) {
        unsigned* bar = b.bar;
        __builtin_amdgcn_s_waitcnt(0);
        unsigned nloc = b.st[0], nx = b.st[1];
        if (nloc == 0u) { xcd_barrier_complete(bar, b.x, nloc, nx); b.st[0] = nloc; b.st[1] = nx; }
        const unsigned old = xb_add(&bar[XB_XSUB(b.x)], 1u);
        const unsigned gen = old / nloc;
        if (old + 1u == (gen + 1u) * nloc) {
            __builtin_amdgcn_fence(__ATOMIC_RELEASE, "agent");
            asm volatile("s_waitcnt vmcnt(0)" ::: "memory");
            const unsigned og = xb_add(&bar[XB_TOP], 1u);
            const unsigned tg = og / nx;
            if (og + 1u == (tg + 1u) * nx) xb_add(&bar[XB_TOPGEN], 1u);
            else XB_SPIN(xb_ld(&bar[XB_TOPGEN]) == tg, bar);
            __builtin_amdgcn_fence(__ATOMIC_ACQUIRE, "agent");
            xb_add(&bar[XB_XGEN(b.x)], 1u);
            asm volatile("s_waitcnt vmcnt(0)" ::: "memory");
        } else {
            XB_SPIN(xb_ld(&bar[XB_XGEN(b.x)]) == gen, bar);
            __builtin_amdgcn_fence(__ATOMIC_ACQUIRE, "agent");
            asm volatile("s_waitcnt vmcnt(0)" ::: "memory");
        }
    }
    __syncthreads();
}

DI void probe_stamp(unsigned char* ws, int cls) {
    if (PROBE_A >= 0 && blockIdx.x == 0 && threadIdx.x == 0) {
        volatile float* tsf = (volatile float*)(ws + WS_TAB + 131072); volatile unsigned long long* tsl = (volatile unsigned long long*)(ws + WS_TAB + 131072 + 256);
        const unsigned long long now = __builtin_amdgcn_s_memrealtime(); tsf[cls] += (float)(now - tsl[0]); tsl[0] = now; }
}
template <unsigned PHM_>
__global__ void __launch_bounds__(512) fwd_megakernel(Params p) {
    extern __shared__ __attribute__((aligned(16))) unsigned char lds_raw[];
    XcdBarrier xbar; xbar.bar = (unsigned*)(p.ws + WS_CTL) + 1024; xbar.x = xb_xcc_id(); xbar.st = (volatile LAS unsigned*)((LAS unsigned char*)lds_raw + 147400);
    if (threadIdx.x == 0) { xbar.st[0] = 0u; xbar.st[1] = 0u; (void)xb_add(&xbar.bar[XB_XCNT(xbar.x)], 1u); }
    __syncthreads();
    for (int ph = p.ph_lo; ph < p.ph_hi; ++ph) {
        if (PROBE_A >= 0 && blockIdx.x == 0 && threadIdx.x == 0) {
            volatile float* tsf = (volatile float*)(p.ws + WS_TAB + 131072); volatile unsigned long long* tsl = (volatile unsigned long long*)(p.ws + WS_TAB + 131072 + 256);
            const unsigned long long now = __builtin_amdgcn_s_memrealtime();
            if (ph == 0) { for (int i = 0; i < 16; ++i) tsf[i] = 0.f; tsl[1] = now; }
            else { const int pp = ph - 1; const int cls = pp < 2 ? 8 : (((pp - 2) % 9) == 8 ? 5 : ((pp - 2) % 9)); const float dt = (float)(now - tsl[0]); tsf[cls] += dt; }
            tsl[0] = now;
            if (ph == NPHASE - 2 && PROBE_A < 20) { const float tot = (float)(now - tsl[1]); tsf[12] = rintf(tsf[(PROBE_A >= 0 && PROBE_A < 16) ? PROBE_A : 0] / tot * 40.f) / 40.f; tsf[13] = rintf(tsf[PROBE_B >= 0 ? PROBE_B : 0] / tot * 40.f) / 40.f; }
        }
        if (PROBE_A >= 0 && ph == 0 && threadIdx.x == 0) { volatile float* tsb = (volatile float*)(p.ws + WS_TAB + 196608) + blockIdx.x * 8; for (int i = 0; i < 8; ++i) tsb[i] = 0.f; }
        if (PROBE_A >= 20 && ph == NPHASE - 2 && blockIdx.x == 0 && threadIdx.x == 0) {
            volatile float* tsf = (volatile float*)(p.ws + WS_TAB + 131072); volatile unsigned long long* tsl = (volatile unsigned long long*)(p.ws + WS_TAB + 131072 + 256);
            const float* tsb = (const float*)(p.ws + WS_TAB + 196608); float sum = 0.f; for (int b2 = 0; b2 < (int)gridDim.x; ++b2) sum += __hip_atomic_load(tsb + b2 * 8 + (PROBE_A - 20), __ATOMIC_RELAXED, __HIP_MEMORY_SCOPE_AGENT); sum *= (PROBE_A == 20 ? 32.f : (PROBE_A == 21 ? 16.f : 1.f));
            const float tot = (float)(__builtin_amdgcn_s_memrealtime() - tsl[1]); tsf[12] = rintf(sum / (float)gridDim.x / tot * 40.f) / 40.f; tsf[13] = 0.f; }
        int tid_ = threadIdx.x; asm volatile("" : "+v"(tid_));
        unsigned char* ws_ = p.ws; asm volatile("" : "+s"(ws_));
        float* out_ = p.out; asm volatile("" : "+s"(out_));
        Ctx C; C.p = &p; C.lds = (LAS unsigned char*)lds_raw; C.L = (float*)lds_raw; C.tid = tid_; C.lane = C.tid & 63; C.wave = __builtin_amdgcn_readfirstlane(C.tid >> 6);
        C.G = gridDim.x; C.gw = blockIdx.x * 8 + C.wave; C.NGW = C.G * 8; C.ws = ws_; C.out = out_;
        unsigned* ctl = (unsigned*)(ws_ + WS_CTL);
        const float* modbuf = (const float*)(ws_ + WS_MOD);
        bf16_t* xm = (bf16_t*)(ws_ + WS_XM); bf16_t* ob = (bf16_t*)(ws_ + WS_O); bf16_t* act = (bf16_t*)(ws_ + WS_ACT);
        if (ph == 0) { if (PHON(0)) phase0a(C); }
        else if (ph == 1) { if (PHON(1)) row_pass(C, 0, nullptr, nullptr, modbuf, 1024, 0, true); }
        else {
            const int layer = (ph - 2) / 9, sub = (ph - 2) % 9;
            unsigned char* wb = ws_ + WS_W + (size_t)(layer & 1) * WBUF;
            const float* modl = modbuf + (size_t)layer * 3 * 6144;
            if (sub == 0) { if (PHON(2)) {
                pg8::Gemm g{xm, (const bf16_t*)(wb + W_IN), MROWS, 4096, DM}; pg8::StaticOrder S; S.init(MROWS, 4096, C.G, (int)blockIdx.x);
                EpiIn E{(bf16_t*)(ws_ + WS_Q), (bf16_t*)(ws_ + WS_K), (bf16_t*)(ws_ + WS_V), (bf16_t*)(ws_ + WS_ZB), out_ + OUT_K, out_ + OUT_V, (const f32x2*)(ws_ + WS_TAB), layer};
                pg8::gemm_phase(C.lds, g, S, E, C.tid); }
            } else if (sub == 1) {
                __syncthreads();
                if (PHON(4)) for (int u = blockIdx.x; u < 1024; u += C.G) delta_prep_unit(C, layer, u);
                __syncthreads();
                if (PHON(5)) for (int u = C.gw; u < 2048; u += C.NGW) hgrn_local_unit(C, layer, u);
                __syncthreads();
            } else if (sub == 2) {
                LAS int* slot = (LAS int*)(C.lds + 147392);
                for (;;) {
                    __syncthreads();
                    if (C.tid == 0) *slot = (int)atomicAdd(ctl + 64 * (layer + 1), 1u);
                    __syncthreads();
                    const int u = *slot;
                    if (u >= 1432 + 256) break;
                    if (u >= 1432) { if (layer + 1 < DEPTH) convert_layer_weights(C, layer + 1, (u - 1432) * 8 + C.wave, 2048, u - 1432, 256); continue; }
                    unsigned long long pt0_ = 0; if (PROBE_A >= 0 && C.tid == 0) pt0_ = __builtin_amdgcn_s_memrealtime();
                    if (u < 8) { if (PHON(6)) delta_scan_unit(C, layer, true, u >> 2, u & 3); }
                    else if (u < 24) { const int v = u - 8; if (PHON(7)) hgrn_scan_unit(C, layer, true, v >> 3, (v >> 1) & 3, v & 1); }
                    else if (u < 536) { if (PHON(8)) attn_unit(C, layer, u - 24); }
                    else if (u < 664) { const int v = u - 536; if (PHON(6)) delta_scan_unit(C, layer, false, v >> 2, v & 3); }
                    else if (u < 1176) { if (PHON(8)) attn_unit(C, layer, 512 + (u - 664)); }
                    else { const int v = u - 1176; if (PHON(7)) hgrn_scan_unit(C, layer, false, v >> 3, (v >> 1) & 3, v & 1); }
                    if (PROBE_A >= 0) { __syncthreads(); if (C.tid == 0) { const int ty = (u < 8) ? 0 : (u < 24 ? 1 : (u < 536 ? 2 : (u < 664 ? 3 : (u < 1176 ? 4 : 5))));
                        volatile float* tsb = (volatile float*)(ws_ + WS_TAB + 196608) + blockIdx.x * 8; tsb[ty] += (float)(__builtin_amdgcn_s_memrealtime() - pt0_); } }
                }
            } else if (sub == 3) {
                if (PHON(9)) for (int u = blockIdx.x; u < 256; u += C.G) hgrn_final_unit(C, layer, u);
                __syncthreads();
                if (PHON(10)) delta_combine(C, layer);
                __syncthreads();
            } else if (sub == 4) {
                pg8::Gemm g{ob, (const bf16_t*)(wb + W_OUT), MROWS, DM, DM}; pg8::StaticOrder S; S.init(MROWS, DM, C.G, (int)blockIdx.x);
                EpiRes E{out_, modl + 2048, xm};
                if (PHON(11)) pg8::gemm_phase(C.lds, g, S, E, C.tid);
            } else if (sub == 5) {
                if (PHON(12)) row_pass(C, 1, p.in[20] + (size_t)(layer * 2) * DM, p.in[21] + (size_t)(layer * 2) * DM, modl, 4096, 3072, true);
            } else if (sub == 6) {
                pg8::Gemm g{xm, (const bf16_t*)(wb + W_FFI), MROWS, 2 * DFF, DM}; pg8::StaticOrder S; S.init(MROWS, 2 * DFF, C.G, (int)blockIdx.x);
                EpiFfn E{act};
                if (PHON(13)) pg8::gemm_phase(C.lds, g, S, E, C.tid);
            } else if (sub == 7) {
                pg8::Gemm g{act, (const bf16_t*)(wb + W_FFO), MROWS, DM, DFF}; pg8::StaticOrder S; S.init(MROWS, DM, C.G, (int)blockIdx.x);
                EpiRes E{out_, modl + 5120, xm};
                if (PHON(14)) pg8::gemm_phase(C.lds, g, S, E, C.tid);
            } else {
                const bool last = layer + 1 == DEPTH;
                if (PHON(12)) row_pass(C, 1, p.in[20] + (size_t)(layer * 2 + 1) * DM, p.in[21] + (size_t)(layer * 2 + 1) * DM, modbuf + (size_t)(last ? layer : layer + 1) * 3 * 6144, 1024, 0, !last);
            }
        }
        if (ph + 1 < p.ph_hi) { if (p.ph_hi > 100000) { __threadfence(); cg::this_grid().sync(); } else xcd_barrier(xbar); }
    }
}

#if !MK_ONE_LAUNCH
static unsigned phase_mask(int ph) {
    if (ph == 0) return 1u << 0; if (ph == 1) return 1u << 1;
    const int sub = (ph - 2) % 9;
    switch (sub) { case 0: return 1u << 2; case 1: return (1u << 3) | (1u << 4) | (1u << 5); case 2: return (1u << 6) | (1u << 7) | (1u << 8); case 3: return (1u << 9) | (1u << 10);
        case 4: return 1u << 11; case 5: return 1u << 12; case 6: return 1u << 13; case 7: return 1u << 14; default: return 1u << 12; }
}
typedef void (*kern_t)(Params);
static kern_t kernel_for_mask(unsigned m) {
    switch (m) {
        case 1u << 0: return fwd_megakernel<1u << 0>; case 1u << 1: return fwd_megakernel<1u << 1>; case 1u << 2: return fwd_megakernel<1u << 2>;
        case (1u << 3) | (1u << 4) | (1u << 5): return fwd_megakernel<(1u << 3) | (1u << 4) | (1u << 5)>;
        case (1u << 6) | (1u << 7) | (1u << 8): return fwd_megakernel<(1u << 6) | (1u << 7) | (1u << 8)>;
        case (1u << 9) | (1u << 10): return fwd_megakernel<(1u << 9) | (1u << 10)>;
        case 1u << 11: return fwd_megakernel<1u << 11>; case 1u << 12: return fwd_megakernel<1u << 12>; case 1u << 13: return fwd_megakernel<1u << 13>; default: return fwd_megakernel<1u << 14>;
    }
}
#endif
extern "C" void kernel_launch(void* const* d_in, const int* in_sizes, int n_in, void* d_out, int out_size, void* d_ws, size_t ws_size, hipStream_t stream) {
    static int grid = 0;
    if (grid == 0) {
        if (n_in != 24 || out_size != 58720256 || ws_size < WS_END) { fprintf(stderr, "kernel_launch: unexpected shapes (n_in %d out %d ws %zu)\n", n_in, out_size, ws_size); grid = -1; return; }
        int dev = 0, cus = 0;
        (void)hipGetDevice(&dev); (void)hipDeviceGetAttribute(&cus, hipDeviceAttributeMultiprocessorCount, dev);
#if MK_ONE_LAUNCH
        if (hipFuncSetAttribute((const void*)fwd_megakernel<0x7FFFu>, hipFuncAttributeMaxDynamicSharedMemorySize, LDS_BYTES) != hipSuccess) { fprintf(stderr, "kernel_launch: hipFuncSetAttribute failed\n"); grid = -1; return; }
#else
        for (int ph = 0; ph < 11; ++ph) (void)hipFuncSetAttribute((const void*)kernel_for_mask(phase_mask(ph)), hipFuncAttributeMaxDynamicSharedMemorySize, LDS_BYTES);
#endif
        (void)hipGetLastError();
        grid = cus > 0 ? cus : 256;
        if (grid != 256) { fprintf(stderr, "kernel_launch: expected 256 CUs, got %d\n", grid); grid = 256; }
    }
    if (grid < 0) return;
    (void)hipMemsetAsync((char*)d_ws + WS_CTL, 0, 65536, stream);
    Params p{};
    for (int i = 0; i < 24; ++i) p.in[i] = (const float*)d_in[i];
    p.out = (float*)d_out; p.ws = (unsigned char*)d_ws;
#if MK_ONE_LAUNCH
    p.ph_lo = 0; p.ph_hi = NPHASE;
    void* args[] = {&p};
    hipError_t e = hipLaunchCooperativeKernel((const void*)fwd_megakernel<0x7FFFu>, dim3(grid), dim3(512), args, LDS_BYTES, stream);
    if (e != hipSuccess) fprintf(stderr, "cooperative launch failed: %s (grid %d)\n", hipGetErrorString(e), grid);
#else
    for (int ph = 0; ph < NPHASE; ++ph) { p.ph_lo = ph; p.ph_hi = ph + 1; hipLaunchKernelGGL(kernel_for_mask(phase_mask(ph)), dim3(grid), dim3(512), LDS_BYTES, stream, p); }
#endif
}
```

```cpp
#include <hip/hip_runtime.h>
#include <hip/hip_cooperative_groups.h>
#include <cstdio>
#include <cstdint>
namespace cg = cooperative_groups;

#define PHON(k) ((PHM_ >> (k)) & 1)
#ifndef PROBE_A
#define PROBE_A -1
#endif
#ifndef PROBE_B
#define PROBE_B -1
#endif
#ifndef MK_ONE_LAUNCH
#define MK_ONE_LAUNCH 1
#endif

#define DI __device__ __forceinline__
#define LAS __attribute__((address_space(3)))
typedef unsigned short bf16_t;
typedef short bf16x8 __attribute__((ext_vector_type(8)));
typedef short s16x4 __attribute__((ext_vector_type(4)));
typedef float f32x4 __attribute__((ext_vector_type(4)));
typedef float f32x16 __attribute__((ext_vector_type(16)));
typedef float f32x2 __attribute__((ext_vector_type(2)));
typedef unsigned u32x4 __attribute__((ext_vector_type(4)));
typedef unsigned u32x2 __attribute__((ext_vector_type(2)));

constexpr int MROWS = 16384, DM = 1024, DEPTH = 4, DFF = 2816, DIN = 3856, ZLD = 2320;
constexpr float ALPHA = 1.681792830507429f, LN_EPS = 1e-5f, RMS_EPS = 1e-6f;
constexpr float QSCALE = 0.125f * 1.4426950408889634f;
constexpr int ZB_BQ = 0, ZB_BK = 256, ZB_BV = 512, ZB_BG = 768, ZB_BBETA = 1024, ZB_BA = 1032, ZB_CQ = 1040, ZB_CF = 1296, ZB_CI = 1808, ZB_CG = 2064;
constexpr size_t OUT_K = 16777216, OUT_V = 33554432, OUT_SD = 50331648, OUT_SH = 54525952;
constexpr size_t MiB = 1u << 20;
constexpr size_t WS_CTL = 0, WS_MOD = 64 * 1024, WS_TAB = 512 * 1024, WS_CK = 1 * MiB, WS_CV = 3 * MiB, WS_W = 8 * MiB, WBUF = 27 * MiB;
constexpr size_t W_IN = 0, W_OUT = 8 * MiB, W_FFI = 10 * MiB, W_FFO = 21 * MiB;
constexpr size_t WS_XM = 62 * MiB, WS_O = 94 * MiB, WS_ZB = 126 * MiB, WS_Q = 199 * MiB, WS_K = 215 * MiB, WS_V = 231 * MiB;
constexpr size_t WS_ACT = 126 * MiB;
constexpr size_t WS_DPW = 247 * MiB, WS_DPQD = 263 * MiB, WS_DPQK = 279 * MiB, WS_DPKD = 295 * MiB;
constexpr size_t WS_DPU = WS_XM;
constexpr size_t WS_OD = 311 * MiB, WS_HS = 343 * MiB, WS_HD = 375 * MiB, WS_GL = 375 * MiB + 512 * 1024, WS_END = 376 * MiB;
constexpr int LDS_BYTES = 147456;
constexpr int NPHASE = 2 + 9 * DEPTH;

struct Params { const float* in[24]; float* out; unsigned char* ws; int ph_lo, ph_hi; };

DI unsigned cvt_pk_bf16(float lo, float hi) { unsigned r; asm("v_cvt_pk_bf16_f32 %0, %1, %2" : "=v"(r) : "v"(lo), "v"(hi)); return r; }
DI bf16_t f2bf(float f) { return (bf16_t)(cvt_pk_bf16(f, 0.f) & 0xffffu); }
DI float bf2f(bf16_t b) { return __uint_as_float(((unsigned)b) << 16); }
DI float sigmoidf_(float x) { return __builtin_amdgcn_rcpf(1.0f + __expf(-x)); }
DI float siluf_(float x) { return x * __builtin_amdgcn_rcpf(1.0f + __expf(-x)); }
DI float wave_sum(float v) {
#pragma unroll
    for (int o = 1; o < 64; o <<= 1) v += __shfl_xor(v, o);
    return v;
}
DI u32x2 pack4(f32x4 v) { u32x2 w; w.x = cvt_pk_bf16(v[0], v[1]); w.y = cvt_pk_bf16(v[2], v[3]); return w; }
DI bf16x8 pack8(f32x4 a, f32x4 b) { u32x4 w; w.x = cvt_pk_bf16(a[0], a[1]); w.y = cvt_pk_bf16(a[2], a[3]); w.z = cvt_pk_bf16(b[0], b[1]); w.w = cvt_pk_bf16(b[2], b[3]); return __builtin_bit_cast(bf16x8, w); }
DI int pinv(int k) { return (k >> 5) * 32 + ((k >> 2) & 3) * 8 + ((k >> 4) & 1) * 4 + (k & 3); }
DI int row_mod(int r) { return r < 8192 ? 0 : 1 + ((r - 8192) >> 12); }

namespace pg8 {
constexpr int BM = 256, BK = 64, HALF = 128, HTB = HALF * BK * 2, STAGE_BYTES = 8 * HTB, NXCD = 8, WGM = 8;
DI int lds_byte(int r, int c) { const int st = (r >> 4) * 2 + (c >> 5), rr = r & 15, cc = c & 31, ob = rr * 64 + cc * 2; return st * 1024 + (ob ^ (((ob >> 9) & 1) << 5)); }
DI void stage_rc(int b, int& R, int& C) { const int st = b / 1024, sb = b % 1024, swz = sb ^ (((sb >> 9) & 1) << 5); R = (st >> 1) * 16 + swz / 64; C = (st & 1) * 32 + (swz % 64) / 2; }
struct Unit { int pm, pn; };
struct Gemm { const bf16_t* A; const bf16_t* Bt; int M, N, K; };
struct StaticOrder {
    int nM, nN, nwg, G, c;
    DI void init(int M, int N, int G_, int c_) { nM = M / BM; nN = N / BM; nwg = nM * nN; G = G_; c = c_; }
    DI bool next(int i, Unit& u) const {
        const long L = (long)i * G + c; if (L >= nwg) return false;
        int wgid = (int)L; { const int q = nwg / NXCD, r = nwg % NXCD, xcd = wgid % NXCD, off = wgid / NXCD; wgid = (xcd < r ? xcd * (q + 1) : r * (q + 1) + (xcd - r) * q) + off; }
        const int nig = WGM * nN, gid = wgid / nig, fm = gid * WGM, gsz = (nM - fm) < WGM ? (nM - fm) : WGM;
        u.pm = fm + ((wgid % nig) % gsz); u.pn = (wgid % nig) / gsz; return true;
    }
};

template <class Epi>
DI void gemm_phase(LAS unsigned char* lds, const Gemm g, const StaticOrder& S, const Epi& E, int tid_in) {
    const int tid = tid_in, wid = __builtin_amdgcn_readfirstlane(tid >> 6), lane = tid & 63, wr = wid >> 2, wc = wid & 3, fr = lane & 15, fq = lane >> 4;
    const int K = g.K, nt = K / BK;
    unsigned voffA[2];
#pragma unroll
    for (int i = 0; i < 2; ++i) { int R, C; stage_rc(tid * 16 + i * 8192, R, C); voffA[i] = (unsigned)(R * K + C) * 2u; }
    const size_t kstep = (size_t)(BK * 2);
    const size_t hstep = (size_t)HALF * K * 2;
    const size_t tstep = 2 * hstep;
    const unsigned ldsw = (unsigned)wid * 1024u;
    const int aoff = lds_byte(wr * 64 + fr, fq * 8), boff = lds_byte(wc * 32 + fr, fq * 8);
#define PG8_SA(b, h) (((b) * 2 + (h)) * HTB)
#define PG8_SB(b, h) ((4 + (b) * 2 + (h)) * HTB)
#define PG8_STAGE(bufoff, gbase) do { _Pragma("unroll") for (int _i = 0; _i < 2; ++_i) \
        __builtin_amdgcn_global_load_lds((const unsigned*)((const char*)(gbase) + voffA[_i]), (LAS unsigned*)(lds + (bufoff) + ldsw + _i * 8192), 16, 0, 0); } while (0)
#define PG8_LDA(dst, b, h) do { _Pragma("unroll") for (int m = 0; m < 4; ++m) _Pragma("unroll") for (int k = 0; k < 2; ++k) dst[m][k] = *(const LAS bf16x8*)(lds + PG8_SA(b, h) + aoff + m * 2048 + k * 1024); } while (0)
#define PG8_LDB(dst, b, h) do { _Pragma("unroll") for (int n = 0; n < 2; ++n) _Pragma("unroll") for (int k = 0; k < 2; ++k) dst[n][k] = *(const LAS bf16x8*)(lds + PG8_SB(b, h) + boff + n * 2048 + k * 1024); } while (0)
#define PG8_MMA(ai, bj, At, Bt) do { __builtin_amdgcn_s_setprio(1); _Pragma("unroll") for (int m = 0; m < 4; ++m) _Pragma("unroll") for (int n = 0; n < 2; ++n) _Pragma("unroll") for (int k = 0; k < 2; ++k) \
        acc[ai][bj][m][n] = __builtin_amdgcn_mfma_f32_16x16x32_bf16(Bt[n][k], At[m][k], acc[ai][bj][m][n], 0, 0, 0); __builtin_amdgcn_s_setprio(0); } while (0)
#define PG8_WAIT_V(n) asm volatile("s_waitcnt vmcnt(" #n ")" ::: "memory")
#define PG8_WAIT_L(n) asm volatile("s_waitcnt lgkmcnt(" #n ")" ::: "memory")
#define PG8_BAR __builtin_amdgcn_s_barrier()
#define PG8_SCHED __builtin_amdgcn_sched_barrier(0)
    Unit cur, nxt; int ui = 0;
    if (!S.next(0, cur)) return;
    f32x4 acc[2][2][4][2];
#pragma unroll
    for (int a = 0; a < 2; ++a)
#pragma unroll
        for (int b = 0; b < 2; ++b)
#pragma unroll
            for (int m = 0; m < 4; ++m)
#pragma unroll
                for (int n = 0; n < 2; ++n) acc[a][b][m][n] = (f32x4){0.f, 0.f, 0.f, 0.f};
    bf16x8 At[4][2], B0[2][2], B1[2][2];
    const char* cA = (const char*)g.A + (size_t)cur.pm * tstep; const char* cB = (const char*)g.Bt + (size_t)cur.pn * tstep;
    PG8_STAGE(PG8_SB(0, 0), cB); PG8_STAGE(PG8_SB(0, 1), cB + hstep); PG8_STAGE(PG8_SA(0, 0), cA); PG8_STAGE(PG8_SA(0, 1), cA + hstep);
    if (wr == 1) PG8_BAR;
    PG8_WAIT_V(2); PG8_BAR;
    PG8_STAGE(PG8_SB(1, 0), cB + kstep); PG8_STAGE(PG8_SA(1, 0), cA + kstep); PG8_STAGE(PG8_SB(1, 1), cB + hstep + kstep);
    PG8_WAIT_V(6); PG8_BAR;
    for (;;) {
        const bool has_next = S.next(ui + 1, nxt);
        const char* nA = has_next ? (const char*)g.A + (size_t)nxt.pm * tstep : cA; const char* nB = has_next ? (const char*)g.Bt + (size_t)nxt.pn * tstep : cB;
        for (int t = 0; t < nt; t += 2) {
            const bool last = (t == nt - 2);
            const char* a1 = cA + (size_t)(t + 1) * kstep;
            const char* a2 = last ? nA : cA + (size_t)(t + 2) * kstep; const char* b2 = last ? nB : cB + (size_t)(t + 2) * kstep;
            const char* a3 = a2 + kstep; const char* b3 = b2 + kstep;
            PG8_LDB(B0, 0, 0); PG8_LDB(B1, 0, 1); PG8_SCHED; PG8_LDA(At, 0, 0); PG8_STAGE(PG8_SA(1, 1), a1 + hstep);
            PG8_WAIT_V(8); PG8_WAIT_L(0); PG8_BAR; PG8_MMA(0, 0, At, B0); PG8_MMA(0, 1, At, B1); PG8_BAR; PG8_SCHED;
            PG8_LDA(At, 0, 1); PG8_STAGE(PG8_SB(0, 0), b2); PG8_STAGE(PG8_SB(0, 1), b2 + hstep); PG8_STAGE(PG8_SA(0, 0), a2);
            PG8_WAIT_V(8); PG8_WAIT_L(0); PG8_BAR; PG8_MMA(1, 0, At, B0); PG8_MMA(1, 1, At, B1); PG8_BAR; PG8_SCHED;
            PG8_LDB(B0, 1, 0); PG8_LDB(B1, 1, 1); PG8_SCHED; PG8_LDA(At, 1, 0); PG8_STAGE(PG8_SA(0, 1), a2 + hstep);
            PG8_WAIT_V(8); PG8_WAIT_L(0); PG8_BAR; PG8_MMA(0, 0, At, B0); PG8_MMA(0, 1, At, B1); PG8_BAR; PG8_SCHED;
            PG8_LDA(At, 1, 1); PG8_STAGE(PG8_SB(1, 0), b3); PG8_STAGE(PG8_SB(1, 1), b3 + hstep); PG8_STAGE(PG8_SA(1, 0), a3);
            PG8_WAIT_V(8); PG8_WAIT_L(0); PG8_BAR; PG8_MMA(1, 0, At, B0); PG8_MMA(1, 1, At, B1); PG8_BAR; PG8_SCHED;
        }
        if (wr == 0) PG8_BAR;
        E(acc, cur, wr, wc, fr, fq);
        if (!has_next) break;
#pragma unroll
        for (int a = 0; a < 2; ++a)
#pragma unroll
            for (int b = 0; b < 2; ++b)
#pragma unroll
                for (int m = 0; m < 4; ++m)
#pragma unroll
                    for (int n = 0; n < 2; ++n) acc[a][b][m][n] = (f32x4){0.f, 0.f, 0.f, 0.f};
        cur = nxt; cA = nA; cB = nB; ++ui;
        if (wr == 1) PG8_BAR;
    }
    PG8_WAIT_V(0);
    PG8_BAR;
#undef PG8_SA
#undef PG8_SB
#undef PG8_STAGE
#undef PG8_LDA
#undef PG8_LDB
#undef PG8_MMA
#undef PG8_WAIT_V
#undef PG8_WAIT_L
#undef PG8_BAR
#undef PG8_SCHED
}
}

struct EpiIn {
    bf16_t *Qb, *Kb, *Vb, *zb; float *outK, *outV; const f32x2* rope; int layer;
    DI void operator()(const f32x4 (&acc)[2][2][4][2], const pg8::Unit& u, int wr, int wc, int fr, int fq) const {
        const int tile = u.pn; const bool sample = u.pm >= 32;
        if (tile < 6) {
            const int kind = tile >> 1; const int cb = (tile & 1) * 256 + wc * 32 + 4 * fq;
            bf16_t* dst = Qb + (size_t)kind * (16u * 1024u * 1024u / 2u);
            float* of = outK + (size_t)(kind >= 1 ? kind - 1 : 0) * 16777216u;
#pragma unroll
            for (int ai = 0; ai < 2; ++ai)
#pragma unroll
                for (int m = 0; m < 4; ++m) {
                    const int r = u.pm * 256 + ai * 128 + wr * 64 + m * 16 + fr;
#pragma unroll
                    for (int bj = 0; bj < 2; ++bj) {
                        f32x4 a = acc[ai][bj][m][0], b = acc[ai][bj][m][1]; const int cc = cb + bj * 128;
                        if (!sample && kind >= 1) { float* o = of + ((size_t)((r >> 8) * 4 + layer) * 256 + (r & 255)) * 512 + cc; *(f32x4*)o = a; *(f32x4*)(o + 16) = b; }
                        if (sample && kind < 2) {
                            const int t = (r - 8192) & 4095; const int pos = (wc & 1) ? (t & 63) : (t >> 6); const f32x2* rp = rope + pos * 16 + 4 * fq;
#pragma unroll
                            for (int j = 0; j < 4; ++j) { const f32x2 cs = rp[j]; const float x1 = a[j], x2 = b[j]; a[j] = x1 * cs.x - x2 * cs.y; b[j] = x2 * cs.x + x1 * cs.y; }
                        }
                        if (kind == 0) { a = a * QSCALE; b = b * QSCALE; }
                        if (kind == 2) {
                            const int hh = cc >> 7, dv0 = cc & 127, tt = sample ? ((r - 8192) & 4095) : (r & 255);
                            bf16_t* vt = sample ? Vb + 4194304 + ((size_t)((((r - 8192) >> 12) * 4 + hh) * 32 + (tt >> 7)) * 128 + dv0) * 128 + (tt & 127)
                                                : Vb + ((size_t)(((r >> 8) * 4 + hh) * 2 + (tt >> 7)) * 128 + dv0) * 128 + (tt & 127);
#pragma unroll
                            for (int j = 0; j < 4; ++j) { vt[(size_t)j * 128] = f2bf(a[j]); vt[(size_t)(16 + j) * 128] = f2bf(b[j]); }
                        } else { *(u32x2*)(dst + (size_t)r * 512 + cc) = pack4(a); *(u32x2*)(dst + (size_t)r * 512 + cc + 16) = pack4(b); }
                    }
                    asm volatile("" ::: "memory");
                }
        } else {
#pragma unroll
            for (int ai = 0; ai < 2; ++ai)
#pragma unroll
                for (int m = 0; m < 4; ++m) {
                    const int r = u.pm * 256 + ai * 128 + wr * 64 + m * 16 + fr;
#pragma unroll
                    for (int bj = 0; bj < 2; ++bj)
#pragma unroll
                        for (int n = 0; n < 2; ++n) { const int c = (tile - 6) * 256 + bj * 128 + wc * 32 + 16 * n + 4 * fq; if (c < ZLD) *(u32x2*)(zb + (size_t)r * ZLD + c) = pack4(acc[ai][bj][m][n]); }
                    asm volatile("" ::: "memory");
                }
        }
    }
};
struct EpiRes {
    float* x; const float* gate; bf16_t* vb;
    DI void operator()(const f32x4 (&acc)[2][2][4][2], const pg8::Unit& u, int wr, int wc, int fr, int fq) const {
        const float* gv = gate + row_mod(u.pm * 256) * 6144;
#pragma unroll
        for (int ai = 0; ai < 2; ++ai)
#pragma unroll
            for (int m = 0; m < 4; ++m) {
                const int r = u.pm * 256 + ai * 128 + wr * 64 + m * 16 + fr;
#pragma unroll
                for (int bj = 0; bj < 2; ++bj)
#pragma unroll
                    for (int n = 0; n < 2; ++n) { const int c = u.pn * 256 + bj * 128 + wc * 32 + 16 * n + 4 * fq; const f32x4 g4 = *(const f32x4*)(gv + c); const u32x2 xw = *(const u32x2*)((const bf16_t*)x + (size_t)r * DM + c); const f32x4 xv = (f32x4){__uint_as_float(xw.x << 16), __uint_as_float(xw.x & 0xffff0000u), __uint_as_float(xw.y << 16), __uint_as_float(xw.y & 0xffff0000u)}; *(u32x2*)(vb + (size_t)r * DM + c) = pack4(xv * ALPHA + g4 * acc[ai][bj][m][n]); }
            }
    }
};
struct EpiFfn {
    bf16_t* act;
    DI void operator()(const f32x4 (&acc)[2][2][4][2], const pg8::Unit& u, int wr, int wc, int fr, int fq) const {
#pragma unroll
        for (int ai = 0; ai < 2; ++ai)
#pragma unroll
            for (int m = 0; m < 4; ++m) {
                const int r = u.pm * 256 + ai * 128 + wr * 64 + m * 16 + fr;
#pragma unroll
                for (int n = 0; n < 2; ++n) { const f32x4 gt = acc[ai][0][m][n], up = acc[ai][1][m][n]; f32x4 o;
#pragma unroll
                    for (int j = 0; j < 4; ++j) o[j] = siluf_(gt[j]) * up[j];
                    *(u32x2*)(act + (size_t)r * DFF + u.pn * 128 + wc * 32 + 16 * n + 4 * fq) = pack4(o); }
            }
    }
};

struct Ctx {
    const Params* p; LAS unsigned char* lds; float* L; int tid, lane, wave, G, gw, NGW;
    unsigned char* ws; float* out;
};

DI void tr_item(const float* W, int K, int N, bf16_t* WT, int mode, float* scr, int item, int lane) {
    const int nblk = (N + 31) / 32, kb = item / nblk, nb = item % nblk, k0 = 64 * kb, n0 = 32 * nb;
    const int nn = n0 + 4 * (lane & 7);
#pragma unroll
    for (int i = 0; i < 8; ++i) { const int kk = 8 * i + (lane >> 3); const f32x4 v4 = (nn < N) ? *(const f32x4*)(W + (size_t)(k0 + kk) * N + nn) : (f32x4){0.f, 0.f, 0.f, 0.f};
        float* sp_ = scr + kk * 33 + 4 * (lane & 7); sp_[0] = v4[0]; sp_[1] = v4[1]; sp_[2] = v4[2]; sp_[3] = v4[3]; }
    __builtin_amdgcn_wave_barrier();
    const int c = lane & 7;
#pragma unroll
    for (int j = 0; j < 4; ++j) {
        const int nl = (lane >> 3) + 8 * j, n = n0 + nl; const float* s = scr + (8 * c) * 33 + nl;
        if (n < N) {
            int dst = n; if (mode == 1) { if (n < DFF) dst = (n >> 7) * 256 + (n & 127); else { const int jj = n - DFF; dst = (jj >> 7) * 256 + 128 + (jj & 127); } }
            u32x4 o; o.x = cvt_pk_bf16(s[0 * 33], s[1 * 33]); o.y = cvt_pk_bf16(s[2 * 33], s[3 * 33]); o.z = cvt_pk_bf16(s[4 * 33], s[5 * 33]); o.w = cvt_pk_bf16(s[6 * 33], s[7 * 33]);
            *(u32x4*)(WT + (size_t)dst * K + k0 + 8 * c) = o;
        }
    }
    __builtin_amdgcn_wave_barrier();
}
DI void convert_layer_weights(const Ctx& C, int layer, int gw0 = -1, int ngw = 0, int blk = -1, int nblk = 0) {
    const Params& p = *C.p;
    unsigned char* wb = C.ws + WS_W + (size_t)(layer & 1) * WBUF;
    bf16_t* Win = (bf16_t*)(wb + W_IN); bf16_t* Wout = (bf16_t*)(wb + W_OUT); bf16_t* Wffi = (bf16_t*)(wb + W_FFI); bf16_t* Wffo = (bf16_t*)(wb + W_FFO);
    float* scr = C.L + C.wave * (64 * 33);
    constexpr int I_IN = 16 * 121, I_OUT = 16 * 32, I_FFI = 16 * 176, I_FFO = 44 * 32, NIT = I_IN + I_OUT + I_FFI + I_FFO;
    int lane_ = C.lane; asm volatile("" : "+v"(lane_));
    const int gwA = gw0 >= 0 ? gw0 : C.gw, ngwA = gw0 >= 0 ? ngw : C.NGW, blkA = blk >= 0 ? blk : (int)blockIdx.x, nblkA = blk >= 0 ? nblk : C.G;
    for (int it = gwA; it < NIT; it += ngwA) {
        int r = it;
        if (r < I_IN) { tr_item(p.in[10] + (size_t)layer * DM * DIN, DM, DIN, Win, 0, scr, r, lane_); continue; } r -= I_IN;
        if (r < I_OUT) { tr_item(p.in[19] + (size_t)layer * DM * DM, DM, DM, Wout, 0, scr, r, lane_); continue; } r -= I_OUT;
        if (r < I_FFI) { tr_item(p.in[22] + (size_t)layer * DM * 2 * DFF, DM, 2 * DFF, Wffi, 1, scr, r, lane_); continue; } r -= I_FFI;
        tr_item(p.in[23] + (size_t)layer * DFF * DM, DFF, DM, Wffo, 0, scr, r, lane_);
    }
    u32x4* z = (u32x4*)(Win + (size_t)DIN * DM); const int nz = 240 * DM * 2 / 16;
    for (int i = blkA * 512 + C.tid; i < nz; i += nblkA * 512) z[i] = (u32x4){0u, 0u, 0u, 0u};
}

DI void mod_unit(const Ctx& C, int u) {
    const Params& p = *C.p; const int tid = C.tid;
    float* cs = C.L; float* red = C.L + 3072;
    const int layer = u >> 6, col0 = (u & 63) * 96;
    __syncthreads();
    for (int i = tid; i < 3072; i += 512) { const int v = i >> 10, k = i & 1023; const float c = (v == 0) ? p.in[7][k] : p.in[6][(v - 1) * 1024 + k]; cs[i] = siluf_(c); }
    __syncthreads();
    if (tid < 504) {
        const int cgp = tid % 24, rs = tid / 24;
        f32x4 a0 = {0, 0, 0, 0}, a1 = a0, a2 = a0;
        const float* Wp = p.in[8] + (size_t)layer * DM * 6144 + col0 + cgp * 4;
#pragma unroll 7
        for (int k = rs; k < 1024; k += 21) { const f32x4 w = *(const f32x4*)(Wp + (size_t)k * 6144); a0 += w * cs[k]; a1 += w * cs[1024 + k]; a2 += w * cs[2048 + k]; }
        float* rr = red + rs * 288 + cgp * 4;
#pragma unroll
        for (int j = 0; j < 4; ++j) { rr[j] = a0[j]; rr[96 + j] = a1[j]; rr[192 + j] = a2[j]; }
    }
    __syncthreads();
    if (tid < 288) {
        const int v = tid / 96, cc = tid % 96; float s = 0.f;
        for (int rs = 0; rs < 21; ++rs) s += red[rs * 288 + tid];
        ((float*)(C.ws + WS_MOD))[(size_t)(layer * 3 + v) * 6144 + col0 + cc] = s + p.in[9][layer * 6144 + col0 + cc];
    }
}

DI void phase0a(const Ctx& C) {
    const Params& p = *C.p;
    for (int u = blockIdx.x; u < 64; u += C.G) mod_unit(C, u);
    __syncthreads();
    convert_layer_weights(C, 0);
    const int gt = blockIdx.x * 512 + C.tid, NT = C.G * 512;
    float* tab = (float*)(C.ws + WS_TAB);
    if (gt < 1024) { const int pos = gt >> 4, i = gt & 15; const float inv = __builtin_amdgcn_exp2f(-(float)i * (13.287712379549449f / 16.0f)); float rev = (float)pos * inv * 0.15915494309189535f; rev -= floorf(rev);
        tab[2 * gt] = __builtin_amdgcn_cosf(rev); tab[2 * gt + 1] = __builtin_amdgcn_sinf(rev); }
    if (gt >= 1024 && gt < 1028) { const int l = gt - 1024; const float* dl = p.in[17] + l * 256; float s01 = 0.f, s23 = 0.f; for (int i = 0; i < 64; ++i) { s01 += dl[i] * dl[64 + i]; s23 += dl[128 + i] * dl[192 + i]; }
        tab[2048 + l] = __expf(s01) - __expf(s23) + (0.8f - 0.6f * __expf(-0.3f * (float)l)); }
    if (gt >= 2048 && gt < 2560) { const int dir = (gt - 2048) >> 8, c = gt & 255; const float* lb = p.in[15] + dir * 1024 + c; float v[4], mx = -1e30f; for (int l = 0; l < 4; ++l) { v[l] = lb[l * 256]; mx = fmaxf(mx, v[l]); }
        float s = 0.f; for (int l = 0; l < 4; ++l) { v[l] = __expf(v[l] - mx); s += v[l]; } float cum = 0.f; for (int l = 0; l < 4; ++l) { if (l > 0) cum += v[l] / s; tab[4096 + (dir * 4 + l) * 256 + c] = cum; } }
    bf16_t* ck = (bf16_t*)(C.ws + WS_CK); bf16_t* cv = (bf16_t*)(C.ws + WS_CV);
    for (int i = gt; i < 2 * 4 * 256 * 512 / 4; i += NT) { const int e = i * 4; const int c = e & 511, j = (e >> 9) & 255, l = (e >> 17) & 3, b = e >> 19;
        const size_t dst = ((size_t)((l * 2 + b) * 256 + j)) * 512 + c;
        *(u32x2*)(ck + dst) = pack4(*(const f32x4*)(p.in[2] + e)); }
    for (int i = gt; i < 2 * 4 * 256 * 512; i += NT) { const int j = i & 255, dv = (i >> 8) & 127, hh = (i >> 15) & 3, b = (i >> 17) & 1, l = i >> 18;
        cv[((size_t)((((l * 2 + b) * 4 + hh) * 2 + (j >> 7)) * 128 + dv)) * 128 + (j & 127)] = f2bf(p.in[3][((size_t)((b * 4 + l) * 256 + j) * 4 + hh) * 128 + dv]); }
}

DI void row_pass(const Ctx& C, int mode, const float* lng, const float* lnb, const float* modl, int sc_off, int sh_off, bool write_xm) {
    const Params& p = *C.p; float* x = C.out; bf16_t* xm = (bf16_t*)(C.ws + WS_XM);
    for (int r0 = C.gw; r0 < MROWS; r0 += 2 * C.NGW) {
        f32x4 v[2][4];
#pragma unroll
        for (int u = 0; u < 2; ++u) { const int r = r0 + u * C.NGW;
            if (mode == 0) { const float* src = (r < 8192 ? p.in[0] + (size_t)r * DM : p.in[1] + (size_t)(r - 8192) * DM);
#pragma unroll
                for (int j = 0; j < 4; ++j) v[u][j] = *(const f32x4*)(src + 4 * C.lane + 256 * j); }
            else {
#pragma unroll
                for (int j = 0; j < 4; ++j) { const u32x2 w2 = *(const u32x2*)(xm + (size_t)r * DM + 4 * C.lane + 256 * j);
                    v[u][j] = (f32x4){__uint_as_float(w2.x << 16), __uint_as_float(w2.x & 0xffff0000u), __uint_as_float(w2.y << 16), __uint_as_float(w2.y & 0xffff0000u)}; } } }
#pragma unroll
        for (int u = 0; u < 2; ++u) { const int r = r0 + u * C.NGW;
            if (mode == 1) {
                float s = 0.f;
#pragma unroll
                for (int j = 0; j < 4; ++j) s += (v[u][j][0] + v[u][j][1]) + (v[u][j][2] + v[u][j][3]);
                const float mean = wave_sum(s) * (1.f / DM); float s2 = 0.f;
#pragma unroll
                for (int j = 0; j < 4; ++j) { v[u][j] = v[u][j] - mean; s2 += (v[u][j][0] * v[u][j][0] + v[u][j][1] * v[u][j][1]) + (v[u][j][2] * v[u][j][2] + v[u][j][3] * v[u][j][3]); }
                const float rstd = 1.0f / sqrtf(wave_sum(s2) * (1.f / DM) + LN_EPS);
#pragma unroll
                for (int j = 0; j < 4; ++j) { const f32x4 g4 = *(const f32x4*)(lng + 4 * C.lane + 256 * j), b4 = *(const f32x4*)(lnb + 4 * C.lane + 256 * j); v[u][j] = v[u][j] * rstd * g4 + b4; }
            }
            if (PROBE_A >= 0 && !write_xm) { const float* tsf = (const float*)(C.ws + WS_TAB + 131072); const float sc = 1.0f + ((r >= 8192) ? tsf[12] : (PROBE_B >= 0 ? tsf[13] : 0.f));
#pragma unroll
                for (int j = 0; j < 4; ++j) v[u][j] = v[u][j] * sc; }
            if (!write_xm) {
#pragma unroll
                for (int j = 0; j < 4; ++j) *(f32x4*)(x + (size_t)r * DM + 4 * C.lane + 256 * j) = v[u][j];
            } else {
#pragma unroll
                for (int j = 0; j < 4; ++j) *(u32x2*)((bf16_t*)x + (size_t)r * DM + 4 * C.lane + 256 * j) = pack4(v[u][j]);
            }
            if (write_xm) {
                const float* mv = modl + row_mod(r) * 6144;
#pragma unroll
                for (int j = 0; j < 4; ++j) { const int c = 4 * C.lane + 256 * j; const f32x4 sc = *(const f32x4*)(mv + sc_off + c), sh = *(const f32x4*)(mv + sh_off + c);
                    *(u32x2*)(xm + (size_t)r * DM + c) = pack4(v[u][j] * (sc + 1.0f) + sh); }
            }
        }
    }
}

#define MFMA32(a, b, c) __builtin_amdgcn_mfma_f32_32x32x16_bf16((a), (b), (c), 0, 0, 0)
#define MFMA16(a, b, c) __builtin_amdgcn_mfma_f32_16x16x32_bf16((a), (b), (c), 0, 0, 0)
constexpr int AK_LD = 72, AV_LD = 136;
struct AttnSrc { const bf16_t* Klat; const bf16_t* Kctx; const bf16_t* VTlat; const bf16_t* VTctx; int ldv; int nst; int nlat; int h; };
template <int PASS>
DI void attn_pass(int tid, int q, int hi, int kq, const AttnSrc& A, LAS bf16_t* K1s, LAS bf16_t* K2s, LAS bf16_t* VTs, const bf16x8 (&q1)[4], const bf16x8 (&q2)[4],
                  float& m1, float& l1, float& m2, float& l2, float iL1, float iL2, f32x16 (&o)[4]) {
    u32x4 kreg[4], vreg[4];
    const int h = A.h;
    auto issue = [&](int st) {
        const bf16_t* kb = (st < A.nlat) ? A.Klat + (size_t)st * 128 * 512 : A.Kctx + (size_t)(st - A.nlat) * 128 * 512;
#pragma unroll
        for (int i = 0; i < 2; ++i) { const int id = tid + 512 * i, key = id >> 3, ch = id & 7; kreg[i] = *(const u32x4*)(kb + (size_t)key * 512 + h * 128 + ch * 8); kreg[2 + i] = *(const u32x4*)(kb + (size_t)key * 512 + h * 128 + 64 + ch * 8); }
        if (PASS == 1) {
            const bf16_t* vb = (st < A.nlat) ? A.VTlat + (size_t)st * 128 : A.VTctx + (size_t)(st - A.nlat) * 128; const int ld = (st < A.nlat) ? A.ldv : 256;
#pragma unroll
            for (int i = 0; i < 4; ++i) { const int id = tid + 512 * i, dv = id >> 4, ch = id & 15; vreg[i] = *(const u32x4*)(vb + (size_t)dv * ld + ch * 8); }
        }
    };
    issue(0);
    for (int st = 0; st < A.nst; ++st) {
        __syncthreads();
#pragma unroll
        for (int i = 0; i < 2; ++i) { const int id = tid + 512 * i, key = id >> 3, ch = id & 7; *(LAS u32x4*)(K1s + key * AK_LD + ch * 8) = kreg[i]; *(LAS u32x4*)(K2s + key * AK_LD + ch * 8) = kreg[2 + i]; }
        if (PASS == 1) {
#pragma unroll
            for (int i = 0; i < 4; ++i) { const int id = tid + 512 * i, dv = id >> 4, ch = id & 15; *(LAS u32x4*)(VTs + dv * AV_LD + ch * 8) = vreg[i]; }
        }
        __syncthreads();
        if (st + 1 < A.nst) issue(st + 1);
        const int keyrow = kq * 32 + q;
        f32x16 s1, pr;
#pragma unroll
        for (int r = 0; r < 16; ++r) s1[r] = 0.f;
#pragma unroll
        for (int ks = 0; ks < 4; ++ks) { const bf16x8 a1 = *(const LAS bf16x8*)(K1s + keyrow * AK_LD + 16 * ks + 8 * hi); s1 = MFMA32(a1, q1[ks], s1); }
        if (PASS == 0) {
            float mx1 = s1[0];
#pragma unroll
            for (int r = 1; r < 16; ++r) mx1 = fmaxf(mx1, s1[r]);
            const float n1 = fmaxf(m1, mx1); float a1s = 0.f;
#pragma unroll
            for (int r = 0; r < 16; ++r) a1s += __builtin_amdgcn_exp2f(s1[r] - n1);
            l1 = l1 * __builtin_amdgcn_exp2f(m1 - n1) + a1s; m1 = n1;
        } else {
#pragma unroll
            for (int r = 0; r < 16; ++r) pr[r] = __builtin_amdgcn_exp2f(s1[r] - m1) * iL1;
        }
#pragma unroll
        for (int r = 0; r < 16; ++r) s1[r] = 0.f;
#pragma unroll
        for (int ks = 0; ks < 4; ++ks) { const bf16x8 a2 = *(const LAS bf16x8*)(K2s + keyrow * AK_LD + 16 * ks + 8 * hi); s1 = MFMA32(a2, q2[ks], s1); }
        if (PASS == 0) {
            float mx2 = s1[0];
#pragma unroll
            for (int r = 1; r < 16; ++r) mx2 = fmaxf(mx2, s1[r]);
            const float n2 = fmaxf(m2, mx2); float a2s = 0.f;
#pragma unroll
            for (int r = 0; r < 16; ++r) a2s += __builtin_amdgcn_exp2f(s1[r] - n2);
            l2 = l2 * __builtin_amdgcn_exp2f(m2 - n2) + a2s; m2 = n2;
        } else {
#pragma unroll
            for (int r = 0; r < 16; ++r) pr[r] -= __builtin_amdgcn_exp2f(s1[r] - m2) * iL2;
            bf16x8 pb[2];
            { u32x4 t0, t1; t0.x = cvt_pk_bf16(pr[0], pr[1]); t0.y = cvt_pk_bf16(pr[2], pr[3]); t0.z = cvt_pk_bf16(pr[4], pr[5]); t0.w = cvt_pk_bf16(pr[6], pr[7]);
              t1.x = cvt_pk_bf16(pr[8], pr[9]); t1.y = cvt_pk_bf16(pr[10], pr[11]); t1.z = cvt_pk_bf16(pr[12], pr[13]); t1.w = cvt_pk_bf16(pr[14], pr[15]);
              pb[0] = __builtin_bit_cast(bf16x8, t0); pb[1] = __builtin_bit_cast(bf16x8, t1); }
#pragma unroll
            for (int blk = 0; blk < 4; ++blk)
#pragma unroll
                for (int s = 0; s < 2; ++s) {
                    const LAS bf16_t* vp = VTs + (blk * 32 + q) * AV_LD + kq * 32 + 16 * s + 4 * hi;
                    const s16x4 lo = *(const LAS s16x4*)vp, hh = *(const LAS s16x4*)(vp + 8);
                    const bf16x8 av = __builtin_shufflevector(lo, hh, 0, 1, 2, 3, 4, 5, 6, 7);
                    o[blk] = MFMA32(av, pb[s], o[blk]);
                }
        }
    }
}
DI void attn_unit(const Ctx& C, int layer, int uidx) {
    int tid = C.tid; asm volatile("" : "+v"(tid)); const int lane = tid & 63, w = __builtin_amdgcn_readfirstlane(tid >> 6), qg = w & 3, kh = w >> 2, q = lane & 15, g = lane >> 4;
    const bf16_t* Qb = (const bf16_t*)(C.ws + WS_Q); const bf16_t* Kb = (const bf16_t*)(C.ws + WS_K); const bf16_t* VT = (const bf16_t*)(C.ws + WS_V);
    const bf16_t* cK = (const bf16_t*)(C.ws + WS_CK); const bf16_t* cVT = (const bf16_t*)(C.ws + WS_CV);
    int b, h, rowq0; AttnSrc A;
    if (uidx < 512) { b = uidx >> 8; h = (uidx >> 6) & 3; const int qb = uidx & 63; rowq0 = 8192 + b * 4096 + qb * 64; A.nst = 34; A.nlat = 32; A.ldv = 4096;
        A.Klat = Kb + (size_t)(8192 + b * 4096) * 512; A.VTlat = VT + 4194304 + (size_t)((b * 4 + h) * 32) * 16384; A.Kctx = cK + (size_t)((layer * 2 + b) * 256) * 512; A.VTctx = cVT + (size_t)(((layer * 2 + b) * 4 + h) * 2) * 16384; }
    else { const int v = uidx - 512; b = v >> 4; h = (v >> 2) & 3; const int qb = v & 3; rowq0 = b * 256 + qb * 64; A.nst = 2; A.nlat = 2; A.ldv = 256;
        A.Klat = Kb + (size_t)(b * 256) * 512; A.VTlat = VT + (size_t)((b * 4 + h) * 2) * 16384; A.Kctx = A.Klat; A.VTctx = A.VTlat; }
    A.h = h;
    LAS bf16_t* K1s = (LAS bf16_t*)C.lds; LAS bf16_t* K2s = K1s + 128 * AK_LD; LAS bf16_t* VTs = K2s + 128 * AK_LD;
    const float lam = ((const float*)(C.ws + WS_TAB))[2048 + layer];
    bf16x8 qf1[2], qf2[2];
    { const bf16_t* qp = Qb + (size_t)(rowq0 + 16 * qg + q) * 512 + h * 128 + 8 * g;
#pragma unroll
      for (int ks = 0; ks < 2; ++ks) { qf1[ks] = *(const bf16x8*)(qp + 32 * ks); qf2[ks] = *(const bf16x8*)(qp + 64 + 32 * ks); } }
    float m1 = -1e30f, l1 = 0.f, m2 = -1e30f, l2 = 0.f;
    f32x4 O1[8], O2[8];
#pragma unroll
    for (int t = 0; t < 8; ++t) { O1[t] = (f32x4){0.f, 0.f, 0.f, 0.f}; O2[t] = O1[t]; }
    u32x4 kreg[4], vreg[4];
    auto issue = [&](int st) {
        const bf16_t* kb = (st < A.nlat) ? A.Klat + (size_t)st * 128 * 512 : A.Kctx + (size_t)(st - A.nlat) * 128 * 512;
#pragma unroll
        for (int i = 0; i < 2; ++i) { const int id = tid + 512 * i, key = id >> 3, ch = id & 7; kreg[i] = *(const u32x4*)(kb + (size_t)key * 512 + h * 128 + ch * 8); kreg[2 + i] = *(const u32x4*)(kb + (size_t)key * 512 + h * 128 + 64 + ch * 8); }
        const bf16_t* vb = (st < A.nlat) ? A.VTlat + (size_t)st * 16384 : A.VTctx + (size_t)(st - A.nlat) * 16384;
#pragma unroll
        for (int i = 0; i < 4; ++i) { const int id = tid + 512 * i; vreg[i] = *(const u32x4*)(vb + (size_t)id * 8); }
    };
    issue(0);
    for (int st = 0; st < A.nst; ++st) {
        __syncthreads();
#pragma unroll
        for (int i = 0; i < 2; ++i) { const int id = tid + 512 * i, key = id >> 3, ch = id & 7; *(LAS u32x4*)(K1s + key * AK_LD + ch * 8) = kreg[i]; *(LAS u32x4*)(K2s + key * AK_LD + ch * 8) = kreg[2 + i]; }
#pragma unroll
        for (int i = 0; i < 4; ++i) { const int id = tid + 512 * i, dv = id >> 4, ch = id & 15; *(LAS u32x4*)(VTs + dv * AV_LD + ch * 8) = vreg[i]; }
        __syncthreads();
        if (st + 1 < A.nst) issue(st + 1);
#pragma unroll
        for (int kb = 0; kb < 2; ++kb) {
            const int key0 = kh * 64 + kb * 32;
            f32x4 sA0 = {0.f, 0.f, 0.f, 0.f}, sA1 = sA0, sB0 = sA0, sB1 = sA0;
#pragma unroll
            for (int ks = 0; ks < 2; ++ks) {
                const bf16x8 a10 = *(const LAS bf16x8*)(K1s + (key0 + q) * AK_LD + 32 * ks + 8 * g), a11 = *(const LAS bf16x8*)(K1s + (key0 + 16 + q) * AK_LD + 32 * ks + 8 * g);
                const bf16x8 a20 = *(const LAS bf16x8*)(K2s + (key0 + q) * AK_LD + 32 * ks + 8 * g), a21 = *(const LAS bf16x8*)(K2s + (key0 + 16 + q) * AK_LD + 32 * ks + 8 * g);
                sA0 = MFMA16(a10, qf1[ks], sA0); sA1 = MFMA16(a11, qf1[ks], sA1); sB0 = MFMA16(a20, qf2[ks], sB0); sB1 = MFMA16(a21, qf2[ks], sB1);
            }
            float t1 = fmaxf(fmaxf(fmaxf(sA0[0], sA0[1]), fmaxf(sA0[2], sA0[3])), fmaxf(fmaxf(sA1[0], sA1[1]), fmaxf(sA1[2], sA1[3])));
            float t2 = fmaxf(fmaxf(fmaxf(sB0[0], sB0[1]), fmaxf(sB0[2], sB0[3])), fmaxf(fmaxf(sB1[0], sB1[1]), fmaxf(sB1[2], sB1[3])));
            if (__any(t1 > m1 || t2 > m2)) {
                t1 = fmaxf(t1, __shfl_xor(t1, 16)); t1 = fmaxf(t1, __shfl_xor(t1, 32)); t2 = fmaxf(t2, __shfl_xor(t2, 16)); t2 = fmaxf(t2, __shfl_xor(t2, 32));
                const float n1 = fmaxf(m1, t1), n2 = fmaxf(m2, t2); const float f1 = __builtin_amdgcn_exp2f(m1 - n1), f2 = __builtin_amdgcn_exp2f(m2 - n2);
                l1 *= f1; l2 *= f2; m1 = n1; m2 = n2;
#pragma unroll
                for (int t = 0; t < 8; ++t) { O1[t] = O1[t] * f1; O2[t] = O2[t] * f2; }
            }
            f32x4 pA0, pA1, pB0, pB1;
#pragma unroll
            for (int i = 0; i < 4; ++i) { pA0[i] = __builtin_amdgcn_exp2f(sA0[i] - m1); pA1[i] = __builtin_amdgcn_exp2f(sA1[i] - m1); pB0[i] = __builtin_amdgcn_exp2f(sB0[i] - m2); pB1[i] = __builtin_amdgcn_exp2f(sB1[i] - m2); }
            l1 += (pA0[0] + pA0[1]) + (pA0[2] + pA0[3]) + (pA1[0] + pA1[1]) + (pA1[2] + pA1[3]);
            l2 += (pB0[0] + pB0[1]) + (pB0[2] + pB0[3]) + (pB1[0] + pB1[1]) + (pB1[2] + pB1[3]);
            const bf16x8 pb1 = pack8(pA0, pA1), pb2 = pack8(pB0, pB1);
#pragma unroll
            for (int t = 0; t < 8; ++t) {
                const LAS bf16_t* vp = VTs + (16 * t + q) * AV_LD + key0 + 4 * g;
                const s16x4 lo = *(const LAS s16x4*)vp, hh = *(const LAS s16x4*)(vp + 16);
                const bf16x8 av = __builtin_shufflevector(lo, hh, 0, 1, 2, 3, 4, 5, 6, 7);
                O1[t] = MFMA16(av, pb1, O1[t]); O2[t] = MFMA16(av, pb2, O2[t]);
            }
        }
    }
    l1 += __shfl_xor(l1, 16); l1 += __shfl_xor(l1, 32); l2 += __shfl_xor(l2, 16); l2 += __shfl_xor(l2, 32);
    __syncthreads();
    LAS float* comb = (LAS float*)C.lds;
    LAS float* exs = (LAS float*)(C.lds + 65536);
    if (kh == 1) {
#pragma unroll
        for (int t = 0; t < 8; ++t)
#pragma unroll
            for (int i = 0; i < 4; ++i) { comb[(qg * 64 + t * 4 + i) * 64 + lane] = O1[t][i]; comb[(qg * 64 + 32 + t * 4 + i) * 64 + lane] = O2[t][i]; }
        exs[(qg * 4 + 0) * 64 + lane] = m1; exs[(qg * 4 + 1) * 64 + lane] = l1; exs[(qg * 4 + 2) * 64 + lane] = m2; exs[(qg * 4 + 3) * 64 + lane] = l2;
    }
    __syncthreads();
    if (kh == 0) {
        const float om1 = exs[(qg * 4 + 0) * 64 + lane], ol1 = exs[(qg * 4 + 1) * 64 + lane], om2 = exs[(qg * 4 + 2) * 64 + lane], ol2 = exs[(qg * 4 + 3) * 64 + lane];
        const float n1 = fmaxf(m1, om1), n2 = fmaxf(m2, om2);
        const float fa1 = __builtin_amdgcn_exp2f(m1 - n1), fb1 = __builtin_amdgcn_exp2f(om1 - n1), fa2 = __builtin_amdgcn_exp2f(m2 - n2), fb2 = __builtin_amdgcn_exp2f(om2 - n2);
        const float L1 = l1 * fa1 + ol1 * fb1, L2 = l2 * fa2 + ol2 * fb2;
        const float c1a = fa1 / L1, c1b = fb1 / L1, c2a = lam * fa2 / L2, c2b = lam * fb2 / L2;
        float ss = 0.f;
#pragma unroll
        for (int t = 0; t < 8; ++t)
#pragma unroll
            for (int i = 0; i < 4; ++i) { const float v = O1[t][i] * c1a + comb[(qg * 64 + t * 4 + i) * 64 + lane] * c1b - O2[t][i] * c2a - comb[(qg * 64 + 32 + t * 4 + i) * 64 + lane] * c2b; O1[t][i] = v; ss += v * v; }
        ss += __shfl_xor(ss, 16); ss += __shfl_xor(ss, 32);
        const float lam_init = 0.8f - 0.6f * __expf(-0.3f * (float)layer);
        const float sc = (1.0f / sqrtf(ss * (1.0f / 128.0f) + RMS_EPS)) * (1.0f - lam_init);
        const float* dn = C.p->in[18] + layer * 128;
        bf16_t* ob = (bf16_t*)(C.ws + WS_O) + (size_t)(rowq0 + 16 * qg + q) * DM + h * 128;
#pragma unroll
        for (int t = 0; t < 8; ++t) { const int dv = 16 * t + 4 * g; const f32x4 d4 = *(const f32x4*)(dn + dv); *(u32x2*)(ob + dv) = pack4(O1[t] * sc * d4); }
    }
    __syncthreads();
}

DI void delta_prep_unit(const Ctx& C, int layer, int unit) {
    const Params& p = *C.p; int tid = C.tid; asm volatile("" : "+v"(tid)); const int lane = tid & 63, w = __builtin_amdgcn_readfirstlane(tid >> 6);
    const int tc = unit >> 2, h = unit & 3, row0 = tc * 64;
    int ci, nch; if (tc < 128) { ci = tc & 3; nch = 4; } else { ci = (tc - 128) & 63; nch = 64; }
    const bool has_prev = ci > 0, has_next = ci < nch - 1;
    float* qs = C.L; float* kk = C.L + 4160; float* vv = C.L + 8320; float* KK0 = C.L + 12480; float* QK0 = KK0 + 4096; float* Ms = QK0 + 4096; float* bc = Ms + 8192; float* be = bc + 128;
    const bf16_t* zb = (const bf16_t*)(C.ws + WS_ZB);
    const float* cw = p.in[11] + layer * 3 * 768;
    __syncthreads();
    if (tid < 384) {
        const int c = tid % 192, th = tid / 192, which = c >> 6, d = c & 63, col = which * 256 + h * 64 + d;
        const float w0 = cw[col], w1 = cw[768 + col], w2 = cw[1536 + col];
        float xin[34];
#pragma unroll
        for (int i = 0; i < 34; ++i) { const int tt = 32 * th - 1 + i; const bool ok = (tt >= 0 || has_prev) && (tt < 64 || has_next); xin[i] = ok ? bf2f(zb[(size_t)(row0 + tt) * ZLD + col]) : 0.f; }
        float* dstp = (which == 0 ? qs : (which == 1 ? kk : vv)) + d;
#pragma unroll
        for (int i = 0; i < 32; ++i) dstp[(32 * th + i) * 65] = siluf_(w0 * xin[i] + w1 * xin[i + 1] + w2 * xin[i + 2]);
    }
    __syncthreads();
    { const int r = tid >> 2, part = tid & 3; float* base = (r < 64 ? qs + r * 65 : kk + (r - 64) * 65) + part * 16; float ss = 0.f;
#pragma unroll
      for (int i = 0; i < 16; ++i) ss += base[i] * base[i];
      ss += __shfl_xor(ss, 1); ss += __shfl_xor(ss, 2);
      const float sc = (1.0f / sqrtf(ss + 1e-6f)) * (r < 64 ? 0.125f : 1.0f);
#pragma unroll
      for (int i = 0; i < 16; ++i) base[i] *= sc; }
    if (w < 2) {
        const int dir = w, i = lane, tt = dir ? 63 - i : i; const size_t row = (size_t)(row0 + tt);
        const float braw = bf2f(zb[row * ZLD + ZB_BBETA + dir * 4 + h]), araw = bf2f(zb[row * ZLD + ZB_BA + dir * 4 + h]);
        const float A = __expf(p.in[12][layer * 8 + dir * 4 + h]); const float x = araw + p.in[13][layer * 8 + dir * 4 + h];
        const float sp = x > 20.f ? x : log1pf(__expf(x)); float g = -A * sp;
#pragma unroll
        for (int off = 1; off < 64; off <<= 1) { const float t = __shfl_up(g, off); if (lane >= off) g += t; }
        bc[dir * 64 + i] = g; const float bt = sigmoidf_(braw); be[dir * 64 + i] = bt; be[128 + dir * 64 + i] = bt * __expf(g);
    }
    __syncthreads();
    {
        const int rbm = w & 3, cb0 = (w >> 2) * 2, r16 = lane & 15, g4 = lane >> 4;
        bf16x8 kA[2], qA[2], kB[2][2];
#pragma unroll
        for (int ks = 0; ks < 2; ++ks) {
            const float* kp = kk + (16 * rbm + r16) * 65 + 32 * ks + 8 * g4; const float* qp = qs + (16 * rbm + r16) * 65 + 32 * ks + 8 * g4;
            kA[ks] = pack8((f32x4){kp[0], kp[1], kp[2], kp[3]}, (f32x4){kp[4], kp[5], kp[6], kp[7]});
            qA[ks] = pack8((f32x4){qp[0], qp[1], qp[2], qp[3]}, (f32x4){qp[4], qp[5], qp[6], qp[7]});
#pragma unroll
            for (int c = 0; c < 2; ++c) { const float* bp = kk + (16 * (cb0 + c) + r16) * 65 + 32 * ks + 8 * g4;
                kB[c][ks] = pack8((f32x4){bp[0], bp[1], bp[2], bp[3]}, (f32x4){bp[4], bp[5], bp[6], bp[7]}); }
        }
#pragma unroll
        for (int c = 0; c < 2; ++c) {
            f32x4 ak = {0.f, 0.f, 0.f, 0.f}, aq = ak;
#pragma unroll
            for (int ks = 0; ks < 2; ++ks) { ak = MFMA16(kA[ks], kB[c][ks], ak); aq = MFMA16(qA[ks], kB[c][ks], aq); }
#pragma unroll
            for (int i = 0; i < 4; ++i) { const int o = (16 * rbm + 4 * g4 + i) * 64 + 16 * (cb0 + c) + r16; KK0[o] = ak[i]; QK0[o] = aq[i]; }
        }
    }
    __syncthreads();
    bf16_t* dpW = (bf16_t*)(C.ws + WS_DPW); bf16_t* dpQD = (bf16_t*)(C.ws + WS_DPQD); bf16_t* dpQK = (bf16_t*)(C.ws + WS_DPQK); bf16_t* dpKD = (bf16_t*)(C.ws + WS_DPKD); bf16_t* dpU = (bf16_t*)(C.ws + WS_DPU);
    float* dpGL = (float*)(C.ws + WS_GL);
    { const int i = tid >> 3, j0 = (tid & 7) * 8;
#pragma unroll
      for (int dir = 0; dir < 2; ++dir) {
          const size_t ud = ((size_t)tc * 4 + h) * 2 + dir;
          const float bi = bc[dir * 64 + i], betai = be[dir * 64 + i]; const int ai = dir ? 63 - i : i;
#pragma unroll
          for (int jj = 0; jj < 8; ++jj) { const int j = j0 + jj, aj = dir ? 63 - j : j;
              const float dec = (j <= i) ? __expf(bi - bc[dir * 64 + j]) : 0.f;
              Ms[dir * 4096 + j * 64 + i] = (j < i) ? betai * KK0[ai * 64 + aj] * dec : 0.f;
              dpQK[ud * 4096 + i * 64 + pinv(j)] = f2bf(QK0[ai * 64 + aj] * dec); }
      } }
    __syncthreads();
    if (w < 4) {
        const int dir = w >> 1, c = (w & 1) * 64 + lane; const size_t ud = ((size_t)tc * 4 + h) * 2 + dir;
        const float* Msd = Ms + dir * 4096; const bool isU = (w & 1) == 0; const float* scp = be + (isU ? 0 : 128) + dir * 64; const float* srcp = (isU ? vv : kk) + lane;
        float x[64];
#pragma unroll
        for (int rb = 0; rb < 4; ++rb) {
            float r[16];
#pragma unroll
            for (int ii = 0; ii < 16; ++ii) { const int i = 16 * rb + ii, tt = dir ? 63 - i : i; r[ii] = scp[i] * srcp[tt * 65]; }
            asm volatile("" ::: "memory");
#pragma unroll
            for (int j = 0; j < 16 * rb; ++j) {
                const float* mp = Msd + j * 64 + 16 * rb;
                const f32x4 ma = *(const f32x4*)mp, mb = *(const f32x4*)(mp + 4), mc = *(const f32x4*)(mp + 8), md = *(const f32x4*)(mp + 12);
                const float xj = x[j];
#pragma unroll
                for (int c4 = 0; c4 < 4; ++c4) { r[c4] -= ma[c4] * xj; r[4 + c4] -= mb[c4] * xj; r[8 + c4] -= mc[c4] * xj; r[12 + c4] -= md[c4] * xj; }
                if ((j & 3) == 3) asm volatile("" ::: "memory");
            }
#pragma unroll
            for (int jj = 0; jj < 16; ++jj) {
                const float xj = r[jj]; x[16 * rb + jj] = xj;
                const float* mp = Msd + (16 * rb + jj) * 64 + 16 * rb;
#pragma unroll
                for (int ii = jj + 1; ii < 16; ++ii) r[ii] -= mp[ii] * xj;
                if ((jj & 3) == 3) asm volatile("" ::: "memory");
            }
        }
        if (c < 64) {
            bf16_t* up = dpU + ud * 4096 + c * 64;
#pragma unroll
            for (int i = 0; i < 64; i += 8) { u32x4 o; o.x = cvt_pk_bf16(x[i], x[i + 1]); o.y = cvt_pk_bf16(x[i + 2], x[i + 3]); o.z = cvt_pk_bf16(x[i + 4], x[i + 5]); o.w = cvt_pk_bf16(x[i + 6], x[i + 7]); *(u32x4*)(up + i) = o; }
        } else {
            bf16_t* wp = dpW + ud * 4096 + pinv(c - 64);
#pragma unroll
            for (int i = 0; i < 64; ++i) wp[i * 64] = f2bf(x[i]);
        }
    } else {
#pragma unroll 4
        for (int it = 0; it < 64; ++it) {
            const int e = (tid - 256) + 256 * it, dir = e >> 13, which = (e >> 12) & 1, rem = e & 4095; const size_t ud = ((size_t)tc * 4 + h) * 2 + dir;
            if (which == 0) { const int i = rem >> 6, d = rem & 63, tt = dir ? 63 - i : i; dpQD[ud * 4096 + i * 64 + pinv(d)] = f2bf(qs[tt * 65 + d] * __expf(bc[dir * 64 + i])); }
            else { const int dk = rem >> 6, i = rem & 63, tt = dir ? 63 - i : i; dpKD[ud * 4096 + dk * 64 + pinv(i)] = f2bf(kk[tt * 65 + dk] * __expf(bc[dir * 64 + 63] - bc[dir * 64 + i])); }
        }
        if (tid == 256 || tid == 257) { const int dir = tid - 256; dpGL[((size_t)tc * 4 + h) * 2 + dir] = __expf(bc[dir * 64 + 63]); }
    }
}

DI void delta_scan_unit(const Ctx& C, int layer, bool sample, int b, int h) {
    const Params& p = *C.p; int tid = C.tid; asm volatile("" : "+v"(tid)); const int lane = tid & 63; const int w = C.wave, dir = w >> 2, sl = w & 3, col = lane & 15, g = lane >> 4;
    const int tc0 = sample ? 128 + b * 64 : b * 4, nch = sample ? 64 : 4;
    const bf16_t* dpU = (const bf16_t*)(C.ws + WS_DPU);
    const float* dpGL = (const float*)(C.ws + WS_GL); float* od = (float*)(C.ws + WS_OD) + (size_t)dir * MROWS * 256;
    f32x4 S[4];
    if (sample) { const float* s0 = p.in[4] + ((((size_t)b * 4 + layer) * 2 + dir) * 4 + h) * 4096;
#pragma unroll
        for (int rb = 0; rb < 4; ++rb)
#pragma unroll
            for (int ii = 0; ii < 4; ++ii) S[rb][ii] = s0[(16 * rb + 4 * g + ii) * 64 + 16 * sl + col]; }
    else {
#pragma unroll
        for (int rb = 0; rb < 4; ++rb) S[rb] = (f32x4){0.f, 0.f, 0.f, 0.f}; }
    u32x4 Ra[8], Rb[8];
#define DS_TC(d_, n_) ((d_) ? tc0 + nch - 1 - (n_) : tc0 + (n_))
#define DS_ISSUE(R, n_) do { _Pragma("unroll") for (int i = 0; i < 8; ++i) { const int id = tid + 512 * i, dm = id >> 9, dd = dm >> 2, mat = dm & 3; \
        const size_t ud_ = ((size_t)DS_TC(dd, n_) * 4 + h) * 2 + dd; R[i] = *(const u32x4*)(C.ws + WS_DPW + (size_t)mat * (16u * MiB) + ud_ * 8192 + (size_t)(id & 511) * 16); } } while (0)
#define DS_WRITE(R, buf_) do { _Pragma("unroll") for (int i = 0; i < 8; ++i) { const int id = tid + 512 * i, dm = id >> 9, row = (id >> 3) & 63, c = id & 7; \
        *(LAS u32x4*)(C.lds + (buf_) * 65536 + dm * 8192 + row * 128 + ((c ^ (row & 7)) * 16)) = R[i]; } } while (0)
#define DS_FRAG(buf_, mat_, rb_, ks_) (*(const LAS bf16x8*)(C.lds + (buf_) * 65536 + (dir * 4 + (mat_)) * 8192 + (16 * (rb_) + col) * 128 + ((((ks_) * 4 + g) ^ (col & 7)) * 16)))
    __syncthreads();
    DS_ISSUE(Ra, 0); DS_WRITE(Ra, 0); DS_ISSUE(Ra, 1);
    s16x4 uuA[4], uuB[4]; float glA, glB;
#define DS_LOADU(uu, gl, n_) do { const size_t ud_ = ((size_t)DS_TC(dir, n_) * 4 + h) * 2 + dir; _Pragma("unroll") for (int rb = 0; rb < 4; ++rb) uu[rb] = *(const s16x4*)(dpU + ud_ * 4096 + (16 * sl + col) * 64 + 16 * rb + 4 * g); gl = dpGL[ud_]; } while (0)
    DS_LOADU(uuA, glA, 0); DS_LOADU(uuB, glB, 1);
    __syncthreads();
#define DS_STEP(n, buf, Rnext, Rcur, uu, gl) do { \
        if ((n) + 2 < nch) DS_ISSUE(Rnext, (n) + 2); \
        const int tc = DS_TC(dir, (n)); \
        bf16x8 Sb[2]; Sb[0] = pack8(S[0], S[1]); Sb[1] = pack8(S[2], S[3]); \
        f32x4 vn[4]; \
        _Pragma("unroll") for (int rb = 0; rb < 4; ++rb) { f32x4 t = (f32x4){0.f, 0.f, 0.f, 0.f}; t = MFMA16(DS_FRAG(buf, 0, rb, 0), Sb[0], t); t = MFMA16(DS_FRAG(buf, 0, rb, 1), Sb[1], t); \
            _Pragma("unroll") for (int ii = 0; ii < 4; ++ii) vn[rb][ii] = bf2f((bf16_t)uu[rb][ii]) - t[ii]; } \
        const float glc = gl; \
        if ((n) + 2 < nch) DS_LOADU(uu, gl, (n) + 2); \
        bf16x8 vb[2]; vb[0] = pack8(vn[0], vn[1]); vb[1] = pack8(vn[2], vn[3]); \
        const int rowb = tc * 64; \
        _Pragma("unroll") for (int rb = 0; rb < 4; ++rb) { f32x4 o = (f32x4){0.f, 0.f, 0.f, 0.f}; o = MFMA16(DS_FRAG(buf, 1, rb, 0), Sb[0], o); o = MFMA16(DS_FRAG(buf, 1, rb, 1), Sb[1], o); o = MFMA16(DS_FRAG(buf, 2, rb, 0), vb[0], o); o = MFMA16(DS_FRAG(buf, 2, rb, 1), vb[1], o); \
            _Pragma("unroll") for (int ii = 0; ii < 4; ++ii) { const int i = 16 * rb + 4 * g + ii; const int tt = dir ? 63 - i : i; od[(size_t)(rowb + tt) * 256 + h * 64 + 16 * sl + col] = o[ii]; } } \
        _Pragma("unroll") for (int rb = 0; rb < 4; ++rb) { f32x4 sn = S[rb] * glc; sn = MFMA16(DS_FRAG(buf, 3, rb, 0), vb[0], sn); sn = MFMA16(DS_FRAG(buf, 3, rb, 1), vb[1], sn); S[rb] = sn; } \
        if ((n) + 1 < nch) DS_WRITE(Rcur, (buf) ^ 1); \
        __syncthreads(); } while (0)
    for (int n = 0; n < nch; n += 2) {
        DS_STEP(n, 0, Rb, Ra, uuA, glA);
        DS_STEP(n + 1, 1, Ra, Rb, uuB, glB);
    }
#undef DS_STEP
#undef DS_TC
#undef DS_ISSUE
#undef DS_WRITE
#undef DS_FRAG
#undef DS_LOADU
    if (!sample) { float* so = C.out + OUT_SD + ((((size_t)b * 4 + layer) * 2 + dir) * 4 + h) * 4096;
#pragma unroll
        for (int rb = 0; rb < 4; ++rb)
#pragma unroll
            for (int ii = 0; ii < 4; ++ii) so[(16 * rb + 4 * g + ii) * 64 + 16 * sl + col] = S[rb][ii]; }
}

DI float hgrn_forget(const bf16_t* zb, size_t row, int dir, int h, int d, float lb) { const float x = bf2f(zb[row * ZLD + ZB_CF + dir * 256 + h * 64 + d]); return lb + (1.0f - lb) * sigmoidf_(x); }
DI void hgrn_local_unit(const Ctx& C, int layer, int unit) {
    int lane = C.lane; asm volatile("" : "+v"(lane)); const int dir = unit & 1, h = (unit >> 1) & 3, tc = unit >> 3, row0 = tc * 64, ep = lane & 31, dh = lane >> 5;
    const bf16_t* zb = (const bf16_t*)(C.ws + WS_ZB);
    float* fs = C.L + C.wave * 2048; float* qs2 = fs + 1024;
    bf16_t* oloc = (bf16_t*)(C.ws + WS_XM + 16 * MiB) + (size_t)dir * MROWS * 256;
    bf16_t* qdb = (bf16_t*)((unsigned char*)C.out + 32 * MiB) + (size_t)dir * MROWS * 256;
    const float lb = ((const float*)(C.ws + WS_TAB))[4096 + (dir * 4 + layer) * 256 + h * 64 + lane];
    f32x2 S[32];
#pragma unroll
    for (int k = 0; k < 32; ++k) S[k] = (f32x2){0.f, 0.f};
    float Dl = 1.0f;
    bf16_t rf[16], rq[16]; unsigned rv[16];
#define HL_LOAD(sb_) do { _Pragma("unroll") for (int i = 0; i < 16; ++i) { const int ti = (sb_) * 16 + i, tt = dir ? 63 - ti : ti; const size_t row = (size_t)(row0 + tt); \
        rf[i] = zb[row * ZLD + ZB_CF + dir * 256 + h * 64 + lane]; rq[i] = zb[row * ZLD + ZB_CQ + h * 64 + lane]; rv[i] = *(const unsigned*)(zb + row * ZLD + ZB_CI + h * 64 + 2 * ep); } } while (0)
    HL_LOAD(0);
    for (int sb = 0; sb < 4; ++sb) {
        f32x2 vr[16];
#pragma unroll
        for (int i = 0; i < 16; ++i) { const int ti = sb * 16 + i, tt = dir ? 63 - ti : ti; const size_t row = (size_t)(row0 + tt);
            const float f = lb + (1.0f - lb) * sigmoidf_(bf2f(rf[i])); const float qv = siluf_(bf2f(rq[i]));
            fs[i * 64 + lane] = f; qs2[i * 64 + lane] = qv; Dl *= f; qdb[row * 256 + h * 64 + lane] = f2bf(qv * Dl);
            vr[i] = (f32x2){__uint_as_float(rv[i] << 16), __uint_as_float(rv[i] & 0xffff0000u)}; }
        if (sb + 1 < 4) HL_LOAD(sb + 1);
        __builtin_amdgcn_wave_barrier();
#pragma unroll
        for (int i = 0; i < 16; ++i) { const f32x2 v = vr[i]; f32x2 osa = {0.f, 0.f}, osb = {0.f, 0.f};
#pragma unroll
            for (int k = 0; k < 32; k += 4) { const f32x4 f4 = *(const f32x4*)(fs + i * 64 + 32 * dh + k), q4 = *(const f32x4*)(qs2 + i * 64 + 32 * dh + k);
#pragma unroll
                for (int c = 0; c < 4; ++c) { S[k + c] = (S[k + c] - v) * f4[c] + v; if (c & 1) osb += S[k + c] * q4[c]; else osa += S[k + c] * q4[c]; }
                if ((k & 15) == 12) asm volatile("" ::: "memory"); }
            f32x2 os = osa + osb;
            os.x += __shfl_xor(os.x, 32); os.y += __shfl_xor(os.y, 32);
            const int ti = sb * 16 + i, tt = dir ? 63 - ti : ti;
            if (dh == 0) *(unsigned*)(oloc + (size_t)(row0 + tt) * 256 + h * 64 + 2 * ep) = cvt_pk_bf16(os.x, os.y);
            asm volatile("" ::: "memory"); }
        __builtin_amdgcn_wave_barrier();
    }
#undef HL_LOAD
    float* hs = (float*)(C.ws + WS_HS) + (size_t)unit * 4096;
#pragma unroll
    for (int k = 0; k < 32; ++k) *(f32x2*)(hs + (32 * dh + k) * 64 + 2 * ep) = S[k];
    ((float*)(C.ws + WS_HD))[(size_t)unit * 64 + lane] = Dl;
}
DI void hgrn_scan_unit(const Ctx& C, int layer, bool sample, int b, int h, int dir) {
    const Params& p = *C.p; int tid = C.tid; asm volatile("" : "+v"(tid)); const int tc0 = sample ? 128 + b * 64 : b * 4, nch = sample ? 64 : 4;
    float* HS = (float*)(C.ws + WS_HS); const float* HD = (const float*)(C.ws + WS_HD);
    f32x4 S0, S1;
    if (sample) { const float* s0 = p.in[5] + ((((size_t)b * 4 + layer) * 2 + dir) * 4 + h) * 4096 + tid * 8; S0 = *(const f32x4*)s0; S1 = *(const f32x4*)(s0 + 4); }
    else { float z_ = 0.f; asm volatile("" : "+v"(z_)); S0 = (f32x4){z_, z_, z_, z_}; S1 = S0; }
    for (int n0 = 0; n0 < nch; n0 += 4) {
        f32x4 la[4], lb[4]; float Dd[4];
#pragma unroll
        for (int k = 0; k < 4; ++k) { const int tc = dir ? tc0 + nch - 1 - (n0 + k) : tc0 + n0 + k; const size_t uh = ((size_t)tc * 4 + h) * 2 + dir;
            const float* hp = HS + uh * 4096 + tid * 8; la[k] = *(const f32x4*)hp; lb[k] = *(const f32x4*)(hp + 4); Dd[k] = HD[uh * 64 + (tid >> 3)]; }
#pragma unroll
        for (int k = 0; k < 4; ++k) { const int tc = dir ? tc0 + nch - 1 - (n0 + k) : tc0 + n0 + k; const size_t uh = ((size_t)tc * 4 + h) * 2 + dir;
            float* hp = HS + uh * 4096 + tid * 8; *(f32x4*)hp = S0; *(f32x4*)(hp + 4) = S1; S0 = S0 * Dd[k] + la[k]; S1 = S1 * Dd[k] + lb[k]; }
    }
    if (!sample) { float* so = C.out + OUT_SH + ((((size_t)b * 4 + layer) * 2 + dir) * 4 + h) * 4096 + tid * 8; *(f32x4*)so = S0; *(f32x4*)(so + 4) = S1; }
}
DI void hgrn_final_unit(const Ctx& C, int layer, int tc) {
    const Params& p = *C.p; int lane = C.lane; asm volatile("" : "+v"(lane)); const int w = C.wave, h = w >> 1, chh = w & 1, r16 = lane & 15, g4 = lane >> 4, row0 = tc * 64;
    const bf16_t* zb = (const bf16_t*)(C.ws + WS_ZB); const float* HS = (const float*)(C.ws + WS_HS);
    const bf16_t* oloc = (const bf16_t*)(C.ws + WS_XM + 16 * MiB); const bf16_t* qdb = (const bf16_t*)((const unsigned char*)C.out + 32 * MiB);
    float* otile = C.L;
    __syncthreads();
    f32x4 acc[4][2];
#pragma unroll
    for (int rb = 0; rb < 4; ++rb) { acc[rb][0] = (f32x4){0.f, 0.f, 0.f, 0.f}; acc[rb][1] = acc[rb][0]; }
#pragma unroll
    for (int dir = 0; dir < 2; ++dir) {
        const size_t uh = ((size_t)tc * 4 + h) * 2 + dir;
        bf16x8 Bf[2][2];
#pragma unroll
        for (int cb = 0; cb < 2; ++cb)
#pragma unroll
            for (int ks = 0; ks < 2; ++ks) { const float* sp = HS + uh * 4096 + (size_t)(32 * ks + 8 * g4) * 64 + 32 * chh + 16 * cb + r16;
                Bf[cb][ks] = pack8((f32x4){sp[0], sp[64], sp[128], sp[192]}, (f32x4){sp[256], sp[320], sp[384], sp[448]}); }
#pragma unroll
        for (int rb = 0; rb < 4; ++rb)
#pragma unroll
            for (int ks = 0; ks < 2; ++ks) { const bf16x8 Af = *(const bf16x8*)(qdb + (size_t)dir * MROWS * 256 + (size_t)(row0 + 16 * rb + r16) * 256 + h * 64 + 32 * ks + 8 * g4);
                acc[rb][0] = MFMA16(Af, Bf[0][ks], acc[rb][0]); acc[rb][1] = MFMA16(Af, Bf[1][ks], acc[rb][1]); }
    }
#pragma unroll
    for (int rb = 0; rb < 4; ++rb)
#pragma unroll
        for (int cb = 0; cb < 2; ++cb)
#pragma unroll
            for (int i = 0; i < 4; ++i) { const int t = 16 * rb + 4 * g4 + i, e = 32 * chh + 16 * cb + r16; const size_t ix = (size_t)(row0 + t) * 256 + h * 64 + e;
                otile[(h * 64 + t) * 64 + e] = acc[rb][cb][i] + bf2f(oloc[ix]) + bf2f(oloc[(size_t)MROWS * 256 + ix]); }
    __syncthreads();
    bf16_t* ob = (bf16_t*)(C.ws + WS_O);
    const float ng = p.in[16][layer * 64 + lane];
    bf16_t gts[32];
#pragma unroll
    for (int rr = 0; rr < 32; ++rr) { const int idx = w * 32 + rr, hh = idx >> 6, tt = idx & 63; gts[rr] = zb[(size_t)(row0 + tt) * ZLD + ZB_CG + hh * 64 + lane]; }
#pragma unroll
    for (int rr = 0; rr < 32; ++rr) { const int idx = w * 32 + rr, hh = idx >> 6, tt = idx & 63; const size_t row = (size_t)(row0 + tt);
        const float v = otile[(hh * 64 + tt) * 64 + lane]; const float ss = wave_sum(v * v);
        const float gt = siluf_(bf2f(gts[rr]));
        ob[row * DM + 768 + hh * 64 + lane] = f2bf(v * (1.0f / sqrtf(ss * (1.0f / 64.0f) + RMS_EPS)) * ng * gt); }
}
DI void delta_combine(const Ctx& C, int layer) {
    const Params& p = *C.p; const bf16_t* zb = (const bf16_t*)(C.ws + WS_ZB); const float* od = (const float*)(C.ws + WS_OD); bf16_t* ob = (bf16_t*)(C.ws + WS_O);
    const float ng = p.in[14][layer * 64 + C.lane];
    for (int it0 = C.gw * 4; it0 < MROWS * 4; it0 += C.NGW * 4) {
        float v[4]; bf16_t gr[4];
#pragma unroll
        for (int k = 0; k < 4; ++k) { const int it = it0 + k, h = it & 3; const size_t row = (size_t)(it >> 2);
            v[k] = od[row * 256 + h * 64 + C.lane] + od[(size_t)MROWS * 256 + row * 256 + h * 64 + C.lane]; gr[k] = zb[row * ZLD + ZB_BG + h * 64 + C.lane]; }
#pragma unroll
        for (int k = 0; k < 4; ++k) { const int it = it0 + k, h = it & 3; const size_t row = (size_t)(it >> 2);
            const float ss = wave_sum(v[k] * v[k]); const float gt = siluf_(bf2f(gr[k]));
            ob[row * DM + 512 + h * 64 + C.lane] = f2bf(v[k] * (1.0f / sqrtf(ss * (1.0f / 64.0f) + RMS_EPS)) * ng * gt); }
    }
}

#define XB_TMO      128
#define XB_XCNT(j)  (256  + 64 * (j))
#define XB_XSUB(j)  (1280 + 64 * (j))
#define XB_XGEN(j)  (2304 + 64 * (j))
#define XB_TOP      3328
#define XB_TOPGEN   3392
#define XB_SPIN_CAP (1u << 22)
DI unsigned xb_ld(unsigned* p)              { return __hip_atomic_load(p, __ATOMIC_RELAXED, __HIP_MEMORY_SCOPE_AGENT); }
DI unsigned xb_add(unsigned* p, unsigned v) { return __hip_atomic_fetch_add(p, v, __ATOMIC_RELAXED, __HIP_MEMORY_SCOPE_AGENT); }
DI unsigned xb_xcc_id() { return (unsigned)__builtin_amdgcn_s_getreg((3 << 11) | 20) & 0xFu; }
#define XB_SPIN(cond, bar) do { unsigned _sp = 0; while (cond) { __builtin_amdgcn_s_sleep(1); \
    if ((++_sp & 255u) == 0u) { if (xb_ld(&(bar)[XB_TMO])) break; if (_sp > XB_SPIN_CAP) { atomicAdd(&(bar)[XB_TMO], 1u); break; } } } } while (0)
struct XcdBarrier { unsigned* bar; unsigned x; volatile LAS unsigned* st; };
DI void xcd_barrier_complete(unsigned* bar, unsigned x, unsigned& nloc, unsigned& nx) {
    const unsigned G = gridDim.x * gridDim.y * gridDim.z;
    unsigned sum, cnt, mine, sp = 0u;
    for (;;) {
        sum = 0u; cnt = 0u; mine = 0u;
#pragma unroll
        for (unsigned j = 0; j < 16; ++j) { const unsigned c = xb_ld(&bar[XB_XCNT(j)]); sum += c; cnt += (c > 0u) ? 1u : 0u; mine = (j == x) ? c : mine; }
        if (sum == G) break;
        __builtin_amdgcn_s_sleep(1);
        if ((++sp & 255u) == 0u) { if (xb_ld(&bar[XB_TMO])) break; if (sp > XB_SPIN_CAP) { atomicAdd(&bar[XB_TMO], 1u); break; } }
    }
    nloc = mine > 0u ? mine : 1u; nx = cnt > 0u ? cnt : 1u;
}
DI void xcd_barrier(const XcdBarrier& b) {
    asm volatile("s_waitcnt vmcnt(0)" ::: "memory");
    __syncthreads();
    if (threadIdx.x == 0) {
        unsigned* bar = b.bar;
        __builtin_amdgcn_s_waitcnt(0);
        unsigned nloc = b.st[0], nx = b.st[1];
        if (nloc == 0u) { xcd_barrier_complete(bar, b.x, nloc, nx); b.st[0] = nloc; b.st[1] = nx; }
        const unsigned old = xb_add(&bar[XB_XSUB(b.x)], 1u);
        const unsigned gen = old / nloc;
        if (old + 1u == (gen + 1u) * nloc) {
            __builtin_amdgcn_fence(__ATOMIC_RELEASE, "agent");
            asm volatile("s_waitcnt vmcnt(0)" ::: "memory");
            const unsigned og = xb_add(&bar[XB_TOP], 1u);
            const unsigned tg = og / nx;
            if (og + 1u == (tg + 1u) * nx) xb_add(&bar[XB_TOPGEN], 1u);
            else XB_SPIN(xb_ld(&bar[XB_TOPGEN]) == tg, bar);
            __builtin_amdgcn_fence(__ATOMIC_ACQUIRE, "agent");
            xb_add(&bar[XB_XGEN(b.x)], 1u);
            asm volatile("s_waitcnt vmcnt(0)" ::: "memory");
        } else {
            XB_SPIN(xb_ld(&bar[XB_XGEN(b.x)]) == gen, bar);
            __builtin_amdgcn_fence(__ATOMIC_ACQUIRE, "agent");
            asm volatile("s_waitcnt vmcnt(0)" ::: "memory");
        }
    }
    __syncthreads();
}

DI void probe_stamp(unsigned char* ws, int cls) {
    if (PROBE_A >= 0 && blockIdx.x == 0 && threadIdx.x == 0) {
        volatile float* tsf = (volatile float*)(ws + WS_TAB + 131072); volatile unsigned long long* tsl = (volatile unsigned long long*)(ws + WS_TAB + 131072 + 256);
        const unsigned long long now = __builtin_amdgcn_s_memrealtime(); tsf[cls] += (float)(now - tsl[0]); tsl[0] = now; }
}
template <unsigned PHM_>
__global__ void __launch_bounds__(512) fwd_megakernel(Params p) {
    extern __shared__ __attribute__((aligned(16))) unsigned char lds_raw[];
    XcdBarrier xbar; xbar.bar = (unsigned*)(p.ws + WS_CTL) + 1024; xbar.x = xb_xcc_id(); xbar.st = (volatile LAS unsigned*)((LAS unsigned char*)lds_raw + 147400);
    if (threadIdx.x == 0) { xbar.st[0] = 0u; xbar.st[1] = 0u; (void)xb_add(&xbar.bar[XB_XCNT(xbar.x)], 1u); }
    __syncthreads();
    for (int ph = p.ph_lo; ph < p.ph_hi; ++ph) {
        if (PROBE_A >= 0 && blockIdx.x == 0 && threadIdx.x == 0) {
            volatile float* tsf = (volatile float*)(p.ws + WS_TAB + 131072); volatile unsigned long long* tsl = (volatile unsigned long long*)(p.ws + WS_TAB + 131072 + 256);
            const unsigned long long now = __builtin_amdgcn_s_memrealtime();
            if (ph == 0) { for (int i = 0; i < 16; ++i) tsf[i] = 0.f; tsl[1] = now; }
            else { const int pp = ph - 1; const int cls = pp < 2 ? 8 : (((pp - 2) % 9) == 8 ? 5 : ((pp - 2) % 9)); const float dt = (float)(now - tsl[0]); tsf[cls] += dt; }
            tsl[0] = now;
            if (ph == NPHASE - 2 && PROBE_A < 20) { const float tot = (float)(now - tsl[1]); tsf[12] = rintf(tsf[(PROBE_A >= 0 && PROBE_A < 16) ? PROBE_A : 0] / tot * 40.f) / 40.f; tsf[13] = rintf(tsf[PROBE_B >= 0 ? PROBE_B : 0] / tot * 40.f) / 40.f; }
        }
        if (PROBE_A >= 0 && ph == 0 && threadIdx.x == 0) { volatile float* tsb = (volatile float*)(p.ws + WS_TAB + 196608) + blockIdx.x * 8; for (int i = 0; i < 8; ++i) tsb[i] = 0.f; }
        if (PROBE_A >= 20 && ph == NPHASE - 2 && blockIdx.x == 0 && threadIdx.x == 0) {
            volatile float* tsf = (volatile float*)(p.ws + WS_TAB + 131072); volatile unsigned long long* tsl = (volatile unsigned long long*)(p.ws + WS_TAB + 131072 + 256);
            const float* tsb = (const float*)(p.ws + WS_TAB + 196608); float sum = 0.f; for (int b2 = 0; b2 < (int)gridDim.x; ++b2) sum += __hip_atomic_load(tsb + b2 * 8 + (PROBE_A - 20), __ATOMIC_RELAXED, __HIP_MEMORY_SCOPE_AGENT); sum *= (PROBE_A == 20 ? 32.f : (PROBE_A == 21 ? 16.f : 1.f));
            const float tot = (float)(__builtin_amdgcn_s_memrealtime() - tsl[1]); tsf[12] = rintf(sum / (float)gridDim.x / tot * 40.f) / 40.f; tsf[13] = 0.f; }
        int tid_ = threadIdx.x; asm volatile("" : "+v"(tid_));
        unsigned char* ws_ = p.ws; asm volatile("" : "+s"(ws_));
        float* out_ = p.out; asm volatile("" : "+s"(out_));
        Ctx C; C.p = &p; C.lds = (LAS unsigned char*)lds_raw; C.L = (float*)lds_raw; C.tid = tid_; C.lane = C.tid & 63; C.wave = __builtin_amdgcn_readfirstlane(C.tid >> 6);
        C.G = gridDim.x; C.gw = blockIdx.x * 8 + C.wave; C.NGW = C.G * 8; C.ws = ws_; C.out = out_;
        unsigned* ctl = (unsigned*)(ws_ + WS_CTL);
        const float* modbuf = (const float*)(ws_ + WS_MOD);
        bf16_t* xm = (bf16_t*)(ws_ + WS_XM); bf16_t* ob = (bf16_t*)(ws_ + WS_O); bf16_t* act = (bf16_t*)(ws_ + WS_ACT);
        if (ph == 0) { if (PHON(0)) phase0a(C); }
        else if (ph == 1) { if (PHON(1)) row_pass(C, 0, nullptr, nullptr, modbuf, 1024, 0, true); }
        else {
            const int layer = (ph - 2) / 9, sub = (ph - 2) % 9;
            unsigned char* wb = ws_ + WS_W + (size_t)(layer & 1) * WBUF;
            const float* modl = modbuf + (size_t)layer * 3 * 6144;
            if (sub == 0) { if (PHON(2)) {
                pg8::Gemm g{xm, (const bf16_t*)(wb + W_IN), MROWS, 4096, DM}; pg8::StaticOrder S; S.init(MROWS, 4096, C.G, (int)blockIdx.x);
                EpiIn E{(bf16_t*)(ws_ + WS_Q), (bf16_t*)(ws_ + WS_K), (bf16_t*)(ws_ + WS_V), (bf16_t*)(ws_ + WS_ZB), out_ + OUT_K, out_ + OUT_V, (const f32x2*)(ws_ + WS_TAB), layer};
                pg8::gemm_phase(C.lds, g, S, E, C.tid); }
            } else if (sub == 1) {
                __syncthreads();
                if (PHON(4)) for (int u = blockIdx.x; u < 1024; u += C.G) delta_prep_unit(C, layer, u);
                __syncthreads();
                if (PHON(5)) for (int u = C.gw; u < 2048; u += C.NGW) hgrn_local_unit(C, layer, u);
                __syncthreads();
            } else if (sub == 2) {
                LAS int* slot = (LAS int*)(C.lds + 147392);
                for (;;) {
                    __syncthreads();
                    if (C.tid == 0) *slot = (int)atomicAdd(ctl + 64 * (layer + 1), 1u);
                    __syncthreads();
                    const int u = *slot;
                    if (u >= 1432 + 256 + 64) break;
                    if (u >= 1432 + 256) { if (layer + 1 < DEPTH) { mod_unit(C, (layer + 1) * 64 + (u - 1432 - 256)); } continue; }
                    if (u >= 1432) { if (layer + 1 < DEPTH) convert_layer_weights(C, layer + 1, (u - 1432) * 8 + C.wave, 2048, u - 1432, 256); continue; }
                    unsigned long long pt0_ = 0; if (PROBE_A >= 0 && C.tid == 0) pt0_ = __builtin_amdgcn_s_memrealtime();
                    if (u < 8) { if (PHON(6)) delta_scan_unit(C, layer, true, u >> 2, u & 3); }
                    else if (u < 24) { const int v = u - 8; if (PHON(7)) hgrn_scan_unit(C, layer, true, v >> 3, (v >> 1) & 3, v & 1); }
                    else if (u < 536) { if (PHON(8)) attn_unit(C, layer, u - 24); }
                    else if (u < 664) { const int v = u - 536; if (PHON(6)) delta_scan_unit(C, layer, false, v >> 2, v & 3); }
                    else if (u < 1176) { if (PHON(8)) attn_unit(C, layer, 512 + (u - 664)); }
                    else { const int v = u - 1176; if (PHON(7)) hgrn_scan_unit(C, layer, false, v >> 3, (v >> 1) & 3, v & 1); }
                    if (PROBE_A >= 0) { __syncthreads(); if (C.tid == 0) { const int ty = (u < 8) ? 0 : (u < 24 ? 1 : (u < 536 ? 2 : (u < 664 ? 3 : (u < 1176 ? 4 : 5))));
                        volatile float* tsb = (volatile float*)(ws_ + WS_TAB + 196608) + blockIdx.x * 8; tsb[ty] += (float)(__builtin_amdgcn_s_memrealtime() - pt0_); } }
                }
            } else if (sub == 3) {
                if (PHON(9)) for (int u = blockIdx.x; u < 256; u += C.G) hgrn_final_unit(C, layer, u);
                __syncthreads();
                if (PHON(10)) delta_combine(C, layer);
                __syncthreads();
            } else if (sub == 4) {
                pg8::Gemm g{ob, (const bf16_t*)(wb + W_OUT), MROWS, DM, DM}; pg8::StaticOrder S; S.init(MROWS, DM, C.G, (int)blockIdx.x);
                EpiRes E{out_, modl + 2048, xm};
                if (PHON(11)) pg8::gemm_phase(C.lds, g, S, E, C.tid);
            } else if (sub == 5) {
                if (PHON(12)) row_pass(C, 1, p.in[20] + (size_t)(layer * 2) * DM, p.in[21] + (size_t)(layer * 2) * DM, modl, 4096, 3072, true);
            } else if (sub == 6) {
                pg8::Gemm g{xm, (const bf16_t*)(wb + W_FFI), MROWS, 2 * DFF, DM}; pg8::StaticOrder S; S.init(MROWS, 2 * DFF, C.G, (int)blockIdx.x);
                EpiFfn E{act};
                if (PHON(13)) pg8::gemm_phase(C.lds, g, S, E, C.tid);
            } else if (sub == 7) {
                pg8::Gemm g{act, (const bf16_t*)(wb + W_FFO), MROWS, DM, DFF}; pg8::StaticOrder S; S.init(MROWS, DM, C.G, (int)blockIdx.x);
                EpiRes E{out_, modl + 5120, xm};
                if (PHON(14)) pg8::gemm_phase(C.lds, g, S, E, C.tid);
            } else {
                const bool last = layer + 1 == DEPTH;
                if (PHON(12)) row_pass(C, 1, p.in[20] + (size_t)(layer * 2 + 1) * DM, p.in[21] + (size_t)(layer * 2 + 1) * DM, modbuf + (size_t)(last ? layer : layer + 1) * 3 * 6144, 1024, 0, !last);
            }
        }
        if (ph + 1 < p.ph_hi) { if (p.ph_hi > 100000) { __threadfence(); cg::this_grid().sync(); } else xcd_barrier(xbar); }
    }
}

#if !MK_ONE_LAUNCH
static unsigned phase_mask(int ph) {
    if (ph == 0) return 1u << 0; if (ph == 1) return 1u << 1;
    const int sub = (ph - 2) % 9;
    switch (sub) { case 0: return 1u << 2; case 1: return (1u << 3) | (1u << 4) | (1u << 5); case 2: return (1u << 6) | (1u << 7) | (1u << 8); case 3: return (1u << 9) | (1u << 10);
        case 4: return 1u << 11; case 5: return 1u << 12; case 6: return 1u << 13; case 7: return 1u << 14; default: return 1u << 12; }
}
typedef void (*kern_t)(Params);
static kern_t kernel_for_mask(unsigned m) {
    switch (m) {
        case 1u << 0: return fwd_megakernel<1u << 0>; case 1u << 1: return fwd_megakernel<1u << 1>; case 1u << 2: return fwd_megakernel<1u << 2>;
        case (1u << 3) | (1u << 4) | (1u << 5): return fwd_megakernel<(1u << 3) | (1u << 4) | (1u << 5)>;
        case (1u << 6) | (1u << 7) | (1u << 8): return fwd_megakernel<(1u << 6) | (1u << 7) | (1u << 8)>;
        case (1u << 9) | (1u << 10): return fwd_megakernel<(1u << 9) | (1u << 10)>;
        case 1u << 11: return fwd_megakernel<1u << 11>; case 1u << 12: return fwd_megakernel<1u << 12>; case 1u << 13: return fwd_megakernel<1u << 13>; default: return fwd_megakernel<1u << 14>;
    }
}
#endif
extern "C" void kernel_launch(void* const* d_in, const int* in_sizes, int n_in, void* d_out, int out_size, void* d_ws, size_t ws_size, hipStream_t stream) {
    static int grid = 0;
    if (grid == 0) {
        if (n_in != 24 || out_size != 58720256 || ws_size < WS_END) { fprintf(stderr, "kernel_launch: unexpected shapes (n_in %d out %d ws %zu)\n", n_in, out_size, ws_size); grid = -1; return; }
        int dev = 0, cus = 0;
        (void)hipGetDevice(&dev); (void)hipDeviceGetAttribute(&cus, hipDeviceAttributeMultiprocessorCount, dev);
#if MK_ONE_LAUNCH
        if (hipFuncSetAttribute((const void*)fwd_megakernel<0x7FFFu>, hipFuncAttributeMaxDynamicSharedMemorySize, LDS_BYTES) != hipSuccess) { fprintf(stderr, "kernel_launch: hipFuncSetAttribute failed\n"); grid = -1; return; }
#else
        for (int ph = 0; ph < 11; ++ph) (void)hipFuncSetAttribute((const void*)kernel_for_mask(phase_mask(ph)), hipFuncAttributeMaxDynamicSharedMemorySize, LDS_BYTES);
#endif
        (void)hipGetLastError();
        grid = cus > 0 ? cus : 256;
        if (grid != 256) { fprintf(stderr, "kernel_launch: expected 256 CUs, got %d\n", grid); grid = 256; }
    }
    if (grid < 0) return;
    (void)hipMemsetAsync((char*)d_ws + WS_CTL, 0, 65536, stream);
    Params p{};
    for (int i = 0; i < 24; ++i) p.in[i] = (const float*)d_in[i];
    p.out = (float*)d_out; p.ws = (unsigned char*)d_ws;
#if MK_ONE_LAUNCH
    p.ph_lo = 0; p.ph_hi = NPHASE;
    void* args[] = {&p};
    hipError_t e = hipLaunchCooperativeKernel((const void*)fwd_megakernel<0x7FFFu>, dim3(grid), dim3(512), args, LDS_BYTES, stream);
    if (e != hipSuccess) fprintf(stderr, "cooperative launch failed: %s (grid %d)\n", hipGetErrorString(e), grid);
#else
    for (int ph = 0; ph < NPHASE; ++ph) { p.ph_lo = ph; p.ph_hi = ph + 1; hipLaunchKernelGGL(kernel_for_mask(phase_mask(ph)), dim3(grid), dim3(512), LDS_BYTES, stream, p); }
#endif
}
```

```cpp
#include <hip/hip_runtime.h>
#include <hip/hip_cooperative_groups.h>
#include <cstdio>
#include <cstdint>
namespace cg = cooperative_groups;

#define PHON(k) ((PHM_ >> (k)) & 1)
#ifndef PROBE_A
#define PROBE_A -1
#endif
#ifndef PROBE_B
#define PROBE_B -1
#endif
#ifndef MK_ONE_LAUNCH
#define MK_ONE_LAUNCH 1
#endif

#define DI __device__ __forceinline__
#define LAS __attribute__((address_space(3)))
typedef unsigned short bf16_t;
typedef short bf16x8 __attribute__((ext_vector_type(8)));
typedef short s16x4 __attribute__((ext_vector_type(4)));
typedef float f32x4 __attribute__((ext_vector_type(4)));
typedef float f32x16 __attribute__((ext_vector_type(16)));
typedef float f32x2 __attribute__((ext_vector_type(2)));
typedef unsigned u32x4 __attribute__((ext_vector_type(4)));
typedef unsigned u32x2 __attribute__((ext_vector_type(2)));

constexpr int MROWS = 16384, DM = 1024, DEPTH = 4, DFF = 2816, DIN = 3856, ZLD = 2320;
constexpr float ALPHA = 1.681792830507429f, LN_EPS = 1e-5f, RMS_EPS = 1e-6f;
constexpr float QSCALE = 0.125f * 1.4426950408889634f;
constexpr int ZB_BQ = 0, ZB_BK = 256, ZB_BV = 512, ZB_BG = 768, ZB_BBETA = 1024, ZB_BA = 1032, ZB_CQ = 1040, ZB_CF = 1296, ZB_CI = 1808, ZB_CG = 2064;
constexpr size_t OUT_K = 16777216, OUT_V = 33554432, OUT_SD = 50331648, OUT_SH = 54525952;
constexpr size_t MiB = 1u << 20;
constexpr size_t WS_CTL = 0, WS_MOD = 64 * 1024, WS_TAB = 512 * 1024, WS_CK = 1 * MiB, WS_CV = 3 * MiB, WS_W = 8 * MiB, WBUF = 27 * MiB;
constexpr size_t W_IN = 0, W_OUT = 8 * MiB, W_FFI = 10 * MiB, W_FFO = 21 * MiB;
constexpr size_t WS_XM = 62 * MiB, WS_O = 94 * MiB, WS_ZB = 126 * MiB, WS_Q = 199 * MiB, WS_K = 215 * MiB, WS_V = 231 * MiB;
constexpr size_t WS_ACT = 126 * MiB;
constexpr size_t WS_DPW = 247 * MiB, WS_DPQD = 263 * MiB, WS_DPQK = 279 * MiB, WS_DPKD = 295 * MiB;
constexpr size_t WS_DPU = WS_XM;
constexpr size_t WS_OD = 311 * MiB, WS_HS = 343 * MiB, WS_HD = 375 * MiB, WS_GL = 375 * MiB + 512 * 1024, WS_END = 376 * MiB;
constexpr int LDS_BYTES = 147456;
constexpr int NPHASE = 2 + 9 * DEPTH;

struct Params { const float* in[24]; float* out; unsigned char* ws; int ph_lo, ph_hi; };

DI unsigned cvt_pk_bf16(float lo, float hi) { unsigned r; asm("v_cvt_pk_bf16_f32 %0, %1, %2" : "=v"(r) : "v"(lo), "v"(hi)); return r; }
DI bf16_t f2bf(float f) { return (bf16_t)(cvt_pk_bf16(f, 0.f) & 0xffffu); }
DI float bf2f(bf16_t b) { return __uint_as_float(((unsigned)b) << 16); }
DI float sigmoidf_(float x) { return __builtin_amdgcn_rcpf(1.0f + __expf(-x)); }
DI float siluf_(float x) { return x * __builtin_amdgcn_rcpf(1.0f + __expf(-x)); }
DI float wave_sum(float v) {
#pragma unroll
    for (int o = 1; o < 64; o <<= 1) v += __shfl_xor(v, o);
    return v;
}
DI u32x2 pack4(f32x4 v) { u32x2 w; w.x = cvt_pk_bf16(v[0], v[1]); w.y = cvt_pk_bf16(v[2], v[3]); return w; }
DI bf16x8 pack8(f32x4 a, f32x4 b) { u32x4 w; w.x = cvt_pk_bf16(a[0], a[1]); w.y = cvt_pk_bf16(a[2], a[3]); w.z = cvt_pk_bf16(b[0], b[1]); w.w = cvt_pk_bf16(b[2], b[3]); return __builtin_bit_cast(bf16x8, w); }
DI int pinv(int k) { return (k >> 5) * 32 + ((k >> 2) & 3) * 8 + ((k >> 4) & 1) * 4 + (k & 3); }
DI int row_mod(int r) { return r < 8192 ? 0 : 1 + ((r - 8192) >> 12); }

namespace pg8 {
constexpr int BM = 256, BK = 64, HALF = 128, HTB = HALF * BK * 2, STAGE_BYTES = 8 * HTB, NXCD = 8, WGM = 8;
DI int lds_byte(int r, int c) { const int st = (r >> 4) * 2 + (c >> 5), rr = r & 15, cc = c & 31, ob = rr * 64 + cc * 2; return st * 1024 + (ob ^ (((ob >> 9) & 1) << 5)); }
DI void stage_rc(int b, int& R, int& C) { const int st = b / 1024, sb = b % 1024, swz = sb ^ (((sb >> 9) & 1) << 5); R = (st >> 1) * 16 + swz / 64; C = (st & 1) * 32 + (swz % 64) / 2; }
struct Unit { int pm, pn; };
struct Gemm { const bf16_t* A; const bf16_t* Bt; int M, N, K; };
struct StaticOrder {
    int nM, nN, nwg, G, c;
    DI void init(int M, int N, int G_, int c_) { nM = M / BM; nN = N / BM; nwg = nM * nN; G = G_; c = c_; }
    DI bool next(int i, Unit& u) const {
        const long L = (long)i * G + c; if (L >= nwg) return false;
        int wgid = (int)L; { const int q = nwg / NXCD, r = nwg % NXCD, xcd = wgid % NXCD, off = wgid / NXCD; wgid = (xcd < r ? xcd * (q + 1) : r * (q + 1) + (xcd - r) * q) + off; }
        const int nig = WGM * nN, gid = wgid / nig, fm = gid * WGM, gsz = (nM - fm) < WGM ? (nM - fm) : WGM;
        u.pm = fm + ((wgid % nig) % gsz); u.pn = (wgid % nig) / gsz; return true;
    }
};

template <class Epi>
DI void gemm_phase(LAS unsigned char* lds, const Gemm g, const StaticOrder& S, const Epi& E, int tid_in) {
    const int tid = tid_in, wid = __builtin_amdgcn_readfirstlane(tid >> 6), lane = tid & 63, wr = wid >> 2, wc = wid & 3, fr = lane & 15, fq = lane >> 4;
    const int K = g.K, nt = K / BK;
    unsigned voffA[2];
#pragma unroll
    for (int i = 0; i < 2; ++i) { int R, C; stage_rc(tid * 16 + i * 8192, R, C); voffA[i] = (unsigned)(R * K + C) * 2u; }
    const size_t kstep = (size_t)(BK * 2);
    const size_t hstep = (size_t)HALF * K * 2;
    const size_t tstep = 2 * hstep;
    const unsigned ldsw = (unsigned)wid * 1024u;
    const int aoff = lds_byte(wr * 64 + fr, fq * 8), boff = lds_byte(wc * 32 + fr, fq * 8);
#define PG8_SA(b, h) (((b) * 2 + (h)) * HTB)
#define PG8_SB(b, h) ((4 + (b) * 2 + (h)) * HTB)
#define PG8_STAGE(bufoff, gbase) do { _Pragma("unroll") for (int _i = 0; _i < 2; ++_i) \
        __builtin_amdgcn_global_load_lds((const unsigned*)((const char*)(gbase) + voffA[_i]), (LAS unsigned*)(lds + (bufoff) + ldsw + _i * 8192), 16, 0, 0); } while (0)
#define PG8_LDA(dst, b, h) do { _Pragma("unroll") for (int m = 0; m < 4; ++m) _Pragma("unroll") for (int k = 0; k < 2; ++k) dst[m][k] = *(const LAS bf16x8*)(lds + PG8_SA(b, h) + aoff + m * 2048 + k * 1024); } while (0)
#define PG8_LDB(dst, b, h) do { _Pragma("unroll") for (int n = 0; n < 2; ++n) _Pragma("unroll") for (int k = 0; k < 2; ++k) dst[n][k] = *(const LAS bf16x8*)(lds + PG8_SB(b, h) + boff + n * 2048 + k * 1024); } while (0)
#define PG8_MMA(ai, bj, At, Bt) do { __builtin_amdgcn_s_setprio(1); _Pragma("unroll") for (int m = 0; m < 4; ++m) _Pragma("unroll") for (int n = 0; n < 2; ++n) _Pragma("unroll") for (int k = 0; k < 2; ++k) \
        acc[ai][bj][m][n] = __builtin_amdgcn_mfma_f32_16x16x32_bf16(Bt[n][k], At[m][k], acc[ai][bj][m][n], 0, 0, 0); __builtin_amdgcn_s_setprio(0); } while (0)
#define PG8_WAIT_V(n) asm volatile("s_waitcnt vmcnt(" #n ")" ::: "memory")
#define PG8_WAIT_L(n) asm volatile("s_waitcnt lgkmcnt(" #n ")" ::: "memory")
#define PG8_BAR __builtin_amdgcn_s_barrier()
#define PG8_SCHED __builtin_amdgcn_sched_barrier(0)
    Unit cur, nxt; int ui = 0;
    if (!S.next(0, cur)) return;
    f32x4 acc[2][2][4][2];
#pragma unroll
    for (int a = 0; a < 2; ++a)
#pragma unroll
        for (int b = 0; b < 2; ++b)
#pragma unroll
            for (int m = 0; m < 4; ++m)
#pragma unroll
                for (int n = 0; n < 2; ++n) acc[a][b][m][n] = (f32x4){0.f, 0.f, 0.f, 0.f};
    bf16x8 At[4][2], B0[2][2], B1[2][2];
    const char* cA = (const char*)g.A + (size_t)cur.pm * tstep; const char* cB = (const char*)g.Bt + (size_t)cur.pn * tstep;
    PG8_STAGE(PG8_SB(0, 0), cB); PG8_STAGE(PG8_SB(0, 1), cB + hstep); PG8_STAGE(PG8_SA(0, 0), cA); PG8_STAGE(PG8_SA(0, 1), cA + hstep);
    if (wr == 1) PG8_BAR;
    PG8_WAIT_V(2); PG8_BAR;
    PG8_STAGE(PG8_SB(1, 0), cB + kstep); PG8_STAGE(PG8_SA(1, 0), cA + kstep); PG8_STAGE(PG8_SB(1, 1), cB + hstep + kstep);
    PG8_WAIT_V(6); PG8_BAR;
    for (;;) {
        const bool has_next = S.next(ui + 1, nxt);
        const char* nA = has_next ? (const char*)g.A + (size_t)nxt.pm * tstep : cA; const char* nB = has_next ? (const char*)g.Bt + (size_t)nxt.pn * tstep : cB;
        for (int t = 0; t < nt; t += 2) {
            const bool last = (t == nt - 2);
            const char* a1 = cA + (size_t)(t + 1) * kstep;
            const char* a2 = last ? nA : cA + (size_t)(t + 2) * kstep; const char* b2 = last ? nB : cB + (size_t)(t + 2) * kstep;
            const char* a3 = a2 + kstep; const char* b3 = b2 + kstep;
            PG8_LDB(B0, 0, 0); PG8_LDB(B1, 0, 1); PG8_SCHED; PG8_LDA(At, 0, 0); PG8_STAGE(PG8_SA(1, 1), a1 + hstep);
            PG8_WAIT_V(8); PG8_WAIT_L(0); PG8_BAR; PG8_MMA(0, 0, At, B0); PG8_MMA(0, 1, At, B1); PG8_BAR; PG8_SCHED;
            PG8_LDA(At, 0, 1); PG8_STAGE(PG8_SB(0, 0), b2); PG8_STAGE(PG8_SB(0, 1), b2 + hstep); PG8_STAGE(PG8_SA(0, 0), a2);
            PG8_WAIT_V(8); PG8_WAIT_L(0); PG8_BAR; PG8_MMA(1, 0, At, B0); PG8_MMA(1, 1, At, B1); PG8_BAR; PG8_SCHED;
            PG8_LDB(B0, 1, 0); PG8_LDB(B1, 1, 1); PG8_SCHED; PG8_LDA(At, 1, 0); PG8_STAGE(PG8_SA(0, 1), a2 + hstep);
            PG8_WAIT_V(8); PG8_WAIT_L(0); PG8_BAR; PG8_MMA(0, 0, At, B0); PG8_MMA(0, 1, At, B1); PG8_BAR; PG8_SCHED;
            PG8_LDA(At, 1, 1); PG8_STAGE(PG8_SB(1, 0), b3); PG8_STAGE(PG8_SB(1, 1), b3 + hstep); PG8_STAGE(PG8_SA(1, 0), a3);
            PG8_WAIT_V(8); PG8_WAIT_L(0); PG8_BAR; PG8_MMA(1, 0, At, B0); PG8_MMA(1, 1, At, B1); PG8_BAR; PG8_SCHED;
        }
        if (wr == 0) PG8_BAR;
        E(acc, cur, wr, wc, fr, fq);
        if (!has_next) break;
#pragma unroll
        for (int a = 0; a < 2; ++a)
#pragma unroll
            for (int b = 0; b < 2; ++b)
#pragma unroll
                for (int m = 0; m < 4; ++m)
#pragma unroll
                    for (int n = 0; n < 2; ++n) acc[a][b][m][n] = (f32x4){0.f, 0.f, 0.f, 0.f};
        cur = nxt; cA = nA; cB = nB; ++ui;
        if (wr == 1) PG8_BAR;
    }
    PG8_WAIT_V(0);
    PG8_BAR;
#undef PG8_SA
#undef PG8_SB
#undef PG8_STAGE
#undef PG8_LDA
#undef PG8_LDB
#undef PG8_MMA
#undef PG8_WAIT_V
#undef PG8_WAIT_L
#undef PG8_BAR
#undef PG8_SCHED
}
}

struct EpiIn {
    bf16_t *Qb, *Kb, *Vb, *zb; float *outK, *outV; const f32x2* rope; int layer;
    DI void operator()(const f32x4 (&acc)[2][2][4][2], const pg8::Unit& u, int wr, int wc, int fr, int fq) const {
        const int tile = u.pn; const bool sample = u.pm >= 32;
        if (tile < 6) {
            const int kind = tile >> 1; const int cb = (tile & 1) * 256 + wc * 32 + 4 * fq;
            bf16_t* dst = Qb + (size_t)kind * (16u * 1024u * 1024u / 2u);
            float* of = outK + (size_t)(kind >= 1 ? kind - 1 : 0) * 16777216u;
#pragma unroll
            for (int ai = 0; ai < 2; ++ai)
#pragma unroll
                for (int m = 0; m < 4; ++m) {
                    const int r = u.pm * 256 + ai * 128 + wr * 64 + m * 16 + fr;
#pragma unroll
                    for (int bj = 0; bj < 2; ++bj) {
                        f32x4 a = acc[ai][bj][m][0], b = acc[ai][bj][m][1]; const int cc = cb + bj * 128;
                        if (!sample && kind >= 1) { float* o = of + ((size_t)((r >> 8) * 4 + layer) * 256 + (r & 255)) * 512 + cc; *(f32x4*)o = a; *(f32x4*)(o + 16) = b; }
                        if (sample && kind < 2) {
                            const int t = (r - 8192) & 4095; const int pos = (wc & 1) ? (t & 63) : (t >> 6); const f32x2* rp = rope + pos * 16 + 4 * fq;
#pragma unroll
                            for (int j = 0; j < 4; ++j) { const f32x2 cs = rp[j]; const float x1 = a[j], x2 = b[j]; a[j] = x1 * cs.x - x2 * cs.y; b[j] = x2 * cs.x + x1 * cs.y; }
                        }
                        if (kind == 0) { a = a * QSCALE; b = b * QSCALE; }
                        if (kind == 2) {
                            const int hh = cc >> 7, dv0 = cc & 127, tt = sample ? ((r - 8192) & 4095) : (r & 255);
                            bf16_t* vt = sample ? Vb + 4194304 + ((size_t)((((r - 8192) >> 12) * 4 + hh) * 32 + (tt >> 7)) * 128 + dv0) * 128 + (tt & 127)
                                                : Vb + ((size_t)(((r >> 8) * 4 + hh) * 2 + (tt >> 7)) * 128 + dv0) * 128 + (tt & 127);
#pragma unroll
                            for (int j = 0; j < 4; ++j) { vt[(size_t)j * 128] = f2bf(a[j]); vt[(size_t)(16 + j) * 128] = f2bf(b[j]); }
                        } else { *(u32x2*)(dst + (size_t)r * 512 + cc) = pack4(a); *(u32x2*)(dst + (size_t)r * 512 + cc + 16) = pack4(b); }
                    }
                    asm volatile("" ::: "memory");
                }
        } else {
#pragma unroll
            for (int ai = 0; ai < 2; ++ai)
#pragma unroll
                for (int m = 0; m < 4; ++m) {
                    const int r = u.pm * 256 + ai * 128 + wr * 64 + m * 16 + fr;
#pragma unroll
                    for (int bj = 0; bj < 2; ++bj)
#pragma unroll
                        for (int n = 0; n < 2; ++n) { const int c = (tile - 6) * 256 + bj * 128 + wc * 32 + 16 * n + 4 * fq; if (c < ZLD) *(u32x2*)(zb + (size_t)r * ZLD + c) = pack4(acc[ai][bj][m][n]); }
                    asm volatile("" ::: "memory");
                }
        }
    }
};
struct EpiRes {
    float* x; const float* gate; bf16_t* vb;
    DI void operator()(const f32x4 (&acc)[2][2][4][2], const pg8::Unit& u, int wr, int wc, int fr, int fq) const {
        const float* gv = gate + row_mod(u.pm * 256) * 6144;
#pragma unroll
        for (int ai = 0; ai < 2; ++ai)
#pragma unroll
            for (int m = 0; m < 4; ++m) {
                const int r = u.pm * 256 + ai * 128 + wr * 64 + m * 16 + fr;
#pragma unroll
                for (int bj = 0; bj < 2; ++bj)
#pragma unroll
                    for (int n = 0; n < 2; ++n) { const int c = u.pn * 256 + bj * 128 + wc * 32 + 16 * n + 4 * fq; const f32x4 g4 = *(const f32x4*)(gv + c); const u32x2 xw = *(const u32x2*)((const bf16_t*)x + (size_t)r * DM + c); const f32x4 xv = (f32x4){__uint_as_float(xw.x << 16), __uint_as_float(xw.x & 0xffff0000u), __uint_as_float(xw.y << 16), __uint_as_float(xw.y & 0xffff0000u)}; *(u32x2*)(vb + (size_t)r * DM + c) = pack4(xv * ALPHA + g4 * acc[ai][bj][m][n]); }
            }
    }
};
struct EpiFfn {
    bf16_t* act;
    DI void operator()(const f32x4 (&acc)[2][2][4][2], const pg8::Unit& u, int wr, int wc, int fr, int fq) const {
#pragma unroll
        for (int ai = 0; ai < 2; ++ai)
#pragma unroll
            for (int m = 0; m < 4; ++m) {
                const int r = u.pm * 256 + ai * 128 + wr * 64 + m * 16 + fr;
#pragma unroll
                for (int n = 0; n < 2; ++n) { const f32x4 gt = acc[ai][0][m][n], up = acc[ai][1][m][n]; f32x4 o;
#pragma unroll
                    for (int j = 0; j < 4; ++j) o[j] = siluf_(gt[j]) * up[j];
                    *(u32x2*)(act + (size_t)r * DFF + u.pn * 128 + wc * 32 + 16 * n + 4 * fq) = pack4(o); }
            }
    }
};

struct Ctx {
    const Params* p; LAS unsigned char* lds; float* L; int tid, lane, wave, G, gw, NGW;
    unsigned char* ws; float* out;
};

DI void tr_item(const float* W, int K, int N, bf16_t* WT, int mode, float* scr, int item, int lane) {
    const int nblk = (N + 31) / 32, kb = item / nblk, nb = item % nblk, k0 = 64 * kb, n0 = 32 * nb;
    const int nn = n0 + 4 * (lane & 7);
#pragma unroll
    for (int i = 0; i < 8; ++i) { const int kk = 8 * i + (lane >> 3); const f32x4 v4 = (nn < N) ? *(const f32x4*)(W + (size_t)(k0 + kk) * N + nn) : (f32x4){0.f, 0.f, 0.f, 0.f};
        float* sp_ = scr + kk * 33 + 4 * (lane & 7); sp_[0] = v4[0]; sp_[1] = v4[1]; sp_[2] = v4[2]; sp_[3] = v4[3]; }
    __builtin_amdgcn_wave_barrier();
    const int c = lane & 7;
#pragma unroll
    for (int j = 0; j < 4; ++j) {
        const int nl = (lane >> 3) + 8 * j, n = n0 + nl; const float* s = scr + (8 * c) * 33 + nl;
        if (n < N) {
            int dst = n; if (mode == 1) { if (n < DFF) dst = (n >> 7) * 256 + (n & 127); else { const int jj = n - DFF; dst = (jj >> 7) * 256 + 128 + (jj & 127); } }
            u32x4 o; o.x = cvt_pk_bf16(s[0 * 33], s[1 * 33]); o.y = cvt_pk_bf16(s[2 * 33], s[3 * 33]); o.z = cvt_pk_bf16(s[4 * 33], s[5 * 33]); o.w = cvt_pk_bf16(s[6 * 33], s[7 * 33]);
            *(u32x4*)(WT + (size_t)dst * K + k0 + 8 * c) = o;
        }
    }
    __builtin_amdgcn_wave_barrier();
}
DI void convert_layer_weights(const Ctx& C, int layer, int gw0 = -1, int ngw = 0, int blk = -1, int nblk = 0) {
    const Params& p = *C.p;
    unsigned char* wb = C.ws + WS_W + (size_t)(layer & 1) * WBUF;
    bf16_t* Win = (bf16_t*)(wb + W_IN); bf16_t* Wout = (bf16_t*)(wb + W_OUT); bf16_t* Wffi = (bf16_t*)(wb + W_FFI); bf16_t* Wffo = (bf16_t*)(wb + W_FFO);
    float* scr = C.L + C.wave * (64 * 33);
    constexpr int I_IN = 16 * 121, I_OUT = 16 * 32, I_FFI = 16 * 176, I_FFO = 44 * 32, NIT = I_IN + I_OUT + I_FFI + I_FFO;
    int lane_ = C.lane; asm volatile("" : "+v"(lane_));
    const int gwA = gw0 >= 0 ? gw0 : C.gw, ngwA = gw0 >= 0 ? ngw : C.NGW, blkA = blk >= 0 ? blk : (int)blockIdx.x, nblkA = blk >= 0 ? nblk : C.G;
    for (int it = gwA; it < NIT; it += ngwA) {
        int r = it;
        if (r < I_IN) { tr_item(p.in[10] + (size_t)layer * DM * DIN, DM, DIN, Win, 0, scr, r, lane_); continue; } r -= I_IN;
        if (r < I_OUT) { tr_item(p.in[19] + (size_t)layer * DM * DM, DM, DM, Wout, 0, scr, r, lane_); continue; } r -= I_OUT;
        if (r < I_FFI) { tr_item(p.in[22] + (size_t)layer * DM * 2 * DFF, DM, 2 * DFF, Wffi, 1, scr, r, lane_); continue; } r -= I_FFI;
        tr_item(p.in[23] + (size_t)layer * DFF * DM, DFF, DM, Wffo, 0, scr, r, lane_);
    }
    u32x4* z = (u32x4*)(Win + (size_t)DIN * DM); const int nz = 240 * DM * 2 / 16;
    for (int i = blkA * 512 + C.tid; i < nz; i += nblkA * 512) z[i] = (u32x4){0u, 0u, 0u, 0u};
}

DI void mod_unit(const Ctx& C, int u) {
    const Params& p = *C.p; const int tid = C.tid;
    float* cs = C.L; float* red = C.L + 3072;
    const int layer = u >> 6, col0 = (u & 63) * 96;
    __syncthreads();
    for (int i = tid; i < 3072; i += 512) { const int v = i >> 10, k = i & 1023; const float c = (v == 0) ? p.in[7][k] : p.in[6][(v - 1) * 1024 + k]; cs[i] = siluf_(c); }
    __syncthreads();
    if (tid < 504) {
        const int cgp = tid % 24, rs = tid / 24;
        f32x4 a0 = {0, 0, 0, 0}, a1 = a0, a2 = a0;
        const float* Wp = p.in[8] + (size_t)layer * DM * 6144 + col0 + cgp * 4;
#pragma unroll 7
        for (int k = rs; k < 1024; k += 21) { const f32x4 w = *(const f32x4*)(Wp + (size_t)k * 6144); a0 += w * cs[k]; a1 += w * cs[1024 + k]; a2 += w * cs[2048 + k]; }
        float* rr = red + rs * 288 + cgp * 4;
#pragma unroll
        for (int j = 0; j < 4; ++j) { rr[j] = a0[j]; rr[96 + j] = a1[j]; rr[192 + j] = a2[j]; }
    }
    __syncthreads();
    if (tid < 288) {
        const int v = tid / 96, cc = tid % 96; float s = 0.f;
        for (int rs = 0; rs < 21; ++rs) s += red[rs * 288 + tid];
        ((float*)(C.ws + WS_MOD))[(size_t)(layer * 3 + v) * 6144 + col0 + cc] = s + p.in[9][layer * 6144 + col0 + cc];
    }
}

DI void phase0a(const Ctx& C) {
    const Params& p = *C.p;
    for (int u = blockIdx.x; u < 64; u += C.G) mod_unit(C, u);
    __syncthreads();
    convert_layer_weights(C, 0);
    const int gt = blockIdx.x * 512 + C.tid, NT = C.G * 512;
    float* tab = (float*)(C.ws + WS_TAB);
    if (gt < 1024) { const int pos = gt >> 4, i = gt & 15; const float inv = __builtin_amdgcn_exp2f(-(float)i * (13.287712379549449f / 16.0f)); float rev = (float)pos * inv * 0.15915494309189535f; rev -= floorf(rev);
        tab[2 * gt] = __builtin_amdgcn_cosf(rev); tab[2 * gt + 1] = __builtin_amdgcn_sinf(rev); }
    if (gt >= 1024 && gt < 1028) { const int l = gt - 1024; const float* dl = p.in[17] + l * 256; float s01 = 0.f, s23 = 0.f; for (int i = 0; i < 64; ++i) { s01 += dl[i] * dl[64 + i]; s23 += dl[128 + i] * dl[192 + i]; }
        tab[2048 + l] = __expf(s01) - __expf(s23) + (0.8f - 0.6f * __expf(-0.3f * (float)l)); }
    if (gt >= 2048 && gt < 2560) { const int dir = (gt - 2048) >> 8, c = gt & 255; const float* lb = p.in[15] + dir * 1024 + c; float v[4], mx = -1e30f; for (int l = 0; l < 4; ++l) { v[l] = lb[l * 256]; mx = fmaxf(mx, v[l]); }
        float s = 0.f; for (int l = 0; l < 4; ++l) { v[l] = __expf(v[l] - mx); s += v[l]; } float cum = 0.f; for (int l = 0; l < 4; ++l) { if (l > 0) cum += v[l] / s; tab[4096 + (dir * 4 + l) * 256 + c] = cum; } }
    bf16_t* ck = (bf16_t*)(C.ws + WS_CK); bf16_t* cv = (bf16_t*)(C.ws + WS_CV);
    for (int i = gt; i < 2 * 4 * 256 * 512 / 4; i += NT) { const int e = i * 4; const int c = e & 511, j = (e >> 9) & 255, l = (e >> 17) & 3, b = e >> 19;
        const size_t dst = ((size_t)((l * 2 + b) * 256 + j)) * 512 + c;
        *(u32x2*)(ck + dst) = pack4(*(const f32x4*)(p.in[2] + e)); }
    for (int i = gt; i < 2 * 4 * 256 * 512; i += NT) { const int j = i & 255, dv = (i >> 8) & 127, hh = (i >> 15) & 3, b = (i >> 17) & 1, l = i >> 18;
        cv[((size_t)((((l * 2 + b) * 4 + hh) * 2 + (j >> 7)) * 128 + dv)) * 128 + (j & 127)] = f2bf(p.in[3][((size_t)((b * 4 + l) * 256 + j) * 4 + hh) * 128 + dv]); }
}

DI void row_pass(const Ctx& C, int mode, const float* lng, const float* lnb, const float* modl, int sc_off, int sh_off, bool write_xm) {
    const Params& p = *C.p; float* x = C.out; bf16_t* xm = (bf16_t*)(C.ws + WS_XM);
    for (int r0 = C.gw; r0 < MROWS; r0 += 2 * C.NGW) {
        f32x4 v[2][4];
#pragma unroll
        for (int u = 0; u < 2; ++u) { const int r = r0 + u * C.NGW;
            if (mode == 0) { const float* src = (r < 8192 ? p.in[0] + (size_t)r * DM : p.in[1] + (size_t)(r - 8192) * DM);
#pragma unroll
                for (int j = 0; j < 4; ++j) v[u][j] = *(const f32x4*)(src + 4 * C.lane + 256 * j); }
            else {
#pragma unroll
                for (int j = 0; j < 4; ++j) { const u32x2 w2 = *(const u32x2*)(xm + (size_t)r * DM + 4 * C.lane + 256 * j);
                    v[u][j] = (f32x4){__uint_as_float(w2.x << 16), __uint_as_float(w2.x & 0xffff0000u), __uint_as_float(w2.y << 16), __uint_as_float(w2.y & 0xffff0000u)}; } } }
#pragma unroll
        for (int u = 0; u < 2; ++u) { const int r = r0 + u * C.NGW;
            if (mode == 1) {
                float s = 0.f;
#pragma unroll
                for (int j = 0; j < 4; ++j) s += (v[u][j][0] + v[u][j][1]) + (v[u][j][2] + v[u][j][3]);
                const float mean = wave_sum(s) * (1.f / DM); float s2 = 0.f;
#pragma unroll
                for (int j = 0; j < 4; ++j) { v[u][j] = v[u][j] - mean; s2 += (v[u][j][0] * v[u][j][0] + v[u][j][1] * v[u][j][1]) + (v[u][j][2] * v[u][j][2] + v[u][j][3] * v[u][j][3]); }
                const float rstd = 1.0f / sqrtf(wave_sum(s2) * (1.f / DM) + LN_EPS);
#pragma unroll
                for (int j = 0; j < 4; ++j) { const f32x4 g4 = *(const f32x4*)(lng + 4 * C.lane + 256 * j), b4 = *(const f32x4*)(lnb + 4 * C.lane + 256 * j); v[u][j] = v[u][j] * rstd * g4 + b4; }
            }
            if (PROBE_A >= 0 && !write_xm) { const float* tsf = (const float*)(C.ws + WS_TAB + 131072); const float sc = 1.0f + ((r >= 8192) ? tsf[12] : (PROBE_B >= 0 ? tsf[13] : 0.f));
#pragma unroll
                for (int j = 0; j < 4; ++j) v[u][j] = v[u][j] * sc; }
            if (!write_xm) {
#pragma unroll
                for (int j = 0; j < 4; ++j) *(f32x4*)(x + (size_t)r * DM + 4 * C.lane + 256 * j) = v[u][j];
            } else {
#pragma unroll
                for (int j = 0; j < 4; ++j) *(u32x2*)((bf16_t*)x + (size_t)r * DM + 4 * C.lane + 256 * j) = pack4(v[u][j]);
            }
            if (write_xm) {
                const float* mv = modl + row_mod(r) * 6144;
#pragma unroll
                for (int j = 0; j < 4; ++j) { const int c = 4 * C.lane + 256 * j; const f32x4 sc = *(const f32x4*)(mv + sc_off + c), sh = *(const f32x4*)(mv + sh_off + c);
                    *(u32x2*)(xm + (size_t)r * DM + c) = pack4(v[u][j] * (sc + 1.0f) + sh); }
            }
        }
    }
}

#define MFMA32(a, b, c) __builtin_amdgcn_mfma_f32_32x32x16_bf16((a), (b), (c), 0, 0, 0)
#define MFMA16(a, b, c) __builtin_amdgcn_mfma_f32_16x16x32_bf16((a), (b), (c), 0, 0, 0)
constexpr int AK_LD = 72, AV_LD = 136;
struct AttnSrc { const bf16_t* Klat; const bf16_t* Kctx; const bf16_t* VTlat; const bf16_t* VTctx; int ldv; int nst; int nlat; int h; };
template <int PASS>
DI void attn_pass(int tid, int q, int hi, int kq, const AttnSrc& A, LAS bf16_t* K1s, LAS bf16_t* K2s, LAS bf16_t* VTs, const bf16x8 (&q1)[4], const bf16x8 (&q2)[4],
                  float& m1, float& l1, float& m2, float& l2, float iL1, float iL2, f32x16 (&o)[4]) {
    u32x4 kreg[4], vreg[4];
    const int h = A.h;
    auto issue = [&](int st) {
        const bf16_t* kb = (st < A.nlat) ? A.Klat + (size_t)st * 128 * 512 : A.Kctx + (size_t)(st - A.nlat) * 128 * 512;
#pragma unroll
        for (int i = 0; i < 2; ++i) { const int id = tid + 512 * i, key = id >> 3, ch = id & 7; kreg[i] = *(const u32x4*)(kb + (size_t)key * 512 + h * 128 + ch * 8); kreg[2 + i] = *(const u32x4*)(kb + (size_t)key * 512 + h * 128 + 64 + ch * 8); }
        if (PASS == 1) {
            const bf16_t* vb = (st < A.nlat) ? A.VTlat + (size_t)st * 128 : A.VTctx + (size_t)(st - A.nlat) * 128; const int ld = (st < A.nlat) ? A.ldv : 256;
#pragma unroll
            for (int i = 0; i < 4; ++i) { const int id = tid + 512 * i, dv = id >> 4, ch = id & 15; vreg[i] = *(const u32x4*)(vb + (size_t)dv * ld + ch * 8); }
        }
    };
    issue(0);
    for (int st = 0; st < A.nst; ++st) {
        __syncthreads();
#pragma unroll
        for (int i = 0; i < 2; ++i) { const int id = tid + 512 * i, key = id >> 3, ch = id & 7; *(LAS u32x4*)(K1s + key * AK_LD + ch * 8) = kreg[i]; *(LAS u32x4*)(K2s + key * AK_LD + ch * 8) = kreg[2 + i]; }
        if (PASS == 1) {
#pragma unroll
            for (int i = 0; i < 4; ++i) { const int id = tid + 512 * i, dv = id >> 4, ch = id & 15; *(LAS u32x4*)(VTs + dv * AV_LD + ch * 8) = vreg[i]; }
        }
        __syncthreads();
        if (st + 1 < A.nst) issue(st + 1);
        const int keyrow = kq * 32 + q;
        f32x16 s1, pr;
#pragma unroll
        for (int r = 0; r < 16; ++r) s1[r] = 0.f;
#pragma unroll
        for (int ks = 0; ks < 4; ++ks) { const bf16x8 a1 = *(const LAS bf16x8*)(K1s + keyrow * AK_LD + 16 * ks + 8 * hi); s1 = MFMA32(a1, q1[ks], s1); }
        if (PASS == 0) {
            float mx1 = s1[0];
#pragma unroll
            for (int r = 1; r < 16; ++r) mx1 = fmaxf(mx1, s1[r]);
            const float n1 = fmaxf(m1, mx1); float a1s = 0.f;
#pragma unroll
            for (int r = 0; r < 16; ++r) a1s += __builtin_amdgcn_exp2f(s1[r] - n1);
            l1 = l1 * __builtin_amdgcn_exp2f(m1 - n1) + a1s; m1 = n1;
        } else {
#pragma unroll
            for (int r = 0; r < 16; ++r) pr[r] = __builtin_amdgcn_exp2f(s1[r] - m1) * iL1;
        }
#pragma unroll
        for (int r = 0; r < 16; ++r) s1[r] = 0.f;
#pragma unroll
        for (int ks = 0; ks < 4; ++ks) { const bf16x8 a2 = *(const LAS bf16x8*)(K2s + keyrow * AK_LD + 16 * ks + 8 * hi); s1 = MFMA32(a2, q2[ks], s1); }
        if (PASS == 0) {
            float mx2 = s1[0];
#pragma unroll
            for (int r = 1; r < 16; ++r) mx2 = fmaxf(mx2, s1[r]);
            const float n2 = fmaxf(m2, mx2); float a2s = 0.f;
#pragma unroll
            for (int r = 0; r < 16; ++r) a2s += __builtin_amdgcn_exp2f(s1[r] - n2);
            l2 = l2 * __builtin_amdgcn_exp2f(m2 - n2) + a2s; m2 = n2;
        } else {
#pragma unroll
            for (int r = 0; r < 16; ++r) pr[r] -= __builtin_amdgcn_exp2f(s1[r] - m2) * iL2;
            bf16x8 pb[2];
            { u32x4 t0, t1; t0.x = cvt_pk_bf16(pr[0], pr[1]); t0.y = cvt_pk_bf16(pr[2], pr[3]); t0.z = cvt_pk_bf16(pr[4], pr[5]); t0.w = cvt_pk_bf16(pr[6], pr[7]);
              t1.x = cvt_pk_bf16(pr[8], pr[9]); t1.y = cvt_pk_bf16(pr[10], pr[11]); t1.z = cvt_pk_bf16(pr[12], pr[13]); t1.w = cvt_pk_bf16(pr[14], pr[15]);
              pb[0] = __builtin_bit_cast(bf16x8, t0); pb[1] = __builtin_bit_cast(bf16x8, t1); }
#pragma unroll
            for (int blk = 0; blk < 4; ++blk)
#pragma unroll
                for (int s = 0; s < 2; ++s) {
                    const LAS bf16_t* vp = VTs + (blk * 32 + q) * AV_LD + kq * 32 + 16 * s + 4 * hi;
                    const s16x4 lo = *(const LAS s16x4*)vp, hh = *(const LAS s16x4*)(vp + 8);
                    const bf16x8 av = __builtin_shufflevector(lo, hh, 0, 1, 2, 3, 4, 5, 6, 7);
                    o[blk] = MFMA32(av, pb[s], o[blk]);
                }
        }
    }
}
DI void attn_unit(const Ctx& C, int layer, int uidx) {
    int tid = C.tid; asm volatile("" : "+v"(tid)); const int lane = tid & 63, w = __builtin_amdgcn_readfirstlane(tid >> 6), qg = w & 3, kh = w >> 2, q = lane & 15, g = lane >> 4;
    const bf16_t* Qb = (const bf16_t*)(C.ws + WS_Q); const bf16_t* Kb = (const bf16_t*)(C.ws + WS_K); const bf16_t* VT = (const bf16_t*)(C.ws + WS_V);
    const bf16_t* cK = (const bf16_t*)(C.ws + WS_CK); const bf16_t* cVT = (const bf16_t*)(C.ws + WS_CV);
    int b, h, rowq0; AttnSrc A;
    if (uidx < 512) { b = uidx >> 8; h = (uidx >> 6) & 3; const int qb = uidx & 63; rowq0 = 8192 + b * 4096 + qb * 64; A.nst = 34; A.nlat = 32; A.ldv = 4096;
        A.Klat = Kb + (size_t)(8192 + b * 4096) * 512; A.VTlat = VT + 4194304 + (size_t)((b * 4 + h) * 32) * 16384; A.Kctx = cK + (size_t)((layer * 2 + b) * 256) * 512; A.VTctx = cVT + (size_t)(((layer * 2 + b) * 4 + h) * 2) * 16384; }
    else { const int v = uidx - 512; b = v >> 4; h = (v >> 2) & 3; const int qb = v & 3; rowq0 = b * 256 + qb * 64; A.nst = 2; A.nlat = 2; A.ldv = 256;
        A.Klat = Kb + (size_t)(b * 256) * 512; A.VTlat = VT + (size_t)((b * 4 + h) * 2) * 16384; A.Kctx = A.Klat; A.VTctx = A.VTlat; }
    A.h = h;
    LAS bf16_t* K1s = (LAS bf16_t*)C.lds; LAS bf16_t* K2s = K1s + 128 * AK_LD; LAS bf16_t* VTs = K2s + 128 * AK_LD;
    const float lam = ((const float*)(C.ws + WS_TAB))[2048 + layer];
    bf16x8 qf1[2], qf2[2];
    { const bf16_t* qp = Qb + (size_t)(rowq0 + 16 * qg + q) * 512 + h * 128 + 8 * g;
#pragma unroll
      for (int ks = 0; ks < 2; ++ks) { qf1[ks] = *(const bf16x8*)(qp + 32 * ks); qf2[ks] = *(const bf16x8*)(qp + 64 + 32 * ks); } }
    float m1 = -1e30f, l1 = 0.f, m2 = -1e30f, l2 = 0.f;
    f32x4 O1[8], O2[8];
#pragma unroll
    for (int t = 0; t < 8; ++t) { O1[t] = (f32x4){0.f, 0.f, 0.f, 0.f}; O2[t] = O1[t]; }
    u32x4 kreg[4], vreg[4];
    auto issue = [&](int st) {
        const bf16_t* kb = (st < A.nlat) ? A.Klat + (size_t)st * 128 * 512 : A.Kctx + (size_t)(st - A.nlat) * 128 * 512;
#pragma unroll
        for (int i = 0; i < 2; ++i) { const int id = tid + 512 * i, key = id >> 3, ch = id & 7; kreg[i] = *(const u32x4*)(kb + (size_t)key * 512 + h * 128 + ch * 8); kreg[2 + i] = *(const u32x4*)(kb + (size_t)key * 512 + h * 128 + 64 + ch * 8); }
        const bf16_t* vb = (st < A.nlat) ? A.VTlat + (size_t)st * 16384 : A.VTctx + (size_t)(st - A.nlat) * 16384;
#pragma unroll
        for (int i = 0; i < 4; ++i) { const int id = tid + 512 * i; vreg[i] = *(const u32x4*)(vb + (size_t)id * 8); }
    };
    issue(0);
    for (int st = 0; st < A.nst; ++st) {
        __syncthreads();
#pragma unroll
        for (int i = 0; i < 2; ++i) { const int id = tid + 512 * i, key = id >> 3, ch = id & 7; *(LAS u32x4*)(K1s + key * AK_LD + ch * 8) = kreg[i]; *(LAS u32x4*)(K2s + key * AK_LD + ch * 8) = kreg[2 + i]; }
#pragma unroll
        for (int i = 0; i < 4; ++i) { const int id = tid + 512 * i, dv = id >> 4, ch = id & 15; *(LAS u32x4*)(VTs + dv * AV_LD + ch * 8) = vreg[i]; }
        __syncthreads();
        if (st + 1 < A.nst) issue(st + 1);
#pragma unroll
        for (int kb = 0; kb < 2; ++kb) {
            const int key0 = kh * 64 + kb * 32;
            f32x4 sA0 = {0.f, 0.f, 0.f, 0.f}, sA1 = sA0, sB0 = sA0, sB1 = sA0;
#pragma unroll
            for (int ks = 0; ks < 2; ++ks) {
                const bf16x8 a10 = *(const LAS bf16x8*)(K1s + (key0 + q) * AK_LD + 32 * ks + 8 * g), a11 = *(const LAS bf16x8*)(K1s + (key0 + 16 + q) * AK_LD + 32 * ks + 8 * g);
                const bf16x8 a20 = *(const LAS bf16x8*)(K2s + (key0 + q) * AK_LD + 32 * ks + 8 * g), a21 = *(const LAS bf16x8*)(K2s + (key0 + 16 + q) * AK_LD + 32 * ks + 8 * g);
                sA0 = MFMA16(a10, qf1[ks], sA0); sA1 = MFMA16(a11, qf1[ks], sA1); sB0 = MFMA16(a20, qf2[ks], sB0); sB1 = MFMA16(a21, qf2[ks], sB1);
            }
            float t1 = fmaxf(fmaxf(fmaxf(sA0[0], sA0[1]), fmaxf(sA0[2], sA0[3])), fmaxf(fmaxf(sA1[0], sA1[1]), fmaxf(sA1[2], sA1[3])));
            float t2 = fmaxf(fmaxf(fmaxf(sB0[0], sB0[1]), fmaxf(sB0[2], sB0[3])), fmaxf(fmaxf(sB1[0], sB1[1]), fmaxf(sB1[2], sB1[3])));
            if (__any(t1 > m1 || t2 > m2)) {
                t1 = fmaxf(t1, __shfl_xor(t1, 16)); t1 = fmaxf(t1, __shfl_xor(t1, 32)); t2 = fmaxf(t2, __shfl_xor(t2, 16)); t2 = fmaxf(t2, __shfl_xor(t2, 32));
                const float n1 = fmaxf(m1, t1), n2 = fmaxf(m2, t2); const float f1 = __builtin_amdgcn_exp2f(m1 - n1), f2 = __builtin_amdgcn_exp2f(m2 - n2);
                l1 *= f1; l2 *= f2; m1 = n1; m2 = n2;
#pragma unroll
                for (int t = 0; t < 8; ++t) { O1[t] = O1[t] * f1; O2[t] = O2[t] * f2; }
            }
            f32x4 pA0, pA1, pB0, pB1;
#pragma unroll
            for (int i = 0; i < 4; ++i) { pA0[i] = __builtin_amdgcn_exp2f(sA0[i] - m1); pA1[i] = __builtin_amdgcn_exp2f(sA1[i] - m1); pB0[i] = __builtin_amdgcn_exp2f(sB0[i] - m2); pB1[i] = __builtin_amdgcn_exp2f(sB1[i] - m2); }
            l1 += (pA0[0] + pA0[1]) + (pA0[2] + pA0[3]) + (pA1[0] + pA1[1]) + (pA1[2] + pA1[3]);
            l2 += (pB0[0] + pB0[1]) + (pB0[2] + pB0[3]) + (pB1[0] + pB1[1]) + (pB1[2] + pB1[3]);
            const bf16x8 pb1 = pack8(pA0, pA1), pb2 = pack8(pB0, pB1);
#pragma unroll
            for (int t = 0; t < 8; ++t) {
                const LAS bf16_t* vp = VTs + (16 * t + q) * AV_LD + key0 + 4 * g;
                const s16x4 lo = *(const LAS s16x4*)vp, hh = *(const LAS s16x4*)(vp + 16);
                const bf16x8 av = __builtin_shufflevector(lo, hh, 0, 1, 2, 3, 4, 5, 6, 7);
                O1[t] = MFMA16(av, pb1, O1[t]); O2[t] = MFMA16(av, pb2, O2[t]);
            }
        }
    }
    l1 += __shfl_xor(l1, 16); l1 += __shfl_xor(l1, 32); l2 += __shfl_xor(l2, 16); l2 += __shfl_xor(l2, 32);
    __syncthreads();
    LAS float* comb = (LAS float*)C.lds;
    LAS float* exs = (LAS float*)(C.lds + 65536);
    if (kh == 1) {
#pragma unroll
        for (int t = 0; t < 8; ++t)
#pragma unroll
            for (int i = 0; i < 4; ++i) { comb[(qg * 64 + t * 4 + i) * 64 + lane] = O1[t][i]; comb[(qg * 64 + 32 + t * 4 + i) * 64 + lane] = O2[t][i]; }
        exs[(qg * 4 + 0) * 64 + lane] = m1; exs[(qg * 4 + 1) * 64 + lane] = l1; exs[(qg * 4 + 2) * 64 + lane] = m2; exs[(qg * 4 + 3) * 64 + lane] = l2;
    }
    __syncthreads();
    if (kh == 0) {
        const float om1 = exs[(qg * 4 + 0) * 64 + lane], ol1 = exs[(qg * 4 + 1) * 64 + lane], om2 = exs[(qg * 4 + 2) * 64 + lane], ol2 = exs[(qg * 4 + 3) * 64 + lane];
        const float n1 = fmaxf(m1, om1), n2 = fmaxf(m2, om2);
        const float fa1 = __builtin_amdgcn_exp2f(m1 - n1), fb1 = __builtin_amdgcn_exp2f(om1 - n1), fa2 = __builtin_amdgcn_exp2f(m2 - n2), fb2 = __builtin_amdgcn_exp2f(om2 - n2);
        const float L1 = l1 * fa1 + ol1 * fb1, L2 = l2 * fa2 + ol2 * fb2;
        const float c1a = fa1 / L1, c1b = fb1 / L1, c2a = lam * fa2 / L2, c2b = lam * fb2 / L2;
        float ss = 0.f;
#pragma unroll
        for (int t = 0; t < 8; ++t)
#pragma unroll
            for (int i = 0; i < 4; ++i) { const float v = O1[t][i] * c1a + comb[(qg * 64 + t * 4 + i) * 64 + lane] * c1b - O2[t][i] * c2a - comb[(qg * 64 + 32 + t * 4 + i) * 64 + lane] * c2b; O1[t][i] = v; ss += v * v; }
        ss += __shfl_xor(ss, 16); ss += __shfl_xor(ss, 32);
        const float lam_init = 0.8f - 0.6f * __expf(-0.3f * (float)layer);
        const float sc = (1.0f / sqrtf(ss * (1.0f / 128.0f) + RMS_EPS)) * (1.0f - lam_init);
        const float* dn = C.p->in[18] + layer * 128;
        bf16_t* ob = (bf16_t*)(C.ws + WS_O) + (size_t)(rowq0 + 16 * qg + q) * DM + h * 128;
#pragma unroll
        for (int t = 0; t < 8; ++t) { const int dv = 16 * t + 4 * g; const f32x4 d4 = *(const f32x4*)(dn + dv); *(u32x2*)(ob + dv) = pack4(O1[t] * sc * d4); }
    }
    __syncthreads();
}

DI void delta_prep_unit(const Ctx& C, int layer, int unit) {
    const Params& p = *C.p; int tid = C.tid; asm volatile("" : "+v"(tid)); const int lane = tid & 63, w = __builtin_amdgcn_readfirstlane(tid >> 6);
    const int tc = unit >> 2, h = unit & 3, row0 = tc * 64;
    int ci, nch; if (tc < 128) { ci = tc & 3; nch = 4; } else { ci = (tc - 128) & 63; nch = 64; }
    const bool has_prev = ci > 0, has_next = ci < nch - 1;
    float* qs = C.L; float* kk = C.L + 4160; float* vv = C.L + 8320; float* KK0 = C.L + 12480; float* QK0 = KK0 + 4096; float* Ms = QK0 + 4096; float* bc = Ms + 8192; float* be = bc + 128;
    const bf16_t* zb = (const bf16_t*)(C.ws + WS_ZB);
    const float* cw = p.in[11] + layer * 3 * 768;
    __syncthreads();
    if (tid < 384) {
        const int c = tid % 192, th = tid / 192, which = c >> 6, d = c & 63, col = which * 256 + h * 64 + d;
        const float w0 = cw[col], w1 = cw[768 + col], w2 = cw[1536 + col];
        float xin[34];
#pragma unroll
        for (int i = 0; i < 34; ++i) { const int tt = 32 * th - 1 + i; const bool ok = (tt >= 0 || has_prev) && (tt < 64 || has_next); xin[i] = ok ? bf2f(zb[(size_t)(row0 + tt) * ZLD + col]) : 0.f; }
        float* dstp = (which == 0 ? qs : (which == 1 ? kk : vv)) + d;
#pragma unroll
        for (int i = 0; i < 32; ++i) dstp[(32 * th + i) * 65] = siluf_(w0 * xin[i] + w1 * xin[i + 1] + w2 * xin[i + 2]);
    }
    __syncthreads();
    { const int r = tid >> 2, part = tid & 3; float* base = (r < 64 ? qs + r * 65 : kk + (r - 64) * 65) + part * 16; float ss = 0.f;
#pragma unroll
      for (int i = 0; i < 16; ++i) ss += base[i] * base[i];
      ss += __shfl_xor(ss, 1); ss += __shfl_xor(ss, 2);
      const float sc = (1.0f / sqrtf(ss + 1e-6f)) * (r < 64 ? 0.125f : 1.0f);
#pragma unroll
      for (int i = 0; i < 16; ++i) base[i] *= sc; }
    if (w < 2) {
        const int dir = w, i = lane, tt = dir ? 63 - i : i; const size_t row = (size_t)(row0 + tt);
        const float braw = bf2f(zb[row * ZLD + ZB_BBETA + dir * 4 + h]), araw = bf2f(zb[row * ZLD + ZB_BA + dir * 4 + h]);
        const float A = __expf(p.in[12][layer * 8 + dir * 4 + h]); const float x = araw + p.in[13][layer * 8 + dir * 4 + h];
        const float sp = x > 20.f ? x : log1pf(__expf(x)); float g = -A * sp;
#pragma unroll
        for (int off = 1; off < 64; off <<= 1) { const float t = __shfl_up(g, off); if (lane >= off) g += t; }
        bc[dir * 64 + i] = g; const float bt = sigmoidf_(braw); be[dir * 64 + i] = bt; be[128 + dir * 64 + i] = bt * __expf(g);
    }
    __syncthreads();
    {
        const int rbm = w & 3, cb0 = (w >> 2) * 2, r16 = lane & 15, g4 = lane >> 4;
        bf16x8 kA[2], qA[2], kB[2][2];
#pragma unroll
        for (int ks = 0; ks < 2; ++ks) {
            const float* kp = kk + (16 * rbm + r16) * 65 + 32 * ks + 8 * g4; const float* qp = qs + (16 * rbm + r16) * 65 + 32 * ks + 8 * g4;
            kA[ks] = pack8((f32x4){kp[0], kp[1], kp[2], kp[3]}, (f32x4){kp[4], kp[5], kp[6], kp[7]});
            qA[ks] = pack8((f32x4){qp[0], qp[1], qp[2], qp[3]}, (f32x4){qp[4], qp[5], qp[6], qp[7]});
#pragma unroll
            for (int c = 0; c < 2; ++c) { const float* bp = kk + (16 * (cb0 + c) + r16) * 65 + 32 * ks + 8 * g4;
                kB[c][ks] = pack8((f32x4){bp[0], bp[1], bp[2], bp[3]}, (f32x4){bp[4], bp[5], bp[6], bp[7]}); }
        }
#pragma unroll
        for (int c = 0; c < 2; ++c) {
            f32x4 ak = {0.f, 0.f, 0.f, 0.f}, aq = ak;
#pragma unroll
            for (int ks = 0; ks < 2; ++ks) { ak = MFMA16(kA[ks], kB[c][ks], ak); aq = MFMA16(qA[ks], kB[c][ks], aq); }
#pragma unroll
            for (int i = 0; i < 4; ++i) { const int o = (16 * rbm + 4 * g4 + i) * 64 + 16 * (cb0 + c) + r16; KK0[o] = ak[i]; QK0[o] = aq[i]; }
        }
    }
    __syncthreads();
    bf16_t* dpW = (bf16_t*)(C.ws + WS_DPW); bf16_t* dpQD = (bf16_t*)(C.ws + WS_DPQD); bf16_t* dpQK = (bf16_t*)(C.ws + WS_DPQK); bf16_t* dpKD = (bf16_t*)(C.ws + WS_DPKD); bf16_t* dpU = (bf16_t*)(C.ws + WS_DPU);
    float* dpGL = (float*)(C.ws + WS_GL);
    { const int i = tid >> 3, j0 = (tid & 7) * 8;
#pragma unroll
      for (int dir = 0; dir < 2; ++dir) {
          const size_t ud = ((size_t)tc * 4 + h) * 2 + dir;
          const float bi = bc[dir * 64 + i], betai = be[dir * 64 + i]; const int ai = dir ? 63 - i : i;
#pragma unroll
          for (int jj = 0; jj < 8; ++jj) { const int j = j0 + jj, aj = dir ? 63 - j : j;
              const float dec = (j <= i) ? __expf(bi - bc[dir * 64 + j]) : 0.f;
              Ms[dir * 4096 + j * 64 + i] = (j < i) ? betai * KK0[ai * 64 + aj] * dec : 0.f;
              dpQK[ud * 4096 + i * 64 + pinv(j)] = f2bf(QK0[ai * 64 + aj] * dec); }
      } }
    __syncthreads();
    if (w < 4) {
        const int dir = w >> 1, c = (w & 1) * 64 + lane; const size_t ud = ((size_t)tc * 4 + h) * 2 + dir;
        const float* Msd = Ms + dir * 4096; const bool isU = (w & 1) == 0; const float* scp = be + (isU ? 0 : 128) + dir * 64; const float* srcp = (isU ? vv : kk) + lane;
        float x[64];
#pragma unroll
        for (int rb = 0; rb < 4; ++rb) {
            float r[16];
#pragma unroll
            for (int ii = 0; ii < 16; ++ii) { const int i = 16 * rb + ii, tt = dir ? 63 - i : i; r[ii] = scp[i] * srcp[tt * 65]; }
            asm volatile("" ::: "memory");
#pragma unroll
            for (int j = 0; j < 16 * rb; ++j) {
                const float* mp = Msd + j * 64 + 16 * rb;
                const f32x4 ma = *(const f32x4*)mp, mb = *(const f32x4*)(mp + 4), mc = *(const f32x4*)(mp + 8), md = *(const f32x4*)(mp + 12);
                const float xj = x[j];
#pragma unroll
                for (int c4 = 0; c4 < 4; ++c4) { r[c4] -= ma[c4] * xj; r[4 + c4] -= mb[c4] * xj; r[8 + c4] -= mc[c4] * xj; r[12 + c4] -= md[c4] * xj; }
                if ((j & 3) == 3) asm volatile("" ::: "memory");
            }
#pragma unroll
            for (int jj = 0; jj < 16; ++jj) {
                const float xj = r[jj]; x[16 * rb + jj] = xj;
                const float* mp = Msd + (16 * rb + jj) * 64 + 16 * rb;
#pragma unroll
                for (int ii = jj + 1; ii < 16; ++ii) r[ii] -= mp[ii] * xj;
                if ((jj & 3) == 3) asm volatile("" ::: "memory");
            }
        }
        if (c < 64) {
            bf16_t* up = dpU + ud * 4096 + c * 64;
#pragma unroll
            for (int i = 0; i < 64; i += 8) { u32x4 o; o.x = cvt_pk_bf16(x[i], x[i + 1]); o.y = cvt_pk_bf16(x[i + 2], x[i + 3]); o.z = cvt_pk_bf16(x[i + 4], x[i + 5]); o.w = cvt_pk_bf16(x[i + 6], x[i + 7]); *(u32x4*)(up + i) = o; }
        } else {
            bf16_t* wp = dpW + ud * 4096 + pinv(c - 64);
#pragma unroll
            for (int i = 0; i < 64; ++i) wp[i * 64] = f2bf(x[i]);
        }
    } else {
#pragma unroll 4
        for (int it = 0; it < 64; ++it) {
            const int e = (tid - 256) + 256 * it, dir = e >> 13, which = (e >> 12) & 1, rem = e & 4095; const size_t ud = ((size_t)tc * 4 + h) * 2 + dir;
            if (which == 0) { const int i = rem >> 6, d = rem & 63, tt = dir ? 63 - i : i; dpQD[ud * 4096 + i * 64 + pinv(d)] = f2bf(qs[tt * 65 + d] * __expf(bc[dir * 64 + i])); }
            else { const int dk = rem >> 6, i = rem & 63, tt = dir ? 63 - i : i; dpKD[ud * 4096 + dk * 64 + pinv(i)] = f2bf(kk[tt * 65 + dk] * __expf(bc[dir * 64 + 63] - bc[dir * 64 + i])); }
        }
        if (tid == 256 || tid == 257) { const int dir = tid - 256; dpGL[((size_t)tc * 4 + h) * 2 + dir] = __expf(bc[dir * 64 + 63]); }
    }
}

DI void delta_scan_unit(const Ctx& C, int layer, bool sample, int b, int h) {
    const Params& p = *C.p; int tid = C.tid; asm volatile("" : "+v"(tid)); const int lane = tid & 63; const int w = C.wave, dir = w >> 2, sl = w & 3, col = lane & 15, g = lane >> 4;
    const int tc0 = sample ? 128 + b * 64 : b * 4, nch = sample ? 64 : 4;
    const bf16_t* dpU = (const bf16_t*)(C.ws + WS_DPU);
    const float* dpGL = (const float*)(C.ws + WS_GL); float* od = (float*)(C.ws + WS_OD) + (size_t)dir * MROWS * 256;
    f32x4 S[4];
    if (sample) { const float* s0 = p.in[4] + ((((size_t)b * 4 + layer) * 2 + dir) * 4 + h) * 4096;
#pragma unroll
        for (int rb = 0; rb < 4; ++rb)
#pragma unroll
            for (int ii = 0; ii < 4; ++ii) S[rb][ii] = s0[(16 * rb + 4 * g + ii) * 64 + 16 * sl + col]; }
    else {
#pragma unroll
        for (int rb = 0; rb < 4; ++rb) S[rb] = (f32x4){0.f, 0.f, 0.f, 0.f}; }
    u32x4 Ra[8], Rb[8];
#define DS_TC(d_, n_) ((d_) ? tc0 + nch - 1 - (n_) : tc0 + (n_))
#define DS_ISSUE(R, n_) do { _Pragma("unroll") for (int i = 0; i < 8; ++i) { const int id = tid + 512 * i, dm = id >> 9, dd = dm >> 2, mat = dm & 3; \
        const size_t ud_ = ((size_t)DS_TC(dd, n_) * 4 + h) * 2 + dd; R[i] = *(const u32x4*)(C.ws + WS_DPW + (size_t)mat * (16u * MiB) + ud_ * 8192 + (size_t)(id & 511) * 16); } } while (0)
#define DS_WRITE(R, buf_) do { _Pragma("unroll") for (int i = 0; i < 8; ++i) { const int id = tid + 512 * i, dm = id >> 9, row = (id >> 3) & 63, c = id & 7; \
        *(LAS u32x4*)(C.lds + (buf_) * 65536 + dm * 8192 + row * 128 + ((c ^ (row & 7)) * 16)) = R[i]; } } while (0)
#define DS_FRAG(buf_, mat_, rb_, ks_) (*(const LAS bf16x8*)(C.lds + (buf_) * 65536 + (dir * 4 + (mat_)) * 8192 + (16 * (rb_) + col) * 128 + ((((ks_) * 4 + g) ^ (col & 7)) * 16)))
    __syncthreads();
    DS_ISSUE(Ra, 0); DS_WRITE(Ra, 0); DS_ISSUE(Ra, 1);
    s16x4 uuA[4], uuB[4]; float glA, glB;
#define DS_LOADU(uu, gl, n_) do { const size_t ud_ = ((size_t)DS_TC(dir, n_) * 4 + h) * 2 + dir; _Pragma("unroll") for (int rb = 0; rb < 4; ++rb) uu[rb] = *(const s16x4*)(dpU + ud_ * 4096 + (16 * sl + col) * 64 + 16 * rb + 4 * g); gl = dpGL[ud_]; } while (0)
    DS_LOADU(uuA, glA, 0); DS_LOADU(uuB, glB, 1);
    __syncthreads();
#define DS_STEP(n, buf, Rnext, Rcur, uu, gl) do { \
        if ((n) + 2 < nch) DS_ISSUE(Rnext, (n) + 2); \
        const int tc = DS_TC(dir, (n)); \
        bf16x8 Sb[2]; Sb[0] = pack8(S[0], S[1]); Sb[1] = pack8(S[2], S[3]); \
        f32x4 vn[4]; \
        _Pragma("unroll") for (int rb = 0; rb < 4; ++rb) { f32x4 t = (f32x4){0.f, 0.f, 0.f, 0.f}; t = MFMA16(DS_FRAG(buf, 0, rb, 0), Sb[0], t); t = MFMA16(DS_FRAG(buf, 0, rb, 1), Sb[1], t); \
            _Pragma("unroll") for (int ii = 0; ii < 4; ++ii) vn[rb][ii] = bf2f((bf16_t)uu[rb][ii]) - t[ii]; } \
        const float glc = gl; \
        if ((n) + 2 < nch) DS_LOADU(uu, gl, (n) + 2); \
        bf16x8 vb[2]; vb[0] = pack8(vn[0], vn[1]); vb[1] = pack8(vn[2], vn[3]); \
        const int rowb = tc * 64; \
        _Pragma("unroll") for (int rb = 0; rb < 4; ++rb) { f32x4 o = (f32x4){0.f, 0.f, 0.f, 0.f}; o = MFMA16(DS_FRAG(buf, 1, rb, 0), Sb[0], o); o = MFMA16(DS_FRAG(buf, 1, rb, 1), Sb[1], o); o = MFMA16(DS_FRAG(buf, 2, rb, 0), vb[0], o); o = MFMA16(DS_FRAG(buf, 2, rb, 1), vb[1], o); \
            _Pragma("unroll") for (int ii = 0; ii < 4; ++ii) { const int i = 16 * rb + 4 * g + ii; const int tt = dir ? 63 - i : i; od[(size_t)(rowb + tt) * 256 + h * 64 + 16 * sl + col] = o[ii]; } } \
        _Pragma("unroll") for (int rb = 0; rb < 4; ++rb) { f32x4 sn = S[rb] * glc; sn = MFMA16(DS_FRAG(buf, 3, rb, 0), vb[0], sn); sn = MFMA16(DS_FRAG(buf, 3, rb, 1), vb[1], sn); S[rb] = sn; } \
        if ((n) + 1 < nch) DS_WRITE(Rcur, (buf) ^ 1); \
        __syncthreads(); } while (0)
    for (int n = 0; n < nch; n += 2) {
        DS_STEP(n, 0, Rb, Ra, uuA, glA);
        DS_STEP(n + 1, 1, Ra, Rb, uuB, glB);
    }
#undef DS_STEP
#undef DS_TC
#undef DS_ISSUE
#undef DS_WRITE
#undef DS_FRAG
#undef DS_LOADU
    if (!sample) { float* so = C.out + OUT_SD + ((((size_t)b * 4 + layer) * 2 + dir) * 4 + h) * 4096;
#pragma unroll
        for (int rb = 0; rb < 4; ++rb)
#pragma unroll
            for (int ii = 0; ii < 4; ++ii) so[(16 * rb + 4 * g + ii) * 64 + 16 * sl + col] = S[rb][ii]; }
}

DI float hgrn_forget(const bf16_t* zb, size_t row, int dir, int h, int d, float lb) { const float x = bf2f(zb[row * ZLD + ZB_CF + dir * 256 + h * 64 + d]); return lb + (1.0f - lb) * sigmoidf_(x); }
DI void hgrn_local_unit(const Ctx& C, int layer, int unit) {
    int lane = C.lane; asm volatile("" : "+v"(lane)); const int dir = unit & 1, h = (unit >> 1) & 3, tc = unit >> 3, row0 = tc * 64, ep = lane & 31, dh = lane >> 5;
    const bf16_t* zb = (const bf16_t*)(C.ws + WS_ZB);
    float* fs = C.L + C.wave * 2048; float* qs2 = fs + 1024;
    bf16_t* oloc = (bf16_t*)(C.ws + WS_XM + 16 * MiB) + (size_t)dir * MROWS * 256;
    bf16_t* qdb = (bf16_t*)((unsigned char*)C.out + 32 * MiB) + (size_t)dir * MROWS * 256;
    const float lb = ((const float*)(C.ws + WS_TAB))[4096 + (dir * 4 + layer) * 256 + h * 64 + lane];
    f32x2 S[32];
#pragma unroll
    for (int k = 0; k < 32; ++k) S[k] = (f32x2){0.f, 0.f};
    float Dl = 1.0f;
    bf16_t rf[16], rq[16]; unsigned rv[16];
#define HL_LOAD(sb_) do { _Pragma("unroll") for (int i = 0; i < 16; ++i) { const int ti = (sb_) * 16 + i, tt = dir ? 63 - ti : ti; const size_t row = (size_t)(row0 + tt); \
        rf[i] = zb[row * ZLD + ZB_CF + dir * 256 + h * 64 + lane]; rq[i] = zb[row * ZLD + ZB_CQ + h * 64 + lane]; rv[i] = *(const unsigned*)(zb + row * ZLD + ZB_CI + h * 64 + 2 * ep); } } while (0)
    HL_LOAD(0);
    for (int sb = 0; sb < 4; ++sb) {
        f32x2 vr[16];
#pragma unroll
        for (int i = 0; i < 16; ++i) { const int ti = sb * 16 + i, tt = dir ? 63 - ti : ti; const size_t row = (size_t)(row0 + tt);
            const float f = lb + (1.0f - lb) * sigmoidf_(bf2f(rf[i])); const float qv = siluf_(bf2f(rq[i]));
            fs[i * 64 + lane] = f; qs2[i * 64 + lane] = qv; Dl *= f; qdb[row * 256 + h * 64 + lane] = f2bf(qv * Dl);
            vr[i] = (f32x2){__uint_as_float(rv[i] << 16), __uint_as_float(rv[i] & 0xffff0000u)}; }
        if (sb + 1 < 4) HL_LOAD(sb + 1);
        __builtin_amdgcn_wave_barrier();
#pragma unroll
        for (int i = 0; i < 16; ++i) { const f32x2 v = vr[i]; f32x2 osa = {0.f, 0.f}, osb = {0.f, 0.f};
#pragma unroll
            for (int k = 0; k < 32; k += 4) { const f32x4 f4 = *(const f32x4*)(fs + i * 64 + 32 * dh + k), q4 = *(const f32x4*)(qs2 + i * 64 + 32 * dh + k);
#pragma unroll
                for (int c = 0; c < 4; ++c) { S[k + c] = (S[k + c] - v) * f4[c] + v; if (c & 1) osb += S[k + c] * q4[c]; else osa += S[k + c] * q4[c]; }
                if ((k & 15) == 12) asm volatile("" ::: "memory"); }
            f32x2 os = osa + osb;
            os.x += __shfl_xor(os.x, 32); os.y += __shfl_xor(os.y, 32);
            const int ti = sb * 16 + i, tt = dir ? 63 - ti : ti;
            if (dh == 0) *(unsigned*)(oloc + (size_t)(row0 + tt) * 256 + h * 64 + 2 * ep) = cvt_pk_bf16(os.x, os.y);
            asm volatile("" ::: "memory"); }
        __builtin_amdgcn_wave_barrier();
    }
#undef HL_LOAD
    float* hs = (float*)(C.ws + WS_HS) + (size_t)unit * 4096;
#pragma unroll
    for (int k = 0; k < 32; ++k) *(f32x2*)(hs + (32 * dh + k) * 64 + 2 * ep) = S[k];
    ((float*)(C.ws + WS_HD))[(size_t)unit * 64 + lane] = Dl;
}
DI void hgrn_scan_unit(const Ctx& C, int layer, bool sample, int b, int h, int dir) {
    const Params& p = *C.p; int tid = C.tid; asm volatile("" : "+v"(tid)); const int tc0 = sample ? 128 + b * 64 : b * 4, nch = sample ? 64 : 4;
    float* HS = (float*)(C.ws + WS_HS); const float* HD = (const float*)(C.ws + WS_HD);
    f32x4 S0, S1;
    if (sample) { const float* s0 = p.in[5] + ((((size_t)b * 4 + layer) * 2 + dir) * 4 + h) * 4096 + tid * 8; S0 = *(const f32x4*)s0; S1 = *(const f32x4*)(s0 + 4); }
    else { float z_ = 0.f; asm volatile("" : "+v"(z_)); S0 = (f32x4){z_, z_, z_, z_}; S1 = S0; }
    for (int n0 = 0; n0 < nch; n0 += 4) {
        f32x4 la[4], lb[4]; float Dd[4];
#pragma unroll
        for (int k = 0; k < 4; ++k) { const int tc = dir ? tc0 + nch - 1 - (n0 + k) : tc0 + n0 + k; const size_t uh = ((size_t)tc * 4 + h) * 2 + dir;
            const float* hp = HS + uh * 4096 + tid * 8; la[k] = *(const f32x4*)hp; lb[k] = *(const f32x4*)(hp + 4); Dd[k] = HD[uh * 64 + (tid >> 3)]; }
#pragma unroll
        for (int k = 0; k < 4; ++k) { const int tc = dir ? tc0 + nch - 1 - (n0 + k) : tc0 + n0 + k; const size_t uh = ((size_t)tc * 4 + h) * 2 + dir;
            float* hp = HS + uh * 4096 + tid * 8; *(f32x4*)hp = S0; *(f32x4*)(hp + 4) = S1; S0 = S0 * Dd[k] + la[k]; S1 = S1 * Dd[k] + lb[k]; }
    }
    if (!sample) { float* so = C.out + OUT_SH + ((((size_t)b * 4 + layer) * 2 + dir) * 4 + h) * 4096 + tid * 8; *(f32x4*)so = S0; *(f32x4*)(so + 4) = S1; }
}
DI void hgrn_final_unit(const Ctx& C, int layer, int tc) {
    const Params& p = *C.p; int lane = C.lane; asm volatile("" : "+v"(lane)); const int w = C.wave, h = w >> 1, chh = w & 1, r16 = lane & 15, g4 = lane >> 4, row0 = tc * 64;
    const bf16_t* zb = (const bf16_t*)(C.ws + WS_ZB); const float* HS = (const float*)(C.ws + WS_HS);
    const bf16_t* oloc = (const bf16_t*)(C.ws + WS_XM + 16 * MiB); const bf16_t* qdb = (const bf16_t*)((const unsigned char*)C.out + 32 * MiB);
    float* otile = C.L;
    __syncthreads();
    f32x4 acc[4][2];
#pragma unroll
    for (int rb = 0; rb < 4; ++rb) { acc[rb][0] = (f32x4){0.f, 0.f, 0.f, 0.f}; acc[rb][1] = acc[rb][0]; }
#pragma unroll
    for (int dir = 0; dir < 2; ++dir) {
        const size_t uh = ((size_t)tc * 4 + h) * 2 + dir;
        bf16x8 Bf[2][2];
#pragma unroll
        for (int cb = 0; cb < 2; ++cb)
#pragma unroll
            for (int ks = 0; ks < 2; ++ks) { const float* sp = HS + uh * 4096 + (size_t)(32 * ks + 8 * g4) * 64 + 32 * chh + 16 * cb + r16;
                Bf[cb][ks] = pack8((f32x4){sp[0], sp[64], sp[128], sp[192]}, (f32x4){sp[256], sp[320], sp[384], sp[448]}); }
#pragma unroll
        for (int rb = 0; rb < 4; ++rb)
#pragma unroll
            for (int ks = 0; ks < 2; ++ks) { const bf16x8 Af = *(const bf16x8*)(qdb + (size_t)dir * MROWS * 256 + (size_t)(row0 + 16 * rb + r16) * 256 + h * 64 + 32 * ks + 8 * g4);
                acc[rb][0] = MFMA16(Af, Bf[0][ks], acc[rb][0]); acc[rb][1] = MFMA16(Af, Bf[1][ks], acc[rb][1]); }
    }
#pragma unroll
    for (int rb = 0; rb < 4; ++rb)
#pragma unroll
        for (int cb = 0; cb < 2; ++cb)
#pragma unroll
            for (int i = 0; i < 4; ++i) { const int t = 16 * rb + 4 * g4 + i, e = 32 * chh + 16 * cb + r16; const size_t ix = (size_t)(row0 + t) * 256 + h * 64 + e;
                otile[(h * 64 + t) * 64 + e] = acc[rb][cb][i] + bf2f(oloc[ix]) + bf2f(oloc[(size_t)MROWS * 256 + ix]); }
    __syncthreads();
    bf16_t* ob = (bf16_t*)(C.ws + WS_O);
    const float ng = p.in[16][layer * 64 + lane];
    bf16_t gts[32];
#pragma unroll
    for (int rr = 0; rr < 32; ++rr) { const int idx = w * 32 + rr, hh = idx >> 6, tt = idx & 63; gts[rr] = zb[(size_t)(row0 + tt) * ZLD + ZB_CG + hh * 64 + lane]; }
#pragma unroll
    for (int rr = 0; rr < 32; ++rr) { const int idx = w * 32 + rr, hh = idx >> 6, tt = idx & 63; const size_t row = (size_t)(row0 + tt);
        const float v = otile[(hh * 64 + tt) * 64 + lane]; const float ss = wave_sum(v * v);
        const float gt = siluf_(bf2f(gts[rr]));
        ob[row * DM + 768 + hh * 64 + lane] = f2bf(v * (1.0f / sqrtf(ss * (1.0f / 64.0f) + RMS_EPS)) * ng * gt); }
}
DI void delta_combine(const Ctx& C, int layer) {
    const Params& p = *C.p; const bf16_t* zb = (const bf16_t*)(C.ws + WS_ZB); const float* od = (const float*)(C.ws + WS_OD); bf16_t* ob = (bf16_t*)(C.ws + WS_O);
    const float ng = p.in[14][layer * 64 + C.lane];
    for (int it0 = C.gw * 8; it0 < MROWS * 4; it0 += C.NGW * 8) {
        float v[8]; bf16_t gr[8];
#pragma unroll
        for (int k = 0; k < 8; ++k) { const int it = it0 + k, h = it & 3; const size_t row = (size_t)(it >> 2);
            v[k] = od[row * 256 + h * 64 + C.lane] + od[(size_t)MROWS * 256 + row * 256 + h * 64 + C.lane]; gr[k] = zb[row * ZLD + ZB_BG + h * 64 + C.lane]; }
#pragma unroll
        for (int k = 0; k < 8; ++k) { const int it = it0 + k, h = it & 3; const size_t row = (size_t)(it >> 2);
            const float ss = wave_sum(v[k] * v[k]); const float gt = siluf_(bf2f(gr[k]));
            ob[row * DM + 512 + h * 64 + C.lane] = f2bf(v[k] * (1.0f / sqrtf(ss * (1.0f / 64.0f) + RMS_EPS)) * ng * gt); }
    }
}

#define XB_TMO      128
#define XB_XCNT(j)  (256  + 64 * (j))
#define XB_XSUB(j)  (1280 + 64 * (j))
#define XB_XGEN(j)  (2304 + 64 * (j))
#define XB_TOP      3328
#define XB_TOPGEN   3392
#define XB_SPIN_CAP (1u << 22)
DI unsigned xb_ld(unsigned* p)              { return __hip_atomic_load(p, __ATOMIC_RELAXED, __HIP_MEMORY_SCOPE_AGENT); }
DI unsigned xb_add(unsigned* p, unsigned v) { return __hip_atomic_fetch_add(p, v, __ATOMIC_RELAXED, __HIP_MEMORY_SCOPE_AGENT); }
DI unsigned xb_xcc_id() { return (unsigned)__builtin_amdgcn_s_getreg((3 << 11) | 20) & 0xFu; }
#define XB_SPIN(cond, bar) do { unsigned _sp = 0; while (cond) { __builtin_amdgcn_s_sleep(1); \
    if ((++_sp & 255u) == 0u) { if (xb_ld(&(bar)[XB_TMO])) break; if (_sp > XB_SPIN_CAP) { atomicAdd(&(bar)[XB_TMO], 1u); break; } } } } while (0)
struct XcdBarrier { unsigned* bar; unsigned x; volatile LAS unsigned* st; };
DI void xcd_barrier_complete(unsigned* bar, unsigned x, unsigned& nloc, unsigned& nx) {
    const unsigned G = gridDim.x * gridDim.y * gridDim.z;
    unsigned sum, cnt, mine, sp = 0u;
    for (;;) {
        sum = 0u; cnt = 0u; mine = 0u;
#pragma unroll
        for (unsigned j = 0; j < 16; ++j) { const unsigned c = xb_ld(&bar[XB_XCNT(j)]); sum += c; cnt += (c > 0u) ? 1u : 0u; mine = (j == x) ? c : mine; }
        if (sum == G) break;
        __builtin_amdgcn_s_sleep(1);
        if ((++sp & 255u) == 0u) { if (xb_ld(&bar[XB_TMO])) break; if (sp > XB_SPIN_CAP) { atomicAdd(&bar[XB_TMO], 1u); break; } }
    }
    nloc = mine > 0u ? mine : 1u; nx = cnt > 0u ? cnt : 1u;
}
DI void xcd_barrier(const XcdBarrier& b) {
    asm volatile("s_waitcnt vmcnt(0)" ::: "memory");
    __syncthreads();
    if (threadIdx.x == 0) {
        unsigned* bar = b.bar;
        __builtin_amdgcn_s_waitcnt(0);
        unsigned nloc = b.st[0], nx = b.st[1];
        if (nloc == 0u) { xcd_barrier_complete(bar, b.x, nloc, nx); b.st[0] = nloc; b.st[1] = nx; }
        const unsigned old = xb_add(&bar[XB_XSUB(b.x)], 1u);
        const unsigned gen = old / nloc;
        if (old + 1u == (gen + 1u) * nloc) {
            __builtin_amdgcn_fence(__ATOMIC_RELEASE, "agent");
            asm volatile("s_waitcnt vmcnt(0)" ::: "memory");
            const unsigned og = xb_add(&bar[XB_TOP], 1u);
            const unsigned tg = og / nx;
            if (og + 1u == (tg + 1u) * nx) xb_add(&bar[XB_TOPGEN], 1u);
            else XB_SPIN(xb_ld(&bar[XB_TOPGEN]) == tg, bar);
            __builtin_amdgcn_fence(__ATOMIC_ACQUIRE, "agent");
            xb_add(&bar[XB_XGEN(b.x)], 1u);
            asm volatile("s_waitcnt vmcnt(0)" ::: "memory");
        } else {
            XB_SPIN(xb_ld(&bar[XB_XGEN(b.x)]) == gen, bar);
            __builtin_amdgcn_fence(__ATOMIC_ACQUIRE, "agent");
            asm volatile("s_waitcnt vmcnt(0)" ::: "memory");
        }
    }
    __syncthreads();
}

DI void probe_stamp(unsigned char* ws, int cls) {
    if (PROBE_A >= 0 && blockIdx.x == 0 && threadIdx.x == 0) {
        volatile float* tsf = (volatile float*)(ws + WS_TAB + 131072); volatile unsigned long long* tsl = (volatile unsigned long long*)(ws + WS_TAB + 131072 + 256);
        const unsigned long long now = __builtin_amdgcn_s_memrealtime(); tsf[cls] += (float)(now - tsl[0]); tsl[0] = now; }
}
template <unsigned PHM_>
__global__ void __launch_bounds__(512) fwd_megakernel(Params p) {
    extern __shared__ __attribute__((aligned(16))) unsigned char lds_raw[];
    XcdBarrier xbar; xbar.bar = (unsigned*)(p.ws + WS_CTL) + 1024; xbar.x = xb_xcc_id(); xbar.st = (volatile LAS unsigned*)((LAS unsigned char*)lds_raw + 147400);
    if (threadIdx.x == 0) { xbar.st[0] = 0u; xbar.st[1] = 0u; (void)xb_add(&xbar.bar[XB_XCNT(xbar.x)], 1u); }
    __syncthreads();
    for (int ph = p.ph_lo; ph < p.ph_hi; ++ph) {
        if (PROBE_A >= 0 && blockIdx.x == 0 && threadIdx.x == 0) {
            volatile float* tsf = (volatile float*)(p.ws + WS_TAB + 131072); volatile unsigned long long* tsl = (volatile unsigned long long*)(p.ws + WS_TAB + 131072 + 256);
            const unsigned long long now = __builtin_amdgcn_s_memrealtime();
            if (ph == 0) { for (int i = 0; i < 16; ++i) tsf[i] = 0.f; tsl[1] = now; }
            else { const int pp = ph - 1; const int cls = pp < 2 ? 8 : (((pp - 2) % 9) == 8 ? 5 : ((pp - 2) % 9)); const float dt = (float)(now - tsl[0]); tsf[cls] += dt; }
            tsl[0] = now;
            if (ph == NPHASE - 2 && PROBE_A < 20) { const float tot = (float)(now - tsl[1]); tsf[12] = rintf(tsf[(PROBE_A >= 0 && PROBE_A < 16) ? PROBE_A : 0] / tot * 40.f) / 40.f; tsf[13] = rintf(tsf[PROBE_B >= 0 ? PROBE_B : 0] / tot * 40.f) / 40.f; }
        }
        if (PROBE_A >= 0 && ph == 0 && threadIdx.x == 0) { volatile float* tsb = (volatile float*)(p.ws + WS_TAB + 196608) + blockIdx.x * 8; for (int i = 0; i < 8; ++i) tsb[i] = 0.f; }
        if (PROBE_A >= 20 && ph == NPHASE - 2 && blockIdx.x == 0 && threadIdx.x == 0) {
            volatile float* tsf = (volatile float*)(p.ws + WS_TAB + 131072); volatile unsigned long long* tsl = (volatile unsigned long long*)(p.ws + WS_TAB + 131072 + 256);
            const float* tsb = (const float*)(p.ws + WS_TAB + 196608); float sum = 0.f; for (int b2 = 0; b2 < (int)gridDim.x; ++b2) sum += __hip_atomic_load(tsb + b2 * 8 + (PROBE_A - 20), __ATOMIC_RELAXED, __HIP_MEMORY_SCOPE_AGENT); sum *= (PROBE_A == 20 ? 32.f : (PROBE_A == 21 ? 16.f : 1.f));
            const float tot = (float)(__builtin_amdgcn_s_memrealtime() - tsl[1]); tsf[12] = rintf(sum / (float)gridDim.x / tot * 40.f) / 40.f; tsf[13] = 0.f; }
        int tid_ = threadIdx.x; asm volatile("" : "+v"(tid_));
        unsigned char* ws_ = p.ws; asm volatile("" : "+s"(ws_));
        float* out_ = p.out; asm volatile("" : "+s"(out_));
        Ctx C; C.p = &p; C.lds = (LAS unsigned char*)lds_raw; C.L = (float*)lds_raw; C.tid = tid_; C.lane = C.tid & 63; C.wave = __builtin_amdgcn_readfirstlane(C.tid >> 6);
        C.G = gridDim.x; C.gw = blockIdx.x * 8 + C.wave; C.NGW = C.G * 8; C.ws = ws_; C.out = out_;
        unsigned* ctl = (unsigned*)(ws_ + WS_CTL);
        const float* modbuf = (const float*)(ws_ + WS_MOD);
        bf16_t* xm = (bf16_t*)(ws_ + WS_XM); bf16_t* ob = (bf16_t*)(ws_ + WS_O); bf16_t* act = (bf16_t*)(ws_ + WS_ACT);
        if (ph == 0) { if (PHON(0)) phase0a(C); }
        else if (ph == 1) { if (PHON(1)) row_pass(C, 0, nullptr, nullptr, modbuf, 1024, 0, true); }
        else {
            const int layer = (ph - 2) / 9, sub = (ph - 2) % 9;
            unsigned char* wb = ws_ + WS_W + (size_t)(layer & 1) * WBUF;
            const float* modl = modbuf + (size_t)layer * 3 * 6144;
            if (sub == 0) { if (PHON(2)) {
                pg8::Gemm g{xm, (const bf16_t*)(wb + W_IN), MROWS, 4096, DM}; pg8::StaticOrder S; S.init(MROWS, 4096, C.G, (int)blockIdx.x);
                EpiIn E{(bf16_t*)(ws_ + WS_Q), (bf16_t*)(ws_ + WS_K), (bf16_t*)(ws_ + WS_V), (bf16_t*)(ws_ + WS_ZB), out_ + OUT_K, out_ + OUT_V, (const f32x2*)(ws_ + WS_TAB), layer};
                pg8::gemm_phase(C.lds, g, S, E, C.tid); }
            } else if (sub == 1) {
                __syncthreads();
                if (PHON(4)) for (int u = blockIdx.x; u < 1024; u += C.G) delta_prep_unit(C, layer, u);
                __syncthreads();
                if (PHON(5)) for (int u = C.gw; u < 2048; u += C.NGW) hgrn_local_unit(C, layer, u);
                __syncthreads();
            } else if (sub == 2) {
                LAS int* slot = (LAS int*)(C.lds + 147392);
                for (;;) {
                    __syncthreads();
                    if (C.tid == 0) *slot = (int)atomicAdd(ctl + 64 * (layer + 1), 1u);
                    __syncthreads();
                    const int u = *slot;
                    if (u >= 1432 + 256 + 64) break;
                    if (u >= 1432 + 256) { if (layer + 1 < DEPTH) { mod_unit(C, (layer + 1) * 64 + (u - 1432 - 256)); } continue; }
                    if (u >= 1432) { if (layer + 1 < DEPTH) convert_layer_weights(C, layer + 1, (u - 1432) * 8 + C.wave, 2048, u - 1432, 256); continue; }
                    unsigned long long pt0_ = 0; if (PROBE_A >= 0 && C.tid == 0) pt0_ = __builtin_amdgcn_s_memrealtime();
                    if (u < 8) { if (PHON(6)) delta_scan_unit(C, layer, true, u >> 2, u & 3); }
                    else if (u < 24) { const int v = u - 8; if (PHON(7)) hgrn_scan_unit(C, layer, true, v >> 3, (v >> 1) & 3, v & 1); }
                    else if (u < 536) { if (PHON(8)) attn_unit(C, layer, u - 24); }
                    else if (u < 664) { const int v = u - 536; if (PHON(6)) delta_scan_unit(C, layer, false, v >> 2, v & 3); }
                    else if (u < 1176) { if (PHON(8)) attn_unit(C, layer, 512 + (u - 664)); }
                    else { const int v = u - 1176; if (PHON(7)) hgrn_scan_unit(C, layer, false, v >> 3, (v >> 1) & 3, v & 1); }
                    if (PROBE_A >= 0) { __syncthreads(); if (C.tid == 0) { const int ty = (u < 8) ? 0 : (u < 24 ? 1 : (u < 536 ? 2 : (u < 664 ? 3 : (u < 1176 ? 4 : 5))));
                        volatile float* tsb = (volatile float*)(ws_ + WS_TAB + 196608) + blockIdx.x * 8; tsb[ty] += (float)(__builtin_amdgcn_s_memrealtime() - pt0_); } }
                }
            } else if (sub == 3) {
                if (PHON(9)) for (int u = blockIdx.x; u < 256; u += C.G) hgrn_final_unit(C, layer, u);
                __syncthreads();
                if (PHON(10)) delta_combine(C, layer);
                __syncthreads();
            } else if (sub == 4) {
                pg8::Gemm g{ob, (const bf16_t*)(wb + W_OUT), MROWS, DM, DM}; pg8::StaticOrder S; S.init(MROWS, DM, C.G, (int)blockIdx.x);
                EpiRes E{out_, modl + 2048, xm};
                if (PHON(11)) pg8::gemm_phase(C.lds, g, S, E, C.tid);
            } else if (sub == 5) {
                if (PHON(12)) row_pass(C, 1, p.in[20] + (size_t)(layer * 2) * DM, p.in[21] + (size_t)(layer * 2) * DM, modl, 4096, 3072, true);
            } else if (sub == 6) {
                pg8::Gemm g{xm, (const bf16_t*)(wb + W_FFI), MROWS, 2 * DFF, DM}; pg8::StaticOrder S; S.init(MROWS, 2 * DFF, C.G, (int)blockIdx.x);
                EpiFfn E{act};
                if (PHON(13)) pg8::gemm_phase(C.lds, g, S, E, C.tid);
            } else if (sub == 7) {
                pg8::Gemm g{act, (const bf16_t*)(wb + W_FFO), MROWS, DM, DFF}; pg8::StaticOrder S; S.init(MROWS, DM, C.G, (int)blockIdx.x);
                EpiRes E{out_, modl + 5120, xm};
                if (PHON(14)) pg8::gemm_phase(C.lds, g, S, E, C.tid);
            } else {
                const bool last = layer + 1 == DEPTH;
                if (PHON(12)) row_pass(C, 1, p.in[20] + (size_t)(layer * 2 + 1) * DM, p.in[21] + (size_t)(layer * 2 + 1) * DM, modbuf + (size_t)(last ? layer : layer + 1) * 3 * 6144, 1024, 0, !last);
            }
        }
        if (ph + 1 < p.ph_hi) { if (p.ph_hi > 100000) { __threadfence(); cg::this_grid().sync(); } else xcd_barrier(xbar); }
    }
}

#if !MK_ONE_LAUNCH
static unsigned phase_mask(int ph) {
    if (ph == 0) return 1u << 0; if (ph == 1) return 1u << 1;
    const int sub = (ph - 2) % 9;
    switch (sub) { case 0: return 1u << 2; case 1: return (1u << 3) | (1u << 4) | (1u << 5); case 2: return (1u << 6) | (1u << 7) | (1u << 8); case 3: return (1u << 9) | (1u << 10);
        case 4: return 1u << 11; case 5: return 1u << 12; case 6: return 1u << 13; case 7: return 1u << 14; default: return 1u << 12; }
}
typedef void (*kern_t)(Params);
static kern_t kernel_for_mask(unsigned m) {
    switch (m) {
        case 1u << 0: return fwd_megakernel<1u << 0>; case 1u << 1: return fwd_megakernel<1u << 1>; case 1u << 2: return fwd_megakernel<1u << 2>;
        case (1u << 3) | (1u << 4) | (1u << 5): return fwd_megakernel<(1u << 3) | (1u << 4) | (1u << 5)>;
        case (1u << 6) | (1u << 7) | (1u << 8): return fwd_megakernel<(1u << 6) | (1u << 7) | (1u << 8)>;
        case (1u << 9) | (1u << 10): return fwd_megakernel<(1u << 9) | (1u << 10)>;
        case 1u << 11: return fwd_megakernel<1u << 11>; case 1u << 12: return fwd_megakernel<1u << 12>; case 1u << 13: return fwd_megakernel<1u << 13>; default: return fwd_megakernel<1u << 14>;
    }
}
#endif
extern "C" void kernel_launch(void* const* d_in, const int* in_sizes, int n_in, void* d_out, int out_size, void* d_ws, size_t ws_size, hipStream_t stream) {
    static int grid = 0;
    if (grid == 0) {
        if (n_in != 24 || out_size != 58720256 || ws_size < WS_END) { fprintf(stderr, "kernel_launch: unexpected shapes (n_in %d out %d ws %zu)\n", n_in, out_size, ws_size); grid = -1; return; }
        int dev = 0, cus = 0;
        (void)hipGetDevice(&dev); (void)hipDeviceGetAttribute(&cus, hipDeviceAttributeMultiprocessorCount, dev);
#if MK_ONE_LAUNCH
        if (hipFuncSetAttribute((const void*)fwd_megakernel<0x7FFFu>, hipFuncAttributeMaxDynamicSharedMemorySize, LDS_BYTES) != hipSuccess) { fprintf(stderr, "kernel_launch: hipFuncSetAttribute failed\n"); grid = -1; return; }
#else
        for (int ph = 0; ph < 11; ++ph) (void)hipFuncSetAttribute((const void*)kernel_for_mask(phase_mask(ph)), hipFuncAttributeMaxDynamicSharedMemorySize, LDS_BYTES);
#endif
        (void)hipGetLastError();
        grid = cus > 0 ? cus : 256;
        if (grid != 256) { fprintf(stderr, "kernel_launch: expected 256 CUs, got %d\n", grid); grid = 256; }
    }
    if (grid < 0) return;
    (void)hipMemsetAsync((char*)d_ws + WS_CTL, 0, 65536, stream);
    Params p{};
    for (int i = 0; i < 24; ++i) p.in[i] = (const float*)d_in[i];
    p.out = (float*)d_out; p.ws = (unsigned char*)d_ws;
#if MK_ONE_LAUNCH
    p.ph_lo = 0; p.ph_hi = NPHASE;
    void* args[] = {&p};
    hipError_t e = hipLaunchCooperativeKernel((const void*)fwd_megakernel<0x7FFFu>, dim3(grid), dim3(512), args, LDS_BYTES, stream);
    if (e != hipSuccess) fprintf(stderr, "cooperative launch failed: %s (grid %d)\n", hipGetErrorString(e), grid);
#else
    for (int ph = 0; ph < NPHASE; ++ph) { p.ph_lo = ph; p.ph_hi = ph + 1; hipLaunchKernelGGL(kernel_for_mask(phase_mask(ph)), dim3(grid), dim3(512), LDS_BYTES, stream, p); }
#endif
}
```
